# Optimizing an MI355X kernel written in HIP

```python
import math
import jax, jax.numpy as jnp
from jax import lax
import numpy as np

D_MODEL = 1024
BATCH = 2
SEQ = 8192
DEPTH = 4

N_HEADS = 16
HEAD_DIM = D_MODEL // N_HEADS
ATTN_SCALE = HEAD_DIM ** -0.5
ROPE_THETA = 10000.0
N_MIXERS = 3
PLE_DIM = 256
MAX_POS_OFFSET = 1024

FOX_Q_BLOCK = 128
FGATE_BIAS_LO = 1.0
FGATE_BIAS_HI = 6.0

NSA_Q_BLOCK = 64
NSA_KV_GROUPS = 4
NSA_HEADS_PER_GROUP = N_HEADS // NSA_KV_GROUPS
NSA_CMP_LEN = 32
NSA_CMP_STRIDE = 16
NSA_CMP_HIDDEN = 2 * HEAD_DIM
NSA_SEL_LEN = 64
NSA_SEL_TOPN = 16
NSA_WINDOW = 512
NSA_FORCE_BONUS = 1e4

MOBA_Q_BLOCK = 32
MOBA_BLOCK = 256
MOBA_TOPK = 3

N_EXPERTS = 64
EXPERT_DIM = 256
TOP_K = 8
N_GROUPS = 8
TOPK_GROUPS = 4
ROUTED_SCALE = 2.5
SHARED_DIM = 256
MOE_BLOCK = 256

DN_ALPHA = (2 * DEPTH) ** 0.25
DN_BETA = (8 * DEPTH) ** -0.25
LN_EPS = 1e-5
NEG = -1e30

N_FOX = (DEPTH + 2) // 3
N_NSA = (DEPTH + 1) // 3
N_MOBA = DEPTH // 3

kernel_name = "hybrid_fox_nsa_moba_moe_deepnorm"


def layer_norm(x, g, b):
    xf = x.astype(jnp.float32)
    mu = jnp.mean(xf, -1, keepdims=True)
    var = jnp.mean(jnp.square(xf - mu), -1, keepdims=True)
    return ((xf - mu) * lax.rsqrt(var + LN_EPS) * g + b).astype(x.dtype)


def rope_tables(positions):
    inv = 1.0 / (ROPE_THETA ** (jnp.arange(0, HEAD_DIM, 2, dtype=jnp.float32) / HEAD_DIM))
    ang = positions.astype(jnp.float32)[..., None] * inv
    return jnp.cos(ang), jnp.sin(ang)


def apply_rope(x, cos, sin):
    x1, x2 = jnp.split(x.astype(jnp.float32), 2, axis=-1)
    c = cos[:, :, None, :]
    s = sin[:, :, None, :]
    return jnp.concatenate([x1 * c - x2 * s, x2 * c + x1 * s], axis=-1).astype(x.dtype)


def masked_softmax(s, mask):
    s = jnp.where(mask, s.astype(jnp.float32), NEG)
    m = jnp.max(s, -1, keepdims=True)
    e = jnp.where(mask, jnp.exp(s - m), 0.0)
    return e / jnp.maximum(jnp.sum(e, -1, keepdims=True), 1e-30)


def merge_blocks(o):
    nb, B, H, Q, HD = o.shape
    return o.transpose(1, 0, 3, 2, 4).reshape(B, nb * Q, H * HD)


def fox_attention(x, w_in, b_f, w_out):
    B, S, D = x.shape
    H, HD = N_HEADS, HEAD_DIM
    q, k, v, fl = jnp.split(x @ w_in, [D, 2 * D, 3 * D], axis=-1)
    q = q.reshape(B, S, H, HD).transpose(0, 2, 1, 3)
    k = k.reshape(B, S, H, HD).transpose(0, 2, 1, 3)
    v = v.reshape(B, S, H, HD).transpose(0, 2, 1, 3)
    log_f = jax.nn.log_sigmoid((fl + b_f).astype(jnp.float32))
    c = jnp.cumsum(log_f, axis=1).transpose(0, 2, 1)
    k_pos = jnp.arange(S)

    def block(i):
        q0 = i * FOX_Q_BLOCK
        qb = lax.dynamic_slice_in_dim(q, q0, FOX_Q_BLOCK, axis=2)
        cq = lax.dynamic_slice_in_dim(c, q0, FOX_Q_BLOCK, axis=2)
        s = (jnp.einsum('bhqd,bhkd->bhqk', qb, k).astype(jnp.float32) * ATTN_SCALE
             + cq[..., :, None] - c[..., None, :])
        mask = (q0 + jnp.arange(FOX_Q_BLOCK))[:, None] >= k_pos[None, :]
        pr = masked_softmax(s, mask)
        return jnp.einsum('bhqk,bhkd->bhqd', pr.astype(v.dtype), v)

    o = lax.map(block, jnp.arange(S // FOX_Q_BLOCK))
    return merge_blocks(o) @ w_out


def nsa_compress(t, pe, w1, w2):
    B, S, G, HD = t.shape
    n_chunks = S // NSA_CMP_STRIDE
    r = NSA_CMP_LEN // NSA_CMP_STRIDE
    n_cmp = n_chunks - r + 1
    ch = t.reshape(B, n_chunks, NSA_CMP_STRIDE, G, HD)
    blocks = jnp.concatenate([ch[:, j:j + n_cmp] for j in range(r)], axis=2)
    blocks = blocks + pe[None, None, :, None, :]
    flat = blocks.transpose(0, 1, 3, 2, 4).reshape(B, n_cmp, G, NSA_CMP_LEN * HD)
    h = jax.nn.gelu(flat @ w1)
    return (h @ w2).transpose(0, 2, 1, 3)


def nsa_attention(x, cos, sin, w_in, b_gate, pe_k, pe_v, ck_w1, ck_w2, cv_w1, cv_w2, w_out):
    B, S, D = x.shape
    G, HG, HD, H = NSA_KV_GROUPS, NSA_HEADS_PER_GROUP, HEAD_DIM, N_HEADS
    QB = NSA_Q_BLOCK
    kvw = G * HD
    splits = [int(v) for v in np.cumsum([D] + [kvw] * 6)]
    q, kc, vc, ks, vs, kw, vw, gl = jnp.split(x @ w_in, splits, axis=-1)

    def to_bghsd(t):
        return t.reshape(B, S, G, HG, HD).transpose(0, 2, 3, 1, 4)

    def to_bsgd(t):
        return t.reshape(B, S, G, HD)

    q_c = to_bghsd(q)
    q_r = to_bghsd(apply_rope(q.reshape(B, S, H, HD), cos, sin))
    k_sel = apply_rope(to_bsgd(ks), cos, sin).transpose(0, 2, 1, 3)
    v_sel = to_bsgd(vs).transpose(0, 2, 1, 3)
    k_win = apply_rope(to_bsgd(kw), cos, sin).transpose(0, 2, 1, 3)
    v_win = to_bsgd(vw).transpose(0, 2, 1, 3)
    gates = jax.nn.sigmoid((gl + b_gate).astype(jnp.float32))
    gates = gates.reshape(B, S, G, HG, 3).transpose(0, 2, 3, 1, 4)

    k_cmp = nsa_compress(to_bsgd(kc), pe_k, ck_w1, ck_w2)
    v_cmp = nsa_compress(to_bsgd(vc), pe_v, cv_w1, cv_w2)
    n_cmp = k_cmp.shape[2]
    cmp_start = jnp.arange(n_cmp) * NSA_CMP_STRIDE
    cmp_end = cmp_start + NSA_CMP_LEN - 1

    n_sel = S // NSA_SEL_LEN
    n_top = min(NSA_SEL_TOPN, n_sel)
    sel_start = jnp.arange(n_sel) * NSA_SEL_LEN
    overlap = ((cmp_start[:, None] < sel_start[None, :] + NSA_SEL_LEN)
               & (cmp_start[:, None] + NSA_CMP_LEN > sel_start[None, :])).astype(jnp.float32)
    ks_blk = k_sel.reshape(B, G, n_sel, NSA_SEL_LEN, HD)
    vs_blk = v_sel.reshape(B, G, n_sel, NSA_SEL_LEN, HD)
    pad = ((0, 0), (0, 0), (NSA_WINDOW, 0), (0, 0))
    kw_pad = jnp.pad(k_win, pad)
    vw_pad = jnp.pad(v_win, pad)
    bi = jnp.arange(B)[:, None, None, None]
    gi = jnp.arange(G)[None, :, None, None]
    jsel = jnp.arange(n_sel)

    def block(i):
        q0 = i * QB
        tq = q0 + jnp.arange(QB)
        qc = lax.dynamic_slice_in_dim(q_c, q0, QB, axis=3)
        qr = lax.dynamic_slice_in_dim(q_r, q0, QB, axis=3)
        gb = lax.dynamic_slice_in_dim(gates, q0, QB, axis=3)
        s_c = jnp.einsum('bghqd,bgnd->bghqn', qc, k_cmp) * ATTN_SCALE
        p_c = masked_softmax(s_c, cmp_end[None, :] <= tq[:, None])
        o_c = jnp.einsum('bghqn,bgnd->bghqd', p_c.astype(v_cmp.dtype), v_cmp)
        imp = jnp.einsum('bghqn,nj->bgqj', p_c, overlap)
        cur = tq // NSA_SEL_LEN
        forced = ((jsel[None, :] == 0) | (jsel[None, :] == cur[:, None])
                  | (jsel[None, :] == cur[:, None] - 1))
        pri = jnp.where(forced, imp + NSA_FORCE_BONUS, imp)
        pri = jnp.where(jsel[None, :] <= cur[:, None], pri, NEG)
        _, idx = lax.top_k(pri, n_top)
        kg = ks_blk[bi, gi, idx].reshape(B, G, QB, n_top * NSA_SEL_LEN, HD)
        vg = vs_blk[bi, gi, idx].reshape(B, G, QB, n_top * NSA_SEL_LEN, HD)
        kpos = (idx[..., None] * NSA_SEL_LEN + jnp.arange(NSA_SEL_LEN)).reshape(B, G, QB, -1)
        m_s = (kpos <= tq[:, None])[:, :, None]
        s_s = jnp.einsum('bghqd,bgqkd->bghqk', qr, kg) * ATTN_SCALE
        p_s = masked_softmax(s_s, m_s)
        o_s = jnp.einsum('bghqk,bgqkd->bghqd', p_s.astype(vg.dtype), vg)
        kwb = lax.dynamic_slice_in_dim(kw_pad, q0, NSA_WINDOW + QB, axis=2)
        vwb = lax.dynamic_slice_in_dim(vw_pad, q0, NSA_WINDOW + QB, axis=2)
        kpw = q0 - NSA_WINDOW + jnp.arange(NSA_WINDOW + QB)
        dlt = tq[:, None] - kpw[None, :]
        m_w = (dlt >= 0) & (dlt < NSA_WINDOW) & (kpw[None, :] >= 0)
        s_w = jnp.einsum('bghqd,bgkd->bghqk', qr, kwb) * ATTN_SCALE
        p_w = masked_softmax(s_w, m_w)
        o_w = jnp.einsum('bghqk,bgkd->bghqd', p_w.astype(vwb.dtype), vwb)
        o = gb[..., 0:1] * o_c + gb[..., 1:2] * o_s + gb[..., 2:3] * o_w
        return o.astype(x.dtype)

    o = lax.map(block, jnp.arange(S // QB))
    o = o.transpose(1, 0, 4, 2, 3, 5).reshape(B, S, D)
    return o @ w_out


def moba_attention(x, cos, sin, w_in, w_out):
    B, S, D = x.shape
    H, HD, BLK, QB = N_HEADS, HEAD_DIM, MOBA_BLOCK, MOBA_Q_BLOCK
    q, k, v = jnp.split(x @ w_in, 3, axis=-1)
    q = apply_rope(q.reshape(B, S, H, HD), cos, sin).transpose(0, 2, 1, 3)
    k = apply_rope(k.reshape(B, S, H, HD), cos, sin).transpose(0, 2, 1, 3)
    v = v.reshape(B, S, H, HD).transpose(0, 2, 1, 3)
    nb = -(-S // BLK)
    s_pad = nb * BLK
    pad = ((0, 0), (0, 0), (0, s_pad - S), (0, 0))
    k_pad = jnp.pad(k, pad)
    v_pad = jnp.pad(v, pad)
    kb = k_pad.reshape(B, H, nb, BLK, HD)
    vb = v_pad.reshape(B, H, nb, BLK, HD)
    k_mean = jnp.mean(kb.astype(jnp.float32), axis=3).astype(k.dtype)
    n_top = min(MOBA_TOPK, nb)
    bi = jnp.arange(B)[:, None, None, None]
    hi = jnp.arange(H)[None, :, None, None]
    jblk = jnp.arange(nb)

    def block(i):
        q0 = i * QB
        tq = q0 + jnp.arange(QB)
        cb = q0 // BLK
        qb = lax.dynamic_slice_in_dim(q, q0, QB, axis=2)
        gs = jnp.einsum('bhqd,bhnd->bhqn', qb, k_mean).astype(jnp.float32)
        gs = jnp.where(jblk < cb, gs, NEG)
        _, idx = lax.top_k(gs, n_top)
        m_sel = jnp.repeat(idx < cb, BLK, axis=-1)
        kg = kb[bi, hi, idx].reshape(B, H, QB, n_top * BLK, HD)
        vg = vb[bi, hi, idx].reshape(B, H, QB, n_top * BLK, HD)
        ko = lax.dynamic_slice_in_dim(k_pad, cb * BLK, BLK, axis=2)
        vo = lax.dynamic_slice_in_dim(v_pad, cb * BLK, BLK, axis=2)
        m_own = jnp.broadcast_to((cb * BLK + jnp.arange(BLK))[None, :] <= tq[:, None], (B, H, QB, BLK))
        s = jnp.concatenate([jnp.einsum('bhqd,bhqkd->bhqk', qb, kg),
                             jnp.einsum('bhqd,bhkd->bhqk', qb, ko)], axis=-1) * ATTN_SCALE
        pr = masked_softmax(s, jnp.concatenate([m_sel, m_own], axis=-1)).astype(v.dtype)
        n_s = n_top * BLK
        return (jnp.einsum('bhqk,bhqkd->bhqd', pr[..., :n_s], vg)
                + jnp.einsum('bhqk,bhkd->bhqd', pr[..., n_s:], vo))

    o = lax.map(block, jnp.arange(S // QB))
    return merge_blocks(o) @ w_out


def moe_ffn(x, router_w, router_b, w_gate, w_up, w_down, s_gate, s_up, s_down):
    B, S, D = x.shape
    T = B * S
    xt = x.reshape(T, D)
    scores = jax.nn.sigmoid((xt @ router_w).astype(jnp.float32))
    biased = scores + router_b
    grp = biased.reshape(T, N_GROUPS, N_EXPERTS // N_GROUPS)
    grp_score = jnp.sum(lax.top_k(grp, 2)[0], axis=-1)
    _, gidx = lax.top_k(grp_score, TOPK_GROUPS)
    gmask = jnp.any(gidx[..., None] == jnp.arange(N_GROUPS), axis=-2)
    emask = jnp.repeat(gmask, N_EXPERTS // N_GROUPS, axis=-1)
    _, eidx = lax.top_k(jnp.where(emask, biased, NEG), TOP_K)
    gw = jnp.take_along_axis(scores, eidx, axis=-1)
    gw = gw / jnp.sum(gw, -1, keepdims=True) * ROUTED_SCALE

    R = T * TOP_K
    e_flat = eidx.reshape(R)
    tok_flat = jnp.repeat(jnp.arange(T, dtype=jnp.int32), TOP_K)
    order = jnp.argsort(e_flat)
    e_sorted = e_flat[order]
    counts = jnp.bincount(e_flat, length=N_EXPERTS)
    starts = jnp.cumsum(counts) - counts
    padded = (counts + MOE_BLOCK - 1) // MOE_BLOCK * MOE_BLOCK
    pends = jnp.cumsum(padded)
    pstarts = pends - padded
    dest = pstarts[e_sorted] + (jnp.arange(R) - starts[e_sorted])
    P = -(-(R + N_EXPERTS * (MOE_BLOCK - 1)) // MOE_BLOCK) * MOE_BLOCK
    NB = P // MOE_BLOCK
    buf_tok = jnp.full((P,), T, jnp.int32).at[dest].set(tok_flat[order])
    buf_w = jnp.zeros((P,), jnp.float32).at[dest].set(gw.reshape(R)[order])
    blk_e = jnp.minimum(jnp.searchsorted(pends, jnp.arange(NB) * MOE_BLOCK, side='right'),
                        N_EXPERTS - 1)
    x_pad = jnp.concatenate([xt, jnp.zeros((1, D), xt.dtype)], axis=0)

    def expert_block(args):
        e, toks, wts = args
        xb = x_pad[toks]
        h = jax.nn.silu(xb @ w_gate[e]) * (xb @ w_up[e])
        return (h @ w_down[e]) * wts[:, None].astype(xb.dtype)

    yb = lax.map(expert_block, (blk_e, buf_tok.reshape(NB, MOE_BLOCK), buf_w.reshape(NB, MOE_BLOCK)))
    routed = jax.ops.segment_sum(yb.reshape(P, D), buf_tok, num_segments=T + 1)[:T]
    shared = (jax.nn.silu(xt @ s_gate) * (xt @ s_up)) @ s_down
    return (routed + shared).reshape(B, S, D).astype(x.dtype)


def _normal(key, shape, fan_in, gain=1.0):
    return jax.random.normal(key, shape, jnp.float32) * (gain * fan_in ** -0.5)


def setup_inputs(seed: int = 0) -> dict:
    key = jax.random.key(seed)
    k = jax.random.split(key, 48)
    D, H, HD = D_MODEL, N_HEADS, HEAD_DIM
    kvw = NSA_KV_GROUPS * HEAD_DIM
    L = NSA_CMP_LEN
    x = jax.random.normal(k[0], (BATCH, SEQ, D), jnp.float32)
    p = jax.random.normal(k[1], (DEPTH, BATCH, SEQ, PLE_DIM), jnp.float32)
    positions = (jax.random.randint(k[2], (BATCH, 1), 0, MAX_POS_OFFSET)
                 + jnp.arange(SEQ, dtype=jnp.int32)[None, :]).astype(jnp.int32)
    fox_w_in = jnp.concatenate([
        _normal(k[3], (N_FOX, D, 2 * D), D),
        _normal(k[4], (N_FOX, D, D), D, DN_BETA),
        _normal(k[5], (N_FOX, D, H), D)], axis=-1)
    fox_b_f = (jnp.linspace(FGATE_BIAS_LO, FGATE_BIAS_HI, H, dtype=jnp.float32)[None, :]
               + 0.1 * jax.random.normal(k[6], (N_FOX, H), jnp.float32))
    fox_w_out = _normal(k[7], (N_FOX, D, D), D, DN_BETA)
    nsa_w_in = jnp.concatenate([
        _normal(k[8], (N_NSA, D, D), D),
        _normal(k[9], (N_NSA, D, kvw), D),
        _normal(k[10], (N_NSA, D, kvw), D, DN_BETA),
        _normal(k[11], (N_NSA, D, kvw), D),
        _normal(k[12], (N_NSA, D, kvw), D, DN_BETA),
        _normal(k[13], (N_NSA, D, kvw), D),
        _normal(k[14], (N_NSA, D, kvw), D, DN_BETA),
        _normal(k[15], (N_NSA, D, 3 * H), D)], axis=-1)
    nsa_b_gate = 0.1 * jax.random.normal(k[16], (N_NSA, 3 * H), jnp.float32)
    nsa_pe_k = 0.02 * jax.random.normal(k[17], (N_NSA, L, HD), jnp.float32)
    nsa_pe_v = 0.02 * jax.random.normal(k[18], (N_NSA, L, HD), jnp.float32)
    nsa_cmp_k_w1 = _normal(k[19], (N_NSA, L * HD, NSA_CMP_HIDDEN), L * HD)
    nsa_cmp_k_w2 = _normal(k[20], (N_NSA, NSA_CMP_HIDDEN, HD), NSA_CMP_HIDDEN)
    nsa_cmp_v_w1 = _normal(k[21], (N_NSA, L * HD, NSA_CMP_HIDDEN), L * HD)
    nsa_cmp_v_w2 = _normal(k[22], (N_NSA, NSA_CMP_HIDDEN, HD), NSA_CMP_HIDDEN)
    nsa_w_out = _normal(k[23], (N_NSA, D, D), D, DN_BETA)
    moba_w_in = jnp.concatenate([
        _normal(k[24], (N_MOBA, D, 2 * D), D),
        _normal(k[25], (N_MOBA, D, D), D, DN_BETA)], axis=-1)
    moba_w_out = _normal(k[26], (N_MOBA, D, D), D, DN_BETA)
    ln1_g = 1.0 + 0.02 * jax.random.normal(k[27], (DEPTH, D), jnp.float32)
    ln1_b = 0.02 * jax.random.normal(k[28], (DEPTH, D), jnp.float32)
    router_w = _normal(k[29], (DEPTH, D, N_EXPERTS), D)
    router_b = 0.01 * jax.random.normal(k[30], (DEPTH, N_EXPERTS), jnp.float32)
    exp_w_gate = _normal(k[31], (DEPTH, N_EXPERTS, D, EXPERT_DIM), D)
    exp_w_up = _normal(k[32], (DEPTH, N_EXPERTS, D, EXPERT_DIM), D)
    exp_w_down = _normal(k[33], (DEPTH, N_EXPERTS, EXPERT_DIM, D), EXPERT_DIM, DN_BETA)
    sh_w_gate = _normal(k[34], (DEPTH, D, SHARED_DIM), D)
    sh_w_up = _normal(k[35], (DEPTH, D, SHARED_DIM), D)
    sh_w_down = _normal(k[36], (DEPTH, SHARED_DIM, D), SHARED_DIM, DN_BETA)
    ln2_g = 1.0 + 0.02 * jax.random.normal(k[37], (DEPTH, D), jnp.float32)
    ln2_b = 0.02 * jax.random.normal(k[38], (DEPTH, D), jnp.float32)
    ple_w_gate = _normal(k[39], (DEPTH, D, D), D)
    ple_w_proj = _normal(k[40], (DEPTH, PLE_DIM, D), PLE_DIM)
    return {"x": x, "p": p, "positions": positions,
            "fox_w_in": fox_w_in, "fox_b_f": fox_b_f, "fox_w_out": fox_w_out,
            "nsa_w_in": nsa_w_in, "nsa_b_gate": nsa_b_gate, "nsa_pe_k": nsa_pe_k, "nsa_pe_v": nsa_pe_v,
            "nsa_cmp_k_w1": nsa_cmp_k_w1, "nsa_cmp_k_w2": nsa_cmp_k_w2,
            "nsa_cmp_v_w1": nsa_cmp_v_w1, "nsa_cmp_v_w2": nsa_cmp_v_w2, "nsa_w_out": nsa_w_out,
            "moba_w_in": moba_w_in, "moba_w_out": moba_w_out,
            "ln1_g": ln1_g, "ln1_b": ln1_b, "router_w": router_w, "router_b": router_b,
            "exp_w_gate": exp_w_gate, "exp_w_up": exp_w_up, "exp_w_down": exp_w_down,
            "sh_w_gate": sh_w_gate, "sh_w_up": sh_w_up, "sh_w_down": sh_w_down,
            "ln2_g": ln2_g, "ln2_b": ln2_b, "ple_w_gate": ple_w_gate, "ple_w_proj": ple_w_proj}


def reference(x, p, positions, fox_w_in, fox_b_f, fox_w_out, nsa_w_in, nsa_b_gate, nsa_pe_k, nsa_pe_v,
              nsa_cmp_k_w1, nsa_cmp_k_w2, nsa_cmp_v_w1, nsa_cmp_v_w2, nsa_w_out, moba_w_in, moba_w_out,
              ln1_g, ln1_b, router_w, router_b, exp_w_gate, exp_w_up, exp_w_down,
              sh_w_gate, sh_w_up, sh_w_down, ln2_g, ln2_b, ple_w_gate, ple_w_proj):
    cos, sin = rope_tables(positions)
    for i in range(DEPTH):
        kind, j = i % N_MIXERS, i // N_MIXERS
        if kind == 0:
            mix = fox_attention(x, fox_w_in[j], fox_b_f[j], fox_w_out[j])
        elif kind == 1:
            mix = nsa_attention(x, cos, sin, nsa_w_in[j], nsa_b_gate[j], nsa_pe_k[j], nsa_pe_v[j],
                                nsa_cmp_k_w1[j], nsa_cmp_k_w2[j], nsa_cmp_v_w1[j], nsa_cmp_v_w2[j],
                                nsa_w_out[j])
        else:
            mix = moba_attention(x, cos, sin, moba_w_in[j], moba_w_out[j])
        x = layer_norm(DN_ALPHA * x + mix, ln1_g[i], ln1_b[i])
        ffn = moe_ffn(x, router_w[i], router_b[i], exp_w_gate[i], exp_w_up[i], exp_w_down[i],
                      sh_w_gate[i], sh_w_up[i], sh_w_down[i])
        x = layer_norm(DN_ALPHA * x + ffn, ln2_g[i], ln2_b[i])
        x = x + jax.nn.sigmoid(x @ ple_w_gate[i]) * (p[i] @ ple_w_proj[i])
    return x
```

```cpp
#define MK_MULTI 1
#include <hip/hip_runtime.h>
#include <cstdio>
#include <cstdint>
namespace pg8 {
#define PG8_LAS __attribute__((address_space(3)))
typedef unsigned short bf16_t;
typedef short bf16x8 __attribute__((ext_vector_type(8)));
typedef float f32x4 __attribute__((ext_vector_type(4)));
typedef unsigned u32x4 __attribute__((ext_vector_type(4)));
constexpr int BM = 256, BK = 64, HALF = 128, HTB = HALF * BK * 2  , STAGE_BYTES = 8 * HTB, NXCD = 8, WGM = 8;

__host__ __device__ __forceinline__ int lds_byte(int r, int c) { const int st = (r >> 4) * 2 + (c >> 5), rr = r & 15, cc = c & 31, ob = rr * 64 + cc * 2; return st * 1024 + (ob ^ (((ob >> 9) & 1) << 5)); }
__host__ __device__ __forceinline__ void stage_rc(int b, int& R, int& C) { const int st = b / 1024, sb = b % 1024, swz = sb ^ (((sb >> 9) & 1) << 5); R = (st >> 1) * 16 + swz / 64; C = (st & 1) * 32 + (swz % 64) / 2; }
__host__ __device__ __forceinline__ int perm32(int rho) { const int n = rho >> 4, i = rho & 15; return 8 * (i >> 2) + 4 * n + (i & 3); }

struct Unit { int pm, pn; };
struct Gemm { const bf16_t* A; const bf16_t* Bt; int M, N, K; };

struct StaticOrder {
    int nM, nN, nwg, G, c;
    __host__ __device__ void init(int M, int N, int G_, int c_) { nM = M / BM; nN = N / BM; nwg = nM * nN; G = G_; c = c_; }
    __host__ __device__ bool next(int i, Unit& u) const {
        const long L = (long)i * G + c; if (L >= nwg) return false;
        int wgid = (int)L; { const int q = nwg / NXCD, r = nwg % NXCD, xcd = wgid % NXCD, off = wgid / NXCD; wgid = (xcd < r ? xcd * (q + 1) : r * (q + 1) + (xcd - r) * q) + off; }
        const int nig = WGM * nN, gid = wgid / nig, fm = gid * WGM, gsz = (nM - fm) < WGM ? (nM - fm) : WGM;
        u.pm = fm + ((wgid % nig) % gsz); u.pn = (wgid % nig) / gsz; return true;
    }
    __device__ __forceinline__ void a_ready(const Unit&) const {}
    __device__ __forceinline__ void done(const Unit&) const {}
};

__device__ __forceinline__ unsigned cvt_pk_bf16(float lo, float hi) { unsigned r; asm volatile("v_cvt_pk_bf16_f32 %0, %1, %2" : "=v"(r) : "v"(lo), "v"(hi)); return r; }
typedef float f32x2 __attribute__((ext_vector_type(2)));
__device__ __forceinline__ f32x2 gelu_pk(f32x2 v) {
    const f32x2 av = __builtin_elementwise_abs(v), d = av * 0.2316418882f + 1.0f;
    f32x2 t; t.x = __builtin_amdgcn_rcpf(d.x); t.y = __builtin_amdgcn_rcpf(d.y);
    f32x2 q = t * 0.5307027145f + (-0.7265760135f); q = q * t + 0.7107068705f; q = q * t + (-0.142248368f); q = q * t + 0.127414796f; q = q * t;
    const f32x2 s = (v * v) * (-0.72134752044f);
    f32x2 e; e.x = __builtin_amdgcn_exp2f(s.x); e.y = __builtin_amdgcn_exp2f(s.y);
    const f32x2 m = v * (q * e), r = v - m;
    f32x2 o; o.x = v.x < 0.f ? m.x : r.x; o.y = v.y < 0.f ? m.y : r.y; return o;
}

template <int ACT  > struct EpiBf16 {
    static constexpr bool PERM = true, AFTER_DRAIN = false; static_assert(ACT == 0 || ACT == 1, "EpiBf16: ACT is 0 (none) or 1 (gelu_pk)");
    bf16_t* O; int ldc; const float* bias; int split_cols; size_t split_stride; float scale0;
    __device__ __forceinline__ void operator()(const f32x4 (&acc)[2][2][4][2], const Unit& u, int wr, int wc, int fr, int fq) const {
        const int row0 = u.pm * BM + wr * 64 + fr; int colt = u.pn * BM; bf16_t* base = O;
        float sc = 1.f; if (split_cols) { const int t = colt / split_cols; base += (size_t)t * split_stride; colt -= t * split_cols; if (t == 0) sc = scale0; }
        const int col0 = colt + wc * 32 + 8 * fq, bcol0 = u.pn * BM + wc * 32 + 8 * fq;
        f32x4 bv[2][2];
#pragma unroll
        for (int bj = 0; bj < 2; ++bj)
#pragma unroll
            for (int n = 0; n < 2; ++n) bv[bj][n] = bias ? *(const f32x4*)(bias + bcol0 + bj * HALF + 4 * n) : (f32x4){0.f, 0.f, 0.f, 0.f};
#pragma unroll
        for (int ai = 0; ai < 2; ++ai)
#pragma unroll
            for (int m = 0; m < 4; ++m) { bf16_t* rowp = base + (size_t)(row0 + ai * HALF + m * 16) * ldc + col0;
#pragma unroll
                for (int bj = 0; bj < 2; ++bj) { f32x4 v0 = acc[ai][bj][m][0] + bv[bj][0], v1 = acc[ai][bj][m][1] + bv[bj][1];
                    if (ACT == 1) { f32x2 a = gelu_pk((f32x2){v0[0], v0[1]}), b = gelu_pk((f32x2){v0[2], v0[3]}), c = gelu_pk((f32x2){v1[0], v1[1]}), d = gelu_pk((f32x2){v1[2], v1[3]});
                        v0 = (f32x4){a.x, a.y, b.x, b.y}; v1 = (f32x4){c.x, c.y, d.x, d.y}; }
                    v0 = v0 * sc; v1 = v1 * sc; u32x4 w; w.x = cvt_pk_bf16(v0[0], v0[1]); w.y = cvt_pk_bf16(v0[2], v0[3]); w.z = cvt_pk_bf16(v1[0], v1[1]); w.w = cvt_pk_bf16(v1[2], v1[3]);
                    *(u32x4*)(rowp + bj * HALF) = w; } }
    }
};

struct PanelStats {
    unsigned* xbuf;
    unsigned* cnt;
    unsigned* tmo;
    int ntn; float eps;
    unsigned code;
    __device__ __forceinline__ bool run(const f32x4 (&v)[2][2][4][2], const Unit& u, int wr, int wc, int fr, int fq, PG8_LAS unsigned char* lds, int wid, int lane) const {
        typedef float f32x2v __attribute__((ext_vector_type(2)));
        PG8_LAS f32x2v* P = (PG8_LAS f32x2v*)lds;
        PG8_LAS f32x2v* S = (PG8_LAS f32x2v*)(lds + 8192);
        PG8_LAS unsigned* flag = (PG8_LAS unsigned*)(lds + 8192 + 2048);
#pragma unroll
        for (int ai = 0; ai < 2; ++ai)
#pragma unroll
            for (int m = 0; m < 4; ++m) {
                float s = 0.f;
#pragma unroll
                for (int bj = 0; bj < 2; ++bj)
#pragma unroll
                    for (int n = 0; n < 2; ++n) { const f32x4 x = v[ai][bj][m][n]; s += (x[0] + x[1]) + (x[2] + x[3]); }
                s += __shfl_xor(s, 16); s += __shfl_xor(s, 32);
                const float mw = s * (1.0f / 64.0f); float q = 0.f;
#pragma unroll
                for (int bj = 0; bj < 2; ++bj)
#pragma unroll
                    for (int n = 0; n < 2; ++n) { const f32x4 d = v[ai][bj][m][n] - mw; q += (d[0] * d[0] + d[1] * d[1]) + (d[2] * d[2] + d[3] * d[3]); }
                q += __shfl_xor(q, 16); q += __shfl_xor(q, 32);
                if (fq == 0) P[(ai * HALF + wr * 64 + m * 16 + fr) * 4 + wc] = (f32x2v){mw, q};
            }
        asm volatile("s_waitcnt lgkmcnt(0)" ::: "memory"); __builtin_amdgcn_s_barrier(); asm volatile("" ::: "memory");
#if defined(BROKEN_EXCHANGE_NO_WAIT)
#warning BROKEN CONTROL BUILD: the row-statistics exchange does not wait; results are wrong by design
        if (blockIdx.x >= 64) { const long long t0_ = clock64(); while (clock64() - t0_ < 60000) __builtin_amdgcn_s_sleep(8); }
#endif
        const int row = wid * 32 + (lane & 31);
        if (lane < 32) {
            const f32x2v a = P[row * 4 + 0], b = P[row * 4 + 1], c = P[row * 4 + 2], d = P[row * 4 + 3];
            const float mt = (a.x + b.x + c.x + d.x) * 0.25f;
            const float da = a.x - mt, db = b.x - mt, dc = c.x - mt, dd = d.x - mt;
            const float m2 = (a.y + b.y) + (c.y + d.y) + 64.0f * ((da * da + db * db) + (dc * dc + dd * dd));
            unsigned long long* slot = (unsigned long long*)xbuf + ((size_t)(u.pm * BM + row) * 4 + u.pn);
            __hip_atomic_store(slot, ((unsigned long long)__float_as_uint(m2) << 32) | __float_as_uint(mt), __ATOMIC_RELAXED, __HIP_MEMORY_SCOPE_AGENT);
        }
        asm volatile("s_waitcnt vmcnt(0)" ::: "memory");
        if (lane == 0) __hip_atomic_fetch_add(cnt + 64 * u.pm, 1u, __ATOMIC_RELAXED, __HIP_MEMORY_SCOPE_AGENT);
        if (wid == 0) {
            bool dead = false; const unsigned long long t0 = __builtin_amdgcn_s_memrealtime(); const unsigned want = 8u * (unsigned)ntn;
            for (;;) {
#if defined(BROKEN_EXCHANGE_NO_WAIT)
                break;
#endif
                if ((unsigned)__builtin_amdgcn_readfirstlane(__hip_atomic_load(cnt + 64 * u.pm, __ATOMIC_RELAXED, __HIP_MEMORY_SCOPE_AGENT)) >= want) break;
                if (__builtin_amdgcn_s_memrealtime() - t0 > 2000000ull) {
                    if (lane == 0) { unsigned expect = 0u; __hip_atomic_compare_exchange_strong(tmo + 1, &expect, code | (unsigned)(u.pm & 0xff), __ATOMIC_RELAXED, __ATOMIC_RELAXED, __HIP_MEMORY_SCOPE_AGENT);
                                     __hip_atomic_store(tmo, 1u, __ATOMIC_RELAXED, __HIP_MEMORY_SCOPE_AGENT); }
                    dead = true; break; }
                __builtin_amdgcn_s_sleep(2);
            }
            __builtin_amdgcn_fence(__ATOMIC_ACQUIRE, "agent");
            if (lane == 0) flag[0] = dead ? 1u : 0u;
        }
        asm volatile("s_waitcnt vmcnt(0) lgkmcnt(0)" ::: "memory"); __builtin_amdgcn_s_barrier(); asm volatile("" ::: "memory");
        const bool bad = flag[0] != 0u;
        if (lane < 32) {
            const unsigned long long* slot = (const unsigned long long*)xbuf + (size_t)(u.pm * BM + row) * 4; float mt[4], m2[4]; float ms = 0.f;
#pragma unroll
            for (int t = 0; t < 4; ++t) { if (t < ntn) { const unsigned long long w = __hip_atomic_load(slot + t, __ATOMIC_RELAXED, __HIP_MEMORY_SCOPE_AGENT); mt[t] = __uint_as_float((unsigned)w); m2[t] = __uint_as_float((unsigned)(w >> 32)); } else { mt[t] = 0.f; m2[t] = 0.f; } ms += mt[t]; }
            const float mean = ms / (float)ntn; float q = 0.f;
#pragma unroll
            for (int t = 0; t < 4; ++t) if (t < ntn) { const float dm = mt[t] - mean; q += m2[t] + 256.0f * dm * dm; }
            S[row] = (f32x2v){mean, 1.0f / sqrtf(q / (256.0f * (float)ntn) + eps)};
        }
        asm volatile("s_waitcnt lgkmcnt(0)" ::: "memory"); __builtin_amdgcn_s_barrier(); asm volatile("" ::: "memory");
        return bad;
    }
};
struct EpiLnRes {
    static constexpr bool PERM = false, AFTER_DRAIN = true;
    const float* base; float* out; int ldc; const float* bias; PanelStats st; unsigned poison;
    __device__ __forceinline__ void fused(f32x4 (&acc)[2][2][4][2], const Unit& u, int wr, int wc, int fr, int fq, PG8_LAS unsigned char* lds, int wid, int lane) const {
        typedef float f32x2v __attribute__((ext_vector_type(2)));
        const PG8_LAS f32x2v* S = (const PG8_LAS f32x2v*)(lds + 8192);
        const int col0 = u.pn * BM + wc * 32 + 4 * fq;
#pragma unroll
        for (int bj = 0; bj < 2; ++bj)
#pragma unroll
            for (int n = 0; n < 2; ++n) { const f32x4 bv = bias ? *(const f32x4*)(bias + col0 + bj * HALF + n * 16) : (f32x4){0.f, 0.f, 0.f, 0.f};
#pragma unroll
                for (int ai = 0; ai < 2; ++ai)
#pragma unroll
                    for (int m = 0; m < 4; ++m) acc[ai][bj][m][n] += bv; }
        f32x4 pre[4][2][2];
#pragma unroll
        for (int m = 0; m < 4; ++m) { const size_t off = (size_t)(u.pm * BM + wr * 64 + m * 16 + fr) * ldc + col0;
#pragma unroll
            for (int bj = 0; bj < 2; ++bj)
#pragma unroll
                for (int n = 0; n < 2; ++n) pre[m][bj][n] = *(const f32x4*)(base + off + bj * HALF + n * 16); }
        const bool bad = st.run(acc, u, wr, wc, fr, fq, lds, wid, lane) || poison != 0u;
        const float qnan = __builtin_nanf("");
#pragma unroll
        for (int ai = 0; ai < 2; ++ai)
#pragma unroll
            for (int m = 0; m < 4; ++m) { const int r = ai * HALF + wr * 64 + m * 16 + fr; const f32x2v sr = S[r]; const size_t off = (size_t)(u.pm * BM + r) * ldc + col0;
#pragma unroll
                for (int bj = 0; bj < 2; ++bj)
#pragma unroll
                    for (int n = 0; n < 2; ++n) { const f32x4 bs = ai == 0 ? pre[m][bj][n] : *(const f32x4*)(base + off + bj * HALF + n * 16); f32x4 o = bs + (acc[ai][bj][m][n] - sr.x) * sr.y;
                        if (bad) o = (f32x4){qnan, qnan, qnan, qnan}; *(f32x4*)(out + off + bj * HALF + n * 16) = o; }
                if (m & 1) asm volatile("" ::: "memory"); }
    }
};
struct EpiLnResLn {
    static constexpr bool PERM = false, AFTER_DRAIN = true;
    const float* base; float* out; bf16_t* xn; int ldc; const float* bias; PanelStats st1, st2; unsigned poison;
    __device__ __forceinline__ void fused(f32x4 (&acc)[2][2][4][2], const Unit& u, int wr, int wc, int fr, int fq, PG8_LAS unsigned char* lds, int wid, int lane) const {
        typedef float f32x2v __attribute__((ext_vector_type(2))); typedef unsigned u32x2v __attribute__((ext_vector_type(2)));
        const PG8_LAS f32x2v* S = (const PG8_LAS f32x2v*)(lds + 8192);
        const int col0 = u.pn * BM + wc * 32 + 4 * fq;
#pragma unroll
        for (int bj = 0; bj < 2; ++bj)
#pragma unroll
            for (int n = 0; n < 2; ++n) { const f32x4 bv = bias ? *(const f32x4*)(bias + col0 + bj * HALF + n * 16) : (f32x4){0.f, 0.f, 0.f, 0.f};
#pragma unroll
                for (int ai = 0; ai < 2; ++ai)
#pragma unroll
                    for (int m = 0; m < 4; ++m) acc[ai][bj][m][n] += bv; }
        bool bad = st1.run(acc, u, wr, wc, fr, fq, lds, wid, lane) || poison != 0u;
        const float qnan = __builtin_nanf("");
#pragma unroll
        for (int ai = 0; ai < 2; ++ai)
#pragma unroll
            for (int m = 0; m < 4; ++m) { const int r = ai * HALF + wr * 64 + m * 16 + fr; const f32x2v sr = S[r]; const size_t off = (size_t)(u.pm * BM + r) * ldc + col0;
#pragma unroll
                for (int bj = 0; bj < 2; ++bj)
#pragma unroll
                    for (int n = 0; n < 2; ++n) { const f32x4 bs = *(const f32x4*)(base + off + bj * HALF + n * 16); acc[ai][bj][m][n] = bs + (acc[ai][bj][m][n] - sr.x) * sr.y; }
                asm volatile("" : "+v"(acc[ai][0][m][0]), "+v"(acc[ai][0][m][1]), "+v"(acc[ai][1][m][0]), "+v"(acc[ai][1][m][1]));
                if (m & 1) asm volatile("" ::: "memory"); }
        const bool bad1 = bad;
        bad = st2.run(acc, u, wr, wc, fr, fq, lds, wid, lane) || bad;
#pragma unroll
        for (int ai = 0; ai < 2; ++ai)
#pragma unroll
            for (int m = 0; m < 4; ++m) { const int r = ai * HALF + wr * 64 + m * 16 + fr; const f32x2v sr = S[r]; const size_t off = (size_t)(u.pm * BM + r) * ldc + col0;
#pragma unroll
                for (int bj = 0; bj < 2; ++bj)
#pragma unroll
                    for (int n = 0; n < 2; ++n) { const f32x4 x1 = acc[ai][bj][m][n]; *(f32x4*)(out + off + bj * HALF + n * 16) = bad1 ? (f32x4){qnan, qnan, qnan, qnan} : x1;
                        const f32x4 o = (x1 - sr.x) * sr.y; u32x2v w; w.x = cvt_pk_bf16(o[0], o[1]); w.y = cvt_pk_bf16(o[2], o[3]);
                        if (bad) { w.x = 0x7fc07fc0u; w.y = 0x7fc07fc0u; } *(u32x2v*)(xn + off + bj * HALF + n * 16) = w; }
                asm volatile("" ::: "memory"); }
    }
};

template <class Epi, class Sched, bool ALIGN_EPI = false, bool SP2 = false>
__device__ __forceinline__ void gemm_phase(PG8_LAS unsigned char* lds, const Gemm g, const Sched& S, const Epi& E) {
    int tid_o = threadIdx.x; asm volatile("" : "+v"(tid_o)); const int tid = tid_o, wid = __builtin_amdgcn_readfirstlane(tid >> 6), lane = tid & 63, wr = wid >> 2, wc = wid & 3, fr = lane & 15, fq = lane >> 4;
    const int K = g.K, nt = K / BK;
    unsigned voffA[2], voffB[2];
#pragma unroll
    for (int i = 0; i < 2; ++i) { int R, C; stage_rc(tid * 16 + i * 8192, R, C); const int Rb = Epi::PERM ? ((R & ~31) + perm32(R & 31)) : R;
        voffA[i] = (unsigned)(R * K + C) * 2u; voffB[i] = (unsigned)(Rb * K + C) * 2u; }
    const size_t kstep = (size_t)(BK * 2);
    const size_t hstep = (size_t)HALF * K * 2;
    const size_t tstep = 2 * hstep;
    const unsigned ldsw = (unsigned)wid * 1024u;
    const int aoff = lds_byte(wr * 64 + fr, fq * 8), boff = lds_byte(wc * 32 + fr, fq * 8);
#define PG8_SA(b, h) (((b) * 2 + (h)) * HTB)
#define PG8_SB(b, h) ((4 + (b) * 2 + (h)) * HTB)
#define PG8_STAGE(bufoff, gbase, voff) do { _Pragma("unroll") for (int _i = 0; _i < 2; ++_i) \
        __builtin_amdgcn_global_load_lds((const unsigned*)((const char*)(gbase) + (voff)[_i]), (PG8_LAS unsigned*)(lds + (bufoff) + ldsw + _i * 8192), 16, 0, 0); } while (0)
#define PG8_LDA(dst, b, h) do { _Pragma("unroll") for (int m = 0; m < 4; ++m) _Pragma("unroll") for (int k = 0; k < 2; ++k) dst[m][k] = *(const PG8_LAS bf16x8*)(lds + PG8_SA(b, h) + aoff + m * 2048 + k * 1024); } while (0)
#define PG8_LDB(dst, b, h) do { _Pragma("unroll") for (int n = 0; n < 2; ++n) _Pragma("unroll") for (int k = 0; k < 2; ++k) dst[n][k] = *(const PG8_LAS bf16x8*)(lds + PG8_SB(b, h) + boff + n * 2048 + k * 1024); } while (0)
#define PG8_MMA(ai, bj, At, Bt) do { __builtin_amdgcn_s_setprio(1); _Pragma("unroll") for (int m = 0; m < 4; ++m) _Pragma("unroll") for (int n = 0; n < 2; ++n) _Pragma("unroll") for (int k = 0; k < 2; ++k) \
        acc[ai][bj][m][n] = __builtin_amdgcn_mfma_f32_16x16x32_bf16(Bt[n][k], At[m][k], acc[ai][bj][m][n], 0, 0, 0); __builtin_amdgcn_s_setprio(0); } while (0)
#define PG8_WAIT_V(n) asm volatile("s_waitcnt vmcnt(" #n ")" ::: "memory")
#define PG8_WAIT_L(n) asm volatile("s_waitcnt lgkmcnt(" #n ")" ::: "memory")
#define PG8_BAR __builtin_amdgcn_s_barrier()
#define PG8_SCHED __builtin_amdgcn_sched_barrier(0)
    Unit cur, nxt; int ui = 0;
    if (!S.next(0, cur)) return;
    f32x4 acc[2][2][4][2];
#pragma unroll
    for (int a = 0; a < 2; ++a)
#pragma unroll
        for (int b = 0; b < 2; ++b)
#pragma unroll
            for (int m = 0; m < 4; ++m)
#pragma unroll
                for (int n = 0; n < 2; ++n) acc[a][b][m][n] = (f32x4){0.f, 0.f, 0.f, 0.f};
    bf16x8 At[4][2], B0[2][2], B1[2][2];
    const char* cA = (const char*)g.A + (size_t)cur.pm * tstep; const char* cB = (const char*)g.Bt + (size_t)cur.pn * tstep;
    S.a_ready(cur);
    if constexpr (SP2) {
        PG8_STAGE(PG8_SB(0, 0), cB, voffB); PG8_STAGE(PG8_SB(0, 1), cB + hstep, voffB); PG8_STAGE(PG8_SA(0, 0), cA, voffA); PG8_STAGE(PG8_SA(0, 1), cA + hstep, voffA);
        if (wr == 1) PG8_BAR;
        PG8_WAIT_V(2); PG8_BAR;
        PG8_STAGE(PG8_SB(1, 0), cB + kstep, voffB); PG8_STAGE(PG8_SA(1, 0), cA + kstep, voffA); PG8_STAGE(PG8_SB(1, 1), cB + hstep + kstep, voffB);
        PG8_WAIT_V(6); PG8_BAR;
    } else {
        PG8_STAGE(PG8_SB(0, 0), cB, voffB); PG8_STAGE(PG8_SA(0, 0), cA, voffA); PG8_STAGE(PG8_SB(0, 1), cB + hstep, voffB); PG8_STAGE(PG8_SA(0, 1), cA + hstep, voffA);
        if (wr == 1) PG8_BAR;
        PG8_WAIT_V(4); PG8_BAR;
        PG8_STAGE(PG8_SB(1, 0), cB + kstep, voffB); PG8_STAGE(PG8_SA(1, 0), cA + kstep, voffA); PG8_STAGE(PG8_SB(1, 1), cB + hstep + kstep, voffB);
        PG8_WAIT_V(6); PG8_BAR;
    }
    for (;;) {
        const bool has_next = S.next(ui + 1, nxt);
        const char* nA = has_next ? (const char*)g.A + (size_t)nxt.pm * tstep : cA; const char* nB = has_next ? (const char*)g.Bt + (size_t)nxt.pn * tstep : cB;
        for (int t = 0; t < nt; t += 2) {
            const bool last = (t == nt - 2);
            const char* a1 = cA + (size_t)(t + 1) * kstep;
            const char* a2 = last ? nA : cA + (size_t)(t + 2) * kstep; const char* b2 = last ? nB : cB + (size_t)(t + 2) * kstep;
            const char* a3 = a2 + kstep; const char* b3 = b2 + kstep;
            if (last && has_next) S.a_ready(nxt);
            if constexpr (SP2) {
            PG8_LDB(B0, 0, 0); PG8_LDB(B1, 0, 1); PG8_SCHED; PG8_LDA(At, 0, 0); PG8_STAGE(PG8_SA(1, 1), a1 + hstep, voffA);
            PG8_WAIT_V(8); PG8_WAIT_L(0); PG8_BAR; PG8_MMA(0, 0, At, B0); PG8_MMA(0, 1, At, B1); PG8_BAR; PG8_SCHED;
            PG8_LDA(At, 0, 1); PG8_STAGE(PG8_SB(0, 0), b2, voffB); PG8_STAGE(PG8_SB(0, 1), b2 + hstep, voffB); PG8_STAGE(PG8_SA(0, 0), a2, voffA);
            PG8_WAIT_V(8); PG8_WAIT_L(0); PG8_BAR; PG8_MMA(1, 0, At, B0); PG8_MMA(1, 1, At, B1); PG8_BAR; PG8_SCHED;
            PG8_LDB(B0, 1, 0); PG8_LDB(B1, 1, 1); PG8_SCHED; PG8_LDA(At, 1, 0); PG8_STAGE(PG8_SA(0, 1), a2 + hstep, voffA);
            PG8_WAIT_V(8); PG8_WAIT_L(0); PG8_BAR; PG8_MMA(0, 0, At, B0); PG8_MMA(0, 1, At, B1); PG8_BAR; PG8_SCHED;
            PG8_LDA(At, 1, 1); PG8_STAGE(PG8_SB(1, 0), b3, voffB); PG8_STAGE(PG8_SB(1, 1), b3 + hstep, voffB); PG8_STAGE(PG8_SA(1, 0), a3, voffA);
            PG8_WAIT_V(8); PG8_WAIT_L(0); PG8_BAR; PG8_MMA(1, 0, At, B0); PG8_MMA(1, 1, At, B1); PG8_BAR; PG8_SCHED;
            } else {
            PG8_LDB(B0, 0, 0); PG8_SCHED; PG8_LDA(At, 0, 0); PG8_STAGE(PG8_SA(1, 1), a1 + hstep, voffA);
            PG8_WAIT_L(8); PG8_BAR; PG8_WAIT_L(0); PG8_MMA(0, 0, At, B0); PG8_BAR; PG8_SCHED;
            PG8_LDB(B1, 0, 1); PG8_STAGE(PG8_SB(0, 0), b2, voffB);
            PG8_BAR; PG8_WAIT_L(0); PG8_MMA(0, 1, At, B1); PG8_BAR;
            PG8_LDA(At, 0, 1); PG8_STAGE(PG8_SA(0, 0), a2, voffA);
            PG8_BAR; PG8_WAIT_L(0); PG8_MMA(1, 0, At, B0); PG8_BAR; PG8_SCHED;
            PG8_STAGE(PG8_SB(0, 1), b2 + hstep, voffB);
            PG8_WAIT_V(6); PG8_BAR; PG8_MMA(1, 1, At, B1); PG8_BAR;
            PG8_LDB(B0, 1, 0); PG8_SCHED; PG8_LDA(At, 1, 0); PG8_STAGE(PG8_SA(0, 1), a2 + hstep, voffA);
            PG8_WAIT_L(8); PG8_BAR; PG8_WAIT_L(0); PG8_MMA(0, 0, At, B0); PG8_BAR; PG8_SCHED;
            PG8_LDB(B1, 1, 1); PG8_STAGE(PG8_SB(1, 0), b3, voffB);
            PG8_BAR; PG8_WAIT_L(0); PG8_MMA(0, 1, At, B1); PG8_BAR;
            PG8_LDA(At, 1, 1); PG8_STAGE(PG8_SA(1, 0), a3, voffA);
            PG8_BAR; PG8_WAIT_L(0); PG8_MMA(1, 0, At, B0); PG8_BAR; PG8_SCHED;
            PG8_STAGE(PG8_SB(1, 1), b3 + hstep, voffB);
            PG8_WAIT_V(6); PG8_BAR; PG8_MMA(1, 1, At, B1); PG8_BAR;
            }
        }
        if constexpr (ALIGN_EPI) { if (wr == 0) PG8_BAR; }
        if constexpr (!Epi::AFTER_DRAIN) { E(acc, cur, wr, wc, fr, fq); S.done(cur); }
        if (!has_next) break;
#pragma unroll
        for (int a = 0; a < 2; ++a)
#pragma unroll
            for (int b = 0; b < 2; ++b)
#pragma unroll
                for (int m = 0; m < 4; ++m)
#pragma unroll
                    for (int n = 0; n < 2; ++n) acc[a][b][m][n] = (f32x4){0.f, 0.f, 0.f, 0.f};
        cur = nxt; cA = nA; cB = nB; ++ui;
        if constexpr (ALIGN_EPI) { if (wr == 1) PG8_BAR; }
    }
    PG8_WAIT_V(0);
    if constexpr (!ALIGN_EPI) { if (wr == 0) PG8_BAR; }
    PG8_BAR;
    if constexpr (Epi::AFTER_DRAIN) { E.fused(acc, cur, wr, wc, fr, fq, lds, wid, lane); S.done(cur); }
#undef PG8_SA
#undef PG8_SB
#undef PG8_STAGE
#undef PG8_LDA
#undef PG8_LDB
#undef PG8_MMA
#undef PG8_WAIT_V
#undef PG8_WAIT_L
#undef PG8_BAR
#undef PG8_SCHED
}
}
#define GAS __attribute__((address_space(1)))
#define LAS __attribute__((address_space(3)))
typedef unsigned short bf16;
typedef unsigned v4u __attribute__((ext_vector_type(4)));
typedef float f32x4 __attribute__((ext_vector_type(4)));
typedef short bf16x8 __attribute__((ext_vector_type(8)));
typedef GAS unsigned gu32;
typedef GAS unsigned long long gu64;
#define RLX_AGENT __ATOMIC_RELAXED, __HIP_MEMORY_SCOPE_AGENT
#define LDS_WAIT() asm volatile("s_waitcnt lgkmcnt(0)" ::: "memory")
#define VM_WAIT() asm volatile("s_waitcnt vmcnt(0)" ::: "memory")
__device__ __forceinline__ unsigned long long rt() { return __builtin_amdgcn_s_memrealtime(); }
__device__ __forceinline__ unsigned f2bf(float f) { unsigned u = __builtin_bit_cast(unsigned, f); return (u + 0x7fffu + ((u >> 16) & 1u)) >> 16; }
__device__ __forceinline__ unsigned pk2(float lo, float hi) { return f2bf(lo) | (f2bf(hi) << 16); }

#define XB_TMO      128
#define XB_XCNT(j)  (256  + 64 * (j))
#define XB_XSUB(j)  (1280 + 64 * (j))
#define XB_XGEN(j)  (2304 + 64 * (j))
#define XB_TOP      3328
#define XB_TOPGEN   3392
#define XCD_BAR_WORDS 3456
#define XB_SPIN_CAP (1u << 18)

__device__ __forceinline__ unsigned xb_ld(unsigned* p)              { return __hip_atomic_load(p, __ATOMIC_RELAXED, __HIP_MEMORY_SCOPE_AGENT); }
__device__ __forceinline__ unsigned xb_add(unsigned* p, unsigned v) { return __hip_atomic_fetch_add(p, v, __ATOMIC_RELAXED, __HIP_MEMORY_SCOPE_AGENT); }
__device__ __forceinline__ unsigned xb_xcc_id() { return (unsigned)__builtin_amdgcn_s_getreg((3 << 11) | 20) & 0xFu; }
#define XB_SPIN(cond, bar) do { unsigned _sp = 0; while (cond) { __builtin_amdgcn_s_sleep(1); \
    if ((++_sp & 255u) == 0u) { if (xb_ld(&(bar)[XB_TMO])) break; if (_sp > XB_SPIN_CAP) { atomicAdd(&(bar)[XB_TMO], 1u); break; } } } } while (0)

struct XcdBarrier {
    unsigned* bar; unsigned x;
    volatile LAS unsigned* st;
};

__device__ __forceinline__ XcdBarrier xcd_barrier_post(unsigned* bar, volatile LAS unsigned* st) {
    XcdBarrier b; b.bar = bar; b.x = xb_xcc_id(); b.st = st;
    if (threadIdx.x == 0) (void)xb_add(&bar[XB_XCNT(b.x)], 1u);
    return b;
}
__device__ __forceinline__ void xcd_barrier_complete(unsigned* bar, unsigned x, unsigned& nloc, unsigned& nx) {
    const unsigned G = gridDim.x * gridDim.y * gridDim.z;
    unsigned sum, cnt, mine, sp = 0u;
    for (;;) {
        sum = 0u; cnt = 0u; mine = 0u;
#pragma unroll
        for (unsigned j = 0; j < 16; ++j) { const unsigned c = xb_ld(&bar[XB_XCNT(j)]); sum += c; cnt += (c > 0u) ? 1u : 0u; mine = (j == x) ? c : mine; }
        if (sum == G) break;
        __builtin_amdgcn_s_sleep(1);
        if ((++sp & 255u) == 0u) { if (xb_ld(&bar[XB_TMO])) break; if (sp > XB_SPIN_CAP) { atomicAdd(&bar[XB_TMO], 1u); break; } }
    }
    nloc = mine > 0u ? mine : 1u; nx = cnt > 0u ? cnt : 1u;
}

__device__ __forceinline__ void xcd_barrier(const XcdBarrier& b) {
    asm volatile("s_waitcnt vmcnt(0)" ::: "memory");
    __syncthreads();
    if (threadIdx.x == 0) {
        unsigned* bar = b.bar;
        __builtin_amdgcn_s_waitcnt(0);
        unsigned nloc = b.st[0], nx = b.st[1];
        if (nloc == 0u) { xcd_barrier_complete(bar, b.x, nloc, nx); b.st[0] = nloc; b.st[1] = nx; }
        const unsigned old = xb_add(&bar[XB_XSUB(b.x)], 1u);
        const unsigned gen = old / nloc;
        if (old + 1u == (gen + 1u) * nloc) {
            __builtin_amdgcn_fence(__ATOMIC_RELEASE, "agent");
            asm volatile("s_waitcnt vmcnt(0)" ::: "memory");
            const unsigned og = xb_add(&bar[XB_TOP], 1u);
            const unsigned tg = og / nx;
            if (og + 1u == (tg + 1u) * nx) xb_add(&bar[XB_TOPGEN], 1u);
            else XB_SPIN(xb_ld(&bar[XB_TOPGEN]) == tg, bar);
            __builtin_amdgcn_fence(__ATOMIC_ACQUIRE, "agent");
            xb_add(&bar[XB_XGEN(b.x)], 1u);
            asm volatile("s_waitcnt vmcnt(0)" ::: "memory");
        } else {
            XB_SPIN(xb_ld(&bar[XB_XGEN(b.x)]) == gen, bar);
            __builtin_amdgcn_fence(__ATOMIC_ACQUIRE, "agent");
            asm volatile("s_waitcnt vmcnt(0)" ::: "memory");
        }
    }
    __syncthreads();
}
#ifndef PH_MASK
#define PH_MASK 0xFFFF
#endif
#define PH_EN(n) ((PH_MASK >> (n)) & 1)
#ifndef MK_MULTI
#define MK_MULTI 0
#endif
constexpr int NWAVES = 8, NTHR = 512;
constexpr int Bn = 2, S = 8192, T = Bn * S, D = 1024, NH = 16, HD = 64, DEPTH = 4;
constexpr int NE = 64, ED = 256, TOPK = 8, PLE = 256;
constexpr int NSA_G = 4, NCMP = 512;
constexpr float LN_EPS = 1e-5f, NEGF = -1e30f;
constexpr float DN_ALPHA = 1.681792830507429f;
constexpr float ATT_SCALE = 0.125f;
constexpr int NPH = 13;

constexpr size_t MiB = 1u << 20;
constexpr size_t WS_CTL = 0, CTL_ZERO_BYTES = 1 * MiB;
constexpr size_t WS_ROPE_C = 2 * MiB, WS_ROPE_S = 4 * MiB;
constexpr size_t WS_LOGF = 6 * MiB, WS_CUM = 7 * MiB;
constexpr size_t WS_GATES = 8 * MiB;
constexpr size_t WS_KMEAN = 11 * MiB;
constexpr size_t WS_KCMP = 12 * MiB, WS_VCMP = 13 * MiB;
constexpr size_t WS_TOKE = 14 * MiB, WS_TOKW = 15 * MiB, WS_TOKP = 16 * MiB;
constexpr size_t WS_ROWW = 17 * MiB;
constexpr size_t WS_X = 32 * MiB;
constexpr size_t WS_XBA = 96 * MiB, WS_XBB = 128 * MiB;
constexpr size_t WS_WIN = 160 * MiB, WS_WOUT = 166 * MiB, WS_WGU = 168 * MiB, WS_WDN = 233 * MiB, WS_WPG = 266 * MiB, WS_WPP = 268 * MiB;
constexpr size_t WS_PB = 270 * MiB;
constexpr size_t WS_Q = 280 * MiB, WS_K = 312 * MiB, WS_V = 344 * MiB;
constexpr size_t WS_AO = 376 * MiB;
constexpr size_t WS_PP = 408 * MiB;
constexpr size_t WS_H = 280 * MiB;
constexpr size_t WS_XG = 440 * MiB;
constexpr size_t WS_OUTR = 440 * MiB;
constexpr size_t WS_END = 760 * MiB;
constexpr int R_PAD_TILES = 576, XG_TILE0 = (int)((WS_XG - WS_XBA) / (256 * 1024 * 2));
static_assert((WS_XG - WS_XBA) % (256 * 1024 * 2) == 0, "XG tile alignment");
constexpr int CW_TMO = 0, CW_CODE = 1, CW_BAR = 4096, CW_CNT = 8192;

constexpr int RING_BYTES = 131072, TAB_OFF = RING_BYTES, MISC_OFF = RING_BYTES + 8192, LDS_BYTES = 147456;

typedef unsigned short bf16_t;
__device__ __forceinline__ float bf2f(unsigned short h) { return __uint_as_float(((unsigned)h) << 16); }
__device__ __forceinline__ float bflo(unsigned u) { return __uint_as_float(u << 16); }
__device__ __forceinline__ float bfhi(unsigned u) { return __uint_as_float(u & 0xffff0000u); }
__device__ __forceinline__ float wave_sum(float v) {
#pragma unroll
    for (int o = 1; o < 64; o <<= 1) v += __shfl_xor(v, o);
    return v;
}
__device__ __forceinline__ float wave_max(float v) {
#pragma unroll
    for (int o = 1; o < 64; o <<= 1) v = fmaxf(v, __shfl_xor(v, o));
    return v;
}
#define WAVE_SYNC() do { asm volatile("s_waitcnt lgkmcnt(0)" ::: "memory"); __builtin_amdgcn_wave_barrier(); } while (0)

namespace epi {
using pg8::f32x4; using pg8::u32x4; using pg8::Unit; using pg8::cvt_pk_bf16; using pg8::HALF; using pg8::BM;
struct Qkv {
    static constexpr bool PERM = true, AFTER_DRAIN = false;
    bf16_t* O0; int ncq, ld0; bf16_t* O1; int w1, ld1; size_t stride1; float scale0;
    __device__ __forceinline__ void operator()(const f32x4 (&acc)[2][2][4][2], const Unit& u, int wr, int wc, int fr, int fq) const {
        const int row0 = u.pm * BM + wr * 64 + fr; int colt = u.pn * BM; bf16_t* base; int ldc; float sc = 1.f;
        if (colt < ncq) { base = O0; ldc = ld0; sc = scale0; } else { colt -= ncq; const int j = colt / w1; colt -= j * w1; base = O1 + (size_t)j * stride1; ldc = ld1; }
        const int col0 = colt + wc * 32 + 8 * fq;
#pragma unroll
        for (int ai = 0; ai < 2; ++ai)
#pragma unroll
            for (int m = 0; m < 4; ++m) { bf16_t* rowp = base + (size_t)(row0 + ai * HALF + m * 16) * ldc + col0;
#pragma unroll
                for (int bj = 0; bj < 2; ++bj) { const f32x4 v0 = acc[ai][bj][m][0] * sc, v1 = acc[ai][bj][m][1] * sc;
                    u32x4 w; w.x = cvt_pk_bf16(v0[0], v0[1]); w.y = cvt_pk_bf16(v0[2], v0[3]); w.z = cvt_pk_bf16(v1[0], v1[1]); w.w = cvt_pk_bf16(v1[2], v1[3]);
                    *(u32x4*)(rowp + bj * HALF) = w; } }
    }
};
struct Res {
    static constexpr bool PERM = false, AFTER_DRAIN = false;
    float* X; int ldc; float alpha;
    __device__ __forceinline__ void operator()(const f32x4 (&acc)[2][2][4][2], const Unit& u, int wr, int wc, int fr, int fq) const {
        const int row0 = u.pm * BM + wr * 64 + fr, col0 = u.pn * BM + wc * 32 + 4 * fq;
#pragma unroll
        for (int ai = 0; ai < 2; ++ai)
#pragma unroll
            for (int m = 0; m < 4; ++m) { float* rowp = X + (size_t)(row0 + ai * HALF + m * 16) * ldc + col0;
#pragma unroll
                for (int bj = 0; bj < 2; ++bj)
#pragma unroll
                    for (int n = 0; n < 2; ++n) { f32x4* p = (f32x4*)(rowp + bj * HALF + n * 16); const f32x4 x = *p; *p = x * alpha + acc[ai][bj][m][n]; } }
    }
};
struct SwiGlu {
    static constexpr bool PERM = true, AFTER_DRAIN = false;
    bf16_t* Hh; int xg0;
    __device__ __forceinline__ void operator()(const f32x4 (&acc)[2][2][4][2], const Unit& u, int wr, int wc, int fr, int fq) const {
        const int ht = u.pm < 64 ? u.pm : 64 + (u.pm - xg0); const int row0 = ht * BM + wr * 64 + fr; const int col0 = (u.pn & 1) * 128 + wc * 32 + 8 * fq;
#pragma unroll
        for (int ai = 0; ai < 2; ++ai)
#pragma unroll
            for (int m = 0; m < 4; ++m) { bf16_t* rowp = Hh + (size_t)(row0 + ai * HALF + m * 16) * ED + col0;
                float h[8];
#pragma unroll
                for (int n = 0; n < 2; ++n)
#pragma unroll
                    for (int j = 0; j < 4; ++j) { const float g = acc[ai][0][m][n][j], up = acc[ai][1][m][n][j];
                        const float sg = g * __builtin_amdgcn_rcpf(1.f + __builtin_amdgcn_exp2f(-g * 1.4426950408889634f)); h[n * 4 + j] = sg * up; }
                u32x4 w; w.x = cvt_pk_bf16(h[0], h[1]); w.y = cvt_pk_bf16(h[2], h[3]); w.z = cvt_pk_bf16(h[4], h[5]); w.w = cvt_pk_bf16(h[6], h[7]);
                *(u32x4*)rowp = w; }
    }
};
struct Down {
    static constexpr bool PERM = true, AFTER_DRAIN = false;
    bf16_t* O; const float* roww;
    __device__ __forceinline__ void operator()(const f32x4 (&acc)[2][2][4][2], const Unit& u, int wr, int wc, int fr, int fq) const {
        const int row0 = u.pm * BM + wr * 64 + fr; const int col0 = (u.pn & 3) * BM + wc * 32 + 8 * fq;
#pragma unroll
        for (int ai = 0; ai < 2; ++ai)
#pragma unroll
            for (int m = 0; m < 4; ++m) { const int row = row0 + ai * HALF + m * 16; const float sc = (u.pm < 64) ? 1.f : roww[row - T];
                bf16_t* rowp = O + (size_t)row * D + col0;
#pragma unroll
                for (int bj = 0; bj < 2; ++bj) { const f32x4 v0 = acc[ai][bj][m][0] * sc, v1 = acc[ai][bj][m][1] * sc;
                    u32x4 w; w.x = cvt_pk_bf16(v0[0], v0[1]); w.y = cvt_pk_bf16(v0[2], v0[3]); w.z = cvt_pk_bf16(v1[0], v1[1]); w.w = cvt_pk_bf16(v1[2], v1[3]);
                    *(u32x4*)(rowp + bj * HALF) = w; } }
    }
};
struct StoreBf16 {
    static constexpr bool PERM = true, AFTER_DRAIN = false;
    bf16_t* O; int ldc;
    __device__ __forceinline__ void operator()(const f32x4 (&acc)[2][2][4][2], const Unit& u, int wr, int wc, int fr, int fq) const {
        const int row0 = u.pm * BM + wr * 64 + fr; const int col0 = u.pn * BM + wc * 32 + 8 * fq;
#pragma unroll
        for (int ai = 0; ai < 2; ++ai)
#pragma unroll
            for (int m = 0; m < 4; ++m) { bf16_t* rowp = O + (size_t)(row0 + ai * HALF + m * 16) * ldc + col0;
#pragma unroll
                for (int bj = 0; bj < 2; ++bj) { const f32x4 v0 = acc[ai][bj][m][0], v1 = acc[ai][bj][m][1];
                    u32x4 w; w.x = cvt_pk_bf16(v0[0], v0[1]); w.y = cvt_pk_bf16(v0[2], v0[3]); w.z = cvt_pk_bf16(v1[0], v1[1]); w.w = cvt_pk_bf16(v1[2], v1[3]);
                    *(u32x4*)(rowp + bj * HALF) = w; } }
    }
};
struct Ple {
    static constexpr bool PERM = false, AFTER_DRAIN = false;
    const float* X; const bf16_t* PP; float* OutF; bf16_t* XBn;
    __device__ __forceinline__ void operator()(const f32x4 (&acc)[2][2][4][2], const Unit& u, int wr, int wc, int fr, int fq) const {
        typedef unsigned u32x2 __attribute__((ext_vector_type(2)));
        const int row0 = u.pm * BM + wr * 64 + fr, col0 = u.pn * BM + wc * 32 + 4 * fq;
#pragma unroll
        for (int ai = 0; ai < 2; ++ai)
#pragma unroll
            for (int m = 0; m < 4; ++m) { const size_t ro = (size_t)(row0 + ai * HALF + m * 16) * D + col0;
#pragma unroll
                for (int bj = 0; bj < 2; ++bj)
#pragma unroll
                    for (int n = 0; n < 2; ++n) { const size_t off = ro + bj * HALF + n * 16; const f32x4 x = *(const f32x4*)(X + off); const u32x2 pp = *(const u32x2*)(PP + off);
                        const f32x4 a = acc[ai][bj][m][n]; f32x4 o;
                        o[0] = x[0] + bflo(pp.x) * __builtin_amdgcn_rcpf(1.f + __builtin_amdgcn_exp2f(-a[0] * 1.4426950408889634f));
                        o[1] = x[1] + bfhi(pp.x) * __builtin_amdgcn_rcpf(1.f + __builtin_amdgcn_exp2f(-a[1] * 1.4426950408889634f));
                        o[2] = x[2] + bflo(pp.y) * __builtin_amdgcn_rcpf(1.f + __builtin_amdgcn_exp2f(-a[2] * 1.4426950408889634f));
                        o[3] = x[3] + bfhi(pp.y) * __builtin_amdgcn_rcpf(1.f + __builtin_amdgcn_exp2f(-a[3] * 1.4426950408889634f));
                        *(f32x4*)(OutF + off) = o; u32x2 w; w.x = cvt_pk_bf16(o[0], o[1]); w.y = cvt_pk_bf16(o[2], o[3]); *(u32x2*)(XBn + off) = w; } }
    }
};
}

struct MoeOrder {
    const LAS int* tstart;
    int NC, G, c, NU, pm_routed0;
    __device__ __forceinline__ bool next(int i, pg8::Unit& u) const {
        const long L = (long)i * G + c; if (L >= NU) return false;
        const int rt = (int)L / NC, cc = (int)L % NC; int e = 64, pm = rt;
        if (rt >= 64) { const int r = rt - 64; e = 0;
            for (int j = 1; j < 64; ++j) e += (tstart[j] <= r) ? 1 : 0;
            pm = pm_routed0 + r; }
        u.pm = pm; u.pn = e * NC + cc; return true;
    }
    __device__ __forceinline__ void a_ready(const pg8::Unit&) const {}
    __device__ __forceinline__ void done(const pg8::Unit&) const {}
};

__device__ __forceinline__ void transpose_item(const float* W, int ldw, int k0, int n0, bf16* WT, int K, int drow0, LAS float* scr, int lane) {
#pragma unroll 8
    for (int i = 0; i < 32; ++i) { const int kk = 2 * i + (lane >> 5); scr[kk * 33 + (lane & 31)] = W[(size_t)(k0 + kk) * ldw + n0 + (lane & 31)]; }
    LDS_WAIT(); asm volatile("" ::: "memory");
    const int c = lane & 7;
#pragma unroll
    for (int j = 0; j < 4; ++j) { const int n = (lane >> 3) + 8 * j; const LAS float* s = scr + (8 * c) * 33 + n;
        v4u o; o.x = pk2(s[0 * 33], s[1 * 33]); o.y = pk2(s[2 * 33], s[3 * 33]); o.z = pk2(s[4 * 33], s[5 * 33]); o.w = pk2(s[6 * 33], s[7 * 33]);
        *(GAS v4u*)(WT + (size_t)(drow0 + n) * K + k0 + 8 * c) = o; }
    LDS_WAIT(); asm volatile("" ::: "memory");
}

template <int NHq, class KeyFn, class BiasFn>
__device__ __forceinline__ void attend_chunk(const float* qs, float* pb, int* kb, const bf16_t* Kp, const bf16_t* Vp, int pitch, int nslots,
                                             KeyFn keyfn, BiasFn biasfn, float scale, float (&m)[NHq], float (&l)[NHq], float (&o)[NHq], int lane) {
    float cm[NHq];
#pragma unroll
    for (int h = 0; h < NHq; ++h) cm[h] = NEGF;
    for (int i = 0; i < 8; ++i) {
        const int slot = lane + 64 * i;
        const int key = (slot < nslots) ? keyfn(slot) : -1;
        float s[NHq];
#pragma unroll
        for (int h = 0; h < NHq; ++h) s[h] = NEGF;
        if (key >= 0) {
            const uint4* kr = (const uint4*)(Kp + (size_t)key * pitch);
#pragma unroll
            for (int h = 0; h < NHq; ++h) s[h] = 0.f;
#pragma unroll
            for (int c = 0; c < 8; ++c) {
                const uint4 kv = kr[c];
                const float k0 = bflo(kv.x), k1 = bfhi(kv.x), k2 = bflo(kv.y), k3 = bfhi(kv.y), k4 = bflo(kv.z), k5 = bfhi(kv.z), k6 = bflo(kv.w), k7 = bfhi(kv.w);
#pragma unroll
                for (int h = 0; h < NHq; ++h) { const float4 qa = *(const float4*)(qs + h * 64 + 8 * c), qb = *(const float4*)(qs + h * 64 + 8 * c + 4);
                    s[h] += qa.x * k0 + qa.y * k1 + qa.z * k2 + qa.w * k3 + qb.x * k4 + qb.y * k5 + qb.z * k6 + qb.w * k7; }
            }
            const float bs = biasfn(slot);
#pragma unroll
            for (int h = 0; h < NHq; ++h) { s[h] = s[h] * scale + bs; cm[h] = fmaxf(cm[h], s[h]); }
        }
#pragma unroll
        for (int h = 0; h < NHq; ++h) pb[h * 512 + slot] = s[h];
        kb[slot] = key;
    }
    float f[NHq], mn[NHq], ls[NHq];
#pragma unroll
    for (int h = 0; h < NHq; ++h) { mn[h] = fmaxf(m[h], wave_max(cm[h])); f[h] = __expf(m[h] - mn[h]); ls[h] = 0.f; }
    WAVE_SYNC();
    for (int i = 0; i < 8; ++i) {
        const int slot = lane + 64 * i; const bool ok = kb[slot] >= 0;
#pragma unroll
        for (int h = 0; h < NHq; ++h) { const float p = ok ? __expf(pb[h * 512 + slot] - mn[h]) : 0.f; pb[h * 512 + slot] = p; ls[h] += p; }
    }
#pragma unroll
    for (int h = 0; h < NHq; ++h) { l[h] = l[h] * f[h] + wave_sum(ls[h]); o[h] *= f[h]; m[h] = mn[h]; }
    WAVE_SYNC();
    const int ns8 = (nslots + 7) & ~7;
    for (int sl = 0; sl < ns8; sl += 8) {
#pragma unroll
        for (int u = 0; u < 8; ++u) { const int key = kb[sl + u]; const int kk = key < 0 ? 0 : key; const float v = bf2f(Vp[(size_t)kk * pitch + lane]);
#pragma unroll
            for (int h = 0; h < NHq; ++h) o[h] += pb[h * 512 + sl + u] * v; }
    }
    WAVE_SYNC();
}

struct Args { const void* in[31]; float* out; unsigned char* ws; int ph_lo, ph_hi; };

__device__ __forceinline__ float sigmoidf_(float z) { return 1.f / (1.f + __expf(-z)); }
__device__ __forceinline__ float gelu_tanh(float x) { const float u = 0.7978845608028654f * (x + 0.044715f * x * x * x); const float e = __expf(2.f * u); return 0.5f * x * (1.f + (1.f - 2.f / (e + 1.f))); }

__device__ __forceinline__ void ln_row(f32x4 (&v)[4], const float* g, const float* b, int lane) {
    float s = 0.f;
#pragma unroll
    for (int j = 0; j < 4; ++j) s += (v[j].x + v[j].y) + (v[j].z + v[j].w);
    const float mean = wave_sum(s) * (1.f / D); float s2 = 0.f;
#pragma unroll
    for (int j = 0; j < 4; ++j) { v[j] = v[j] - mean; s2 += (v[j].x * v[j].x + v[j].y * v[j].y) + (v[j].z * v[j].z + v[j].w * v[j].w); }
    const float rstd = 1.f / sqrtf(wave_sum(s2) * (1.f / D) + LN_EPS);
#pragma unroll
    for (int j = 0; j < 4; ++j) { const f32x4 gg = *(const f32x4*)(g + 4 * lane + 256 * j), bb = *(const f32x4*)(b + 4 * lane + 256 * j); v[j] = v[j] * rstd * gg + bb; }
}

__global__ void __launch_bounds__(NTHR, 2) mk_fwd(Args args) {
    extern __shared__ __attribute__((aligned(16))) unsigned char lds[];
    const int G = gridDim.x, bx = blockIdx.x;
    const int NGW = G * NWAVES, NGT = G * NTHR;
#define PH_IDS() int tid_o = threadIdx.x; asm volatile("" : "+v"(tid_o)); const int tid = tid_o, lane = tid & 63, wave = __builtin_amdgcn_readfirstlane(tid >> 6); \
    const int gw = bx * NWAVES + wave, gtid = bx * NTHR + tid; (void)gw; (void)gtid; (void)lane; (void)wave;
    unsigned char* ws = args.ws;
    gu32* ctl = (gu32*)(ws + WS_CTL);
    LAS unsigned char* ldsl = (LAS unsigned char*)lds;
    volatile LAS unsigned* MISC = (volatile LAS unsigned*)(ldsl + MISC_OFF);
    LAS int* TAB = (LAS int*)(ldsl + TAB_OFF);
    for (int u = threadIdx.x; u < (LDS_BYTES - RING_BYTES) / 4; u += NTHR) ((LAS unsigned*)(ldsl + RING_BYTES))[u] = 0u;
    __syncthreads();
    XcdBarrier bar; bar.bar = (unsigned*)(ctl + CW_BAR); bar.x = 0; bar.st = nullptr;
    if (!MK_MULTI) bar = xcd_barrier_post((unsigned*)(ctl + CW_BAR), MISC + 8);
#define SEAM() do { if (!MK_MULTI) { xcd_barrier(bar); } } while (0)
#define IN(gp) (args.ph_lo <= (gp) && (gp) < args.ph_hi)

    float* X = (float*)(ws + WS_X);
    bf16_t* XBA = (bf16_t*)(ws + WS_XBA); bf16_t* XBB = (bf16_t*)(ws + WS_XBB);
    float* ROPE_C = (float*)(ws + WS_ROPE_C); float* ROPE_S = (float*)(ws + WS_ROPE_S);
    float* LOGF = (float*)(ws + WS_LOGF); float* CUM = (float*)(ws + WS_CUM); float* GATES = (float*)(ws + WS_GATES); float* KMEAN = (float*)(ws + WS_KMEAN);
    bf16_t* KCMP = (bf16_t*)(ws + WS_KCMP); bf16_t* VCMP = (bf16_t*)(ws + WS_VCMP);
    int* TOKE = (int*)(ws + WS_TOKE); float* TOKW = (float*)(ws + WS_TOKW); int* TOKP = (int*)(ws + WS_TOKP); float* ROWW = (float*)(ws + WS_ROWW);
    bf16_t* WIN_T = (bf16_t*)(ws + WS_WIN); bf16_t* WOUT_T = (bf16_t*)(ws + WS_WOUT); bf16_t* WGU_T = (bf16_t*)(ws + WS_WGU); bf16_t* WDN_T = (bf16_t*)(ws + WS_WDN);
    bf16_t* WPG_T = (bf16_t*)(ws + WS_WPG); bf16_t* WPP_T = (bf16_t*)(ws + WS_WPP); bf16_t* PB = (bf16_t*)(ws + WS_PB);
    bf16_t* QB = (bf16_t*)(ws + WS_Q); bf16_t* KB = (bf16_t*)(ws + WS_K); bf16_t* VB = (bf16_t*)(ws + WS_V); bf16_t* AO = (bf16_t*)(ws + WS_AO);
    bf16_t* PP = (bf16_t*)(ws + WS_PP); bf16_t* QR = (bf16_t*)(ws + WS_PP); bf16_t* HB = (bf16_t*)(ws + WS_H); bf16_t* XG = (bf16_t*)(ws + WS_XG); bf16_t* OUTR = (bf16_t*)(ws + WS_OUTR);
    const int* positions = (const int*)args.in[2];

    if (IN(0)) { PH_IDS();
        for (int i = gtid; i < T * 32; i += NGT) { const int t = i >> 5, f = i & 31;
            const float inv = __builtin_amdgcn_exp2f(-(float)f * (13.287712379549449f / 32.f));
            const double ang = (double)positions[t] * (double)inv; double rev = ang * 0.15915494309189535; rev = rev - floor(rev);
            ROPE_C[i] = __builtin_amdgcn_cosf((float)rev); ROPE_S[i] = __builtin_amdgcn_sinf((float)rev); }
        const float* xin = (const float*)args.in[0];
        for (int i = gtid; i < T * D / 4; i += NGT) { const f32x4 v = ((const f32x4*)xin)[i]; ((f32x4*)X)[i] = v;
            unsigned long long w = (unsigned long long)pk2(v.x, v.y) | ((unsigned long long)pk2(v.z, v.w) << 32); ((unsigned long long*)XBB)[i] = w; }
        SEAM();
    }

    for (int L = 0; L < DEPTH; ++L) {
        const int kind = L % 3, jj = L / 3, gp0 = 1 + L * NPH;
        const float* w_in_src = kind == 0 ? (const float*)args.in[3] + (size_t)jj * D * 3088 : kind == 1 ? (const float*)args.in[6] : (const float*)args.in[15];
        const int ldw_in = kind == 0 ? 3088 : kind == 1 ? 2608 : 3072, ncol_in = kind == 1 ? 2560 : 3072;
        const float* w_out_src = kind == 0 ? (const float*)args.in[5] + (size_t)jj * D * D : kind == 1 ? (const float*)args.in[14] : (const float*)args.in[16];

        if (PH_EN(0) && IN(gp0 + 0)) { PH_IDS();
            LAS float* scr = (LAS float*)(ldsl + wave * 16384);
            const int n_win = 16 * (ncol_in / 32), n_wout = 512, n_gu = 65 * 256, n_dn = 65 * 128, n_pg = 512, n_pp = 128;
            const int NIT = n_win + n_wout + n_gu + n_dn + n_pg + n_pp;
            for (int it = gw; it < NIT; it += NGW) {
                int r = it;
                if (r < n_win) { const int nblk = ncol_in / 32, kb = r / nblk, nb = r % nblk; transpose_item(w_in_src, ldw_in, 64 * kb, 32 * nb, WIN_T, D, 32 * nb, scr, lane); continue; } r -= n_win;
                if (r < n_wout) { const int kb = r / 32, nb = r % 32; transpose_item(w_out_src, D, 64 * kb, 32 * nb, WOUT_T, D, 32 * nb, scr, lane); continue; } r -= n_wout;
                if (r < n_gu) { const int e = r / 256, rr = r % 256, mat = rr / 128, kb = (rr % 128) / 8, nb = rr % 8, n0 = 32 * nb;
                    const float* W = e < 64 ? (const float*)args.in[mat ? 22 : 21] + ((size_t)(L * 64 + e)) * D * ED : (const float*)args.in[mat ? 25 : 24] + (size_t)L * D * ED;
                    transpose_item(W, ED, 64 * kb, n0, WGU_T, D, e * 512 + (n0 / 128) * 256 + mat * 128 + (n0 % 128), scr, lane); continue; } r -= n_gu;
                if (r < n_dn) { const int e = r / 128, rr = r % 128, kb = rr / 32, nb = rr % 32;
                    const float* W = e < 64 ? (const float*)args.in[23] + ((size_t)(L * 64 + e)) * ED * D : (const float*)args.in[26] + (size_t)L * ED * D;
                    transpose_item(W, D, 64 * kb, 32 * nb, WDN_T, ED, e * 1024 + 32 * nb, scr, lane); continue; } r -= n_dn;
                if (r < n_pg) { const int kb = r / 32, nb = r % 32; transpose_item((const float*)args.in[29] + (size_t)L * D * D, D, 64 * kb, 32 * nb, WPG_T, D, 32 * nb, scr, lane); continue; } r -= n_pg;
                { const int kb = r / 32, nb = r % 32; transpose_item((const float*)args.in[30] + (size_t)L * PLE * D, D, 64 * kb, 32 * nb, WPP_T, PLE, 32 * nb, scr, lane); }
            }
            { const float* psrc = (const float*)args.in[1] + (size_t)L * T * PLE;
              for (int i = gtid; i < T * PLE / 4; i += NGT) { const f32x4 v = ((const f32x4*)psrc)[i];
                  ((unsigned long long*)PB)[i] = (unsigned long long)pk2(v.x, v.y) | ((unsigned long long)pk2(v.z, v.w) << 32); } }
            if (kind != 2) {
                const int npass = kind == 0 ? 1 : 3; const int colbase = kind == 0 ? 3072 : 2560;
                const float* bsrc = kind == 0 ? (const float*)args.in[4] + jj * 16 : (const float*)args.in[7];
                LAS float* wl = (LAS float*)ldsl;
                for (int ps = 0; ps < npass; ++ps) {
                    __syncthreads();
                    for (int i = tid; i < D * 16; i += NTHR) wl[i] = w_in_src[(size_t)(i >> 4) * ldw_in + colbase + ps * 16 + (i & 15)];
                    __syncthreads();
                    for (int row = gw; row < T; row += NGW) {
                        float acc[16];
#pragma unroll
                        for (int c = 0; c < 16; ++c) acc[c] = 0.f;
#pragma unroll 4
                        for (int q = 0; q < 16; ++q) { const int k = lane + 64 * q; const float xv = X[(size_t)row * D + k]; const LAS f32x4* w4 = (const LAS f32x4*)(wl + k * 16);
#pragma unroll
                            for (int c4 = 0; c4 < 4; ++c4) { const f32x4 w = w4[c4]; acc[c4 * 4 + 0] += xv * w.x; acc[c4 * 4 + 1] += xv * w.y; acc[c4 * 4 + 2] += xv * w.z; acc[c4 * 4 + 3] += xv * w.w; } }
                        float mine = 0.f;
#pragma unroll
                        for (int c = 0; c < 16; ++c) { const float sacc = wave_sum(acc[c]); mine = (lane == c) ? sacc : mine; }
                        if (lane < 16) { const float z = mine + bsrc[ps * 16 + lane];
                            if (kind == 0) LOGF[(size_t)row * 16 + lane] = fminf(z, 0.f) - __logf(1.f + __expf(-fabsf(z)));
                            else GATES[(size_t)row * 48 + ps * 16 + lane] = sigmoidf_(z); }
                    }
                }
            }
            SEAM();
        }

        if (PH_EN(1) && IN(gp0 + 1)) { PH_IDS();
            pg8::Gemm g{XBB, WIN_T, T, ncol_in, D}; pg8::StaticOrder So; So.init(T, ncol_in, G, bx);
            epi::Qkv E{QB, 1024, D, KB, kind == 1 ? 256 : 1024, kind == 1 ? 256 : 1024, kind == 1 ? (size_t)(4 * MiB) : (size_t)(16 * MiB), 1.f};
            pg8::gemm_phase<epi::Qkv, pg8::StaticOrder, true, true>(ldsl, g, So, E);
            SEAM();
        }

        if (PH_EN(2) && IN(gp0 + 2)) { PH_IDS();
            if (kind == 0) {
                LAS double* wsum = (LAS double*)ldsl;
                for (int bh = bx; bh < Bn * NH; bh += G) { const int b = bh / NH, h = bh % NH;
                    double loc[16]; double run = 0.0;
#pragma unroll
                    for (int i = 0; i < 16; ++i) { run += (double)LOGF[((size_t)b * S + tid * 16 + i) * 16 + h]; loc[i] = run; }
                    double sc = run;
#pragma unroll
                    for (int o = 1; o < 64; o <<= 1) { const double up = __shfl_up(sc, o); if (lane >= o) sc += up; }
                    __syncthreads();
                    if (lane == 63) wsum[wave] = sc;
                    __syncthreads();
                    double pre = sc - run;
                    for (int w = 0; w < wave; ++w) pre += wsum[w];
#pragma unroll
                    for (int i = 0; i < 16; ++i) CUM[(size_t)bh * S + tid * 16 + i] = (float)(pre + loc[i]);
                }
            } else {
                const size_t st6 = 4 * MiB;
                for (int pass = 0; pass < (kind == 1 ? 3 : 2); ++pass) {
                    const bf16_t* src; bf16_t* dst; int nhd;
                    if (kind == 1) { if (pass == 0) { src = QB; dst = QR; nhd = 16; } else if (pass == 1) { src = KB + 2 * st6; dst = KB + 2 * st6; nhd = 4; } else { src = KB + 4 * st6; dst = KB + 4 * st6; nhd = 4; } }
                    else { if (pass == 0) { src = QB; dst = QB; } else { src = KB; dst = KB; } nhd = 16; }
                    const int per_row = nhd * 4, total = T * per_row;
                    for (int i = gtid; i < total; i += NGT) { const int t = i / per_row, r = i % per_row, hd = r >> 2, fq = r & 3;
                        const size_t o1 = (size_t)t * (nhd * 64) + hd * 64 + 8 * fq;
                        const uint4 a = *(const uint4*)(src + o1), bq = *(const uint4*)(src + o1 + 32);
                        const f32x4 c0 = *(const f32x4*)(ROPE_C + t * 32 + 8 * fq), c1 = *(const f32x4*)(ROPE_C + t * 32 + 8 * fq + 4);
                        const f32x4 s0 = *(const f32x4*)(ROPE_S + t * 32 + 8 * fq), s1 = *(const f32x4*)(ROPE_S + t * 32 + 8 * fq + 4);
                        uint4 oa, ob;
#define ROPE2(W, CA, CB, SA, SB) { const float x1l = bflo(a.W), x1h = bfhi(a.W), x2l = bflo(bq.W), x2h = bfhi(bq.W); \
                            oa.W = pk2(x1l * CA - x2l * SA, x1h * CB - x2h * SB); ob.W = pk2(x2l * CA + x1l * SA, x2h * CB + x1h * SB); }
                        ROPE2(x, c0.x, c0.y, s0.x, s0.y) ROPE2(y, c0.z, c0.w, s0.z, s0.w) ROPE2(z, c1.x, c1.y, s1.x, s1.y) ROPE2(w, c1.z, c1.w, s1.z, s1.w)
#undef ROPE2
                        *(uint4*)(dst + o1) = oa; *(uint4*)(dst + o1 + 32) = ob; }
                }
            }
            SEAM();
        }

        if (PH_EN(3) && IN(gp0 + 3)) { PH_IDS();
            if (kind == 1) {
                const size_t st6 = 4 * MiB;
                float* xs = (float*)(lds + wave * 16384);
                float* hb = xs + 48 * 64;
                for (int task = gw; task < 2 * Bn * NSA_G * 256; task += NGW) {
                    const int i2 = task & 255, g = (task >> 8) & 3, b = (task >> 10) & 1, kv = task >> 11;
                    const bf16_t* src = KB + (size_t)kv * st6;
                    const float* pe = (const float*)args.in[kv ? 9 : 8]; const float* w1 = (const float*)args.in[kv ? 12 : 10]; const float* w2 = (const float*)args.in[kv ? 13 : 11];
                    const int tok0 = 32 * i2;
                    for (int q = 0; q < 48; ++q) { int tk = tok0 + q; tk = tk < S ? tk : S - 1; xs[q * 64 + lane] = bf2f(src[((size_t)b * S + tk) * 256 + g * 64 + lane]); }
                    WAVE_SYNC();
                    float a00 = 0.f, a01 = 0.f, a10 = 0.f, a11 = 0.f;
                    for (int l = 0; l < 32; ++l) {
#pragma unroll 4
                        for (int d = 0; d < 64; ++d) { const float pv = pe[l * 64 + d]; const float x0 = xs[l * 64 + d] + pv, x1 = xs[(l + 16) * 64 + d] + pv;
                            const float wa = w1[(size_t)(l * 64 + d) * 128 + lane], wb = w1[(size_t)(l * 64 + d) * 128 + 64 + lane];
                            a00 += x0 * wa; a01 += x0 * wb; a10 += x1 * wa; a11 += x1 * wb; }
                    }
                    hb[lane] = gelu_tanh(a00); hb[64 + lane] = gelu_tanh(a01); hb[128 + lane] = gelu_tanh(a10); hb[192 + lane] = gelu_tanh(a11);
                    WAVE_SYNC();
                    float o0 = 0.f, o1 = 0.f;
#pragma unroll 4
                    for (int hu = 0; hu < 128; ++hu) { const float w = w2[hu * 64 + lane]; o0 += hb[hu] * w; o1 += hb[128 + hu] * w; }
                    bf16_t* dst = (kv ? VCMP : KCMP) + (((size_t)(b * NSA_G + g)) * NCMP + 2 * i2) * 64;
                    dst[lane] = (bf16_t)f2bf(o0); dst[64 + lane] = (bf16_t)f2bf(o1);
                    WAVE_SYNC();
                }
            } else if (kind == 2) {
                for (int item = gw; item < Bn * NH * 32; item += NGW) { const int blk = item & 31, bh = item >> 5, b = bh / NH, h = bh % NH;
                    float s = 0.f;
                    for (int r = 0; r < 256; ++r) s += bf2f(KB[((size_t)b * S + blk * 256 + r) * D + h * 64 + lane]);
                    KMEAN[(size_t)item * 64 + lane] = s * (1.f / 256.f); }
            }
            SEAM();
        }

        if (PH_EN(4) && IN(gp0 + 4)) { PH_IDS();
            float* wl = (float*)(lds + wave * 14336);
            float* qs = wl; float* qs2 = wl + 256; float* pb = wl + 512; int* kb = (int*)(wl + 512 + 2048); float* misc = wl + 512 + 2048 + 512;
            if (kind == 0) {
                for (int task = gw; task < T * NH; task += NGW) {
                    const int t = task % S, bh = task / S, h = bh % NH, b = bh / NH; const size_t row = (size_t)b * S + t;
                    qs[lane] = bf2f(QB[row * D + h * 64 + lane]);
                    const float* cum = CUM + (size_t)bh * S; const float cq = cum[t];
                    WAVE_SYNC();
                    float m[1] = {NEGF}, l[1] = {0.f}, o[1] = {0.f};
                    for (int c0 = 0; c0 <= t; c0 += 512) {
                        attend_chunk<1>(qs, pb, kb, KB + h * 64, VB + h * 64, D, 512,
                            [=](int slot) { const int kk = c0 + slot; return kk <= t ? (int)(b * S + kk) : -1; },
                            [=](int slot) { return cq - cum[c0 + slot]; }, ATT_SCALE, m, l, o, lane);
                    }
                    AO[row * D + h * 64 + lane] = (bf16_t)f2bf(o[0] / fmaxf(l[0], 1e-30f));
                }
            } else if (kind == 1) {
                const size_t st6 = 4 * MiB;
                float* Pn = misc;
                for (int task = gw; task < T * NSA_G; task += NGW) {
                    const int t = task % S, bg = task / S, g = bg % NSA_G, b = bg / NSA_G; const size_t row = (size_t)b * S + t;
#pragma unroll
                    for (int h = 0; h < 4; ++h) { qs[h * 64 + lane] = bf2f(QB[row * D + (g * 4 + h) * 64 + lane]); qs2[h * 64 + lane] = bf2f(QR[row * D + (g * 4 + h) * 64 + lane]); }
                    WAVE_SYNC();
                    float oc[4], os[4], ow[4];
                    const int nvalid = t >= 31 ? ((t - 31) >> 4) + 1 : 0;
                    {
                        float m[4] = {NEGF, NEGF, NEGF, NEGF}, l[4] = {0.f, 0.f, 0.f, 0.f}; oc[0] = oc[1] = oc[2] = oc[3] = 0.f;
                        attend_chunk<4>(qs, pb, kb, KCMP + (size_t)bg * NCMP * 64, VCMP + (size_t)bg * NCMP * 64, 64, 512,
                            [=](int slot) { return slot < nvalid ? slot : -1; }, [=](int) { return 0.f; }, ATT_SCALE, m, l, oc, lane);
                        float il[4];
#pragma unroll
                        for (int h = 0; h < 4; ++h) { il[h] = 1.f / fmaxf(l[h], 1e-30f); oc[h] *= il[h]; }
                        for (int i = 0; i < 8; ++i) { const int n = lane + 64 * i; Pn[n] = pb[n] * il[0] + pb[512 + n] * il[1] + pb[1024 + n] * il[2] + pb[1536 + n] * il[3]; }
                        WAVE_SYNC();
                    }
                    const int cur = t >> 6;
                    float pri0, pri1;
                    {
                        float imp[2];
#pragma unroll
                        for (int c = 0; c < 2; ++c) { const int j = lane + 64 * c; float a = 0.f;
#pragma unroll
                            for (int dn = -1; dn <= 3; ++dn) { const int n = 4 * j + dn; if (n >= 0 && n < 511) a += Pn[n]; }
                            imp[c] = a; }
                        const int j0 = lane, j1 = lane + 64;
                        const bool f0 = (j0 == 0) || (j0 == cur) || (j0 == cur - 1), f1 = (j1 == 0) || (j1 == cur) || (j1 == cur - 1);
                        pri0 = f0 ? imp[0] + 1e4f : imp[0]; pri1 = f1 ? imp[1] + 1e4f : imp[1];
                        pri0 = j0 <= cur ? pri0 : NEGF; pri1 = j1 <= cur ? pri1 : NEGF;
                    }
                    float* pri = (float*)kb;
                    int* sidx = kb + 128;
                    pri[lane] = pri0; pri[lane + 64] = pri1;
                    WAVE_SYNC();
                    int rk0 = 0, rk1 = 0;
                    for (int i = 0; i < 128; ++i) { const float pi = pri[i]; rk0 += (pi > pri0 || (pi == pri0 && i < lane)) ? 1 : 0; rk1 += (pi > pri1 || (pi == pri1 && i < lane + 64)) ? 1 : 0; }
                    const bool s0 = (lane <= cur) && rk0 < 16, s1 = (lane + 64 <= cur) && rk1 < 16;
                    const unsigned long long b0 = __ballot(s0), b1 = __ballot(s1);
                    const unsigned long long lt = (1ull << lane) - 1ull;
                    const int n0 = __popcll(b0);
                    WAVE_SYNC();
                    if (lane < 16) sidx[lane] = -1;
                    WAVE_SYNC();
                    if (s0) sidx[__popcll(b0 & lt)] = lane;
                    if (s1) sidx[n0 + __popcll(b1 & lt)] = lane + 64;
                    WAVE_SYNC();
                    int myblk = sidx[lane & 15];
                    {
                        float m[4] = {NEGF, NEGF, NEGF, NEGF}, l[4] = {0.f, 0.f, 0.f, 0.f}; os[0] = os[1] = os[2] = os[3] = 0.f;
                        const bf16_t* Ks = KB + 2 * st6 + g * 64; const bf16_t* Vs = KB + 3 * st6 + g * 64;
                        for (int c = 0; c < 2; ++c) {
                            attend_chunk<4>(qs2, pb, kb, Ks, Vs, 256, 512,
                                [=](int slot) { const int j = __shfl(myblk, c * 8 + (slot >> 6)); const int kk = j * 64 + (slot & 63); return (j >= 0 && kk <= t) ? (int)(b * S + kk) : -1; },
                                [=](int) { return 0.f; }, ATT_SCALE, m, l, os, lane);
                        }
#pragma unroll
                        for (int h = 0; h < 4; ++h) os[h] /= fmaxf(l[h], 1e-30f);
                    }
                    {
                        float m[4] = {NEGF, NEGF, NEGF, NEGF}, l[4] = {0.f, 0.f, 0.f, 0.f}; ow[0] = ow[1] = ow[2] = ow[3] = 0.f;
                        const bf16_t* Kw = KB + 4 * st6 + g * 64; const bf16_t* Vw = KB + 5 * st6 + g * 64;
                        attend_chunk<4>(qs2, pb, kb, Kw, Vw, 256, 512,
                            [=](int slot) { const int kk = t - 511 + slot; return kk >= 0 ? (int)(b * S + kk) : -1; },
                            [=](int) { return 0.f; }, ATT_SCALE, m, l, ow, lane);
#pragma unroll
                        for (int h = 0; h < 4; ++h) ow[h] /= fmaxf(l[h], 1e-30f);
                    }
#pragma unroll
                    for (int h = 0; h < 4; ++h) { const float* gt = GATES + row * 48 + (g * 4 + h) * 3;
                        AO[row * D + (g * 4 + h) * 64 + lane] = (bf16_t)f2bf(gt[0] * oc[h] + gt[1] * os[h] + gt[2] * ow[h]); }
                }
            } else {
                for (int task = gw; task < T * NH; task += NGW) {
                    const int t = task % S, bh = task / S, h = bh % NH, b = bh / NH; const size_t row = (size_t)b * S + t;
                    qs[lane] = bf2f(QB[row * D + h * 64 + lane]);
                    WAVE_SYNC();
                    const int cb = t >> 8;
                    float gs = NEGF;
                    if (lane < cb) { const float* km = KMEAN + ((size_t)bh * 32 + lane) * 64; float a = 0.f;
#pragma unroll 8
                        for (int d = 0; d < 64; ++d) a += qs[d] * km[d];
                        gs = a; }
                    if (lane >= 32) gs = -3e30f;
                    int sel[3];
#pragma unroll
                    for (int r = 0; r < 3; ++r) { const float mx = wave_max(gs); const unsigned long long bm = __ballot(gs == mx); const int win = __ffsll((long long)bm) - 1;
                        sel[r] = (win < cb) ? win : -1; if (lane == win) gs = -3e30f; }
                    float m[1] = {NEGF}, l[1] = {0.f}, o[1] = {0.f};
                    for (int c = 0; c < 2; ++c) {
                        const int blk0 = c == 0 ? sel[0] : sel[2], blk1 = c == 0 ? sel[1] : cb;
                        attend_chunk<1>(qs, pb, kb, KB + h * 64, VB + h * 64, D, 512,
                            [=](int slot) { const int blk = slot < 256 ? blk0 : blk1; const int kk = blk * 256 + (slot & 255); return (blk >= 0 && kk <= t) ? (int)(b * S + kk) : -1; },
                            [=](int) { return 0.f; }, ATT_SCALE, m, l, o, lane);
                    }
                    AO[row * D + h * 64 + lane] = (bf16_t)f2bf(o[0] / fmaxf(l[0], 1e-30f));
                }
            }
            SEAM();
        }

        if (PH_EN(5) && IN(gp0 + 5)) { PH_IDS();
            pg8::Gemm g{AO, WOUT_T, T, D, D}; pg8::StaticOrder So; So.init(T, D, G, bx);
            epi::Res E{X, D, DN_ALPHA};
            pg8::gemm_phase<epi::Res, pg8::StaticOrder, true, true>(ldsl, g, So, E);
            SEAM();
        }

        if (PH_EN(6) && IN(gp0 + 6)) { PH_IDS();
            float* xs = (float*)(lds + wave * 16384);
            const float* g1 = (const float*)args.in[17] + L * D; const float* b1 = (const float*)args.in[18] + L * D;
            const float* Wr = (const float*)args.in[19] + (size_t)L * D * NE; const float* rb = (const float*)args.in[20] + L * NE;
            unsigned* cnt = (unsigned*)(ctl + CW_CNT + L * 64);
            for (int base = gw * 4; base < T; base += NGW * 4) {
#pragma unroll
                for (int r = 0; r < 4; ++r) { const size_t row = base + r; f32x4 v[4];
#pragma unroll
                    for (int j = 0; j < 4; ++j) v[j] = *(const f32x4*)(X + row * D + 4 * lane + 256 * j);
                    ln_row(v, g1, b1, lane);
#pragma unroll
                    for (int j = 0; j < 4; ++j) { *(f32x4*)(X + row * D + 4 * lane + 256 * j) = v[j]; *(f32x4*)(xs + r * 1024 + 4 * lane + 256 * j) = v[j];
                        *(unsigned long long*)(XBA + row * D + 4 * lane + 256 * j) = (unsigned long long)pk2(v[j].x, v[j].y) | ((unsigned long long)pk2(v[j].z, v[j].w) << 32); } }
                WAVE_SYNC();
                float lg[4] = {0.f, 0.f, 0.f, 0.f};
#pragma unroll 2
                for (int k = 0; k < D; k += 4) { const float w0 = Wr[(k + 0) * 64 + lane], w1 = Wr[(k + 1) * 64 + lane], w2 = Wr[(k + 2) * 64 + lane], w3 = Wr[(k + 3) * 64 + lane];
#pragma unroll
                    for (int r = 0; r < 4; ++r) { const f32x4 xv = *(const f32x4*)(xs + r * 1024 + k); lg[r] += xv.x * w0 + xv.y * w1 + xv.z * w2 + xv.w * w3; } }
                const float rbl = rb[lane];
#pragma unroll
                for (int r = 0; r < 4; ++r) { const size_t row = base + r;
                    const float sc = sigmoidf_(lg[r]); const float bi = sc + rbl;
                    float m1 = bi; m1 = fmaxf(m1, __shfl_xor(m1, 1)); m1 = fmaxf(m1, __shfl_xor(m1, 2)); m1 = fmaxf(m1, __shfl_xor(m1, 4));
                    int cand = (bi == m1) ? lane : 64; cand = min(cand, __shfl_xor(cand, 1)); cand = min(cand, __shfl_xor(cand, 2)); cand = min(cand, __shfl_xor(cand, 4));
                    float m2 = (lane == cand) ? -3e38f : bi; m2 = fmaxf(m2, __shfl_xor(m2, 1)); m2 = fmaxf(m2, __shfl_xor(m2, 2)); m2 = fmaxf(m2, __shfl_xor(m2, 4));
                    const float gsc = m1 + m2; const int grp = lane >> 3; int grank = 0;
#pragma unroll
                    for (int gg = 0; gg < 8; ++gg) { const float og = __shfl(gsc, gg * 8); grank += (og > gsc || (og == gsc && gg < grp)) ? 1 : 0; }
                    const bool gsel = grank < 4; const float v = gsel ? bi : NEGF; int rk = 0;
#pragma unroll 8
                    for (int e2 = 0; e2 < 64; ++e2) { const float oe = __shfl(v, e2); rk += (oe > v || (oe == v && e2 < lane)) ? 1 : 0; }
                    const bool sel = gsel && rk < 8;
                    const float ssum = wave_sum(sel ? sc : 0.f);
                    if (sel) { const unsigned pos = atomicAdd(cnt + lane, 1u); TOKE[row * 8 + rk] = lane; TOKW[row * 8 + rk] = sc / ssum * 2.5f; TOKP[row * 8 + rk] = (int)pos; }
                }
                WAVE_SYNC();
            }
            SEAM();
        }

        if (IN(gp0 + 7) || IN(gp0 + 8) || IN(gp0 + 9)) { PH_IDS();
            __syncthreads();
            if (tid <= 64) { const unsigned* cnt = (const unsigned*)(ctl + CW_CNT + L * 64); int s = 0;
                for (int e = 0; e < tid; ++e) s += (int)((__hip_atomic_load(cnt + e, RLX_AGENT) + 255u) >> 8);
                TAB[tid] = s; }
            __syncthreads();
        }

        if (PH_EN(7) && IN(gp0 + 7)) { PH_IDS();
            for (int idx = gw; idx < T * TOPK; idx += NGW) { const int t = idx >> 3; const int e = TOKE[idx], pos = TOKP[idx]; const int dest = TAB[e] * 256 + pos;
                const uint4* s = (const uint4*)(XBA + (size_t)t * D); uint4* d = (uint4*)(XG + (size_t)dest * D);
                const uint4 a = s[lane], bq = s[lane + 64]; d[lane] = a; d[lane + 64] = bq;
                if (lane == 0) { ROWW[dest] = TOKW[idx]; }
                WAVE_SYNC();
                if (lane == 0) TOKP[idx] = dest; }
            SEAM();
        }

        if (PH_EN(8) && IN(gp0 + 8)) { PH_IDS();
            const int nrt = 64 + TAB[64];
            pg8::Gemm g{XBA, WGU_T, 0, 0, D}; MoeOrder So{TAB, 2, G, bx, nrt * 2, XG_TILE0};
            epi::SwiGlu E{HB, XG_TILE0};
            pg8::gemm_phase<epi::SwiGlu, MoeOrder, true, true>(ldsl, g, So, E);
            SEAM();
        }

        if (PH_EN(9) && IN(gp0 + 9)) { PH_IDS();
            const int nrt = 64 + TAB[64];
            int kdn = ED; asm volatile("" : "+s"(kdn)); pg8::Gemm g{HB, WDN_T, 0, 0, kdn}; MoeOrder So{TAB, 4, G, bx, nrt * 4, 64};
            epi::Down E{OUTR, ROWW};
            pg8::gemm_phase<epi::Down, MoeOrder, true, true>(ldsl, g, So, E);
            SEAM();
        }

        if (PH_EN(10) && IN(gp0 + 10)) { PH_IDS();
            const float* g2 = (const float*)args.in[27] + L * D; const float* b2 = (const float*)args.in[28] + L * D;
            for (int row = gw; row < T; row += NGW) {
                f32x4 v[4];
#pragma unroll
                for (int j = 0; j < 4; ++j) v[j] = *(const f32x4*)(X + (size_t)row * D + 4 * lane + 256 * j) * DN_ALPHA;
                {
                    const bf16_t* o = OUTR + (size_t)row * D;
#pragma unroll
                    for (int j = 0; j < 4; ++j) { const uint2 w = *(const uint2*)(o + 4 * lane + 256 * j); v[j].x += bflo(w.x); v[j].y += bfhi(w.x); v[j].z += bflo(w.y); v[j].w += bfhi(w.y); }
                }
                for (int k = 0; k < TOPK; ++k) { const int dest = TOKP[row * 8 + k]; const bf16_t* o = OUTR + ((size_t)T + dest) * D;
#pragma unroll
                    for (int j = 0; j < 4; ++j) { const uint2 w = *(const uint2*)(o + 4 * lane + 256 * j); v[j].x += bflo(w.x); v[j].y += bfhi(w.x); v[j].z += bflo(w.y); v[j].w += bfhi(w.y); } }
                ln_row(v, g2, b2, lane);
#pragma unroll
                for (int j = 0; j < 4; ++j) { *(f32x4*)(X + (size_t)row * D + 4 * lane + 256 * j) = v[j];
                    *(unsigned long long*)(XBA + (size_t)row * D + 4 * lane + 256 * j) = (unsigned long long)pk2(v[j].x, v[j].y) | ((unsigned long long)pk2(v[j].z, v[j].w) << 32); }
            }
            SEAM();
        }

        if (PH_EN(11) && IN(gp0 + 11)) { PH_IDS();
            int kpp = PLE; asm volatile("" : "+s"(kpp)); pg8::Gemm g{PB, WPP_T, T, D, kpp}; pg8::StaticOrder So; So.init(T, D, G, bx);
            epi::StoreBf16 E{PP, D};
            pg8::gemm_phase<epi::StoreBf16, pg8::StaticOrder, true, true>(ldsl, g, So, E);
            SEAM();
        }

        if (PH_EN(12) && IN(gp0 + 12)) { PH_IDS();
            pg8::Gemm g{XBA, WPG_T, T, D, D}; pg8::StaticOrder So; So.init(T, D, G, bx);
            epi::Ple E{X, PP, L == DEPTH - 1 ? args.out : X, XBB};
            pg8::gemm_phase<epi::Ple, pg8::StaticOrder, true, true>(ldsl, g, So, E);
            if (L != DEPTH - 1) SEAM();
        }
    }
#undef SEAM
#undef IN
}

extern "C" void kernel_launch(void* const* d_in, const int* in_sizes, int n_in, void* d_out, int out_size, void* d_ws, size_t ws_size, hipStream_t stream) {
    static int grid = 0;
    if (grid == 0) {
        if (n_in != 31 || out_size != T * D || ws_size < WS_END) { fprintf(stderr, "kernel_launch: unexpected problem (n_in %d, out %d, ws %zu < %zu)\n", n_in, out_size, ws_size, (size_t)WS_END); grid = -1; return; }
        int dev = 0, cus = 0, per_cu = 0;
        if (hipGetDevice(&dev) != hipSuccess || hipDeviceGetAttribute(&cus, hipDeviceAttributeMultiprocessorCount, dev) != hipSuccess) { grid = -1; return; }
        if (hipFuncSetAttribute((const void*)mk_fwd, hipFuncAttributeMaxDynamicSharedMemorySize, LDS_BYTES) != hipSuccess) { fprintf(stderr, "kernel_launch: hipFuncSetAttribute failed\n"); grid = -1; return; }
        if (hipOccupancyMaxActiveBlocksPerMultiprocessor(&per_cu, (const void*)mk_fwd, NTHR, LDS_BYTES) != hipSuccess || per_cu < 1) fprintf(stderr, "kernel_launch: occupancy query says %d\n", per_cu);
        (void)hipGetLastError();
        grid = cus;
    }
    if (grid < 0) return;
    (void)hipMemsetAsync((char*)d_ws + WS_CTL, 0, CTL_ZERO_BYTES, stream);
    Args a{};
    for (int i = 0; i < 31; ++i) a.in[i] = d_in[i];
    a.out = (float*)d_out; a.ws = (unsigned char*)d_ws;
#if MK_MULTI
    const int nph = 1 + DEPTH * NPH;
    for (int p = 0; p < nph; ++p) { a.ph_lo = p; a.ph_hi = p + 1; hipLaunchKernelGGL(mk_fwd, dim3(grid), dim3(NTHR), LDS_BYTES, stream, a); }
#else
    a.ph_lo = 0; a.ph_hi = 1 + DEPTH * NPH;
    hipLaunchKernelGGL(mk_fwd, dim3(grid), dim3(NTHR), LDS_BYTES, stream, a);
#endif
}
```

```cpp
#define MK_MULTI 0
#define OUTR_FP8 1
#include <hip/hip_runtime.h>
#include <cstdio>
#include <cstdint>
namespace pg8 {
#define PG8_LAS __attribute__((address_space(3)))
typedef unsigned short bf16_t;
typedef short bf16x8 __attribute__((ext_vector_type(8)));
typedef float f32x4 __attribute__((ext_vector_type(4)));
typedef unsigned u32x4 __attribute__((ext_vector_type(4)));
constexpr int BM = 256, BK = 64, HALF = 128, HTB = HALF * BK * 2  , STAGE_BYTES = 8 * HTB, NXCD = 8, WGM = 8;

__host__ __device__ __forceinline__ int lds_byte(int r, int c) { const int st = (r >> 4) * 2 + (c >> 5), rr = r & 15, cc = c & 31, ob = rr * 64 + cc * 2; return st * 1024 + (ob ^ (((ob >> 9) & 1) << 5)); }
__host__ __device__ __forceinline__ void stage_rc(int b, int& R, int& C) { const int st = b / 1024, sb = b % 1024, swz = sb ^ (((sb >> 9) & 1) << 5); R = (st >> 1) * 16 + swz / 64; C = (st & 1) * 32 + (swz % 64) / 2; }
__host__ __device__ __forceinline__ int perm32(int rho) { const int n = rho >> 4, i = rho & 15; return 8 * (i >> 2) + 4 * n + (i & 3); }

struct Unit { int pm, pn; long aofs; };
struct Gemm { const bf16_t* A; const bf16_t* Bt; int M, N, K; int lda, kstepA; const int* gidx; };

struct StaticOrder {
    int nM, nN, nwg, G, c;
    __host__ __device__ void init(int M, int N, int G_, int c_) { nM = M / BM; nN = N / BM; nwg = nM * nN; G = G_; c = c_; }
    __host__ __device__ bool next(int i, Unit& u) const {
        const long L = (long)i * G + c; if (L >= nwg) return false;
        int wgid = (int)L; { const int q = nwg / NXCD, r = nwg % NXCD, xcd = wgid % NXCD, off = wgid / NXCD; wgid = (xcd < r ? xcd * (q + 1) : r * (q + 1) + (xcd - r) * q) + off; }
        const int nig = WGM * nN, gid = wgid / nig, fm = gid * WGM, gsz = (nM - fm) < WGM ? (nM - fm) : WGM;
        u.pm = fm + ((wgid % nig) % gsz); u.pn = (wgid % nig) / gsz; u.aofs = 0; return true;
    }
    __device__ __forceinline__ void a_ready(const Unit&) const {}
    __device__ __forceinline__ void done(const Unit&) const {}
};

__device__ __forceinline__ unsigned cvt_pk_bf16(float lo, float hi) { unsigned r; asm volatile("v_cvt_pk_bf16_f32 %0, %1, %2" : "=v"(r) : "v"(lo), "v"(hi)); return r; }
typedef float f32x2 __attribute__((ext_vector_type(2)));
__device__ __forceinline__ f32x2 gelu_pk(f32x2 v) {
    const f32x2 av = __builtin_elementwise_abs(v), d = av * 0.2316418882f + 1.0f;
    f32x2 t; t.x = __builtin_amdgcn_rcpf(d.x); t.y = __builtin_amdgcn_rcpf(d.y);
    f32x2 q = t * 0.5307027145f + (-0.7265760135f); q = q * t + 0.7107068705f; q = q * t + (-0.142248368f); q = q * t + 0.127414796f; q = q * t;
    const f32x2 s = (v * v) * (-0.72134752044f);
    f32x2 e; e.x = __builtin_amdgcn_exp2f(s.x); e.y = __builtin_amdgcn_exp2f(s.y);
    const f32x2 m = v * (q * e), r = v - m;
    f32x2 o; o.x = v.x < 0.f ? m.x : r.x; o.y = v.y < 0.f ? m.y : r.y; return o;
}

template <int ACT  > struct EpiBf16 {
    static constexpr bool PERM = true, AFTER_DRAIN = false; static_assert(ACT == 0 || ACT == 1, "EpiBf16: ACT is 0 (none) or 1 (gelu_pk)");
    bf16_t* O; int ldc; const float* bias; int split_cols; size_t split_stride; float scale0;
    __device__ __forceinline__ void operator()(const f32x4 (&acc)[2][2][4][2], const Unit& u, int wr, int wc, int fr, int fq) const {
        const int row0 = u.pm * BM + wr * 64 + fr; int colt = u.pn * BM; bf16_t* base = O;
        float sc = 1.f; if (split_cols) { const int t = colt / split_cols; base += (size_t)t * split_stride; colt -= t * split_cols; if (t == 0) sc = scale0; }
        const int col0 = colt + wc * 32 + 8 * fq, bcol0 = u.pn * BM + wc * 32 + 8 * fq;
        f32x4 bv[2][2];
#pragma unroll
        for (int bj = 0; bj < 2; ++bj)
#pragma unroll
            for (int n = 0; n < 2; ++n) bv[bj][n] = bias ? *(const f32x4*)(bias + bcol0 + bj * HALF + 4 * n) : (f32x4){0.f, 0.f, 0.f, 0.f};
#pragma unroll
        for (int ai = 0; ai < 2; ++ai)
#pragma unroll
            for (int m = 0; m < 4; ++m) { bf16_t* rowp = base + (size_t)(row0 + ai * HALF + m * 16) * ldc + col0;
#pragma unroll
                for (int bj = 0; bj < 2; ++bj) { f32x4 v0 = acc[ai][bj][m][0] + bv[bj][0], v1 = acc[ai][bj][m][1] + bv[bj][1];
                    if (ACT == 1) { f32x2 a = gelu_pk((f32x2){v0[0], v0[1]}), b = gelu_pk((f32x2){v0[2], v0[3]}), c = gelu_pk((f32x2){v1[0], v1[1]}), d = gelu_pk((f32x2){v1[2], v1[3]});
                        v0 = (f32x4){a.x, a.y, b.x, b.y}; v1 = (f32x4){c.x, c.y, d.x, d.y}; }
                    v0 = v0 * sc; v1 = v1 * sc; u32x4 w; w.x = cvt_pk_bf16(v0[0], v0[1]); w.y = cvt_pk_bf16(v0[2], v0[3]); w.z = cvt_pk_bf16(v1[0], v1[1]); w.w = cvt_pk_bf16(v1[2], v1[3]);
                    *(u32x4*)(rowp + bj * HALF) = w; } }
    }
};

struct PanelStats {
    unsigned* xbuf;
    unsigned* cnt;
    unsigned* tmo;
    int ntn; float eps;
    unsigned code;
    __device__ __forceinline__ bool run(const f32x4 (&v)[2][2][4][2], const Unit& u, int wr, int wc, int fr, int fq, PG8_LAS unsigned char* lds, int wid, int lane) const {
        typedef float f32x2v __attribute__((ext_vector_type(2)));
        PG8_LAS f32x2v* P = (PG8_LAS f32x2v*)lds;
        PG8_LAS f32x2v* S = (PG8_LAS f32x2v*)(lds + 8192);
        PG8_LAS unsigned* flag = (PG8_LAS unsigned*)(lds + 8192 + 2048);
#pragma unroll
        for (int ai = 0; ai < 2; ++ai)
#pragma unroll
            for (int m = 0; m < 4; ++m) {
                float s = 0.f;
#pragma unroll
                for (int bj = 0; bj < 2; ++bj)
#pragma unroll
                    for (int n = 0; n < 2; ++n) { const f32x4 x = v[ai][bj][m][n]; s += (x[0] + x[1]) + (x[2] + x[3]); }
                s += __shfl_xor(s, 16); s += __shfl_xor(s, 32);
                const float mw = s * (1.0f / 64.0f); float q = 0.f;
#pragma unroll
                for (int bj = 0; bj < 2; ++bj)
#pragma unroll
                    for (int n = 0; n < 2; ++n) { const f32x4 d = v[ai][bj][m][n] - mw; q += (d[0] * d[0] + d[1] * d[1]) + (d[2] * d[2] + d[3] * d[3]); }
                q += __shfl_xor(q, 16); q += __shfl_xor(q, 32);
                if (fq == 0) P[(ai * HALF + wr * 64 + m * 16 + fr) * 4 + wc] = (f32x2v){mw, q};
            }
        asm volatile("s_waitcnt lgkmcnt(0)" ::: "memory"); __builtin_amdgcn_s_barrier(); asm volatile("" ::: "memory");
#if defined(BROKEN_EXCHANGE_NO_WAIT)
#warning BROKEN CONTROL BUILD: the row-statistics exchange does not wait; results are wrong by design
        if (blockIdx.x >= 64) { const long long t0_ = clock64(); while (clock64() - t0_ < 60000) __builtin_amdgcn_s_sleep(8); }
#endif
        const int row = wid * 32 + (lane & 31);
        if (lane < 32) {
            const f32x2v a = P[row * 4 + 0], b = P[row * 4 + 1], c = P[row * 4 + 2], d = P[row * 4 + 3];
            const float mt = (a.x + b.x + c.x + d.x) * 0.25f;
            const float da = a.x - mt, db = b.x - mt, dc = c.x - mt, dd = d.x - mt;
            const float m2 = (a.y + b.y) + (c.y + d.y) + 64.0f * ((da * da + db * db) + (dc * dc + dd * dd));
            unsigned long long* slot = (unsigned long long*)xbuf + ((size_t)(u.pm * BM + row) * 4 + u.pn);
            __hip_atomic_store(slot, ((unsigned long long)__float_as_uint(m2) << 32) | __float_as_uint(mt), __ATOMIC_RELAXED, __HIP_MEMORY_SCOPE_AGENT);
        }
        asm volatile("s_waitcnt vmcnt(0)" ::: "memory");
        if (lane == 0) __hip_atomic_fetch_add(cnt + 64 * u.pm, 1u, __ATOMIC_RELAXED, __HIP_MEMORY_SCOPE_AGENT);
        if (wid == 0) {
            bool dead = false; const unsigned long long t0 = __builtin_amdgcn_s_memrealtime(); const unsigned want = 8u * (unsigned)ntn;
            for (;;) {
#if defined(BROKEN_EXCHANGE_NO_WAIT)
                break;
#endif
                if ((unsigned)__builtin_amdgcn_readfirstlane(__hip_atomic_load(cnt + 64 * u.pm, __ATOMIC_RELAXED, __HIP_MEMORY_SCOPE_AGENT)) >= want) break;
                if (__builtin_amdgcn_s_memrealtime() - t0 > 2000000ull) {
                    if (lane == 0) { unsigned expect = 0u; __hip_atomic_compare_exchange_strong(tmo + 1, &expect, code | (unsigned)(u.pm & 0xff), __ATOMIC_RELAXED, __ATOMIC_RELAXED, __HIP_MEMORY_SCOPE_AGENT);
                                     __hip_atomic_store(tmo, 1u, __ATOMIC_RELAXED, __HIP_MEMORY_SCOPE_AGENT); }
                    dead = true; break; }
                __builtin_amdgcn_s_sleep(2);
            }
            __builtin_amdgcn_fence(__ATOMIC_ACQUIRE, "agent");
            if (lane == 0) flag[0] = dead ? 1u : 0u;
        }
        asm volatile("s_waitcnt vmcnt(0) lgkmcnt(0)" ::: "memory"); __builtin_amdgcn_s_barrier(); asm volatile("" ::: "memory");
        const bool bad = flag[0] != 0u;
        if (lane < 32) {
            const unsigned long long* slot = (const unsigned long long*)xbuf + (size_t)(u.pm * BM + row) * 4; float mt[4], m2[4]; float ms = 0.f;
#pragma unroll
            for (int t = 0; t < 4; ++t) { if (t < ntn) { const unsigned long long w = __hip_atomic_load(slot + t, __ATOMIC_RELAXED, __HIP_MEMORY_SCOPE_AGENT); mt[t] = __uint_as_float((unsigned)w); m2[t] = __uint_as_float((unsigned)(w >> 32)); } else { mt[t] = 0.f; m2[t] = 0.f; } ms += mt[t]; }
            const float mean = ms / (float)ntn; float q = 0.f;
#pragma unroll
            for (int t = 0; t < 4; ++t) if (t < ntn) { const float dm = mt[t] - mean; q += m2[t] + 256.0f * dm * dm; }
            S[row] = (f32x2v){mean, 1.0f / sqrtf(q / (256.0f * (float)ntn) + eps)};
        }
        asm volatile("s_waitcnt lgkmcnt(0)" ::: "memory"); __builtin_amdgcn_s_barrier(); asm volatile("" ::: "memory");
        return bad;
    }
};
struct EpiLnRes {
    static constexpr bool PERM = false, AFTER_DRAIN = true;
    const float* base; float* out; int ldc; const float* bias; PanelStats st; unsigned poison;
    __device__ __forceinline__ void fused(f32x4 (&acc)[2][2][4][2], const Unit& u, int wr, int wc, int fr, int fq, PG8_LAS unsigned char* lds, int wid, int lane) const {
        typedef float f32x2v __attribute__((ext_vector_type(2)));
        const PG8_LAS f32x2v* S = (const PG8_LAS f32x2v*)(lds + 8192);
        const int col0 = u.pn * BM + wc * 32 + 4 * fq;
#pragma unroll
        for (int bj = 0; bj < 2; ++bj)
#pragma unroll
            for (int n = 0; n < 2; ++n) { const f32x4 bv = bias ? *(const f32x4*)(bias + col0 + bj * HALF + n * 16) : (f32x4){0.f, 0.f, 0.f, 0.f};
#pragma unroll
                for (int ai = 0; ai < 2; ++ai)
#pragma unroll
                    for (int m = 0; m < 4; ++m) acc[ai][bj][m][n] += bv; }
        f32x4 pre[4][2][2];
#pragma unroll
        for (int m = 0; m < 4; ++m) { const size_t off = (size_t)(u.pm * BM + wr * 64 + m * 16 + fr) * ldc + col0;
#pragma unroll
            for (int bj = 0; bj < 2; ++bj)
#pragma unroll
                for (int n = 0; n < 2; ++n) pre[m][bj][n] = *(const f32x4*)(base + off + bj * HALF + n * 16); }
        const bool bad = st.run(acc, u, wr, wc, fr, fq, lds, wid, lane) || poison != 0u;
        const float qnan = __builtin_nanf("");
#pragma unroll
        for (int ai = 0; ai < 2; ++ai)
#pragma unroll
            for (int m = 0; m < 4; ++m) { const int r = ai * HALF + wr * 64 + m * 16 + fr; const f32x2v sr = S[r]; const size_t off = (size_t)(u.pm * BM + r) * ldc + col0;
#pragma unroll
                for (int bj = 0; bj < 2; ++bj)
#pragma unroll
                    for (int n = 0; n < 2; ++n) { const f32x4 bs = ai == 0 ? pre[m][bj][n] : *(const f32x4*)(base + off + bj * HALF + n * 16); f32x4 o = bs + (acc[ai][bj][m][n] - sr.x) * sr.y;
                        if (bad) o = (f32x4){qnan, qnan, qnan, qnan}; *(f32x4*)(out + off + bj * HALF + n * 16) = o; }
                if (m & 1) asm volatile("" ::: "memory"); }
    }
};
struct EpiLnResLn {
    static constexpr bool PERM = false, AFTER_DRAIN = true;
    const float* base; float* out; bf16_t* xn; int ldc; const float* bias; PanelStats st1, st2; unsigned poison;
    __device__ __forceinline__ void fused(f32x4 (&acc)[2][2][4][2], const Unit& u, int wr, int wc, int fr, int fq, PG8_LAS unsigned char* lds, int wid, int lane) const {
        typedef float f32x2v __attribute__((ext_vector_type(2))); typedef unsigned u32x2v __attribute__((ext_vector_type(2)));
        const PG8_LAS f32x2v* S = (const PG8_LAS f32x2v*)(lds + 8192);
        const int col0 = u.pn * BM + wc * 32 + 4 * fq;
#pragma unroll
        for (int bj = 0; bj < 2; ++bj)
#pragma unroll
            for (int n = 0; n < 2; ++n) { const f32x4 bv = bias ? *(const f32x4*)(bias + col0 + bj * HALF + n * 16) : (f32x4){0.f, 0.f, 0.f, 0.f};
#pragma unroll
                for (int ai = 0; ai < 2; ++ai)
#pragma unroll
                    for (int m = 0; m < 4; ++m) acc[ai][bj][m][n] += bv; }
        bool bad = st1.run(acc, u, wr, wc, fr, fq, lds, wid, lane) || poison != 0u;
        const float qnan = __builtin_nanf("");
#pragma unroll
        for (int ai = 0; ai < 2; ++ai)
#pragma unroll
            for (int m = 0; m < 4; ++m) { const int r = ai * HALF + wr * 64 + m * 16 + fr; const f32x2v sr = S[r]; const size_t off = (size_t)(u.pm * BM + r) * ldc + col0;
#pragma unroll
                for (int bj = 0; bj < 2; ++bj)
#pragma unroll
                    for (int n = 0; n < 2; ++n) { const f32x4 bs = *(const f32x4*)(base + off + bj * HALF + n * 16); acc[ai][bj][m][n] = bs + (acc[ai][bj][m][n] - sr.x) * sr.y; }
                asm volatile("" : "+v"(acc[ai][0][m][0]), "+v"(acc[ai][0][m][1]), "+v"(acc[ai][1][m][0]), "+v"(acc[ai][1][m][1]));
                if (m & 1) asm volatile("" ::: "memory"); }
        const bool bad1 = bad;
        bad = st2.run(acc, u, wr, wc, fr, fq, lds, wid, lane) || bad;
#pragma unroll
        for (int ai = 0; ai < 2; ++ai)
#pragma unroll
            for (int m = 0; m < 4; ++m) { const int r = ai * HALF + wr * 64 + m * 16 + fr; const f32x2v sr = S[r]; const size_t off = (size_t)(u.pm * BM + r) * ldc + col0;
#pragma unroll
                for (int bj = 0; bj < 2; ++bj)
#pragma unroll
                    for (int n = 0; n < 2; ++n) { const f32x4 x1 = acc[ai][bj][m][n]; *(f32x4*)(out + off + bj * HALF + n * 16) = bad1 ? (f32x4){qnan, qnan, qnan, qnan} : x1;
                        const f32x4 o = (x1 - sr.x) * sr.y; u32x2v w; w.x = cvt_pk_bf16(o[0], o[1]); w.y = cvt_pk_bf16(o[2], o[3]);
                        if (bad) { w.x = 0x7fc07fc0u; w.y = 0x7fc07fc0u; } *(u32x2v*)(xn + off + bj * HALF + n * 16) = w; }
                asm volatile("" ::: "memory"); }
    }
};

template <class Epi, class Sched, bool ALIGN_EPI = false, bool SP2 = false, bool GATHER = false>
__device__ __forceinline__ void gemm_phase(PG8_LAS unsigned char* lds, const Gemm g, const Sched& S, const Epi& E) {
    static_assert(!GATHER || SP2, "gathered A rows: SP2 loop only");
    int tid_o = threadIdx.x; asm volatile("" : "+v"(tid_o)); const int tid = tid_o, wid = __builtin_amdgcn_readfirstlane(tid >> 6), lane = tid & 63, wr = wid >> 2, wc = wid & 3, fr = lane & 15, fq = lane >> 4;
    const int K = g.K, nt = K / BK, lda = g.lda ? g.lda : K;
    unsigned voffA[2], voffB[2];
#pragma unroll
    for (int i = 0; i < 2; ++i) { int R, C; stage_rc(tid * 16 + i * 8192, R, C); const int Rb = Epi::PERM ? ((R & ~31) + perm32(R & 31)) : R;
        voffA[i] = (unsigned)(R * lda + C) * 2u; voffB[i] = (unsigned)(Rb * K + C) * 2u; }
    const size_t kstep = (size_t)(BK * 2);
    const size_t hstep = (size_t)HALF * K * 2;
    const size_t tstep = 2 * hstep;
    const size_t kstepA = g.kstepA ? (size_t)g.kstepA : kstep, hstepA = (size_t)HALF * lda * 2, tstepA = 2 * hstepA;
    const unsigned ldsw = (unsigned)wid * 1024u;
    const int aoff = lds_byte(wr * 64 + fr, fq * 8), boff = lds_byte(wc * 32 + fr, fq * 8);
#define PG8_SA(b, h) (((b) * 2 + (h)) * HTB)
#define PG8_SB(b, h) ((4 + (b) * 2 + (h)) * HTB)
#define PG8_STAGE(bufoff, gbase, voff) do { _Pragma("unroll") for (int _i = 0; _i < 2; ++_i) \
        __builtin_amdgcn_global_load_lds((const unsigned*)((const char*)(gbase) + (voff)[_i]), (PG8_LAS unsigned*)(lds + (bufoff) + ldsw + _i * 8192), 16, 0, 0); } while (0)
#define PG8_LDA(dst, b, h) do { _Pragma("unroll") for (int m = 0; m < 4; ++m) _Pragma("unroll") for (int k = 0; k < 2; ++k) dst[m][k] = *(const PG8_LAS bf16x8*)(lds + PG8_SA(b, h) + aoff + m * 2048 + k * 1024); } while (0)
#define PG8_LDB(dst, b, h) do { _Pragma("unroll") for (int n = 0; n < 2; ++n) _Pragma("unroll") for (int k = 0; k < 2; ++k) dst[n][k] = *(const PG8_LAS bf16x8*)(lds + PG8_SB(b, h) + boff + n * 2048 + k * 1024); } while (0)
#define PG8_MMA(ai, bj, At, Bt) do { __builtin_amdgcn_s_setprio(1); _Pragma("unroll") for (int m = 0; m < 4; ++m) _Pragma("unroll") for (int n = 0; n < 2; ++n) _Pragma("unroll") for (int k = 0; k < 2; ++k) \
        acc[ai][bj][m][n] = __builtin_amdgcn_mfma_f32_16x16x32_bf16(Bt[n][k], At[m][k], acc[ai][bj][m][n], 0, 0, 0); __builtin_amdgcn_s_setprio(0); } while (0)
#define PG8_WAIT_V(n) asm volatile("s_waitcnt vmcnt(" #n ")" ::: "memory")
#define PG8_WAIT_L(n) asm volatile("s_waitcnt lgkmcnt(" #n ")" ::: "memory")
#define PG8_BAR __builtin_amdgcn_s_barrier()
#define PG8_SCHED __builtin_amdgcn_sched_barrier(0)
    unsigned gcu[2][2] = {{0u, 0u}, {0u, 0u}}, gnx[2][2] = {{0u, 0u}, {0u, 0u}};
#define PG8_GOFF(dst, u) do { int t_ = tid; asm volatile("" : "+v"(t_));   \
        _Pragma("unroll") for (int _h = 0; _h < 2; ++_h) _Pragma("unroll") for (int _i = 0; _i < 2; ++_i) { int R_, C_; stage_rc(t_ * 16 + _i * 8192, R_, C_); \
        dst[_h][_i] = (unsigned)((g.gidx[(u).pm * BM + _h * HALF + R_] & 16383) * lda + C_) * 2u; } } while (0)
#define PG8_STAGE_A(bufoff, gbase, H, NEXT) do { if constexpr (GATHER) { if (NEXT) PG8_STAGE(bufoff, gbase, gnx[H]); else PG8_STAGE(bufoff, gbase, gcu[H]); } else { PG8_STAGE(bufoff, (gbase) + ((H) ? hstepA : 0), voffA); } } while (0)
    Unit cur, nxt; int ui = 0;
    if (!S.next(0, cur)) return;
    f32x4 acc[2][2][4][2];
#pragma unroll
    for (int a = 0; a < 2; ++a)
#pragma unroll
        for (int b = 0; b < 2; ++b)
#pragma unroll
            for (int m = 0; m < 4; ++m)
#pragma unroll
                for (int n = 0; n < 2; ++n) acc[a][b][m][n] = (f32x4){0.f, 0.f, 0.f, 0.f};
    bf16x8 At[4][2], B0[2][2], B1[2][2];
    if constexpr (GATHER) PG8_GOFF(gcu, cur);
    const char* cA = GATHER ? (const char*)g.A : (const char*)g.A + (size_t)cur.pm * tstepA + cur.aofs; const char* cB = (const char*)g.Bt + (size_t)cur.pn * tstep;
    S.a_ready(cur);
    if constexpr (SP2) {
        PG8_STAGE(PG8_SB(0, 0), cB, voffB); PG8_STAGE(PG8_SB(0, 1), cB + hstep, voffB); PG8_STAGE_A(PG8_SA(0, 0), cA, 0, false); PG8_STAGE_A(PG8_SA(0, 1), cA, 1, false);
        if (wr == 1) PG8_BAR;
        PG8_WAIT_V(2); PG8_BAR;
        PG8_STAGE(PG8_SB(1, 0), cB + kstep, voffB); PG8_STAGE_A(PG8_SA(1, 0), cA + kstepA, 0, false); PG8_STAGE(PG8_SB(1, 1), cB + hstep + kstep, voffB);
        PG8_WAIT_V(6); PG8_BAR;
    } else {
        PG8_STAGE(PG8_SB(0, 0), cB, voffB); PG8_STAGE(PG8_SA(0, 0), cA, voffA); PG8_STAGE(PG8_SB(0, 1), cB + hstep, voffB); PG8_STAGE(PG8_SA(0, 1), cA + hstepA, voffA);
        if (wr == 1) PG8_BAR;
        PG8_WAIT_V(4); PG8_BAR;
        PG8_STAGE(PG8_SB(1, 0), cB + kstep, voffB); PG8_STAGE(PG8_SA(1, 0), cA + kstepA, voffA); PG8_STAGE(PG8_SB(1, 1), cB + hstep + kstep, voffB);
        PG8_WAIT_V(6); PG8_BAR;
    }
    for (;;) {
        const bool has_next = S.next(ui + 1, nxt);
        const char* nA = GATHER ? cA : (has_next ? (const char*)g.A + (size_t)nxt.pm * tstepA + nxt.aofs : cA); const char* nB = has_next ? (const char*)g.Bt + (size_t)nxt.pn * tstep : cB;
        for (int t = 0; t < nt; t += 2) {
            const bool last = (t == nt - 2);
            const char* a1 = cA + (size_t)(t + 1) * kstepA;
            const char* a2 = last ? nA : cA + (size_t)(t + 2) * kstepA; const char* b2 = last ? nB : cB + (size_t)(t + 2) * kstep;
            const char* a3 = a2 + kstepA; const char* b3 = b2 + kstep;
            if (last && has_next) S.a_ready(nxt);
            if constexpr (GATHER) { if (t == (nt >= 4 ? nt - 4 : 0)) { if (has_next) PG8_GOFF(gnx, nxt); else { gnx[0][0] = gcu[0][0]; gnx[0][1] = gcu[0][1]; gnx[1][0] = gcu[1][0]; gnx[1][1] = gcu[1][1]; } } }
            if constexpr (SP2) {
            PG8_LDB(B0, 0, 0); PG8_LDB(B1, 0, 1); PG8_SCHED; PG8_LDA(At, 0, 0); PG8_STAGE_A(PG8_SA(1, 1), a1, 1, false);
            PG8_WAIT_V(8); PG8_WAIT_L(0); PG8_BAR; PG8_MMA(0, 0, At, B0); PG8_MMA(0, 1, At, B1); PG8_BAR; PG8_SCHED;
            PG8_LDA(At, 0, 1); PG8_STAGE(PG8_SB(0, 0), b2, voffB); PG8_STAGE(PG8_SB(0, 1), b2 + hstep, voffB); PG8_STAGE_A(PG8_SA(0, 0), a2, 0, last);
            PG8_WAIT_V(8); PG8_WAIT_L(0); PG8_BAR; PG8_MMA(1, 0, At, B0); PG8_MMA(1, 1, At, B1); PG8_BAR; PG8_SCHED;
            PG8_LDB(B0, 1, 0); PG8_LDB(B1, 1, 1); PG8_SCHED; PG8_LDA(At, 1, 0); PG8_STAGE_A(PG8_SA(0, 1), a2, 1, last);
            PG8_WAIT_V(8); PG8_WAIT_L(0); PG8_BAR; PG8_MMA(0, 0, At, B0); PG8_MMA(0, 1, At, B1); PG8_BAR; PG8_SCHED;
            PG8_LDA(At, 1, 1); PG8_STAGE(PG8_SB(1, 0), b3, voffB); PG8_STAGE(PG8_SB(1, 1), b3 + hstep, voffB); PG8_STAGE_A(PG8_SA(1, 0), a3, 0, last);
            PG8_WAIT_V(8); PG8_WAIT_L(0); PG8_BAR; PG8_MMA(1, 0, At, B0); PG8_MMA(1, 1, At, B1); PG8_BAR; PG8_SCHED;
            } else {
            PG8_LDB(B0, 0, 0); PG8_SCHED; PG8_LDA(At, 0, 0); PG8_STAGE(PG8_SA(1, 1), a1 + hstepA, voffA);
            PG8_WAIT_L(8); PG8_BAR; PG8_WAIT_L(0); PG8_MMA(0, 0, At, B0); PG8_BAR; PG8_SCHED;
            PG8_LDB(B1, 0, 1); PG8_STAGE(PG8_SB(0, 0), b2, voffB);
            PG8_BAR; PG8_WAIT_L(0); PG8_MMA(0, 1, At, B1); PG8_BAR;
            PG8_LDA(At, 0, 1); PG8_STAGE(PG8_SA(0, 0), a2, voffA);
            PG8_BAR; PG8_WAIT_L(0); PG8_MMA(1, 0, At, B0); PG8_BAR; PG8_SCHED;
            PG8_STAGE(PG8_SB(0, 1), b2 + hstep, voffB);
            PG8_WAIT_V(6); PG8_BAR; PG8_MMA(1, 1, At, B1); PG8_BAR;
            PG8_LDB(B0, 1, 0); PG8_SCHED; PG8_LDA(At, 1, 0); PG8_STAGE(PG8_SA(0, 1), a2 + hstepA, voffA);
            PG8_WAIT_L(8); PG8_BAR; PG8_WAIT_L(0); PG8_MMA(0, 0, At, B0); PG8_BAR; PG8_SCHED;
            PG8_LDB(B1, 1, 1); PG8_STAGE(PG8_SB(1, 0), b3, voffB);
            PG8_BAR; PG8_WAIT_L(0); PG8_MMA(0, 1, At, B1); PG8_BAR;
            PG8_LDA(At, 1, 1); PG8_STAGE(PG8_SA(1, 0), a3, voffA);
            PG8_BAR; PG8_WAIT_L(0); PG8_MMA(1, 0, At, B0); PG8_BAR; PG8_SCHED;
            PG8_STAGE(PG8_SB(1, 1), b3 + hstep, voffB);
            PG8_WAIT_V(6); PG8_BAR; PG8_MMA(1, 1, At, B1); PG8_BAR;
            }
        }
        if constexpr (ALIGN_EPI) { if (wr == 0) PG8_BAR; }
        if constexpr (!Epi::AFTER_DRAIN) { E(acc, cur, wr, wc, fr, fq); S.done(cur); }
        if (!has_next) break;
#pragma unroll
        for (int a = 0; a < 2; ++a)
#pragma unroll
            for (int b = 0; b < 2; ++b)
#pragma unroll
                for (int m = 0; m < 4; ++m)
#pragma unroll
                    for (int n = 0; n < 2; ++n) acc[a][b][m][n] = (f32x4){0.f, 0.f, 0.f, 0.f};
        cur = nxt; cA = nA; cB = nB; ++ui;
        if constexpr (GATHER) { gcu[0][0] = gnx[0][0]; gcu[0][1] = gnx[0][1]; gcu[1][0] = gnx[1][0]; gcu[1][1] = gnx[1][1]; }
        if constexpr (ALIGN_EPI) { if (wr == 1) PG8_BAR; }
    }
    PG8_WAIT_V(0);
    if constexpr (!ALIGN_EPI) { if (wr == 0) PG8_BAR; }
    PG8_BAR;
    if constexpr (Epi::AFTER_DRAIN) { E.fused(acc, cur, wr, wc, fr, fq, lds, wid, lane); S.done(cur); }
#undef PG8_SA
#undef PG8_SB
#undef PG8_STAGE
#undef PG8_STAGE_A
#undef PG8_GOFF
#undef PG8_LDA
#undef PG8_LDB
#undef PG8_MMA
#undef PG8_WAIT_V
#undef PG8_WAIT_L
#undef PG8_BAR
#undef PG8_SCHED
}
}
#include <hip/hip_bf16.h>
#include <cmath>
namespace gattn {
using bf16=__hip_bfloat16;
using bf16x8=__attribute__((ext_vector_type(8)))short;
using s16x4=__attribute__((ext_vector_type(4)))short;
using f32x16=__attribute__((ext_vector_type(16)))float;
using u32x4=__attribute__((ext_vector_type(4)))unsigned;
constexpr int BATCH=2,NHEAD=16,SEQ=8192,D=64,DM=NHEAD*D;
constexpr int NW=8,QBLK=32,QB=QBLK*NW,KVBLK=64,NQB=SEQ/QB;
constexpr int ATTN_PITCH=DM, ATTN_UNIT_ROWS=QB;
__device__ __forceinline__ int crow(int r,int hi){return (r&3)+8*(r>>2)+4*hi;}
#define SBAR() __builtin_amdgcn_sched_barrier(0)
constexpr float NEGM=-60000.f;
__device__ __forceinline__ void emask(f32x16&p0,f32x16&p1,int kb,int lo,int hi_){
  #pragma unroll
  for(int r=0;r<16;++r){const int kv=kb+(r&3)+8*(r>>2); if(kv<lo||kv>hi_)p0[r]=NEGM; if(kv+32<lo||kv+32>hi_)p1[r]=NEGM;}
}

constexpr int NSLOT=3, SLOTB=8192;
constexpr int LDS_K=0, LDS_V=NSLOT*SLOTB, LDS_WS=2*NSLOT*SLOTB, LDS_OST=LDS_WS+NW*64*4, LDS_BT=LDS_OST+NW*4096, LDS_BYTES=LDS_BT+SEQ*4;
constexpr float C2=0.125f*1.4426950408889634f;
__device__ __forceinline__ void glds16(const void*gsrc,unsigned lds_dst){unsigned keep;
  asm volatile("s_mov_b32 %0, m0\n\ts_mov_b32 m0, %2\n\ts_nop 0\n\tglobal_load_lds_dwordx4 %1, off\n\ts_mov_b32 m0, %0":"=&s"(keep):"v"(gsrc),"s"(lds_dst):"memory");}
__device__ __forceinline__ float max3f(float a,float b,float c){float r;asm("v_max3_f32 %0, %1, %2, %3":"=v"(r):"v"(a),"v"(b),"v"(c));return r;}
__device__ __forceinline__ float max2f(float a,float b){float r;asm("v_max_f32_e32 %0, %1, %2":"=v"(r):"v"(a),"v"(b));return r;}
__device__ __forceinline__ float fadd_s(float a,float b){float r;asm("v_add_f32_e32 %0, %1, %2":"=v"(r):"v"(a),"v"(b));return r;}
__device__ __forceinline__ float fsub_s(float a,float b){float r;asm("v_sub_f32_e32 %0, %1, %2":"=v"(r):"v"(a),"v"(b));return r;}
typedef float f32x2_t __attribute__((ext_vector_type(2))); typedef __bf16 bf16x2_t __attribute__((ext_vector_type(2)));
__device__ __forceinline__ unsigned cvtpk_s(float lo,float hi){f32x2_t v={lo,hi};bf16x2_t b=__builtin_convertvector(v,bf16x2_t);return __builtin_bit_cast(unsigned,b);}
#define WAIT_BAR(N) asm volatile("s_waitcnt vmcnt(" #N ") lgkmcnt(0)\n\ts_barrier":::"memory")

typedef unsigned u32x2b __attribute__((ext_vector_type(2)));
__device__ __forceinline__ s16x4 bfrag(unsigned w){ u32x2b v={w,0u}; return __builtin_bit_cast(s16x4,v); }
#define BMFMA(a,b,c) __builtin_amdgcn_mfma_f32_32x32x8bf16_1k(a,b,c,0,0,0)
__device__ __forceinline__ void qkt(f32x16&p0,f32x16&p1,const char*Kslot,const bf16x8*qr,int r32,int hi){
  const char*kb=Kslot+hi*1024+r32*16;
  #pragma unroll
  for(int d0=0;d0<4;++d0){
    const bf16x8 b0=*reinterpret_cast<const bf16x8*>(kb+d0*2048);
    const bf16x8 b1=*reinterpret_cast<const bf16x8*>(kb+d0*2048+512);
    if(d0==0){const f32x16 z={};p0=__builtin_amdgcn_mfma_f32_32x32x16_bf16(b0,qr[0],z,0,0,0);p1=__builtin_amdgcn_mfma_f32_32x32x16_bf16(b1,qr[0],z,0,0,0);}
    else{p0=__builtin_amdgcn_mfma_f32_32x32x16_bf16(b0,qr[d0],p0,0,0,0);p1=__builtin_amdgcn_mfma_f32_32x32x16_bf16(b1,qr[d0],p1,0,0,0);}}
}
typedef __attribute__((address_space(3))) const char* lds_cptr;
typedef short v4i16_t __attribute__((ext_vector_type(4)));
__device__ __forceinline__ void kload8(bf16x8*kf,lds_cptr kp){
  kf[0]=*(const __attribute__((address_space(3))) bf16x8*)(kp);      kf[1]=*(const __attribute__((address_space(3))) bf16x8*)(kp+512);
  kf[2]=*(const __attribute__((address_space(3))) bf16x8*)(kp+2048); kf[3]=*(const __attribute__((address_space(3))) bf16x8*)(kp+2560);
  kf[4]=*(const __attribute__((address_space(3))) bf16x8*)(kp+4096); kf[5]=*(const __attribute__((address_space(3))) bf16x8*)(kp+4608);
  kf[6]=*(const __attribute__((address_space(3))) bf16x8*)(kp+6144); kf[7]=*(const __attribute__((address_space(3))) bf16x8*)(kp+6656);
}
__device__ __forceinline__ void kload2(bf16x8*kf,lds_cptr kp,int j){ kf[2*j]=*(const __attribute__((address_space(3))) bf16x8*)(kp+j*2048); kf[2*j+1]=*(const __attribute__((address_space(3))) bf16x8*)(kp+j*2048+512); }
__device__ __forceinline__ s16x4 vtr(lds_cptr p){ return __builtin_bit_cast(s16x4,__builtin_amdgcn_ds_read_tr16_b64_v4i16((__attribute__((address_space(3))) v4i16_t*)p)); }
__device__ __forceinline__ float rowmax(const f32x16&p0,const f32x16&p1){
  float a=max3f(p0[0],p0[1],p1[0]),b=max3f(p0[2],p0[3],p1[1]);a=max3f(a,p1[2],p1[3]);
  #pragma unroll
  for(int r=4;r<16;r+=4){a=max3f(a,p0[r],p0[r+1]);b=max3f(b,p0[r+2],p0[r+3]);a=max3f(a,p1[r],p1[r+1]);b=max3f(b,p1[r+2],p1[r+3]);}
  const float m=max2f(a,b);
  auto rr=__builtin_amdgcn_permlane32_swap(__float_as_uint(m),__float_as_uint(m),false,false);
  return max2f(__uint_as_float(rr[0]),__uint_as_float(rr[1]));
}
__device__ __forceinline__ void pv(f32x16*o,int vb,bf16x8 pa0,bf16x8 pa1,bf16x8 pa2,bf16x8 pa3){
  #pragma unroll
  for(int d0=0;d0<2;++d0){s16x4 lo[4],hi[4];
    #pragma unroll
    for(int ks=0;ks<4;++ks){
      asm volatile("ds_read_b64_tr_b16 %0,%1 offset:%c2":"=&v"(lo[ks]):"v"(vb),"i"(d0*4096+ks*1024):"memory");
      asm volatile("ds_read_b64_tr_b16 %0,%1 offset:%c2":"=&v"(hi[ks]):"v"(vb),"i"(d0*4096+ks*1024+512):"memory");}
    asm volatile("s_waitcnt lgkmcnt(0)":::"memory");SBAR();
    #define PK(k) (bf16x8){lo[k][0],lo[k][1],lo[k][2],lo[k][3],hi[k][0],hi[k][1],hi[k][2],hi[k][3]}
    o[d0]=__builtin_amdgcn_mfma_f32_32x32x16_bf16(pa0,PK(0),o[d0],0,0,0);
    o[d0]=__builtin_amdgcn_mfma_f32_32x32x16_bf16(pa1,PK(1),o[d0],0,0,0);
    o[d0]=__builtin_amdgcn_mfma_f32_32x32x16_bf16(pa2,PK(2),o[d0],0,0,0);
    o[d0]=__builtin_amdgcn_mfma_f32_32x32x16_bf16(pa3,PK(3),o[d0],0,0,0);
    #undef PK
  }
}

#ifndef ATTN_STORE16
#define ATTN_STORE16(p,v) (*(u32x4*)(p)=(v))
#endif
template<int THRL,bool HAS_BIAS,int OMODE,int ORS,class U> __device__ __forceinline__ void gunit(char*shm,const U&un){
  int tid_o=threadIdx.x; asm volatile("":"+v"(tid_o)); const int tid=tid_o,lane=tid&63,r32=lane&31,hi=lane>>5; const int wid=__builtin_amdgcn_readfirstlane(tid>>6);
  const int kpitch=un.kpitch;
  const bf16*Qw=un.qrow(wid,r32);
  const bf16*Kh=un.Kb,*Vh=un.Vb;
  const unsigned lds0=(unsigned)(uintptr_t)shm;
  float*wsf=(float*)(shm+LDS_WS)+wid*64;
  const bf16*ksrc=Kh+(long)lane*kpitch+wid*8;
  const bf16*vsrc=Vh+(long)(16*(wid&3)+(lane>>2))*kpitch+(wid>>2)*32+(lane&3)*8;
  const unsigned kdst=lds0+LDS_K+wid*1024, vdst=lds0+LDS_V+wid*1024;
  #define TABS(t) min(max(un.t0+(t),0),un.tmax)
  #define DMA_K(t,slot) glds16(ksrc+(long)TABS(t)*KVBLK*kpitch,(unsigned)__builtin_amdgcn_readfirstlane(kdst+(slot)))
  #define DMA_V(t,slot) glds16(vsrc+(long)TABS(t)*KVBLK*kpitch,(unsigned)__builtin_amdgcn_readfirstlane(vdst+(slot)))
  const int vb0=(int)(lds0+LDS_V)+((lane>>4)&1)*32+(lane&3)*8+(4*hi+((lane&15)>>2))*64;
  const char*Kbase=shm+LDS_K; bf16x8 kf[8];
  const lds_cptr shm3=(lds_cptr)shm; const lds_cptr kp0=shm3+LDS_K+hi*1024+r32*16; const lds_cptr vp0=shm3+LDS_V+((lane>>4)&1)*32+(lane&3)*8+(4*hi+((lane&15)>>2))*64;
  const int NT=un.NT;
  typedef __attribute__((address_space(3))) unsigned lds_u32;
  lds_u32* const btab=(lds_u32*)(shm3+LDS_BT);
  if(HAS_BIAS){ const float*cum=un.cum; const float cq0=cum[un.q0]; const float*cumt=cum+(long)un.t0*KVBLK; for(int k=tid;k<NT*KVBLK;k+=NW*64){ const float be=(cq0-cumt[k])*1.4426950408889634f; unsigned ub=__builtin_bit_cast(unsigned,be); const unsigned hb=(ub+0x7fffu+((ub>>16)&1u))>>16;
      const float rl=be-__builtin_bit_cast(float,hb<<16); unsigned ul=__builtin_bit_cast(unsigned,rl); const unsigned lb=(ul+0x7fffu+((ul>>16)&1u))>>16; btab[k]=hb|(lb<<16); } }
  int bto=0;
  #define BIAS_MFMA(C0,C1) do{ unsigned ln_; asm volatile("v_mbcnt_lo_u32_b32 %0, -1, 0\n\tv_mbcnt_hi_u32_b32 %0, -1, %0":"=v"(ln_)); const bool up_=ln_>=32u; \
      unsigned w0_=0u, w1_=0u; if(HAS_BIAS){ const lds_u32* bp_=btab+bto+(ln_&31u); w0_=bp_[0]; w1_=bp_[32]; } \
      const unsigned tm_=un.term(wid,(int)(ln_&31u),un.t0+(bto>>6)); \
      u32x2b a0_, a1_, q_; a0_.x=up_?0x3F803F80u:w0_; a0_.y=up_?0u:0x3F803F80u; a1_.x=up_?0x3F803F80u:w1_; a1_.y=a0_.y; q_.x=qm0|(up_?(tm_<<16):0u); q_.y=qm1; \
      C0=BMFMA(__builtin_bit_cast(s16x4,a0_),__builtin_bit_cast(s16x4,q_),C0); C1=BMFMA(__builtin_bit_cast(s16x4,a1_),__builtin_bit_cast(s16x4,q_),C1); }while(0)
  DMA_K(0,0);DMA_V(0,0);DMA_K(1,SLOTB);
  bf16x8 qr[4];
  #pragma unroll
  for(int d0=0;d0<4;++d0)qr[d0]=*reinterpret_cast<const bf16x8*>(&Qw[d0*16+hi*8]);
  float mhat=0.f,l_reg=0.f;f32x16 o[2];o[0]=f32x16{};o[1]=f32x16{};unsigned qm0=hi?0u:0x3F803F80u,qm1=0u;
  #define UPDQM() do{ const float nm_=-mhat; const unsigned u0_=__builtin_bit_cast(unsigned,nm_); const unsigned h_=(u0_+0x7fffu+((u0_>>16)&1u))>>16; const float r1_=nm_-__builtin_bit_cast(float,h_<<16); \
      const unsigned u1_=__builtin_bit_cast(unsigned,r1_); const unsigned m_=(u1_+0x7fffu+((u1_>>16)&1u))>>16; const float r2_=r1_-__builtin_bit_cast(float,m_<<16); const unsigned l_=__builtin_bit_cast(unsigned,r2_)>>16; \
      qm0=hi?l_:0x3F803F80u; qm1=hi?0u:(h_|(m_<<16)); }while(0)
  const int klo=un.klo(wid,r32),khi=un.khi(wid,r32);
  #define CMASK(P0,P1,t) do{ if((t)==0||(t)>=NT-4) emask(P0,P1,(un.t0+(t))*KVBLK+4*hi,klo,khi); }while(0)
  bool resc=false;
  #define START(P0,P1) do{ const float rm=rowmax(P0,P1); resc=false; \
    { const float dl=rm; mhat=fadd_s(mhat,dl); \
      _Pragma("unroll") for(int r=0;r<16;++r){P0[r]=fsub_s(P0[r],dl);P1[r]=fsub_s(P1[r],dl);} \
      UPDQM(); } \
    _Pragma("unroll") for(int r=0;r<16;++r)P0[r]=__builtin_amdgcn_exp2f(P0[r]); }while(0)
  #define RESC() do{ if(resc){ asm volatile("s_waitcnt lgkmcnt(0)":::"memory"); \
      _Pragma("unroll") for(int d_=0;d_<2;++d_) _Pragma("unroll") for(int r=0;r<16;++r)o[d_][r]*=wsf[crow(r,hi)]; } }while(0)
  f32x16 pA0,pA1,pB0,pB1;
  int sl_prev=0,sl_cur=0,sl_next=SLOTB;
  #define ROT() do{sl_prev=sl_cur;sl_cur=sl_next;sl_next=(sl_next==(NSLOT-1)*SLOTB)?0:sl_next+SLOTB;bto+=KVBLK;}while(0)
  DMA_K(2,2*SLOTB);
  WAIT_BAR(3);
  qkt(pA0,pA1,Kbase,qr,r32,hi);BIAS_MFMA(pA0,pA1);asm volatile("s_nop 15\n\ts_nop 7":"+v"(pA0),"+v"(pA1));CMASK(pA0,pA1,0);
  START(pA0,pA1);
  _Pragma("unroll") for(int r=0;r<16;++r)pA1[r]=__builtin_amdgcn_exp2f(pA1[r]);
  WAIT_BAR(0);
  DMA_K(3,0);DMA_V(1,SLOTB);
  ROT();
  kload8(kf,kp0+sl_cur);
  WAIT_BAR(2);
  s16x4 vlo[8],vhi[8]; u32x4 pw0,pw1,pw2,pw3;
  #define PKW(P,B) cvtpk_s(P[B],P[B+1])
  #define PAF(k) __builtin_bit_cast(bf16x8,pw##k)
  #define VFR(i) (bf16x8){vlo[i][0],vlo[i][1],vlo[i][2],vlo[i][3],vhi[i][0],vhi[i][1],vhi[i][2],vhi[i][3]}
  #define PIN(x) asm volatile("":"+v"(x))
  #define MX3(a,b,c) __builtin_fmaxf(__builtin_fmaxf((a),(b)),(c))
  #define GAPA(MF,A0,A1,A2,A3,W0,W1,PW) do{ MF; sacc+=A0; sacc+=A1; sacc+=A2; sacc+=A3; PIN(sacc); W0; W1; PIN(PW); SBAR(); }while(0)
  #define EX(v) __builtin_amdgcn_exp2f(v)
  #define GAPB(MF,X,B) do{ MF; X[B]=EX(X[B]); X[B+1]=EX(X[B+1]); X[B+2]=EX(X[B+2]); X[B+3]=EX(X[B+3]); PIN(X); SBAR(); }while(0)
  #define VRD(i) do{ vlo[i]=vtr(vp_+(((i)>>2)*4096+((i)&3)*1024)); vhi[i]=vtr(vp_+(((i)>>2)*4096+((i)&3)*1024+512)); }while(0)
  #define KRD(G,j) do{ if(G){ kload2(kf,kp0+sl_next,j); SBAR(); } }while(0)
  #define STEP(C0,C1,P0,P1,t,GK,GV,GL) do{ SBAR(); \
    const lds_cptr vp_=vp0+sl_prev; \
    VRD(0); SBAR(); float sacc=(P0[0]+P0[1]); \
    GAPA(C0=__builtin_amdgcn_mfma_f32_32x32x16_bf16(kf[0],qr[0],(f32x16){},0,0,0), P0[2],P0[3],P0[4],P0[5],     pw0[0]=PKW(P0,0), pw0[1]=PKW(P0,2), pw0); \
    VRD(4); SBAR(); GAPA(C1=__builtin_amdgcn_mfma_f32_32x32x16_bf16(kf[1],qr[0],(f32x16){},0,0,0), P0[6],P0[7],P0[8],P0[9],     pw0[2]=PKW(P0,4), pw0[3]=PKW(P0,6), pw0); \
    VRD(1); SBAR(); GAPA(C0=__builtin_amdgcn_mfma_f32_32x32x16_bf16(kf[2],qr[1],C0,0,0,0),   P0[10],P0[11],P0[12],P0[13], pw1[0]=PKW(P0,8), pw1[1]=PKW(P0,10), pw1); \
    VRD(5); SBAR(); GAPA(C1=__builtin_amdgcn_mfma_f32_32x32x16_bf16(kf[3],qr[1],C1,0,0,0),   P0[14],P0[15],P1[0],P1[1],   pw1[2]=PKW(P0,12),pw1[3]=PKW(P0,14), pw1); \
    VRD(2); SBAR(); GAPA(C0=__builtin_amdgcn_mfma_f32_32x32x16_bf16(kf[4],qr[2],C0,0,0,0),   P1[2],P1[3],P1[4],P1[5],     pw2[0]=PKW(P1,0), pw2[1]=PKW(P1,2), pw2); \
    VRD(6); SBAR(); GAPA(C1=__builtin_amdgcn_mfma_f32_32x32x16_bf16(kf[5],qr[2],C1,0,0,0),   P1[6],P1[7],P1[8],P1[9],     pw2[2]=PKW(P1,4), pw2[3]=PKW(P1,6), pw2); \
    VRD(3); SBAR(); GAPA(C0=__builtin_amdgcn_mfma_f32_32x32x16_bf16(kf[6],qr[3],C0,0,0,0),   P1[10],P1[11],P1[12],P1[13], pw3[0]=PKW(P1,8), pw3[1]=PKW(P1,10), pw3); \
    VRD(7); SBAR(); GAPA(C1=__builtin_amdgcn_mfma_f32_32x32x16_bf16(kf[7],qr[3],C1,0,0,0),   P1[14],P1[15],0.f,0.f,       pw3[2]=PKW(P1,12),pw3[3]=PKW(P1,14), pw3); \
    BIAS_MFMA(C0,C1); \
    l_reg+=sacc; \
    if(GK){DMA_K((t)+3,sl_cur);} if(GV){DMA_V((t)+1,sl_next);} \
    CMASK(C0,C1,t); \
    { float a=MX3(C0[0],C0[1],C1[0]),b=MX3(C0[2],C0[3],C1[1]); a=MX3(a,C1[2],C1[3]); \
      _Pragma("unroll") for(int r=4;r<16;r+=4){a=MX3(a,C0[r],C0[r+1]);b=MX3(b,C0[r+2],C0[r+3]);a=MX3(a,C1[r],C1[r+1]);b=MX3(b,C1[r+2],C1[r+3]);} \
      float rm=__builtin_fmaxf(a,b); { auto rr=__builtin_amdgcn_permlane32_swap(__float_as_uint(rm),__float_as_uint(rm),false,false); rm=__builtin_fmaxf(__uint_as_float(rr[0]),__uint_as_float(rr[1])); } \
      resc=false; \
      if(__builtin_expect(__any(rm>(float)THRL),0)){ const float dl=__builtin_fmaxf(rm,0.f); mhat+=dl; \
        _Pragma("unroll") for(int r=0;r<16;++r){C0[r]-=dl;C1[r]-=dl;} \
        UPDQM(); \
        const float f=__builtin_amdgcn_exp2f(-dl); l_reg*=f; if(hi==0)wsf[r32]=f; resc=true; } } \
    SBAR(); \
    GAPB(o[0]=__builtin_amdgcn_mfma_f32_32x32x16_bf16(PAF(0),VFR(0),o[0],0,0,0), C0,0); \
    GAPB(o[1]=__builtin_amdgcn_mfma_f32_32x32x16_bf16(PAF(0),VFR(4),o[1],0,0,0), C0,4); \
    KRD(GL,0); GAPB(o[0]=__builtin_amdgcn_mfma_f32_32x32x16_bf16(PAF(1),VFR(1),o[0],0,0,0), C0,8); \
    KRD(GL,1); GAPB(o[1]=__builtin_amdgcn_mfma_f32_32x32x16_bf16(PAF(1),VFR(5),o[1],0,0,0), C0,12); \
    KRD(GL,2); GAPB(o[0]=__builtin_amdgcn_mfma_f32_32x32x16_bf16(PAF(2),VFR(2),o[0],0,0,0), C1,0); \
    KRD(GL,3); GAPB(o[1]=__builtin_amdgcn_mfma_f32_32x32x16_bf16(PAF(2),VFR(6),o[1],0,0,0), C1,4); \
    GAPB(o[0]=__builtin_amdgcn_mfma_f32_32x32x16_bf16(PAF(3),VFR(3),o[0],0,0,0), C1,8); \
    GAPB(o[1]=__builtin_amdgcn_mfma_f32_32x32x16_bf16(PAF(3),VFR(7),o[1],0,0,0), C1,12); \
    }while(0)
  int t=1;
  #undef CMASK
  #define CMASK(P0,P1,t) do{}while(0)
  for(;t+5<NT;t+=2){
    STEP(pB0,pB1,pA0,pA1,t,true,true,true);     WAIT_BAR(2); RESC(); ROT();
    STEP(pA0,pA1,pB0,pB1,t+1,true,true,true);   WAIT_BAR(2); RESC(); ROT();
  }
  #undef CMASK
  #define CMASK(P0,P1,t) do{ if((t)>=NT-4) emask(P0,P1,(un.t0+(t))*KVBLK+4*hi,klo,khi); }while(0)
  #define ENDW(tt) do{ if((tt)+3<NT){WAIT_BAR(2);} else if((tt)+2<NT){WAIT_BAR(1);} else {WAIT_BAR(0);} }while(0)
  for(;t+1<NT;t+=2){
    STEP(pB0,pB1,pA0,pA1,t,(t+3<NT),(t+1<NT),(t+1<NT));       ENDW(t);   RESC(); ROT();
    STEP(pA0,pA1,pB0,pB1,t+1,(t+4<NT),(t+2<NT),(t+2<NT));     ENDW(t+1); RESC(); ROT();
  }
  STEP(pB0,pB1,pA0,pA1,NT-1,false,false,false); RESC();
  { float sacc=pB0[0]+pB0[1]; _Pragma("unroll") for(int r=2;r<16;++r)sacc+=pB0[r]; _Pragma("unroll") for(int r=0;r<16;++r)sacc+=pB1[r]; l_reg+=sacc;
    pw0=(u32x4){PKW(pB0,0),PKW(pB0,2),PKW(pB0,4),PKW(pB0,6)};pw1=(u32x4){PKW(pB0,8),PKW(pB0,10),PKW(pB0,12),PKW(pB0,14)};pw2=(u32x4){PKW(pB1,0),PKW(pB1,2),PKW(pB1,4),PKW(pB1,6)};pw3=(u32x4){PKW(pB1,8),PKW(pB1,10),PKW(pB1,12),PKW(pB1,14)};
    SBAR(); pv(o,vb0+sl_cur,PAF(0),PAF(1),PAF(2),PAF(3)); }
  #undef PKW
  #undef PAF
  #undef VFR
  #undef PIN
  #undef MX3
  #undef GAPA
  #undef GAPB
  #undef EX
  #undef VRD
  #undef KRD
  #undef STEP
  #undef ENDW
  {auto rr=__builtin_amdgcn_permlane32_swap(__float_as_uint(l_reg),__float_as_uint(l_reg),false,false);l_reg=__uint_as_float(rr[0])+__uint_as_float(rr[1]);}
  if(hi==0)wsf[32+r32]=un.colscale(wid,r32)*__builtin_amdgcn_rcpf(l_reg);asm volatile("s_waitcnt lgkmcnt(0)":::"memory");
  float rli[16];
  #pragma unroll
  for(int r=0;r<16;++r)rli[r]=wsf[32+crow(r,hi)];
  bf16*Ow=un.Ob+(long)wid*un.owstride;
  { bf16*stg=(bf16*)(shm+LDS_OST)+wid*2048;
    #pragma unroll
    for(int r=0;r<16;++r){const int orow=crow(r,hi);
      #pragma unroll
      for(int d0=0;d0<2;++d0){ float v_=o[d0][r]*rli[r]; if(OMODE>=2) v_+=__bfloat162float(stg[orow*64+d0*32+r32]); stg[orow*64+d0*32+r32]=__float2bfloat16(v_);} }
    asm volatile("s_waitcnt lgkmcnt(0)":::"memory");
    if(OMODE==0||OMODE==3){
    #pragma unroll
    for(int i=0;i<4;++i){const int row=i*8+(lane>>3),ch=lane&7; const u32x4 v=*(const u32x4*)(stg+row*64+ch*8); bf16*gp=Ow+(long)(row>>ORS)*DM+(row&((1<<ORS)-1))*D+ch*8;
      ATTN_STORE16(gp,v);} } }
  asm volatile("s_waitcnt lgkmcnt(0)\n\ts_barrier":::"memory");
  #undef DMA_K
  #undef TABS
  #undef BIAS_MFMA
  #undef UPDQM
  #undef DMA_V
  #undef CMASK
  #undef START
  #undef RESC
  #undef ROT
}
constexpr int ATTN_LDS_BYTES=LDS_BYTES;
#undef SBAR
#undef WAIT_BAR
}
#define GAS __attribute__((address_space(1)))
#define LAS __attribute__((address_space(3)))
typedef unsigned short bf16;
typedef unsigned v4u __attribute__((ext_vector_type(4)));
typedef float f32x4 __attribute__((ext_vector_type(4)));
typedef short bf16x8 __attribute__((ext_vector_type(8)));
typedef GAS unsigned gu32;
typedef GAS unsigned long long gu64;
#define RLX_AGENT __ATOMIC_RELAXED, __HIP_MEMORY_SCOPE_AGENT
#define LDS_WAIT() asm volatile("s_waitcnt lgkmcnt(0)" ::: "memory")
#define VM_WAIT() asm volatile("s_waitcnt vmcnt(0)" ::: "memory")
__device__ __forceinline__ unsigned long long rt() { return __builtin_amdgcn_s_memrealtime(); }
__device__ __forceinline__ unsigned f2bf(float f) { unsigned u = __builtin_bit_cast(unsigned, f); return (u + 0x7fffu + ((u >> 16) & 1u)) >> 16; }
__device__ __forceinline__ unsigned pk2(float lo, float hi) { return f2bf(lo) | (f2bf(hi) << 16); }

#define XB_TMO      128
#define XB_XCNT(j)  (256  + 64 * (j))
#define XB_XSUB(j)  (1280 + 64 * (j))
#define XB_XGEN(j)  (2304 + 64 * (j))
#define XB_TOP      3328
#define XB_TOPGEN   3392
#define XCD_BAR_WORDS 3456
#define XB_SPIN_CAP (1u << 25)

__device__ __forceinline__ unsigned xb_ld(unsigned* p)              { return __hip_atomic_load(p, __ATOMIC_RELAXED, __HIP_MEMORY_SCOPE_AGENT); }
__device__ __forceinline__ unsigned xb_add(unsigned* p, unsigned v) { return __hip_atomic_fetch_add(p, v, __ATOMIC_RELAXED, __HIP_MEMORY_SCOPE_AGENT); }
__device__ __forceinline__ unsigned xb_xcc_id() { return (unsigned)__builtin_amdgcn_s_getreg((3 << 11) | 20) & 0xFu; }
#define XB_SPIN(cond, bar) do { unsigned _sp = 0; while (cond) { __builtin_amdgcn_s_sleep(1); \
    if ((++_sp & 255u) == 0u) { if (xb_ld(&(bar)[XB_TMO])) break; if (_sp > XB_SPIN_CAP) { atomicAdd(&(bar)[XB_TMO], 1u); break; } } } } while (0)

struct XcdBarrier {
    unsigned* bar; unsigned x;
    volatile LAS unsigned* st;
};

__device__ __forceinline__ XcdBarrier xcd_barrier_post(unsigned* bar, volatile LAS unsigned* st) {
    XcdBarrier b; b.bar = bar; b.x = xb_xcc_id(); b.st = st;
    if (threadIdx.x == 0) (void)xb_add(&bar[XB_XCNT(b.x)], 1u);
    return b;
}
__device__ __forceinline__ void xcd_barrier_complete(unsigned* bar, unsigned x, unsigned& nloc, unsigned& nx) {
    const unsigned G = gridDim.x * gridDim.y * gridDim.z;
    unsigned sum, cnt, mine, sp = 0u;
    for (;;) {
        sum = 0u; cnt = 0u; mine = 0u;
#pragma unroll
        for (unsigned j = 0; j < 16; ++j) { const unsigned c = xb_ld(&bar[XB_XCNT(j)]); sum += c; cnt += (c > 0u) ? 1u : 0u; mine = (j == x) ? c : mine; }
        if (sum == G) break;
        __builtin_amdgcn_s_sleep(1);
        if ((++sp & 255u) == 0u) { if (xb_ld(&bar[XB_TMO])) break; if (sp > XB_SPIN_CAP) { atomicAdd(&bar[XB_TMO], 1u); break; } }
    }
    nloc = mine > 0u ? mine : 1u; nx = cnt > 0u ? cnt : 1u;
}

__device__ __forceinline__ void xcd_barrier(const XcdBarrier& b) {
    asm volatile("s_waitcnt vmcnt(0)" ::: "memory");
    __syncthreads();
    if (threadIdx.x == 0) {
        unsigned* bar = b.bar;
        __builtin_amdgcn_s_waitcnt(0);
        unsigned nloc = b.st[0], nx = b.st[1];
        if (nloc == 0u) { xcd_barrier_complete(bar, b.x, nloc, nx); b.st[0] = nloc; b.st[1] = nx; }
        const unsigned old = xb_add(&bar[XB_XSUB(b.x)], 1u);
        const unsigned gen = old / nloc;
        if (old + 1u == (gen + 1u) * nloc) {
            __builtin_amdgcn_fence(__ATOMIC_RELEASE, "agent");
            asm volatile("s_waitcnt vmcnt(0)" ::: "memory");
            const unsigned og = xb_add(&bar[XB_TOP], 1u);
            const unsigned tg = og / nx;
            if (og + 1u == (tg + 1u) * nx) xb_add(&bar[XB_TOPGEN], 1u);
            else XB_SPIN(xb_ld(&bar[XB_TOPGEN]) == tg, bar);
            __builtin_amdgcn_fence(__ATOMIC_ACQUIRE, "agent");
            xb_add(&bar[XB_XGEN(b.x)], 1u);
            asm volatile("s_waitcnt vmcnt(0)" ::: "memory");
        } else {
            XB_SPIN(xb_ld(&bar[XB_XGEN(b.x)]) == gen, bar);
            __builtin_amdgcn_fence(__ATOMIC_ACQUIRE, "agent");
            asm volatile("s_waitcnt vmcnt(0)" ::: "memory");
        }
    }
    __syncthreads();
}
#include <type_traits>
#ifndef PH_MASK
#define PH_MASK 0xFFFF
#endif
#define PH_EN(n) ((PH_MASK >> (n)) & 1)
#ifndef TIME_LSEL
#define TIME_LSEL -1
#endif
#ifndef TIME_LSEL2
#define TIME_LSEL2 TIME_LSEL
#endif
#ifndef TIME_MUL
#define TIME_MUL 1.f
#endif
#ifndef MK_MULTI
#define MK_MULTI 0
#endif
constexpr int NWAVES = 8, NTHR = 512;
constexpr int Bn = 2, S = 8192, T = Bn * S, D = 1024, NH = 16, HD = 64, DEPTH = 4;
constexpr int NE = 64, ED = 256, TOPK = 8, PLE = 256;
constexpr int NSA_G = 4, NCMP = 512;
constexpr float LN_EPS = 1e-5f, NEGF = -1e30f;
constexpr float DN_ALPHA = 1.681792830507429f;
constexpr float ATT_SCALE = 0.125f, QSC = 0.6931471805599453f;
constexpr int NPH = 13;

constexpr size_t MiB = 1u << 20;
constexpr size_t WS_CTL = 0, CTL_ZERO_BYTES = 1 * MiB;
constexpr size_t WS_ROPE_C = 2 * MiB, WS_ROPE_S = 4 * MiB;
constexpr size_t WS_LOGF = 6 * MiB, WS_CUM = 7 * MiB;
constexpr size_t WS_GATES = 8 * MiB;
constexpr size_t WS_KMEAN = 11 * MiB;
constexpr size_t WS_KCMP = 12 * MiB, WS_VCMP = 13 * MiB;
constexpr size_t WS_VCT = 13 * MiB + 512 * 1024;
constexpr size_t WS_PEB = 11 * MiB + 512 * 1024;
constexpr size_t WS_WRT = 11 * MiB + 768 * 1024;
constexpr size_t WS_H1 = 20 * MiB;
constexpr size_t WS_WC1 = 278 * MiB;
constexpr size_t WS_ROWTOK = 24 * MiB;
constexpr size_t WS_LS32 = 18 * MiB + 512 * 1024;
constexpr size_t WS_SELMG = 18 * MiB;
constexpr size_t WS_TOKE = 14 * MiB, WS_TOKW = 15 * MiB, WS_TOKP = 16 * MiB;
constexpr size_t WS_ROWW = 17 * MiB;
constexpr size_t WS_X = 32 * MiB;
constexpr size_t WS_XBA = 96 * MiB, WS_XBB = 128 * MiB;
constexpr size_t WS_WIN = 160 * MiB, WS_WOUT = 166 * MiB, WS_WGU = 168 * MiB, WS_WDN = 233 * MiB, WS_WPG = 266 * MiB, WS_WPP = 268 * MiB;
constexpr size_t WS_PB = 270 * MiB;
constexpr size_t WS_Q = 280 * MiB, WS_K = 312 * MiB, WS_V = 344 * MiB;
constexpr size_t WS_AO = 376 * MiB;
constexpr size_t WS_PP = 408 * MiB;
constexpr size_t WS_QR = 504 * MiB;
constexpr size_t WS_H = 280 * MiB;
constexpr size_t WS_XG = 440 * MiB;
constexpr size_t WS_OUTR = 440 * MiB;
constexpr size_t WS_SET1 = 600 * MiB;
constexpr size_t WS_PEB1 = 11 * MiB + 512 * 1024 + 4096, WS_WRT1 = 11 * MiB + 256 * 1024;
constexpr size_t WS_END = 880 * MiB;
constexpr int R_PAD_TILES = 576, XG_TILE0 = (int)((WS_XG - WS_XBA) / (256 * 1024 * 2));
static_assert((WS_XG - WS_XBA) % (256 * 1024 * 2) == 0, "XG tile alignment");
constexpr int CW_TMO = 0, CW_CODE = 1, CW_BAR = 4096, CW_CNT = 16384  , CW_CHK = 9216, CW_TS = 10240, CW_NRM = 12288, CW_Q = 12800;

constexpr int RING_BYTES = 131072, TAB_OFF = RING_BYTES, MISC_OFF = RING_BYTES + 9216, LDS_BYTES = 147456;

typedef unsigned short bf16_t;
__device__ __forceinline__ float bf2f(unsigned short h) { return __uint_as_float(((unsigned)h) << 16); }
__device__ __forceinline__ float bflo(unsigned u) { return __uint_as_float(u << 16); }
__device__ __forceinline__ float bfhi(unsigned u) { return __uint_as_float(u & 0xffff0000u); }
template <int O> __device__ __forceinline__ float xor_f(float v) { return __int_as_float(__builtin_amdgcn_ds_swizzle(__float_as_int(v), 0x1F | (O << 10))); }
template <int O> __device__ __forceinline__ int xor_i(int v) { return __builtin_amdgcn_ds_swizzle(v, 0x1F | (O << 10)); }
__device__ __forceinline__ float bcast_f(float v, int srclane) { return __int_as_float(__builtin_amdgcn_readlane(__float_as_int(v), srclane)); }
__device__ __forceinline__ float wave_sum(float v) {
    v += xor_f<1>(v); v += xor_f<2>(v); v += xor_f<4>(v); v += xor_f<8>(v); v += xor_f<16>(v);
    auto rr = __builtin_amdgcn_permlane32_swap(__float_as_uint(v), __float_as_uint(v), false, false); return __uint_as_float(rr[0]) + __uint_as_float(rr[1]);
}
__device__ __forceinline__ float wave_max(float v) {
    v = fmaxf(v, xor_f<1>(v)); v = fmaxf(v, xor_f<2>(v)); v = fmaxf(v, xor_f<4>(v)); v = fmaxf(v, xor_f<8>(v)); v = fmaxf(v, xor_f<16>(v));
    auto rr = __builtin_amdgcn_permlane32_swap(__float_as_uint(v), __float_as_uint(v), false, false); return fmaxf(__uint_as_float(rr[0]), __uint_as_float(rr[1]));
}
#define WAVE_SYNC() do { asm volatile("s_waitcnt lgkmcnt(0)" ::: "memory"); __builtin_amdgcn_wave_barrier(); } while (0)

namespace epi {
using pg8::f32x4; using pg8::u32x4; using pg8::Unit; using pg8::cvt_pk_bf16; using pg8::HALF; using pg8::BM;
struct Qkv {
    static constexpr bool PERM = true, AFTER_DRAIN = false;
    bf16_t* O0; int ncq, ld0; bf16_t* O1; int w1, ld1; size_t stride1; float scale0;
    __device__ __forceinline__ void operator()(const f32x4 (&acc)[2][2][4][2], const Unit& u, int wr, int wc, int fr, int fq) const {
        const int row0 = u.pm * BM + wr * 64 + fr; int colt = u.pn * BM; bf16_t* base; int ldc; float sc = 1.f;
        if (colt < ncq) { base = O0; ldc = ld0; sc = scale0; } else { colt -= ncq; const int j = colt / w1; colt -= j * w1; base = O1 + (size_t)j * stride1; ldc = ld1; }
        const int col0 = colt + wc * 32 + 8 * fq;
#pragma unroll
        for (int ai = 0; ai < 2; ++ai)
#pragma unroll
            for (int m = 0; m < 4; ++m) { bf16_t* rowp = base + (size_t)(row0 + ai * HALF + m * 16) * ldc + col0;
#pragma unroll
                for (int bj = 0; bj < 2; ++bj) { const f32x4 v0 = acc[ai][bj][m][0] * sc, v1 = acc[ai][bj][m][1] * sc;
                    u32x4 w; w.x = cvt_pk_bf16(v0[0], v0[1]); w.y = cvt_pk_bf16(v0[2], v0[3]); w.z = cvt_pk_bf16(v1[0], v1[1]); w.w = cvt_pk_bf16(v1[2], v1[3]);
                    *(u32x4*)(rowp + bj * HALF) = w; } }
    }
};
template <bool BF> struct Res {
    static constexpr bool PERM = false, AFTER_DRAIN = false;
    _Float16* X; const void* base; int ldc; float alpha;
    __device__ __forceinline__ void operator()(const f32x4 (&acc)[2][2][4][2], const Unit& u, int wr, int wc, int fr, int fq) const {
        typedef unsigned u32x2 __attribute__((ext_vector_type(2)));
        const int row0 = u.pm * BM + wr * 64 + fr, col0 = u.pn * BM + wc * 32 + 4 * fq;
#pragma unroll
        for (int ai = 0; ai < 2; ++ai)
#pragma unroll
            for (int m = 0; m < 4; ++m) { const size_t ro = (size_t)(row0 + ai * HALF + m * 16) * ldc + col0;
#pragma unroll
                for (int bj = 0; bj < 2; ++bj)
#pragma unroll
                    for (int n = 0; n < 2; ++n) { const size_t off = ro + bj * HALF + n * 16; f32x4 x;
                        if (BF) { const u32x2 w = *(const u32x2*)((const bf16_t*)base + off); x = (f32x4){bflo(w.x), bfhi(w.x), bflo(w.y), bfhi(w.y)}; } else x = *(const f32x4*)((const float*)base + off);
                        const f32x4 o = x * alpha + acc[ai][bj][m][n]; typedef _Float16 h4 __attribute__((ext_vector_type(4)));
                        *(h4*)(X + off) = (h4){(_Float16)o[0], (_Float16)o[1], (_Float16)o[2], (_Float16)o[3]}; } }
    }
};
struct SwiGlu {
    static constexpr bool PERM = true, AFTER_DRAIN = false;
    bf16_t* Hh; int xg0;
    __device__ __forceinline__ void operator()(const f32x4 (&acc)[2][2][4][2], const Unit& u, int wr, int wc, int fr, int fq) const {
        const int ht = (int)u.aofs; const int row0 = ht * BM + wr * 64 + fr; const int col0 = (u.pn & 1) * 128 + wc * 32 + 8 * fq;
#pragma unroll
        for (int ai = 0; ai < 2; ++ai)
#pragma unroll
            for (int m = 0; m < 4; ++m) { bf16_t* rowp = Hh + (size_t)(row0 + ai * HALF + m * 16) * ED + col0;
                float h[8];
#pragma unroll
                for (int n = 0; n < 2; ++n)
#pragma unroll
                    for (int j = 0; j < 4; ++j) { const float g = acc[ai][0][m][n][j], up = acc[ai][1][m][n][j];
                        const float sg = g * __builtin_amdgcn_rcpf(1.f + __builtin_amdgcn_exp2f(-g * 1.4426950408889634f)); h[n * 4 + j] = sg * up; }
                u32x4 w; w.x = cvt_pk_bf16(h[0], h[1]); w.y = cvt_pk_bf16(h[2], h[3]); w.z = cvt_pk_bf16(h[4], h[5]); w.w = cvt_pk_bf16(h[6], h[7]);
                *(u32x4*)rowp = w; }
    }
};
struct Down {
    static constexpr bool PERM = true, AFTER_DRAIN = false;
    bf16_t* O;
    __device__ __forceinline__ void operator()(const f32x4 (&acc)[2][2][4][2], const Unit& u, int wr, int wc, int fr, int fq) const {
        const int row0 = u.pm * BM + wr * 64 + fr; const int col0 = (u.pn & 3) * BM + wc * 32 + 8 * fq;
#pragma unroll
        for (int ai = 0; ai < 2; ++ai)
#pragma unroll
            for (int m = 0; m < 4; ++m) { const int row = row0 + ai * HALF + m * 16; const float sc = 1.f;
#if defined(OUTR_FP8)
                typedef unsigned u32x2 __attribute__((ext_vector_type(2)));
                unsigned char* rowp = (unsigned char*)O + (size_t)row * D + col0;
#pragma unroll
                for (int bj = 0; bj < 2; ++bj) { f32x4 v0 = acc[ai][bj][m][0] * (64.f * sc), v1 = acc[ai][bj][m][1] * (64.f * sc);
#pragma unroll
                    for (int e = 0; e < 4; ++e) { v0[e] = fminf(fmaxf(v0[e], -440.f), 440.f); v1[e] = fminf(fmaxf(v1[e], -440.f), 440.f); }
                    u32x2 w; int t0 = __builtin_amdgcn_cvt_pk_fp8_f32(v0[0], v0[1], 0, false); t0 = __builtin_amdgcn_cvt_pk_fp8_f32(v0[2], v0[3], t0, true);
                    int t1 = __builtin_amdgcn_cvt_pk_fp8_f32(v1[0], v1[1], 0, false); t1 = __builtin_amdgcn_cvt_pk_fp8_f32(v1[2], v1[3], t1, true); w.x = (unsigned)t0; w.y = (unsigned)t1;
                    *(u32x2*)(rowp + bj * HALF) = w; } }
#else
                bf16_t* rowp = O + (size_t)row * D + col0;
#pragma unroll
                for (int bj = 0; bj < 2; ++bj) { const f32x4 v0 = acc[ai][bj][m][0] * sc, v1 = acc[ai][bj][m][1] * sc;
                    u32x4 w; w.x = cvt_pk_bf16(v0[0], v0[1]); w.y = cvt_pk_bf16(v0[2], v0[3]); w.z = cvt_pk_bf16(v1[0], v1[1]); w.w = cvt_pk_bf16(v1[2], v1[3]);
                    *(u32x4*)(rowp + bj * HALF) = w; } }
#endif
    }
};
struct StoreBf16 {
    static constexpr bool PERM = true, AFTER_DRAIN = false;
    bf16_t* O; int ldc;
    __device__ __forceinline__ void operator()(const f32x4 (&acc)[2][2][4][2], const Unit& u, int wr, int wc, int fr, int fq) const {
        const int row0 = u.pm * BM + wr * 64 + fr; const int col0 = u.pn * BM + wc * 32 + 8 * fq;
#pragma unroll
        for (int ai = 0; ai < 2; ++ai)
#pragma unroll
            for (int m = 0; m < 4; ++m) { bf16_t* rowp = O + (size_t)(row0 + ai * HALF + m * 16) * ldc + col0;
#pragma unroll
                for (int bj = 0; bj < 2; ++bj) { const f32x4 v0 = acc[ai][bj][m][0], v1 = acc[ai][bj][m][1];
                    u32x4 w; w.x = cvt_pk_bf16(v0[0], v0[1]); w.y = cvt_pk_bf16(v0[2], v0[3]); w.z = cvt_pk_bf16(v1[0], v1[1]); w.w = cvt_pk_bf16(v1[2], v1[3]);
                    *(u32x4*)(rowp + bj * HALF) = w; } }
    }
};
template <bool LAST> struct Ple {
    static constexpr bool PERM = false, AFTER_DRAIN = false;
    const bf16_t* XB; const bf16_t* PP; float* OutF; bf16_t* XBn;
    __device__ __forceinline__ void operator()(const f32x4 (&acc)[2][2][4][2], const Unit& u, int wr, int wc, int fr, int fq) const {
        typedef unsigned u32x2 __attribute__((ext_vector_type(2)));
        const int row0 = u.pm * BM + wr * 64 + fr, col0 = u.pn * BM + wc * 32 + 4 * fq;
#pragma unroll
        for (int ai = 0; ai < 2; ++ai)
#pragma unroll
            for (int m = 0; m < 4; ++m) { const size_t ro = (size_t)(row0 + ai * HALF + m * 16) * D + col0;
#pragma unroll
                for (int bj = 0; bj < 2; ++bj)
#pragma unroll
                    for (int n = 0; n < 2; ++n) { const size_t off = ro + bj * HALF + n * 16; const u32x2 xw = *(const u32x2*)(XB + off); const f32x4 x = {bflo(xw.x), bfhi(xw.x), bflo(xw.y), bfhi(xw.y)}; const u32x2 pp = *(const u32x2*)(PP + off);
                        const f32x4 a = acc[ai][bj][m][n]; f32x4 o;
                        o[0] = x[0] + bflo(pp.x) * __builtin_amdgcn_rcpf(1.f + __builtin_amdgcn_exp2f(-a[0] * 1.4426950408889634f));
                        o[1] = x[1] + bfhi(pp.x) * __builtin_amdgcn_rcpf(1.f + __builtin_amdgcn_exp2f(-a[1] * 1.4426950408889634f));
                        o[2] = x[2] + bflo(pp.y) * __builtin_amdgcn_rcpf(1.f + __builtin_amdgcn_exp2f(-a[2] * 1.4426950408889634f));
                        o[3] = x[3] + bfhi(pp.y) * __builtin_amdgcn_rcpf(1.f + __builtin_amdgcn_exp2f(-a[3] * 1.4426950408889634f));
                        if (LAST) *(f32x4*)(OutF + off) = o; else { u32x2 w; w.x = cvt_pk_bf16(o[0], o[1]); w.y = cvt_pk_bf16(o[2], o[3]); *(u32x2*)(XBn + off) = w; } } }
    }
};
}

struct MoeOrder {
    const LAS int* tstart;
    int NC, G, c, NU, lists;
    __device__ __forceinline__ bool next(int i, pg8::Unit& u) const {
        const int x = c & 7, npx = G >> 3; int li = i * npx + (c >> 3); int e, j, cc, rt;
        if (li < 8 * NC) { e = 64; j = x + 8 * (li / NC); cc = li % NC; rt = j; }
        else { li -= 8 * NC; e = -1; j = 0; cc = 0; rt = 0;
            for (int q = 0; q < 8; ++q) { const int eq = x + 8 * q; const int t0 = tstart[eq], n = (tstart[eq + 1] - t0) * NC;
                if (e < 0) { if (li < n) { e = eq; j = li / NC; cc = li % NC; rt = 64 + t0 + j; } else li -= n; } }
            if (e < 0) return false; }
        u.pm = lists ? e * 64 + j : rt; u.pn = e * NC + cc; u.aofs = lists ? rt : 0; return true; }
    __device__ __forceinline__ void a_ready(const pg8::Unit&) const {}
    __device__ __forceinline__ void done(const pg8::Unit&) const {}
};

struct CmpOrder {
    int G, c;
    __device__ __forceinline__ bool next(int i, pg8::Unit& u) const { const long L = (long)i * G + c; if (L >= 32) return false;
        const int kv = (int)L >> 4, bg = ((int)L >> 1) & 7, half = (int)L & 1, b = bg >> 2, g = bg & 3;
        u.pm = 0; u.pn = kv; u.aofs = (long)kv * (8 << 20) + (long)b * (4 << 20) + g * 128 + (long)half * (2 << 20); return true; }
    __device__ __forceinline__ void a_ready(const pg8::Unit&) const {}
    __device__ __forceinline__ void done(const pg8::Unit&) const {}
};
namespace epi {
struct H1Store {
    static constexpr bool PERM = false, AFTER_DRAIN = false;
    float* H;
    __device__ __forceinline__ void operator()(const f32x4 (&acc)[2][2][4][2], const Unit& u, int wr, int wc, int fr, int fq) const {
        const long a = u.aofs; const int kv = (int)(a >> 23), b = (int)(a >> 22) & 1, half = (int)(a >> 21) & 1, g = (int)(a >> 7) & 3;
        const size_t rowb = ((size_t)(kv * 8 + b * 4 + g) * 512 + half * 256 + wr * 64 + fr);
#pragma unroll
        for (int ai = 0; ai < 2; ++ai)
#pragma unroll
            for (int m = 0; m < 4; ++m) { float* rowp = H + (rowb + ai * HALF + m * 16) * 128 + wc * 32 + 4 * fq;
#pragma unroll
                for (int n = 0; n < 2; ++n) *(f32x4*)(rowp + n * 16) = acc[ai][0][m][n]; }
    }
};
}
__device__ __forceinline__ void transpose_item(const float* W, int ldw, int k0, int n0, bf16* WT, int K, int drow0, LAS float* scr, int lane) {
#pragma unroll 8
    for (int i = 0; i < 32; ++i) { const int kk = 2 * i + (lane >> 5); scr[kk * 33 + (lane & 31)] = W[(size_t)(k0 + kk) * ldw + n0 + (lane & 31)]; }
    LDS_WAIT(); asm volatile("" ::: "memory");
    const int c = lane & 7;
#pragma unroll
    for (int j = 0; j < 4; ++j) { const int n = (lane >> 3) + 8 * j; const LAS float* s = scr + (8 * c) * 33 + n;
        v4u o; o.x = pk2(s[0 * 33], s[1 * 33]); o.y = pk2(s[2 * 33], s[3 * 33]); o.z = pk2(s[4 * 33], s[5 * 33]); o.w = pk2(s[6 * 33], s[7 * 33]);
        *(GAS v4u*)(WT + (size_t)(drow0 + n) * K + k0 + 8 * c) = o; }
    LDS_WAIT(); asm volatile("" ::: "memory");
}

__device__ __forceinline__ void transpose_item64(const float* W, int ldw, int k0, int n0, bf16* WT, int K, int drow0, int lane) {
    const int n4 = lane & 15, kg = lane >> 4; const float* src = W + (size_t)(k0 + 16 * kg) * ldw + n0 + 4 * n4;
    f32x4 v[16];
#pragma unroll
    for (int i = 0; i < 16; ++i) v[i] = __builtin_nontemporal_load((const GAS f32x4*)(src + (size_t)i * ldw));
    bf16* dst = WT + (size_t)(drow0 + 4 * n4) * K + k0 + 16 * kg;
#pragma unroll
    for (int j = 0; j < 4; ++j) { v4u a, b;
        a.x = pk2(v[0][j], v[1][j]); a.y = pk2(v[2][j], v[3][j]); a.z = pk2(v[4][j], v[5][j]); a.w = pk2(v[6][j], v[7][j]);
        b.x = pk2(v[8][j], v[9][j]); b.y = pk2(v[10][j], v[11][j]); b.z = pk2(v[12][j], v[13][j]); b.w = pk2(v[14][j], v[15][j]);
        *(GAS v4u*)(dst + (size_t)j * K) = a; *(GAS v4u*)(dst + (size_t)j * K + 8) = b; }
}

__device__ __forceinline__ void titem_load(f32x4 (&v)[16], const float* W, int ldw, int lane) {
    const int n4 = lane & 15, kg = lane >> 4; const float* src = W + (size_t)(8 * kg) * ldw + 4 * n4;
#pragma unroll
    for (int i = 0; i < 16; ++i) v[i] = *(const GAS f32x4*)(src + (size_t)((i & 7) + 32 * (i >> 3)) * ldw);
}
__device__ __forceinline__ void titem_store(const f32x4 (&v)[16], bf16* WT, int K, int lane) {
    const int n4 = lane & 15, kg = lane >> 4; bf16* dst = WT + (size_t)(4 * n4) * K + 8 * kg;
#pragma unroll
    for (int j = 0; j < 4; ++j) { v4u a, b;
        a.x = gattn::cvtpk_s(v[0][j], v[1][j]); a.y = gattn::cvtpk_s(v[2][j], v[3][j]); a.z = gattn::cvtpk_s(v[4][j], v[5][j]); a.w = gattn::cvtpk_s(v[6][j], v[7][j]);
        b.x = gattn::cvtpk_s(v[8][j], v[9][j]); b.y = gattn::cvtpk_s(v[10][j], v[11][j]); b.z = gattn::cvtpk_s(v[12][j], v[13][j]); b.w = gattn::cvtpk_s(v[14][j], v[15][j]);
        *(GAS v4u*)(dst + (size_t)j * K) = a; *(GAS v4u*)(dst + (size_t)j * K + 32) = b; }
}

template <int NHq, class KeyFn, class BiasFn>
__device__ __forceinline__ void attend_chunk(const float* qs, float* pb, int* kb, const bf16_t* Kp, const bf16_t* Vp, int pitch, int nslots,
                                             KeyFn keyfn, BiasFn biasfn, float scale, float (&m)[NHq], float (&l)[NHq], float (&o)[NHq], int lane) {
    float cm[NHq];
#pragma unroll
    for (int h = 0; h < NHq; ++h) cm[h] = NEGF;
    for (int i = 0; i < 8; ++i) {
        const int slot = lane + 64 * i;
        const int key = (slot < nslots) ? keyfn(slot) : -1;
        float s[NHq];
#pragma unroll
        for (int h = 0; h < NHq; ++h) s[h] = NEGF;
        if (key >= 0) {
            const uint4* kr = (const uint4*)(Kp + (size_t)key * pitch);
#pragma unroll
            for (int h = 0; h < NHq; ++h) s[h] = 0.f;
#pragma unroll
            for (int c = 0; c < 8; ++c) {
                const uint4 kv = kr[c];
                const float k0 = bflo(kv.x), k1 = bfhi(kv.x), k2 = bflo(kv.y), k3 = bfhi(kv.y), k4 = bflo(kv.z), k5 = bfhi(kv.z), k6 = bflo(kv.w), k7 = bfhi(kv.w);
#pragma unroll
                for (int h = 0; h < NHq; ++h) { const float4 qa = *(const float4*)(qs + h * 64 + 8 * c), qb = *(const float4*)(qs + h * 64 + 8 * c + 4);
                    s[h] += qa.x * k0 + qa.y * k1 + qa.z * k2 + qa.w * k3 + qb.x * k4 + qb.y * k5 + qb.z * k6 + qb.w * k7; }
            }
            const float bs = biasfn(slot);
#pragma unroll
            for (int h = 0; h < NHq; ++h) { s[h] = s[h] * scale + bs; cm[h] = fmaxf(cm[h], s[h]); }
        }
#pragma unroll
        for (int h = 0; h < NHq; ++h) pb[h * 512 + slot] = s[h];
        kb[slot] = key;
    }
    float f[NHq], mn[NHq], ls[NHq];
#pragma unroll
    for (int h = 0; h < NHq; ++h) { mn[h] = fmaxf(m[h], wave_max(cm[h])); f[h] = __expf(m[h] - mn[h]); ls[h] = 0.f; }
    WAVE_SYNC();
    for (int i = 0; i < 8; ++i) {
        const int slot = lane + 64 * i; const bool ok = kb[slot] >= 0;
#pragma unroll
        for (int h = 0; h < NHq; ++h) { const float p = ok ? __expf(pb[h * 512 + slot] - mn[h]) : 0.f; pb[h * 512 + slot] = p; ls[h] += p; }
    }
#pragma unroll
    for (int h = 0; h < NHq; ++h) { l[h] = l[h] * f[h] + wave_sum(ls[h]); o[h] *= f[h]; m[h] = mn[h]; }
    WAVE_SYNC();
    const int ns8 = (nslots + 7) & ~7;
    for (int sl = 0; sl < ns8; sl += 8) {
#pragma unroll
        for (int u = 0; u < 8; ++u) { const int key = kb[sl + u]; const int kk = key < 0 ? 0 : key; const float v = bf2f(Vp[(size_t)kk * pitch + lane]);
#pragma unroll
            for (int h = 0; h < NHq; ++h) o[h] += pb[h * 512 + sl + u] * v; }
    }
    WAVE_SYNC();
}

typedef gattn::bf16 abf16;
struct FoxU {
    const abf16 *Kb, *Vb; int kpitch, t0, NT, tmax; const float* cum; int q0; abf16* Ob; long owstride; const abf16* Qb; const LAS unsigned* mtab;
    __device__ __forceinline__ const abf16* qrow(int wid, int r32) const { return Qb + (long)(wid * 32 + r32) * D; }
    __device__ __forceinline__ int klo(int, int) const { return -2147483647; }
    __device__ __forceinline__ int khi(int wid, int r32) const { return q0 + wid * 32 + r32; }
    __device__ __forceinline__ float colscale(int, int) const { return 1.f; }
    __device__ __forceinline__ unsigned term(int wid, int r32, int tabs) const { return mtab ? (((mtab[wid * 32 + r32] >> (tabs >> 2)) & 1u) ? 0u : 0xC700u) : 0u; }
};
__device__ __forceinline__ void fox_order(int vcu, int i, int& bh, int& qb) { const int s = vcu & 7; bh = vcu >> 3; qb = (i == 0) ? s : (i == 1) ? 15 - s : (i == 2) ? 16 + s : 31 - s; }

struct NsaU {
    const abf16 *Kb, *Vb; int kpitch, t0, NT, tmax; const float* cum; int q0; abf16* Ob; long owstride; const abf16* Qb; const LAS unsigned* selm; const float* gates; int br; int wlen;
    __device__ __forceinline__ const abf16* qrow(int wid, int r32) const { return Qb + (long)(wid * 8 + (r32 >> 2)) * D + (r32 & 3) * 64; }
    __device__ __forceinline__ int khi(int wid, int r32) const { return q0 + wid * 8 + (r32 >> 2); }
    __device__ __forceinline__ int klo(int wid, int r32) const { return wlen ? q0 + wid * 8 + (r32 >> 2) - (wlen - 1) : -2147483647; }
    __device__ __forceinline__ float colscale(int wid, int r32) const { return gates[(wid * 8 + (r32 >> 2)) * 48 + (r32 & 3) * 3 + br]; }
    __device__ __forceinline__ unsigned term(int wid, int r32, int tabs) const {
        if (selm) { const unsigned w = selm[(wid * 8 + (r32 >> 2)) * 4 + ((tabs >> 5) & 3)]; return (tabs < 128 && ((w >> (tabs & 31)) & 1u)) ? 0u : 0xC700u; }
        return tabs < 0 ? 0xC700u : 0u; }
};
constexpr int NSA_IMP_LD = 132;
constexpr int NSA_LDS_IMP = gattn::LDS_BT, NSA_LDS_SELM = NSA_LDS_IMP + 64 * NSA_IMP_LD * 4, NSA_LDS_PRI = NSA_LDS_SELM + 1024;
static_assert(NSA_LDS_PRI + 8 * 512 <= RING_BYTES, "NSA LDS map");
__device__ __forceinline__ int swapmid(int x) { return (x & 3) | ((x & 4) << 1) | ((x & 8) >> 1); }

__device__ __forceinline__ void nsa_cmp_select(char* shm, int b, int g, int q0, const bf16_t* QBs, const bf16_t* KCMPs, const bf16_t* VCTs, const float* GATESs, unsigned* selm_g) {
    using gattn::bf16x8; using gattn::f32x16; using gattn::u32x4; using gattn::crow; using gattn::cvtpk_s;
    int tid_o = threadIdx.x; asm volatile("" : "+v"(tid_o)); const int tid = tid_o, lane = tid & 63, r32 = lane & 31, hi = lane >> 5; const int wid = __builtin_amdgcn_readfirstlane(tid >> 6);
    const size_t rb = (size_t)b * S; const int bg = b * NSA_G + g;
    const int tl = r32 >> 2, hh = r32 & 3, tq = q0 + wid * 8 + tl;
    const int nv = tq >= 31 ? ((tq - 31) >> 4) + 1 : 0;
    const int nvmax = ((q0 + 63 - 31) >> 4) + 1, ntile = (nvmax + 63) >> 6;
    float* imp = (float*)(shm + NSA_LDS_IMP); unsigned* selm = (unsigned*)(shm + NSA_LDS_SELM); float* pri = (float*)(shm + NSA_LDS_PRI) + wid * 128;
    for (int i = lane; i < 8 * NSA_IMP_LD; i += 64) imp[wid * 8 * NSA_IMP_LD + i] = 0.f;
    const bf16_t* qp = QBs + (rb + tq) * D + (g * 4 + hh) * 64;
    bf16x8 qf[4];
#pragma unroll
    for (int d0 = 0; d0 < 4; ++d0) qf[d0] = *(const bf16x8*)(qp + d0 * 16 + hi * 8);
    const bf16_t* KC = KCMPs + (size_t)bg * NCMP * 64; const bf16_t* VC = VCTs + (size_t)bg * 8 * 64 * 64;
    bf16x8 ovf[4];
#pragma unroll
    for (int kk = 0; kk < 4; ++kk) { u32x4 w = {0u, 0u, 0u, 0u};
#pragma unroll
        for (int i = 0; i < 8; ++i) { const int nl = 16 * kk + swapmid(8 * hi + i); const unsigned one = (r32 <= 16 && nl >= 4 * r32 - 1 && nl <= 4 * r32 + 3) ? 0x3F80u : 0u; w[i >> 1] |= one << (16 * (i & 1)); }
        ovf[kk] = __builtin_bit_cast(bf16x8, w); }
#define NSA_KLD(KA, KB_, k) do { const bf16_t* kr0 = KC + (size_t)(64 * (k) + r32) * 64 + hi * 8; \
        _Pragma("unroll") for (int d0 = 0; d0 < 4; ++d0) { KA[d0] = *(const bf16x8*)(kr0 + d0 * 16); KB_[d0] = *(const bf16x8*)(kr0 + 32 * 64 + d0 * 16); } } while (0)
#define NSA_QK(P0, P1, KA, KB_) do { const f32x16 z = {}; P0 = z; P1 = z; \
        _Pragma("unroll") for (int d0 = 0; d0 < 4; ++d0) { P0 = __builtin_amdgcn_mfma_f32_32x32x16_bf16(KA[d0], qf[d0], P0, 0, 0, 0); P1 = __builtin_amdgcn_mfma_f32_32x32x16_bf16(KB_[d0], qf[d0], P1, 0, 0, 0); } } while (0)
    float m = -60000.f, l = 0.f;
    bf16x8 ka[4], kb[4], na[4], nb[4]; NSA_KLD(ka, kb, 0);
    for (int k = 0; k < ntile; ++k) { f32x16 p0, p1; NSA_KLD(na, nb, (k + 1 < ntile ? k + 1 : 0)); NSA_QK(p0, p1, ka, kb);
#pragma unroll
        for (int d0 = 0; d0 < 4; ++d0) { ka[d0] = na[d0]; kb[d0] = nb[d0]; }
        float tm = -60000.f;
#pragma unroll
        for (int r = 0; r < 16; ++r) { const int n = 64 * k + crow(r, hi); p0[r] = n < nv ? p0[r] : -60000.f; p1[r] = n + 32 < nv ? p1[r] : -60000.f; tm = fmaxf(tm, fmaxf(p0[r], p1[r])); }
        { auto rr = __builtin_amdgcn_permlane32_swap(__float_as_uint(tm), __float_as_uint(tm), false, false); tm = fmaxf(__uint_as_float(rr[0]), __uint_as_float(rr[1])); }
        const float mn = fmaxf(m, tm); float ls = 0.f;
#pragma unroll
        for (int r = 0; r < 16; ++r) { const int n = 64 * k + crow(r, hi); ls += (n < nv ? __builtin_amdgcn_exp2f(p0[r] - mn) : 0.f) + (n + 32 < nv ? __builtin_amdgcn_exp2f(p1[r] - mn) : 0.f); }
        l = l * __builtin_amdgcn_exp2f(m - mn) + ls; m = mn; }
    { auto rr = __builtin_amdgcn_permlane32_swap(__float_as_uint(l), __float_as_uint(l), false, false); l = __uint_as_float(rr[0]) + __uint_as_float(rr[1]); }
    const float il = 1.f / fmaxf(l, 1e-30f);
    NSA_KLD(ka, kb, 0);
    f32x16 o[2]; o[0] = f32x16{}; o[1] = f32x16{};
    for (int k = 0; k < ntile; ++k) { f32x16 p0, p1; NSA_KLD(na, nb, (k + 1 < ntile ? k + 1 : 0));
        bf16x8 vfr[4][2];
#pragma unroll
        for (int kk = 0; kk < 4; ++kk)
#pragma unroll
            for (int d0 = 0; d0 < 2; ++d0) vfr[kk][d0] = *(const bf16x8*)(VC + ((size_t)(k * 64 + d0 * 32 + r32)) * 64 + kk * 16 + hi * 8);
        NSA_QK(p0, p1, ka, kb);
#pragma unroll
        for (int d0 = 0; d0 < 4; ++d0) { ka[d0] = na[d0]; kb[d0] = nb[d0]; }
#pragma unroll
        for (int r = 0; r < 16; ++r) { const int n = 64 * k + crow(r, hi); p0[r] = n < nv ? __builtin_amdgcn_exp2f(p0[r] - m) * il : 0.f; p1[r] = n + 32 < nv ? __builtin_amdgcn_exp2f(p1[r] - m) * il : 0.f; }
        u32x4 pw[4];
        pw[0] = (u32x4){cvtpk_s(p0[0], p0[1]), cvtpk_s(p0[2], p0[3]), cvtpk_s(p0[4], p0[5]), cvtpk_s(p0[6], p0[7])};
        pw[1] = (u32x4){cvtpk_s(p0[8], p0[9]), cvtpk_s(p0[10], p0[11]), cvtpk_s(p0[12], p0[13]), cvtpk_s(p0[14], p0[15])};
        pw[2] = (u32x4){cvtpk_s(p1[0], p1[1]), cvtpk_s(p1[2], p1[3]), cvtpk_s(p1[4], p1[5]), cvtpk_s(p1[6], p1[7])};
        pw[3] = (u32x4){cvtpk_s(p1[8], p1[9]), cvtpk_s(p1[10], p1[11]), cvtpk_s(p1[12], p1[13]), cvtpk_s(p1[14], p1[15])};
        f32x16 u = f32x16{};
#pragma unroll
        for (int kk = 0; kk < 4; ++kk) { const bf16x8 pa = __builtin_bit_cast(bf16x8, pw[kk]);
#pragma unroll
            for (int d0 = 0; d0 < 2; ++d0) o[d0] = __builtin_amdgcn_mfma_f32_32x32x16_bf16(pa, vfr[kk][d0], o[d0], 0, 0, 0);
            u = __builtin_amdgcn_mfma_f32_32x32x16_bf16(pa, ovf[kk], u, 0, 0, 0); }
        if (r32 <= 16) {
#pragma unroll
            for (int c = 0; c < 4; ++c) { const float sgrp = (u[4 * c] + u[4 * c + 1]) + (u[4 * c + 2] + u[4 * c + 3]); float* ip = imp + (wid * 8 + 2 * c + hi) * NSA_IMP_LD + 16 * k + r32; *ip += sgrp; } }
        WAVE_SYNC(); }
#undef NSA_QK
#undef NSA_KLD
    { float* wsf = (float*)(shm + gattn::LDS_WS) + wid * 64; if (hi == 0) wsf[32 + r32] = GATESs[(rb + tq) * 48 + (g * 4 + hh) * 3 + 0]; WAVE_SYNC();
      abf16* stg = (abf16*)(shm + gattn::LDS_OST) + wid * 2048;
#pragma unroll
      for (int r = 0; r < 16; ++r) { const int orow = crow(r, hi); const float gsc = wsf[32 + orow];
#pragma unroll
          for (int d0 = 0; d0 < 2; ++d0) stg[orow * 64 + d0 * 32 + r32] = __float2bfloat16(o[d0][r] * gsc); } }
    WAVE_SYNC();
    const int cur = q0 >> 6;
    for (int t8 = 0; t8 < 8; ++t8) { const int tok = wid * 8 + t8; const float* ip = imp + tok * NSA_IMP_LD;
        const int j0 = lane, j1 = lane + 64; const float i0 = ip[j0], i1 = ip[j1];
        const bool f0 = (j0 == 0) || (j0 == cur) || (j0 == cur - 1), f1 = (j1 == 0) || (j1 == cur) || (j1 == cur - 1);
        float pr0 = f0 ? i0 + 1e4f : i0, pr1 = f1 ? i1 + 1e4f : i1; pr0 = j0 <= cur ? pr0 : NEGF; pr1 = j1 <= cur ? pr1 : NEGF;
        const unsigned ub0 = __float_as_uint(pr0), ub1 = __float_as_uint(pr1);
        const unsigned k0 = (ub0 & 0x80000000u) ? ~ub0 : (ub0 | 0x80000000u), k1 = (ub1 & 0x80000000u) ? ~ub1 : (ub1 | 0x80000000u);
        unsigned thr = 0u;
        for (int bit = 31; bit >= 0; --bit) { const unsigned cand = thr | (1u << bit);
            const int c = __popcll(__builtin_amdgcn_ballot_w64(k0 >= cand)) + __popcll(__builtin_amdgcn_ballot_w64(k1 >= cand));
            thr = c >= 16 ? cand : thr; }
        const unsigned long long g0 = __builtin_amdgcn_ballot_w64(k0 > thr), g1 = __builtin_amdgcn_ballot_w64(k1 > thr);
        const unsigned long long e0 = __builtin_amdgcn_ballot_w64(k0 == thr), e1 = __builtin_amdgcn_ballot_w64(k1 == thr);
        int need = 16 - (__popcll(g0) + __popcll(g1));
        unsigned long long t0m = 0ull, t1m = 0ull;
        { unsigned long long e = e0; while (need > 0 && e) { const unsigned long long lowb = e & (0ull - e); t0m |= lowb; e ^= lowb; --need; } }
        { unsigned long long e = e1; while (need > 0 && e) { const unsigned long long lowb = e & (0ull - e); t1m |= lowb; e ^= lowb; --need; } }
        const unsigned long long vm0 = cur >= 63 ? ~0ull : ((1ull << (cur + 1)) - 1ull), vm1 = cur >= 127 ? ~0ull : (cur >= 64 ? ((1ull << (cur - 63)) - 1ull) : 0ull);
        const unsigned long long b0 = (g0 | t0m) & vm0, b1 = (g1 | t1m) & vm1;
        if (lane == 0) { selm[tok * 4 + 0] = (unsigned)b0; selm[tok * 4 + 1] = (unsigned)(b0 >> 32); selm[tok * 4 + 2] = (unsigned)b1; selm[tok * 4 + 3] = (unsigned)(b1 >> 32);
            if (selm_g) { unsigned* sg = selm_g + ((size_t)(rb + q0 + tok) * NSA_G + g) * 4; sg[0] = (unsigned)b0; sg[1] = (unsigned)(b0 >> 32); sg[2] = (unsigned)b1; sg[3] = (unsigned)(b1 >> 32); } }
        WAVE_SYNC(); }
}

struct Args { const void* in[31]; float* out; unsigned char* ws; int ph_lo, ph_hi; };

__device__ __forceinline__ float sigmoidf_(float z) { return 1.f / (1.f + __expf(-z)); }
__device__ __forceinline__ float gelu_tanh(float x) { const float u = 0.7978845608028654f * (x + 0.044715f * x * x * x); const float e = __expf(2.f * u); return 0.5f * x * (1.f + (1.f - 2.f / (e + 1.f))); }

__device__ __forceinline__ void ln_row(f32x4 (&v)[4], const float* g, const float* b, int lane) {
    float s = 0.f;
#pragma unroll
    for (int j = 0; j < 4; ++j) s += (v[j].x + v[j].y) + (v[j].z + v[j].w);
    const float mean = wave_sum(s) * (1.f / D); float s2 = 0.f;
#pragma unroll
    for (int j = 0; j < 4; ++j) { v[j] = v[j] - mean; s2 += (v[j].x * v[j].x + v[j].y * v[j].y) + (v[j].z * v[j].z + v[j].w * v[j].w); }
    const float rstd = 1.f / sqrtf(wave_sum(s2) * (1.f / D) + LN_EPS);
#pragma unroll
    for (int j = 0; j < 4; ++j) { const f32x4 gg = *(const f32x4*)(g + 4 * lane + 256 * j), bb = *(const f32x4*)(b + 4 * lane + 256 * j); v[j] = v[j] * rstd * gg + bb; }
}

__global__ void __launch_bounds__(NTHR, 2) mk_fwd(Args args) {
    extern __shared__ __attribute__((aligned(16))) unsigned char lds[];
    const int G = gridDim.x, bx = blockIdx.x;
    const int NGW = G * NWAVES, NGT = G * NTHR;
#define PH_IDS() int tid_o = threadIdx.x; asm volatile("" : "+v"(tid_o)); const int tid = tid_o, lane = tid & 63, wave = __builtin_amdgcn_readfirstlane(tid >> 6); \
    const int gw = bx * NWAVES + wave, gtid = bx * NTHR + tid; (void)gw; (void)gtid; (void)lane; (void)wave;
    unsigned char* ws = args.ws;
    gu32* ctl = (gu32*)(ws + WS_CTL);
    LAS unsigned char* ldsl = (LAS unsigned char*)lds;
    volatile LAS unsigned* MISC = (volatile LAS unsigned*)(ldsl + MISC_OFF);
    LAS int* TAB = (LAS int*)(ldsl + TAB_OFF);
    for (int u = threadIdx.x; u < (LDS_BYTES - RING_BYTES) / 4; u += NTHR) ((LAS unsigned*)(ldsl + RING_BYTES))[u] = 0u;
    __syncthreads();
    XcdBarrier bar; bar.bar = (unsigned*)(ctl + CW_BAR); bar.x = 0; bar.st = nullptr;
    if (!MK_MULTI) bar = xcd_barrier_post((unsigned*)(ctl + CW_BAR), MISC + 8);
#if defined(TIME_P1)
#define SEAM_AT(k) do { xcd_barrier(bar); if (blockIdx.x == 0 && threadIdx.x == 0) { ((unsigned long long*)(ctl + CW_TS))[(k)] = __builtin_amdgcn_s_memrealtime(); } } while (0)
#else
#define SEAM_AT(k) do { xcd_barrier(bar); } while (0)
#endif
#define SEAM() SEAM_AT(0)
#define IN(gp) (args.ph_lo <= (gp) && (gp) < args.ph_hi)

    float* X = (float*)(ws + WS_X);
    bf16_t* XBA = (bf16_t*)(ws + WS_XBA); bf16_t* XBB = (bf16_t*)(ws + WS_XBB);
    float* ROPE_C = (float*)(ws + WS_ROPE_C); float* ROPE_S = (float*)(ws + WS_ROPE_S);
    float* LOGF = (float*)(ws + WS_LOGF); float* CUM = (float*)(ws + WS_CUM); float* GATES = (float*)(ws + WS_GATES); float* KMEAN = (float*)(ws + WS_KMEAN);
    bf16_t* KCMP = (bf16_t*)(ws + WS_KCMP); bf16_t* VCMP = (bf16_t*)(ws + WS_VCMP); bf16_t* VCT = (bf16_t*)(ws + WS_VCT); unsigned* SELMG = (unsigned*)(ws + WS_SELMG);
    int* ROWTOK = (int*)(ws + WS_ROWTOK); float* LS32 = (float*)(ws + WS_LS32); float* H1 = (float*)(ws + WS_H1);
    int* TOKE = (int*)(ws + WS_TOKE); float* TOKW = (float*)(ws + WS_TOKW); int* TOKP = (int*)(ws + WS_TOKP); float* ROWW = (float*)(ws + WS_ROWW);
#define WSET_PTRS(LL) constexpr size_t so_ = ((LL) & 1) ? WS_SET1 : 0; \
    bf16_t* const WIN_T = (bf16_t*)(ws + WS_WIN + so_); bf16_t* const WOUT_T = (bf16_t*)(ws + WS_WOUT + so_); bf16_t* const WGU_T = (bf16_t*)(ws + WS_WGU + so_); bf16_t* const WDN_T = (bf16_t*)(ws + WS_WDN + so_); \
    bf16_t* const WPG_T = (bf16_t*)(ws + WS_WPG + so_); bf16_t* const WPP_T = (bf16_t*)(ws + WS_WPP + so_); bf16_t* const PB = (bf16_t*)(ws + WS_PB + so_); bf16_t* const WC1_T = (bf16_t*)(ws + WS_WC1 + so_); \
    float* const PEB = (float*)(ws + (((LL) & 1) ? WS_PEB1 : WS_PEB)); bf16_t* const WRT = (bf16_t*)(ws + (((LL) & 1) ? WS_WRT1 : WS_WRT)); \
    (void)WIN_T; (void)WOUT_T; (void)WGU_T; (void)WDN_T; (void)WPG_T; (void)WPP_T; (void)PB; (void)WC1_T; (void)PEB; (void)WRT;
    bf16_t* QB = (bf16_t*)(ws + WS_Q); bf16_t* KB = (bf16_t*)(ws + WS_K); bf16_t* VB = (bf16_t*)(ws + WS_V); bf16_t* AO = (bf16_t*)(ws + WS_AO);
    bf16_t* PP = (bf16_t*)(ws + WS_PP); bf16_t* QR = (bf16_t*)(ws + WS_QR); bf16_t* HB = (bf16_t*)(ws + WS_H); bf16_t* XG = (bf16_t*)(ws + WS_XG); bf16_t* OUTR = (bf16_t*)(ws + WS_OUTR);
    const int* positions = (const int*)args.in[2];

    if (IN(0)) { PH_IDS();
        for (int i = gtid; i < T * 32; i += NGT) { const int t = i >> 5, f = i & 31;
            const float inv = __builtin_amdgcn_exp2f(-(float)f * (13.287712379549449f / 32.f));
            const double ang = (double)positions[t] * (double)inv; double rev = ang * 0.15915494309189535; rev = rev - floor(rev);
            ROPE_C[i] = __builtin_amdgcn_cosf((float)rev); ROPE_S[i] = __builtin_amdgcn_sinf((float)rev); }
        for (int i = gtid; i < T; i += NGT) ROWTOK[64 * 16384 + i] = i;
        const float* xin = (const float*)args.in[0];
        for (int i = gtid; i < T * D / 4; i += NGT) { const f32x4 v = ((const f32x4*)xin)[i];
            unsigned long long w = (unsigned long long)pk2(v.x, v.y) | ((unsigned long long)pk2(v.z, v.w) << 32); ((unsigned long long*)XBB)[i] = w; }
    }

    auto conv = [&](auto Ltc) __attribute__((always_inline)) {
        constexpr int LT = decltype(Ltc)::value; PH_IDS(); WSET_PTRS(LT);
        const int kind = LT % 3, jj = LT / 3;
        const float* w_in_src = kind == 0 ? (const float*)args.in[3] + (size_t)jj * D * 3088 : kind == 1 ? (const float*)args.in[6] : (const float*)args.in[15];
        const int ldw_in = kind == 0 ? 3088 : kind == 1 ? 2608 : 3072, ncol_in = kind == 1 ? 2560 : 3072;
        const float* w_out_src = kind == 0 ? (const float*)args.in[5] + (size_t)jj * D * D : kind == 1 ? (const float*)args.in[14] : (const float*)args.in[16];
        {
            const int n_win = 16 * (ncol_in / 64), n_wout = 256, n_gu = 65 * 128, n_dn = 65 * 64, n_pg = 256, n_pp = 64;
            const int NIT = n_win + n_wout + n_gu + n_dn + n_pg + n_pp;
            auto dec = [&](int r, const float*& sp, int& ldw, bf16*& dp, int& K) __attribute__((always_inline)) {
                if (r < n_win) { const int nblk = ncol_in / 64, kb = r / nblk, nb = r % nblk; sp = w_in_src + (size_t)(64 * kb) * ldw_in + 64 * nb; ldw = ldw_in; dp = WIN_T + (size_t)(64 * nb) * D + 64 * kb; K = D; return; } r -= n_win;
                if (r < n_wout) { const int kb = r / 16, nb = r % 16; sp = w_out_src + (size_t)(64 * kb) * D + 64 * nb; ldw = D; dp = WOUT_T + (size_t)(64 * nb) * D + 64 * kb; K = D; return; } r -= n_wout;
                if (r < n_gu) { const int e = r / 128, rr = r % 128, mat = rr / 64, kb = (rr % 64) / 4, nb = rr % 4, n0 = 64 * nb;
                    const float* W = e < 64 ? (const float*)args.in[mat ? 22 : 21] + ((size_t)(LT * 64 + e)) * D * ED : (const float*)args.in[mat ? 25 : 24] + (size_t)LT * D * ED;
                    sp = W + (size_t)(64 * kb) * ED + n0; ldw = ED; dp = WGU_T + (size_t)(e * 512 + (n0 / 128) * 256 + mat * 128 + (n0 % 128)) * D + 64 * kb; K = D; return; } r -= n_gu;
                if (r < n_dn) { const int e = r / 64, rr = r % 64, kb = rr / 16, nb = rr % 16;
                    const float* W = e < 64 ? (const float*)args.in[23] + ((size_t)(LT * 64 + e)) * ED * D : (const float*)args.in[26] + (size_t)LT * ED * D;
                    sp = W + (size_t)(64 * kb) * D + 64 * nb; ldw = D; dp = WDN_T + (size_t)(e * 1024 + 64 * nb) * ED + 64 * kb; K = ED; return; } r -= n_dn;
                if (r < n_pg) { const int kb = r / 16, nb = r % 16; sp = (const float*)args.in[29] + (size_t)LT * D * D + (size_t)(64 * kb) * D + 64 * nb; ldw = D; dp = WPG_T + (size_t)(64 * nb) * D + 64 * kb; K = D; return; } r -= n_pg;
                { const int kb = r / 16, nb = r % 16; sp = (const float*)args.in[30] + (size_t)LT * PLE * D + (size_t)(64 * kb) * D + 64 * nb; ldw = D; dp = WPP_T + (size_t)(64 * nb) * PLE + 64 * kb; K = PLE; }
            };
            for (int it = gw; it < NIT; it += 3 * NGW) {
                const float* s0; int l0; bf16* d0; int K0; const float* s1 = nullptr; int l1 = 0; bf16* d1 = nullptr; int K1 = 0; const float* s2 = nullptr; int l2 = 0; bf16* d2 = nullptr; int K2 = 0;
                f32x4 va[16], vb[16], vc[16];
                dec(it, s0, l0, d0, K0); titem_load(va, s0, l0, lane);
                const bool two = it + NGW < NIT, three = it + 2 * NGW < NIT;
                if (two) { dec(it + NGW, s1, l1, d1, K1); titem_load(vb, s1, l1, lane); }
                if (three) { dec(it + 2 * NGW, s2, l2, d2, K2); titem_load(vc, s2, l2, lane); }
                titem_store(va, d0, K0, lane);
                if (two) titem_store(vb, d1, K1, lane);
                if (three) titem_store(vc, d2, K2, lane);
            }
            { const f32x4* ps = (const f32x4*)((const float*)args.in[1] + (size_t)LT * T * PLE); unsigned long long* pd = (unsigned long long*)PB; constexpr int NP = T * PLE / 4;
              for (int i0 = gtid; i0 < NP; i0 += 8 * NGT) { f32x4 v[8];
#pragma unroll
                  for (int u = 0; u < 8; ++u) { const int i = i0 + u * NGT; if (i < NP) v[u] = __builtin_nontemporal_load((const GAS f32x4*)(ps + i)); }
#pragma unroll
                  for (int u = 0; u < 8; ++u) { const int i = i0 + u * NGT; if (i < NP) pd[i] = (unsigned long long)gattn::cvtpk_s(v[u].x, v[u].y) | ((unsigned long long)gattn::cvtpk_s(v[u].z, v[u].w) << 32); } } }
            { const float* Wr = (const float*)args.in[19] + (size_t)LT * D * NE;
              for (int i = gtid; i < NE * D; i += NGT) { const int e = i >> 10, k = i & 1023; const float w = Wr[k * 64 + e]; const unsigned h = f2bf(w); const float r = w - __uint_as_float(h << 16);
                  WRT[i] = (bf16_t)h; WRT[NE * D + i] = (bf16_t)f2bf(r); } }
            if (kind == 1) {
                for (int it = gw; it < 2 * 64; it += NGW) { const int kv = it >> 6, r = it & 63, kb = r >> 1, nb = r & 1;
                    transpose_item64((const float*)args.in[kv ? 12 : 10], 128, 64 * kb, 64 * nb, WC1_T, 2048, kv * 256 + 64 * nb, lane); }
                for (int it = gw; it < 2 * 128; it += NGW) { const int kv = it >> 7, hu = it & 127; const float* pe = (const float*)args.in[kv ? 9 : 8]; const float* w1 = (const float*)args.in[kv ? 12 : 10];
                    float wv[32], a = 0.f;
#pragma unroll
                    for (int i = 0; i < 32; ++i) wv[i] = w1[(size_t)(lane + 64 * i) * 128 + hu];
#pragma unroll
                    for (int i = 0; i < 32; ++i) a += pe[lane + 64 * i] * wv[i];
                    a = wave_sum(a); if (lane == 0) PEB[kv * 128 + hu] = a; }
            }
        }
    };

    auto layer_body = [&](auto Lc) __attribute__((always_inline)) {
        constexpr int L = decltype(Lc)::value; WSET_PTRS(L);
        const int kind = L % 3, jj = L / 3, gp0 = 1 + L * NPH;
        const float* w_in_src = kind == 0 ? (const float*)args.in[3] + (size_t)jj * D * 3088 : kind == 1 ? (const float*)args.in[6] : (const float*)args.in[15];
        const int ldw_in = kind == 0 ? 3088 : kind == 1 ? 2608 : 3072, ncol_in = kind == 1 ? 2560 : 3072;
        (void)jj; (void)w_in_src; (void)ldw_in;

        auto gates = [&]() __attribute__((always_inline)) { PH_IDS();
            if constexpr (L % 3 != 2) {
                using gattn::bf16x8; using gattn::f32x16; using gattn::u32x4; using gattn::crow; using gattn::cvtpk_s;
                constexpr int NB = (L % 3 == 0) ? 1 : 2, NCOL = (L % 3 == 0) ? 16 : 48;
                const int colbase = kind == 0 ? 3072 : 2560;
                const float* bsrc = kind == 0 ? (const float*)args.in[4] + jj * 16 : (const float*)args.in[7];
                constexpr int XP = 1032;
                bf16_t* XH = (bf16_t*)lds; bf16_t* XL = XH + 32 * XP; float* PL = (float*)lds;
                const int r32 = lane & 31, hi = lane >> 5;
                bf16x8 wh[8][NB], wl[8][NB];
#pragma unroll
                for (int st = 0; st < 8; ++st)
#pragma unroll
                    for (int nb = 0; nb < NB; ++nb) { const int n = nb * 32 + r32; u32x4 ph = {0u, 0u, 0u, 0u}, pl = {0u, 0u, 0u, 0u};
                        if (n < NCOL) { float wv[8];
#pragma unroll
                            for (int i = 0; i < 8; ++i) wv[i] = w_in_src[(size_t)(wave * 128 + 16 * st + 8 * hi + i) * ldw_in + colbase + n];
#pragma unroll
                            for (int i = 0; i < 4; ++i) { const unsigned h2 = cvtpk_s(wv[2 * i], wv[2 * i + 1]); ph[i] = h2; pl[i] = cvtpk_s(wv[2 * i] - bflo(h2), wv[2 * i + 1] - bfhi(h2)); } }
                        wh[st][nb] = __builtin_bit_cast(bf16x8, ph); wl[st][nb] = __builtin_bit_cast(bf16x8, pl); }
                for (int pass = bx; pass < T / 32; pass += G) { const size_t row0 = (size_t)pass * 32;
                    __syncthreads();
#pragma unroll
                    for (int r = 0; r < 4; ++r) { const int rl = wave * 4 + r; const size_t row = row0 + rl;
#pragma unroll
                        for (int j = 0; j < 4; ++j) {
                            if constexpr (L == 0) { const f32x4 v = *(const f32x4*)((const float*)args.in[0] + row * D + 4 * lane + 256 * j);
                                const unsigned h0 = cvtpk_s(v.x, v.y), h1 = cvtpk_s(v.z, v.w); const unsigned l0 = cvtpk_s(v.x - bflo(h0), v.y - bfhi(h0)), l1 = cvtpk_s(v.z - bflo(h1), v.w - bfhi(h1));
                                *(uint2*)(XH + rl * XP + 4 * lane + 256 * j) = make_uint2(h0, h1); *(uint2*)(XL + rl * XP + 4 * lane + 256 * j) = make_uint2(l0, l1); }
                            else *(uint2*)(XH + rl * XP + 4 * lane + 256 * j) = *(const uint2*)(XBB + row * D + 4 * lane + 256 * j); } }
                    __syncthreads();
                    f32x16 acc[NB];
#pragma unroll
                    for (int nb = 0; nb < NB; ++nb) acc[nb] = f32x16{};
#pragma unroll
                    for (int st = 0; st < 8; ++st) { const int k = wave * 128 + 16 * st + 8 * hi; const bf16x8 xh = *(const bf16x8*)(XH + r32 * XP + k); bf16x8 xl = xh; if constexpr (L == 0) xl = *(const bf16x8*)(XL + r32 * XP + k);
#pragma unroll
                        for (int nb = 0; nb < NB; ++nb) { acc[nb] = __builtin_amdgcn_mfma_f32_32x32x16_bf16(xh, wh[st][nb], acc[nb], 0, 0, 0); if constexpr (L == 0) acc[nb] = __builtin_amdgcn_mfma_f32_32x32x16_bf16(xl, wh[st][nb], acc[nb], 0, 0, 0);
                            acc[nb] = __builtin_amdgcn_mfma_f32_32x32x16_bf16(xh, wl[st][nb], acc[nb], 0, 0, 0); } }
                    __syncthreads();
#pragma unroll
                    for (int nb = 0; nb < NB; ++nb)
#pragma unroll
                        for (int r = 0; r < 16; ++r) PL[(wave * 32 + crow(r, hi)) * 64 + nb * 32 + r32] = acc[nb][r];
                    __syncthreads();
                    for (int o = tid; o < 32 * NCOL; o += NTHR) { const int rl = o / NCOL, c = o % NCOL; float z = bsrc[c];
#pragma unroll
                        for (int w = 0; w < 8; ++w) z += PL[(w * 32 + rl) * 64 + c];
                        if (kind == 0) { const float lf = fminf(z, 0.f) - __logf(1.f + __expf(-fabsf(z))); LOGF[(row0 + rl) * 16 + c] = lf;
                            float s4 = lf; s4 += xor_f<16>(s4); { auto rr = __builtin_amdgcn_permlane32_swap(__float_as_uint(s4), __float_as_uint(s4), false, false); s4 = __uint_as_float(rr[0]) + __uint_as_float(rr[1]); }
                            if (lane < 16) PL[8 * 32 * 64 + wave * 16 + lane] = s4; }
                        else GATES[(row0 + rl) * 48 + c] = sigmoidf_(z); }
                    if (kind == 0) { __syncthreads(); if (tid < 16) { float s = 0.f;
#pragma unroll
                            for (int w = 0; w < 8; ++w) s += PL[8 * 32 * 64 + w * 16 + tid]; LS32[(size_t)pass * 16 + tid] = s; } }
                }
                __syncthreads();
            }
        };

        if (L == 0 && PH_EN(0) && IN(gp0 + 0)) {
            conv(std::integral_constant<int, 0>{}); gates();
            SEAM_AT(1 + L * NPH + 0);
        }

        if (PH_EN(1) && IN(gp0 + 1)) { PH_IDS();
            if constexpr (L > 0) gates();
            pg8::Gemm g{XBB, WIN_T, T, ncol_in, D, 0, 0, nullptr}; pg8::StaticOrder So; So.init(T, ncol_in, G, bx);
            epi::Qkv E{QB, 1024, D, KB, kind == 1 ? 256 : 1024, kind == 1 ? 256 : 1024, kind == 1 ? (size_t)(4 * MiB) : (size_t)(16 * MiB), gattn::C2};
            pg8::gemm_phase<epi::Qkv, pg8::StaticOrder, true, true>(ldsl, g, So, E);
            {
              int kpp = PLE; asm volatile("" : "+s"(kpp)); pg8::Gemm g{PB, WPP_T, T, D, kpp, 0, 0, nullptr}; pg8::StaticOrder So; So.init(T, D, G, bx);
              epi::StoreBf16 E{PP, D};
              pg8::gemm_phase<epi::StoreBf16, pg8::StaticOrder, true, true>(ldsl, g, So, E); }
            SEAM_AT(1 + L * NPH + 1);
        }

        if (PH_EN(2) && IN(gp0 + 2)) { PH_IDS();
            if (kind == 0) {
                for (int task = gw; task < Bn * NH * 32; task += NGW) { const int q = task & 31, bh = task >> 5, b = bh / NH, h = bh % NH;
                    double base = 0.0;
                    for (int p = lane; p < 8 * q; p += 64) base += (double)LS32[((size_t)b * 256 + p) * 16 + h];
#pragma unroll
                    for (int o = 1; o < 64; o <<= 1) { const unsigned long long sb = __builtin_bit_cast(unsigned long long, base); const int sl4 = (lane ^ o) << 2;
                        const unsigned ulo = (unsigned)__builtin_amdgcn_ds_bpermute(sl4, (int)(unsigned)sb), uhi = (unsigned)__builtin_amdgcn_ds_bpermute(sl4, (int)(unsigned)(sb >> 32));
                        base += __builtin_bit_cast(double, ((unsigned long long)uhi << 32) | ulo); }
                    const size_t t0 = (size_t)b * S + q * 256 + lane * 4; double loc[4]; double run = 0.0;
#pragma unroll
                    for (int i = 0; i < 4; ++i) { run += (double)LOGF[(t0 + i) * 16 + h]; loc[i] = run; }
                    double sc = run;
#pragma unroll
                    for (int o = 1; o < 64; o <<= 1) { const unsigned long long sb = __builtin_bit_cast(unsigned long long, sc); const int sl4 = ((lane - o) & 63) << 2;
                        const unsigned ulo = (unsigned)__builtin_amdgcn_ds_bpermute(sl4, (int)(unsigned)sb), uhi = (unsigned)__builtin_amdgcn_ds_bpermute(sl4, (int)(unsigned)(sb >> 32));
                        const double up = __builtin_bit_cast(double, ((unsigned long long)uhi << 32) | ulo); if (lane >= o) sc += up; }
                    const double pre = base + (sc - run);
#pragma unroll
                    for (int i = 0; i < 4; ++i) CUM[(size_t)bh * S + q * 256 + lane * 4 + i] = (float)(pre + loc[i]); }
                for (int b = 0; b < Bn; ++b) { float mq = 0.f, mk = 0.f;
                    for (int rbase = gw; rbase < S; rbase += 4 * NGW) { uint4 q0a[4], q1a[4], k0a[4], k1a[4];
#pragma unroll
                      for (int u4 = 0; u4 < 4; ++u4) { const int r = rbase + u4 * NGW; if (r < S) { const size_t off = ((size_t)b * S + r) * D + lane * 16;
                          q0a[u4] = *(const uint4*)(QB + off); q1a[u4] = *(const uint4*)(QB + off + 8); k0a[u4] = *(const uint4*)(KB + off); k1a[u4] = *(const uint4*)(KB + off + 8); } }
#pragma unroll
                      for (int u4 = 0; u4 < 4; ++u4) { const int r = rbase + u4 * NGW; if (r >= S) continue; const uint4 q0 = q0a[u4], q1 = q1a[u4], k0 = k0a[u4], k1 = k1a[u4];
                        float sq = 0.f, sk = 0.f;
#define SQ2(w) (bflo(w) * bflo(w) + bfhi(w) * bfhi(w))
                        sq = SQ2(q0.x) + SQ2(q0.y) + SQ2(q0.z) + SQ2(q0.w) + SQ2(q1.x) + SQ2(q1.y) + SQ2(q1.z) + SQ2(q1.w);
                        sk = SQ2(k0.x) + SQ2(k0.y) + SQ2(k0.z) + SQ2(k0.w) + SQ2(k1.x) + SQ2(k1.y) + SQ2(k1.z) + SQ2(k1.w);
#undef SQ2
                        sq += xor_f<1>(sq); sq += xor_f<2>(sq); sk += xor_f<1>(sk); sk += xor_f<2>(sk);
                        mq = fmaxf(mq, sq); mk = fmaxf(mk, sk); } }
                    LAS float* nl = (LAS float*)ldsl; __syncthreads();
                    if ((lane & 3) == 0) { nl[(wave * 16 + (lane >> 2)) * 2] = mq; nl[(wave * 16 + (lane >> 2)) * 2 + 1] = mk; }
                    __syncthreads();
                    if (tid < 32) { float m = 0.f;
#pragma unroll
                        for (int w = 0; w < 8; ++w) m = fmaxf(m, nl[(w * 16 + (tid >> 1)) * 2 + (tid & 1)]);
                        __hip_atomic_fetch_max((unsigned*)(ctl + CW_NRM + L * 64 + (b * NH + (tid >> 1)) * 2 + (tid & 1)), __float_as_uint(m), RLX_AGENT); } }
            } else {
                const size_t st6 = 4 * MiB;
                for (int pass = 0; pass < (kind == 1 ? 3 : 2); ++pass) {
                    const bf16_t* src; bf16_t* dst; int nhd;
                    if (kind == 1) { if (pass == 0) { src = QB; dst = QR; nhd = 16; } else if (pass == 1) { src = KB + 2 * st6; dst = KB + 2 * st6; nhd = 4; } else { src = KB + 4 * st6; dst = KB + 4 * st6; nhd = 4; } }
                    else { if (pass == 0) { src = QB; dst = QB; } else { src = KB; dst = KB; } nhd = 16; }
                    const int per_row = nhd * 4, total = T * per_row;
                    for (int i = gtid; i < total; i += NGT) { const int t = i / per_row, r = i % per_row, hd = r >> 2, fq = r & 3;
                        const size_t o1 = (size_t)t * (nhd * 64) + hd * 64 + 8 * fq;
                        const uint4 a = *(const uint4*)(src + o1), bq = *(const uint4*)(src + o1 + 32);
                        const f32x4 c0 = *(const f32x4*)(ROPE_C + t * 32 + 8 * fq), c1 = *(const f32x4*)(ROPE_C + t * 32 + 8 * fq + 4);
                        const f32x4 s0 = *(const f32x4*)(ROPE_S + t * 32 + 8 * fq), s1 = *(const f32x4*)(ROPE_S + t * 32 + 8 * fq + 4);
                        uint4 oa, ob;
#define ROPE2(W, CA, CB, SA, SB) { const float x1l = bflo(a.W), x1h = bfhi(a.W), x2l = bflo(bq.W), x2h = bfhi(bq.W); \
                            oa.W = pk2(x1l * CA - x2l * SA, x1h * CB - x2h * SB); ob.W = pk2(x2l * CA + x1l * SA, x2h * CB + x1h * SB); }
                        ROPE2(x, c0.x, c0.y, s0.x, s0.y) ROPE2(y, c0.z, c0.w, s0.z, s0.w) ROPE2(z, c1.x, c1.y, s1.x, s1.y) ROPE2(w, c1.z, c1.w, s1.z, s1.w)
#undef ROPE2
                        *(uint4*)(dst + o1) = oa; *(uint4*)(dst + o1 + 32) = ob; }
                }
            }
            SEAM_AT(1 + L * NPH + 2);
        }

        if (kind != 0 && PH_EN(3) && IN(gp0 + 3)) { PH_IDS();
            if (kind == 1) {
                { pg8::Gemm g{KB, WC1_T, 0, 0, 2048, 4096, 512, nullptr}; CmpOrder So{G, bx}; epi::H1Store E{H1};
                  pg8::gemm_phase<epi::H1Store, CmpOrder, true, true>(ldsl, g, So, E); }
                if (!MK_MULTI) xcd_barrier(bar);
                float* hb = (float*)(lds + wave * 1024);
                for (int task = gw; task < 2 * 8 * NCMP; task += NGW) { const int i = task & 511, bg = (task >> 9) & 7, kv = task >> 12;
                    const float* h1 = H1 + (size_t)task * 128; const float* w2 = (const float*)args.in[kv ? 13 : 11];
                    hb[lane] = gelu_tanh(h1[lane] + PEB[kv * 128 + lane]); hb[64 + lane] = gelu_tanh(h1[64 + lane] + PEB[kv * 128 + 64 + lane]);
                    WAVE_SYNC();
                    float o0 = 0.f;
#pragma unroll 8
                    for (int hu = 0; hu < 128; ++hu) o0 += hb[hu] * w2[hu * 64 + lane];
                    const bf16_t ob = (bf16_t)f2bf(o0);
                    if (kv == 0) KCMP[((size_t)bg * NCMP + i) * 64 + lane] = ob;
                    else { VCMP[((size_t)bg * NCMP + i) * 64 + lane] = ob; const int nl = i & 63; VCT[(((size_t)bg * 8 + (i >> 6)) * 64 + lane) * 64 + (nl & 48) + swapmid(nl & 15)] = ob; }
                    WAVE_SYNC(); }
            } else if (kind == 2) {
                for (int item = gw; item < Bn * NH * 32; item += NGW) { const int blk = item & 31, bh = item >> 5, b = bh / NH, h = bh % NH;
                    float s = 0.f; const bf16_t* kp = KB + ((size_t)b * S + blk * 256) * D + h * 64 + lane;
                    for (int r0 = 0; r0 < 256; r0 += 32) { bf16_t kv[32];
#pragma unroll
                        for (int r = 0; r < 32; ++r) kv[r] = kp[(size_t)(r0 + r) * D];
#pragma unroll
                        for (int r = 0; r < 32; ++r) s += bf2f(kv[r]); }
                    KMEAN[(size_t)item * 64 + lane] = s * (1.f / 256.f); }
            }
            SEAM_AT(1 + L * NPH + 3);
        }

        if (PH_EN(4) && IN(gp0 + 4)) { PH_IDS();
            float* wl = (float*)(lds + wave * 14336);
            float* qs = wl; float* qs2 = wl + 256; float* pb = wl + 512; int* kb = (int*)(wl + 512 + 2048); float* misc = wl + 512 + 2048 + 512;
#if defined(ZERO_KIND)
            if ((ZERO_KIND >> kind) & 1) { for (int i = gtid; i < T * D / 8; i += NGT) ((uint4*)AO)[i] = make_uint4(0u, 0u, 0u, 0u); } else {
#endif
            bf16_t* AOn = AO;
#if !defined(FOX_NAIVE)
            if (kind == 0) {
                volatile LAS int* qw = (volatile LAS int*)(ldsl + TAB_OFF);
                int nun = 0; const int cslot = bx & 3; (void)cslot;
                for (;; ++nun) {
                    if constexpr (L + 1 < DEPTH) { if (nun == cslot) conv(std::integral_constant<int, (L + 1 < DEPTH ? L + 1 : 0)>{}); }
                    if (tid == 0) { qw[100] = (int)__hip_atomic_fetch_add((unsigned*)(ctl + CW_Q + L), 1u, RLX_AGENT); qw[101] = 0; }
                    __syncthreads();
                    const int u = qw[100]; if (u >= Bn * NH * 32) break;
                    const int qb = 31 - (u >> 5), bh = u & 31, b = bh / NH, h = bh % NH; const size_t rb = (size_t)b * S; const int ntabs = 4 * qb + 4;
                    const float* cum = CUM + (size_t)bh * S;
                    { const unsigned* nr = (const unsigned*)(ctl + CW_NRM + L * 64 + bh * 2);
                      const float qk = sqrtf(__uint_as_float(__hip_atomic_load(nr, RLX_AGENT)) * __uint_as_float(__hip_atomic_load(nr + 1, RLX_AGENT)));
                      const float thr = -(30.f + 2.f * qk);
                      bool skip = false; if (tid < ntabs) skip = (cum[qb * 256] - cum[64 * tid + 63]) * 1.4426950408889634f < thr;
                      const int nsk = __popcll(__builtin_amdgcn_ballot_w64(skip)); if (lane == 0 && nsk) atomicAdd((int*)&qw[101], nsk); }
                    __syncthreads();
                    int t0 = qw[101]; t0 = t0 > ntabs - 4 ? ntabs - 4 : t0; t0 &= ~1;
                    __syncthreads();
                    FoxU un{(const abf16*)KB + rb * D + h * 64, (const abf16*)VB + rb * D + h * 64, D, t0, ntabs - t0, ntabs - 1, cum, qb * 256,
                            (abf16*)AO + (rb + qb * 256) * D + h * 64, 32L * D, (const abf16*)QB + (rb + qb * 256) * D + h * 64, nullptr};
                    gattn::gunit<8, true, 0, 0>((char*)lds, un); }
                if constexpr (L + 1 < DEPTH) { if (nun < cslot) conv(std::integral_constant<int, (L + 1 < DEPTH ? L + 1 : 0)>{}); }
            }
#endif
#if !defined(MOBA_NAIVE)
            if (kind == 2) {
                const int vcu = (bx % 8) * (G / 8) + bx / 8;
                LAS unsigned* mtab = (LAS unsigned*)(ldsl + gattn::LDS_BT); LAS float* kml = (LAS float*)(ldsl + gattn::LDS_BT + 1024);
                const int cslot = bx % 5;
                for (int ui = 0; ui < 4; ++ui) { int bh, qb; fox_order(vcu, ui, bh, qb); const int b = bh / NH, h = bh % NH; const size_t rb = (size_t)b * S;
                    if constexpr (L + 1 < DEPTH) { if (ui == cslot) conv(std::integral_constant<int, (L + 1 < DEPTH ? L + 1 : 0)>{}); }
                    for (int i = tid; i < qb * 64; i += NTHR) kml[i] = KMEAN[(size_t)bh * 32 * 64 + i];
                    __syncthreads();
                    if (tid < 256) { const uint4* qp = (const uint4*)(QB + (rb + qb * 256 + tid) * D + h * 64); float q[64];
#pragma unroll
                        for (int c = 0; c < 8; ++c) { const uint4 w = qp[c]; q[8 * c] = bflo(w.x); q[8 * c + 1] = bfhi(w.x); q[8 * c + 2] = bflo(w.y); q[8 * c + 3] = bfhi(w.y); q[8 * c + 4] = bflo(w.z); q[8 * c + 5] = bfhi(w.z); q[8 * c + 6] = bflo(w.w); q[8 * c + 7] = bfhi(w.w); }
                        float v0 = -3e38f, v1 = -3e38f, v2 = -3e38f; int i0 = -1, i1 = -1, i2 = -1;
                        for (int n = 0; n < qb; ++n) { float sacc = 0.f;
#pragma unroll
                            for (int d = 0; d < 64; ++d) sacc += q[d] * kml[n * 64 + d];
                            if (sacc > v0) { v2 = v1; i2 = i1; v1 = v0; i1 = i0; v0 = sacc; i0 = n; } else if (sacc > v1) { v2 = v1; i2 = i1; v1 = sacc; i1 = n; } else if (sacc > v2) { v2 = sacc; i2 = n; } }
                        unsigned mk = 1u << qb; if (i0 >= 0) mk |= 1u << i0; if (i1 >= 0) mk |= 1u << i1; if (i2 >= 0) mk |= 1u << i2;
                        mtab[tid] = mk; }
                    __syncthreads();
                    FoxU un{(const abf16*)KB + rb * D + h * 64, (const abf16*)VB + rb * D + h * 64, D, 0, 4 * qb + 4, 4 * qb + 3, nullptr, qb * 256,
                            (abf16*)AO + (rb + qb * 256) * D + h * 64, 32L * D, (const abf16*)QB + (rb + qb * 256) * D + h * 64, mtab};
                    gattn::gunit<8, false, 0, 0>((char*)lds, un); }
                if constexpr (L + 1 < DEPTH) { if (cslot == 4) conv(std::integral_constant<int, (L + 1 < DEPTH ? L + 1 : 0)>{}); }
            }
#endif
#if !defined(NSA_NAIVE)
            if (kind == 1) {
                const int vcu = (bx % 8) * (G / 8) + bx / 8; const size_t st6 = 4 * MiB;
                const int cslot = bx % 5;
                for (int ui = 0; ui < 4; ++ui) { const int bg = vcu >> 5, s5 = vcu & 31, b = bg / NSA_G, g = bg % NSA_G;
                    if constexpr (L + 1 < DEPTH) { if (ui == cslot) conv(std::integral_constant<int, (L + 1 < DEPTH ? L + 1 : 0)>{}); } const int qt = (ui == 0) ? s5 : (ui == 1) ? 63 - s5 : (ui == 2) ? 64 + s5 : 127 - s5;
                    const int q0 = qt * 64, cur = qt; const size_t rb = (size_t)b * S;
#if defined(CHECK_KIND)
                    unsigned* selg = SELMG;
#else
                    unsigned* selg = nullptr;
#endif
                    nsa_cmp_select((char*)lds, b, g, q0, QB, KCMP, VCT, GATES, selg);
                    const LAS unsigned* selm = (const LAS unsigned*)(ldsl + NSA_LDS_SELM);
                    { int nt = (cur + 2) & ~1; nt = nt < 4 ? 4 : nt;
                      NsaU un{(const abf16*)KB + 2 * st6 + rb * 256 + g * 64, (const abf16*)KB + 3 * st6 + rb * 256 + g * 64, 256, 0, nt, 127, nullptr, q0,
                              (abf16*)AO + (rb + q0) * D + g * 256, 8L * D, (const abf16*)QR + (rb + q0) * D + g * 256, selm, GATES + (rb + q0) * 48 + g * 12, 1, 0};
                      gattn::gunit<8, false, 2, 2>((char*)lds, un); }
                    { NsaU un{(const abf16*)KB + 4 * st6 + rb * 256 + g * 64, (const abf16*)KB + 5 * st6 + rb * 256 + g * 64, 256, cur - 8, 10, 127, nullptr, q0,
                              (abf16*)AO + (rb + q0) * D + g * 256, 8L * D, (const abf16*)QR + (rb + q0) * D + g * 256, nullptr, GATES + (rb + q0) * 48 + g * 12, 2, 512};
                      gattn::gunit<8, false, 3, 2>((char*)lds, un); }
                }
                if constexpr (L + 1 < DEPTH) { if (cslot == 4) conv(std::integral_constant<int, (L + 1 < DEPTH ? L + 1 : 0)>{}); }
            }
#endif
#if defined(CHECK_KIND)
            if (kind == CHECK_KIND) { AOn = XG; SEAM_AT(1 + L * NPH + 4); }
#endif
#if defined(FOX_NAIVE) || (defined(CHECK_KIND) && CHECK_KIND == 0)
            if (kind == 0) {
                for (int task = gw; task < T * NH; task += NGW) {
                    const int t = task % S, bh = task / S, h = bh % NH, b = bh / NH; const size_t row = (size_t)b * S + t;
                    qs[lane] = bf2f(QB[row * D + h * 64 + lane]);
                    const float* cum = CUM + (size_t)bh * S; const float cq = cum[t];
                    WAVE_SYNC();
                    float m[1] = {NEGF}, l[1] = {0.f}, o[1] = {0.f};
                    for (int c0 = 0; c0 <= t; c0 += 512) {
                        attend_chunk<1>(qs, pb, kb, KB + h * 64, VB + h * 64, D, 512,
                            [=](int slot) { const int kk = c0 + slot; return kk <= t ? (int)(b * S + kk) : -1; },
                            [=](int slot) { return cq - cum[c0 + slot]; }, QSC, m, l, o, lane);
                    }
                    AOn[row * D + h * 64 + lane] = (bf16_t)f2bf(o[0] / fmaxf(l[0], 1e-30f));
                }
            }
#endif
#if defined(NSA_NAIVE) || (defined(CHECK_KIND) && CHECK_KIND == 1)
            if (kind == 1) {
                const size_t st6 = 4 * MiB;
                float* Pn = misc;
                for (int task = gw; task < T * NSA_G; task += NGW) {
                    const int t = task % S, bg = task / S, g = bg % NSA_G, b = bg / NSA_G; const size_t row = (size_t)b * S + t;
#pragma unroll
                    for (int h = 0; h < 4; ++h) { qs[h * 64 + lane] = bf2f(QB[row * D + (g * 4 + h) * 64 + lane]); qs2[h * 64 + lane] = bf2f(QR[row * D + (g * 4 + h) * 64 + lane]); }
                    WAVE_SYNC();
                    float oc[4], os[4], ow[4];
                    const int nvalid = t >= 31 ? ((t - 31) >> 4) + 1 : 0;
                    {
                        float m[4] = {NEGF, NEGF, NEGF, NEGF}, l[4] = {0.f, 0.f, 0.f, 0.f}; oc[0] = oc[1] = oc[2] = oc[3] = 0.f;
                        attend_chunk<4>(qs, pb, kb, KCMP + (size_t)bg * NCMP * 64, VCMP + (size_t)bg * NCMP * 64, 64, 512,
                            [=](int slot) { return slot < nvalid ? slot : -1; }, [=](int) { return 0.f; }, QSC, m, l, oc, lane);
                        float il[4];
#pragma unroll
                        for (int h = 0; h < 4; ++h) { il[h] = 1.f / fmaxf(l[h], 1e-30f); oc[h] *= il[h]; }
                        for (int i = 0; i < 8; ++i) { const int n = lane + 64 * i; Pn[n] = pb[n] * il[0] + pb[512 + n] * il[1] + pb[1024 + n] * il[2] + pb[1536 + n] * il[3]; }
                        WAVE_SYNC();
                    }
                    const int cur = t >> 6;
                    float pri0, pri1;
                    {
                        float imp[2];
#pragma unroll
                        for (int c = 0; c < 2; ++c) { const int j = lane + 64 * c; float a = 0.f;
#pragma unroll
                            for (int dn = -1; dn <= 3; ++dn) { const int n = 4 * j + dn; if (n >= 0 && n < 511) a += Pn[n]; }
                            imp[c] = a; }
                        const int j0 = lane, j1 = lane + 64;
                        const bool f0 = (j0 == 0) || (j0 == cur) || (j0 == cur - 1), f1 = (j1 == 0) || (j1 == cur) || (j1 == cur - 1);
                        pri0 = f0 ? imp[0] + 1e4f : imp[0]; pri1 = f1 ? imp[1] + 1e4f : imp[1];
                        pri0 = j0 <= cur ? pri0 : NEGF; pri1 = j1 <= cur ? pri1 : NEGF;
                    }
                    float* pri = (float*)kb;
                    int* sidx = kb + 128;
                    pri[lane] = pri0; pri[lane + 64] = pri1;
                    WAVE_SYNC();
                    int rk0 = 0, rk1 = 0;
                    for (int i = 0; i < 128; ++i) { const float pi = pri[i]; rk0 += (pi > pri0 || (pi == pri0 && i < lane)) ? 1 : 0; rk1 += (pi > pri1 || (pi == pri1 && i < lane + 64)) ? 1 : 0; }
                    bool s0 = (lane <= cur) && rk0 < 16, s1 = (lane + 64 <= cur) && rk1 < 16;
#if defined(CHECK_KIND) && !defined(CHECK_OWNSEL)
                    { const unsigned* sg = SELMG + ((size_t)row * NSA_G + g) * 4; s0 = (sg[lane >> 5] >> (lane & 31)) & 1u; s1 = (sg[2 + (lane >> 5)] >> (lane & 31)) & 1u; }
#endif
                    const unsigned long long b0 = __ballot(s0), b1 = __ballot(s1);
                    const unsigned long long lt = (1ull << lane) - 1ull;
                    const int n0 = __popcll(b0);
                    WAVE_SYNC();
                    if (lane < 16) sidx[lane] = -1;
                    WAVE_SYNC();
                    if (s0) sidx[__popcll(b0 & lt)] = lane;
                    if (s1) sidx[n0 + __popcll(b1 & lt)] = lane + 64;
                    WAVE_SYNC();
                    int myblk = sidx[lane & 15];
                    {
                        float m[4] = {NEGF, NEGF, NEGF, NEGF}, l[4] = {0.f, 0.f, 0.f, 0.f}; os[0] = os[1] = os[2] = os[3] = 0.f;
                        const bf16_t* Ks = KB + 2 * st6 + g * 64; const bf16_t* Vs = KB + 3 * st6 + g * 64;
                        for (int c = 0; c < 2; ++c) {
                            attend_chunk<4>(qs2, pb, kb, Ks, Vs, 256, 512,
                                [=](int slot) { const int j = __shfl(myblk, c * 8 + (slot >> 6)); const int kk = j * 64 + (slot & 63); return (j >= 0 && kk <= t) ? (int)(b * S + kk) : -1; },
                                [=](int) { return 0.f; }, QSC, m, l, os, lane);
                        }
#pragma unroll
                        for (int h = 0; h < 4; ++h) os[h] /= fmaxf(l[h], 1e-30f);
                    }
                    {
                        float m[4] = {NEGF, NEGF, NEGF, NEGF}, l[4] = {0.f, 0.f, 0.f, 0.f}; ow[0] = ow[1] = ow[2] = ow[3] = 0.f;
                        const bf16_t* Kw = KB + 4 * st6 + g * 64; const bf16_t* Vw = KB + 5 * st6 + g * 64;
                        attend_chunk<4>(qs2, pb, kb, Kw, Vw, 256, 512,
                            [=](int slot) { const int kk = t - 511 + slot; return kk >= 0 ? (int)(b * S + kk) : -1; },
                            [=](int) { return 0.f; }, QSC, m, l, ow, lane);
#pragma unroll
                        for (int h = 0; h < 4; ++h) ow[h] /= fmaxf(l[h], 1e-30f);
                    }
#pragma unroll
                    for (int h = 0; h < 4; ++h) { const float* gt = GATES + row * 48 + (g * 4 + h) * 3;
                        AOn[row * D + (g * 4 + h) * 64 + lane] = (bf16_t)f2bf(gt[0] * oc[h] + gt[1] * os[h] + gt[2] * ow[h]); }
                }
            }
#endif
#if defined(MOBA_NAIVE) || (defined(CHECK_KIND) && CHECK_KIND == 2)
            if (kind == 2) {
                for (int task = gw; task < T * NH; task += NGW) {
                    const int t = task % S, bh = task / S, h = bh % NH, b = bh / NH; const size_t row = (size_t)b * S + t;
                    qs[lane] = bf2f(QB[row * D + h * 64 + lane]);
                    WAVE_SYNC();
                    const int cb = t >> 8;
                    float gs = NEGF;
                    if (lane < cb) { const float* km = KMEAN + ((size_t)bh * 32 + lane) * 64; float a = 0.f;
#pragma unroll 8
                        for (int d = 0; d < 64; ++d) a += qs[d] * km[d];
                        gs = a; }
                    if (lane >= 32) gs = -3e30f;
                    int sel[3];
#pragma unroll
                    for (int r = 0; r < 3; ++r) { const float mx = wave_max(gs); const unsigned long long bm = __ballot(gs == mx); const int win = __ffsll((long long)bm) - 1;
                        sel[r] = (win < cb) ? win : -1; if (lane == win) gs = -3e30f; }
                    float m[1] = {NEGF}, l[1] = {0.f}, o[1] = {0.f};
                    for (int c = 0; c < 2; ++c) {
                        const int blk0 = c == 0 ? sel[0] : sel[2], blk1 = c == 0 ? sel[1] : cb;
                        attend_chunk<1>(qs, pb, kb, KB + h * 64, VB + h * 64, D, 512,
                            [=](int slot) { const int blk = slot < 256 ? blk0 : blk1; const int kk = blk * 256 + (slot & 255); return (blk >= 0 && kk <= t) ? (int)(b * S + kk) : -1; },
                            [=](int) { return 0.f; }, QSC, m, l, o, lane);
                    }
                    AOn[row * D + h * 64 + lane] = (bf16_t)f2bf(o[0] / fmaxf(l[0], 1e-30f));
                }
            }
#endif
#if defined(ZERO_KIND)
            }
#endif
#if defined(CHECK_KIND)
            if (kind == CHECK_KIND) {
                SEAM_AT(1 + L * NPH + 4);
                float num = 0.f, den = 0.f;
                for (int i = gtid; i < T * D; i += NGT) { const float a = bf2f(AO[i]), b = bf2f(AOn[i]); num += (a - b) * (a - b); den += b * b; }
                num = wave_sum(num); den = wave_sum(den);
                if (lane == 0) { atomicAdd((float*)(ctl + CW_CHK), num); atomicAdd((float*)(ctl + CW_CHK + 1), den); }
            }
#endif
            SEAM_AT(1 + L * NPH + 4);
        }

        if (PH_EN(5) && IN(gp0 + 5)) { PH_IDS();
            pg8::Gemm g{AO, WOUT_T, T, D, D, 0, 0, nullptr}; pg8::StaticOrder So; So.init(T, D, G, bx);
            epi::Res<(L > 0)> E{(_Float16*)X, L == 0 ? args.in[0] : (const void*)XBB, D, DN_ALPHA};
            pg8::gemm_phase<epi::Res<(L > 0)>, pg8::StaticOrder, true, true>(ldsl, g, So, E);
            SEAM_AT(1 + L * NPH + 5);
        }

        if (PH_EN(6) && IN(gp0 + 6)) { PH_IDS();
            using gattn::bf16x8; using gattn::f32x16; using gattn::u32x4; using gattn::crow; using gattn::cvtpk_s;
            const float* g1 = (const float*)args.in[17] + L * D; const float* b1 = (const float*)args.in[18] + L * D;
            const float* rb = (const float*)args.in[20] + L * NE;
            unsigned* cnt = (unsigned*)(ctl + CW_CNT + L * 2048);
            constexpr int XP = 1032;
            bf16_t* XH = (bf16_t*)lds; bf16_t* XL = XH + 32 * XP;
            float* PL = (float*)lds;
            LAS int* lcnt = (LAS int*)(ldsl + 66048 * 2); LAS int* lbase = lcnt + 64;
            const int r32 = lane & 31, hi = lane >> 5;
            bf16x8 wh[8][2], wl[8][2];
#pragma unroll
            for (int st = 0; st < 8; ++st)
#pragma unroll
                for (int nb = 0; nb < 2; ++nb) { const size_t wo = (size_t)(nb * 32 + r32) * D + wave * 128 + 16 * st + 8 * hi; wh[st][nb] = *(const bf16x8*)(WRT + wo); wl[st][nb] = *(const bf16x8*)(WRT + (size_t)NE * D + wo); }
            for (int pass = bx; pass < T / 32; pass += G) {
                const size_t row0 = (size_t)pass * 32;
                if (tid < 64) lcnt[tid] = 0;
#pragma unroll
                for (int r = 0; r < 4; ++r) { const int rl = wave * 4 + r; const size_t row = row0 + rl; f32x4 v[4];
#pragma unroll
                    for (int j = 0; j < 4; ++j) { typedef _Float16 h4 __attribute__((ext_vector_type(4))); const h4 hv = *(const h4*)((const _Float16*)X + row * D + 4 * lane + 256 * j); v[j] = (f32x4){(float)hv[0], (float)hv[1], (float)hv[2], (float)hv[3]}; }
                    ln_row(v, g1, b1, lane);
#pragma unroll
                    for (int j = 0; j < 4; ++j) {
                        const unsigned h0 = cvtpk_s(v[j].x, v[j].y), h1 = cvtpk_s(v[j].z, v[j].w);
                        *(uint2*)(XBA + row * D + 4 * lane + 256 * j) = make_uint2(h0, h1);
                        const unsigned l0 = cvtpk_s(v[j].x - bflo(h0), v[j].y - bfhi(h0)), l1 = cvtpk_s(v[j].z - bflo(h1), v[j].w - bfhi(h1));
                        *(uint2*)(XH + rl * XP + 4 * lane + 256 * j) = make_uint2(h0, h1); *(uint2*)(XL + rl * XP + 4 * lane + 256 * j) = make_uint2(l0, l1); } }
                __syncthreads();
                f32x16 acc[2]; acc[0] = f32x16{}; acc[1] = f32x16{};
                {
#pragma unroll
                  for (int st = 0; st < 8; ++st) { const int k = wave * 128 + 16 * st + 8 * hi;
                      const bf16x8 xh = *(const bf16x8*)(XH + r32 * XP + k), xl = *(const bf16x8*)(XL + r32 * XP + k);
#pragma unroll
                      for (int nb = 0; nb < 2; ++nb) { acc[nb] = __builtin_amdgcn_mfma_f32_32x32x16_bf16(xh, wh[st][nb], acc[nb], 0, 0, 0); acc[nb] = __builtin_amdgcn_mfma_f32_32x32x16_bf16(xl, wh[st][nb], acc[nb], 0, 0, 0);
                          acc[nb] = __builtin_amdgcn_mfma_f32_32x32x16_bf16(xh, wl[st][nb], acc[nb], 0, 0, 0); } } }
                __syncthreads();
#pragma unroll
                for (int nb = 0; nb < 2; ++nb)
#pragma unroll
                    for (int r = 0; r < 16; ++r) PL[(wave * 32 + crow(r, hi)) * 64 + nb * 32 + r32] = acc[nb][r];
                __syncthreads();
                const float rbl = rb[lane]; float gws[4]; int rks[4], lps[4];
                float scv[4], bi[4], m1[4], m2[4]; int cand[4]; unsigned key[4], thr[4]; bool selv[4];
#pragma unroll
                for (int r = 0; r < 4; ++r) { const int rl = wave * 4 + r; float lg = 0.f;
#pragma unroll
                    for (int w = 0; w < 8; ++w) lg += PL[(w * 32 + rl) * 64 + lane];
                    scv[r] = sigmoidf_(lg); bi[r] = scv[r] + rbl; m1[r] = bi[r]; }
#pragma unroll
                for (int r = 0; r < 4; ++r) m1[r] = fmaxf(m1[r], xor_f<1>(m1[r]));
#pragma unroll
                for (int r = 0; r < 4; ++r) m1[r] = fmaxf(m1[r], xor_f<2>(m1[r]));
#pragma unroll
                for (int r = 0; r < 4; ++r) { m1[r] = fmaxf(m1[r], xor_f<4>(m1[r])); cand[r] = (bi[r] == m1[r]) ? lane : 64; }
#pragma unroll
                for (int r = 0; r < 4; ++r) cand[r] = min(cand[r], xor_i<1>(cand[r]));
#pragma unroll
                for (int r = 0; r < 4; ++r) cand[r] = min(cand[r], xor_i<2>(cand[r]));
#pragma unroll
                for (int r = 0; r < 4; ++r) { cand[r] = min(cand[r], xor_i<4>(cand[r])); m2[r] = (lane == cand[r]) ? -3e38f : bi[r]; }
#pragma unroll
                for (int r = 0; r < 4; ++r) m2[r] = fmaxf(m2[r], xor_f<1>(m2[r]));
#pragma unroll
                for (int r = 0; r < 4; ++r) m2[r] = fmaxf(m2[r], xor_f<2>(m2[r]));
#pragma unroll
                for (int r = 0; r < 4; ++r) { m2[r] = fmaxf(m2[r], xor_f<4>(m2[r]));
                    const float gsc = m1[r] + m2[r]; const int grp = lane >> 3; int grank = 0;
#pragma unroll
                    for (int gg = 0; gg < 8; ++gg) { const float og = bcast_f(gsc, gg * 8); grank += (og > gsc || (og == gsc && gg < grp)) ? 1 : 0; }
                    const float v = grank < 4 ? bi[r] : NEGF; const unsigned ub = __float_as_uint(v);
                    key[r] = (ub & 0x80000000u) ? ~ub : (ub | 0x80000000u); thr[r] = 0u; }
                for (int bit = 31; bit >= 0; --bit) {
#pragma unroll
                    for (int r = 0; r < 4; ++r) { const unsigned cd = thr[r] | (1u << bit); thr[r] = __popcll(__builtin_amdgcn_ballot_w64(key[r] >= cd)) >= 8 ? cd : thr[r]; } }
                const unsigned long long lt = (1ull << lane) - 1ull;
#pragma unroll
                for (int r = 0; r < 4; ++r) { const unsigned long long gm = __builtin_amdgcn_ballot_w64(key[r] > thr[r]); unsigned long long em = __builtin_amdgcn_ballot_w64(key[r] == thr[r]);
                    int need = 8 - __popcll(gm); unsigned long long tm = 0ull;
                    while (need > 0 && em) { const unsigned long long lowb = em & (0ull - em); tm |= lowb; em ^= lowb; --need; }
                    const unsigned long long m = gm | tm; selv[r] = (m >> lane) & 1ull; rks[r] = selv[r] ? __popcll(m & lt) : -1; }
                float ssum[4];
#pragma unroll
                for (int r = 0; r < 4; ++r) ssum[r] = selv[r] ? scv[r] : 0.f;
#pragma unroll
                for (int r = 0; r < 4; ++r) ssum[r] += xor_f<1>(ssum[r]);
#pragma unroll
                for (int r = 0; r < 4; ++r) ssum[r] += xor_f<2>(ssum[r]);
#pragma unroll
                for (int r = 0; r < 4; ++r) ssum[r] += xor_f<4>(ssum[r]);
#pragma unroll
                for (int r = 0; r < 4; ++r) ssum[r] += xor_f<8>(ssum[r]);
#pragma unroll
                for (int r = 0; r < 4; ++r) { ssum[r] += xor_f<16>(ssum[r]); auto rr = __builtin_amdgcn_permlane32_swap(__float_as_uint(ssum[r]), __float_as_uint(ssum[r]), false, false); ssum[r] = __uint_as_float(rr[0]) + __uint_as_float(rr[1]);
                    gws[r] = scv[r] / ssum[r] * 2.5f; }
#pragma unroll
                for (int r = 0; r < 4; ++r) lps[r] = selv[r] ? __hip_atomic_fetch_add((int*)(lcnt + lane), 1, __ATOMIC_RELAXED, __HIP_MEMORY_SCOPE_WORKGROUP) : 0;
                __syncthreads();
                if (tid < 64) { const int c = lcnt[tid]; lbase[tid] = c ? (int)atomicAdd(cnt + tid * 32, (unsigned)c) : 0; }
                __syncthreads();
                { const int base = lbase[lane];
#pragma unroll
                  for (int r = 0; r < 4; ++r) if (rks[r] >= 0) { const size_t rw = row0 + wave * 4 + r; const int pos = base + lps[r];
                      TOKE[rw * 8 + rks[r]] = lane; TOKW[rw * 8 + rks[r]] = gws[r]; TOKP[rw * 8 + rks[r]] = pos; ROWTOK[lane * 16384 + pos] = (int)rw; } }
                __syncthreads();
            }
            SEAM_AT(1 + L * NPH + 6);
        }

        if (PH_EN(8) && IN(gp0 + 8)) { PH_IDS();
            __syncthreads();
            { LAS int* ntl = (LAS int*)ldsl;
              if (tid < 64) ntl[tid] = (int)((__hip_atomic_load((const unsigned*)(ctl + CW_CNT + L * 2048) + tid * 32, RLX_AGENT) + 255u) >> 8);
              __syncthreads();
              if (tid <= 64) { int s = 0; for (int e = 0; e < tid; ++e) s += ntl[e]; TAB[tid] = s; } }
            __syncthreads();
            const int nrt = 64 + TAB[64];
            pg8::Gemm g{XBA, WGU_T, 0, 0, D, 0, 0, ROWTOK}; MoeOrder So{TAB, 2, G, bx, nrt * 2, 1};
            epi::SwiGlu E{HB, 0};
            pg8::gemm_phase<epi::SwiGlu, MoeOrder, true, true, true>(ldsl, g, So, E);
            SEAM_AT(1 + L * NPH + 8);
        }

        if (PH_EN(9) && IN(gp0 + 9)) { PH_IDS();
            const int nrt = 64 + TAB[64];
            int kdn = ED; asm volatile("" : "+s"(kdn)); pg8::Gemm g{HB, WDN_T, 0, 0, kdn, 0, 0, nullptr}; MoeOrder So{TAB, 4, G, bx, nrt * 4, 0};
            epi::Down E{OUTR};
            pg8::gemm_phase<epi::Down, MoeOrder, true, true>(ldsl, g, So, E);
            SEAM_AT(1 + L * NPH + 9);
        }

        if (PH_EN(10) && IN(gp0 + 10)) { PH_IDS();
            const float* g2 = (const float*)args.in[27] + L * D; const float* b2 = (const float*)args.in[28] + L * D;
#if defined(OUTR_FP8)
            for (int rowa = gw; rowa < T; rowa += 2 * NGW) {
                typedef float f32x2n __attribute__((ext_vector_type(2)));
                f32x4 v[2][4]; int ws_[2][4], wk[2][TOPK][4]; float gk[2][TOPK]; bool has[2];
#pragma unroll
                for (int u = 0; u < 2; ++u) { const int row = rowa + u * NGW; has[u] = row < T; if (!has[u]) continue;
#pragma unroll
                    for (int j = 0; j < 4; ++j) { const uint2 w = *(const uint2*)(XBA + (size_t)row * D + 4 * lane + 256 * j); v[u][j] = (f32x4){bflo(w.x), bfhi(w.x), bflo(w.y), bfhi(w.y)} * DN_ALPHA; }
                    const unsigned char* o = (const unsigned char*)OUTR + (size_t)row * D;
#pragma unroll
                    for (int j = 0; j < 4; ++j) ws_[u][j] = (int)__builtin_nontemporal_load((const unsigned*)(o + 4 * lane + 256 * j));
#pragma unroll
                    for (int k = 0; k < TOPK; ++k) { const int dest = TAB[TOKE[row * 8 + k]] * 256 + TOKP[row * 8 + k]; gk[u][k] = TOKW[row * 8 + k] * (1.f / 64.f); const unsigned char* ok = (const unsigned char*)OUTR + ((size_t)T + dest) * D;
#pragma unroll
                        for (int j = 0; j < 4; ++j) wk[u][k][j] = (int)__builtin_nontemporal_load((const unsigned*)(ok + 4 * lane + 256 * j)); } }
#pragma unroll
                for (int u = 0; u < 2; ++u) { const int row = rowa + u * NGW; if (!has[u]) continue;
#pragma unroll
                    for (int j = 0; j < 4; ++j) { const f32x2n a = __builtin_amdgcn_cvt_pk_f32_fp8(ws_[u][j], false), c = __builtin_amdgcn_cvt_pk_f32_fp8(ws_[u][j], true);
                        v[u][j].x += a.x * (1.f / 64.f); v[u][j].y += a.y * (1.f / 64.f); v[u][j].z += c.x * (1.f / 64.f); v[u][j].w += c.y * (1.f / 64.f); }
#pragma unroll
                    for (int k = 0; k < TOPK; ++k) { const float gwk = gk[u][k];
#pragma unroll
                        for (int j = 0; j < 4; ++j) { const f32x2n a = __builtin_amdgcn_cvt_pk_f32_fp8(wk[u][k][j], false), c = __builtin_amdgcn_cvt_pk_f32_fp8(wk[u][k][j], true);
                            v[u][j].x += gwk * a.x; v[u][j].y += gwk * a.y; v[u][j].z += gwk * c.x; v[u][j].w += gwk * c.y; } }
                    ln_row(v[u], g2, b2, lane);
#pragma unroll
                    for (int j = 0; j < 4; ++j)
                        *(unsigned long long*)(XBA + (size_t)row * D + 4 * lane + 256 * j) = (unsigned long long)pk2(v[u][j].x, v[u][j].y) | ((unsigned long long)pk2(v[u][j].z, v[u][j].w) << 32); }
            }
#else
            for (int row = gw; row < T; row += NGW) {
                f32x4 v[4];
#pragma unroll
                for (int j = 0; j < 4; ++j) { const uint2 w = *(const uint2*)(XBA + (size_t)row * D + 4 * lane + 256 * j); v[j] = (f32x4){bflo(w.x), bfhi(w.x), bflo(w.y), bfhi(w.y)} * DN_ALPHA; }
#if defined(OUTR_FP8)
                {   typedef float f32x2n __attribute__((ext_vector_type(2)));
                    const unsigned char* o = (const unsigned char*)OUTR + (size_t)row * D;
#pragma unroll
                    for (int j = 0; j < 4; ++j) { const int w = (int)__builtin_nontemporal_load((const unsigned*)(o + 4 * lane + 256 * j)); const f32x2n a = __builtin_amdgcn_cvt_pk_f32_fp8(w, false), c = __builtin_amdgcn_cvt_pk_f32_fp8(w, true);
                        v[j].x += a.x * (1.f / 64.f); v[j].y += a.y * (1.f / 64.f); v[j].z += c.x * (1.f / 64.f); v[j].w += c.y * (1.f / 64.f); }
                    for (int k = 0; k < TOPK; ++k) { const int dest = TAB[TOKE[row * 8 + k]] * 256 + TOKP[row * 8 + k]; const float gwk = TOKW[row * 8 + k] * (1.f / 64.f); const unsigned char* ok = (const unsigned char*)OUTR + ((size_t)T + dest) * D;
#pragma unroll
                        for (int j = 0; j < 4; ++j) { const int w = (int)__builtin_nontemporal_load((const unsigned*)(ok + 4 * lane + 256 * j)); const f32x2n a = __builtin_amdgcn_cvt_pk_f32_fp8(w, false), c = __builtin_amdgcn_cvt_pk_f32_fp8(w, true);
                            v[j].x += gwk * a.x; v[j].y += gwk * a.y; v[j].z += gwk * c.x; v[j].w += gwk * c.y; } } }
#else
                {
                    const bf16_t* o = OUTR + (size_t)row * D;
#pragma unroll
                    for (int j = 0; j < 4; ++j) { typedef unsigned u32x2n __attribute__((ext_vector_type(2))); const u32x2n w = __builtin_nontemporal_load((const u32x2n*)(o + 4 * lane + 256 * j)); v[j].x += bflo(w.x); v[j].y += bfhi(w.x); v[j].z += bflo(w.y); v[j].w += bfhi(w.y); }
                }
                for (int k = 0; k < TOPK; ++k) { const int dest = TAB[TOKE[row * 8 + k]] * 256 + TOKP[row * 8 + k]; const float gwk = TOKW[row * 8 + k]; const bf16_t* o = OUTR + ((size_t)T + dest) * D;
#pragma unroll
                    for (int j = 0; j < 4; ++j) { typedef unsigned u32x2n __attribute__((ext_vector_type(2))); const u32x2n w = __builtin_nontemporal_load((const u32x2n*)(o + 4 * lane + 256 * j)); v[j].x += gwk * bflo(w.x); v[j].y += gwk * bfhi(w.x); v[j].z += gwk * bflo(w.y); v[j].w += gwk * bfhi(w.y); } }
#endif
                ln_row(v, g2, b2, lane);
#pragma unroll
                for (int j = 0; j < 4; ++j) {
                    *(unsigned long long*)(XBA + (size_t)row * D + 4 * lane + 256 * j) = (unsigned long long)pk2(v[j].x, v[j].y) | ((unsigned long long)pk2(v[j].z, v[j].w) << 32); }
            }
#endif
            SEAM_AT(1 + L * NPH + 10);
        }

        if (PH_EN(12) && IN(gp0 + 12)) { PH_IDS();
            pg8::Gemm g{XBA, WPG_T, T, D, D, 0, 0, nullptr}; pg8::StaticOrder So; So.init(T, D, G, bx);
            epi::Ple<(L == DEPTH - 1)> E{XBA, PP, args.out, XBB};
            pg8::gemm_phase<epi::Ple<(L == DEPTH - 1)>, pg8::StaticOrder, true, true>(ldsl, g, So, E);
#if defined(TIME_P1)
            SEAM_AT(1 + L * NPH + 12);
#else
            if (L != DEPTH - 1) SEAM_AT(1 + L * NPH + 12);
#endif
        }
    };
    layer_body(std::integral_constant<int, 0>{}); layer_body(std::integral_constant<int, 1>{}); layer_body(std::integral_constant<int, 2>{}); layer_body(std::integral_constant<int, 3>{});
#if defined(TIME_P1)
    {   PH_IDS();
        xcd_barrier(bar);
        const unsigned long long* ts = (const unsigned long long*)(ctl + CW_TS);
        int dig[2];
        for (int q = 0; q < 2; ++q) { const int p = q ? TIME_P2 : TIME_P1; unsigned long long tot = 0;
            for (int L2 = 0; L2 < DEPTH; ++L2) { if (TIME_LSEL >= 0 && L2 != (q ? TIME_LSEL2 : TIME_LSEL)) continue; const int k = 1 + L2 * NPH + p; const unsigned long long te = __hip_atomic_load(ts + k, RLX_AGENT); if (te == 0ull) continue;
                unsigned long long tb = 0ull; for (int k2 = k - 1; k2 >= 0 && tb == 0ull; --k2) tb = __hip_atomic_load(ts + k2, RLX_AGENT);
                tot += te - tb; }
            const float us = (float)tot * 0.01f * TIME_MUL; int d = (int)floorf(log2f(fmaxf(us, 1.f))) - 3; dig[q] = d < 0 ? 0 : d > 9 ? 9 : d; }
        const float sc = 1.f + sqrtf(0.01f * (float)(10 * (dig[0] + 1) + dig[1]));
        for (int i = gtid; i < T * D; i += NGT) args.out[i] *= sc; }
#endif
#if defined(CHECK_KIND)
    {   PH_IDS(); SEAM();
        const float num = __hip_atomic_load((float*)(ctl + CW_CHK), RLX_AGENT), den = __hip_atomic_load((float*)(ctl + CW_CHK + 1), RLX_AGENT);
        const float sc = 1.f + 100.f * sqrtf(num / fmaxf(den, 1e-30f));
        for (int i = gtid; i < T * D; i += NGT) args.out[i] *= sc; }
#endif
#undef SEAM
#undef IN
}

extern "C" void kernel_launch(void* const* d_in, const int* in_sizes, int n_in, void* d_out, int out_size, void* d_ws, size_t ws_size, hipStream_t stream) {
    static int grid = 0;
    if (grid == 0) {
        if (n_in != 31 || out_size != T * D || ws_size < WS_END) { fprintf(stderr, "kernel_launch: unexpected problem (n_in %d, out %d, ws %zu < %zu)\n", n_in, out_size, ws_size, (size_t)WS_END); grid = -1; return; }
        int dev = 0, cus = 0, per_cu = 0;
        if (hipGetDevice(&dev) != hipSuccess || hipDeviceGetAttribute(&cus, hipDeviceAttributeMultiprocessorCount, dev) != hipSuccess) { grid = -1; return; }
        if (hipFuncSetAttribute((const void*)mk_fwd, hipFuncAttributeMaxDynamicSharedMemorySize, LDS_BYTES) != hipSuccess) { fprintf(stderr, "kernel_launch: hipFuncSetAttribute failed\n"); grid = -1; return; }
        if (hipOccupancyMaxActiveBlocksPerMultiprocessor(&per_cu, (const void*)mk_fwd, NTHR, LDS_BYTES) != hipSuccess || per_cu < 1) fprintf(stderr, "kernel_launch: occupancy query says %d\n", per_cu);
        (void)hipGetLastError();
        grid = cus;
    }
    if (grid < 0) return;
    (void)hipMemsetAsync((char*)d_ws + WS_CTL, 0, CTL_ZERO_BYTES, stream);
    Args a{};
    for (int i = 0; i < 31; ++i) a.in[i] = d_in[i];
    a.out = (float*)d_out; a.ws = (unsigned char*)d_ws;
#if MK_MULTI
    const int nph = 1 + DEPTH * NPH;
    for (int p = 0; p < nph; ++p) { a.ph_lo = p; a.ph_hi = p + 1; hipLaunchKernelGGL(mk_fwd, dim3(grid), dim3(NTHR), LDS_BYTES, stream, a); }
#else
    a.ph_lo = 0; a.ph_hi = 1 + DEPTH * NPH;
    hipLaunchKernelGGL(mk_fwd, dim3(grid), dim3(NTHR), LDS_BYTES, stream, a);
#endif
}
```

```cpp
#define MK_MULTI 0
#define OUTR_FP8 1
#include <hip/hip_runtime.h>
#include <cstdio>
#include <cstdint>
namespace pg8 {
#define PG8_LAS __attribute__((address_space(3)))
typedef unsigned short bf16_t;
typedef short bf16x8 __attribute__((ext_vector_type(8)));
typedef float f32x4 __attribute__((ext_vector_type(4)));
typedef unsigned u32x4 __attribute__((ext_vector_type(4)));
constexpr int BM = 256, BK = 64, HALF = 128, HTB = HALF * BK * 2  , STAGE_BYTES = 8 * HTB, NXCD = 8, WGM = 8;

__host__ __device__ __forceinline__ int lds_byte(int r, int c) { const int st = (r >> 4) * 2 + (c >> 5), rr = r & 15, cc = c & 31, ob = rr * 64 + cc * 2; return st * 1024 + (ob ^ (((ob >> 9) & 1) << 5)); }
__host__ __device__ __forceinline__ void stage_rc(int b, int& R, int& C) { const int st = b / 1024, sb = b % 1024, swz = sb ^ (((sb >> 9) & 1) << 5); R = (st >> 1) * 16 + swz / 64; C = (st & 1) * 32 + (swz % 64) / 2; }
__host__ __device__ __forceinline__ int perm32(int rho) { const int n = rho >> 4, i = rho & 15; return 8 * (i >> 2) + 4 * n + (i & 3); }

struct Unit { int pm, pn; long aofs; };
struct Gemm { const bf16_t* A; const bf16_t* Bt; int M, N, K; int lda, kstepA; const int* gidx; };

struct StaticOrder {
    int nM, nN, nwg, G, c;
    __host__ __device__ void init(int M, int N, int G_, int c_) { nM = M / BM; nN = N / BM; nwg = nM * nN; G = G_; c = c_; }
    __host__ __device__ bool next(int i, Unit& u) const {
        const long L = (long)i * G + c; if (L >= nwg) return false;
        int wgid = (int)L; { const int q = nwg / NXCD, r = nwg % NXCD, xcd = wgid % NXCD, off = wgid / NXCD; wgid = (xcd < r ? xcd * (q + 1) : r * (q + 1) + (xcd - r) * q) + off; }
        const int nig = WGM * nN, gid = wgid / nig, fm = gid * WGM, gsz = (nM - fm) < WGM ? (nM - fm) : WGM;
        u.pm = fm + ((wgid % nig) % gsz); u.pn = (wgid % nig) / gsz; u.aofs = 0; return true;
    }
    __device__ __forceinline__ void a_ready(const Unit&) const {}
    __device__ __forceinline__ void done(const Unit&) const {}
};

__device__ __forceinline__ unsigned cvt_pk_bf16(float lo, float hi) { unsigned r; asm volatile("v_cvt_pk_bf16_f32 %0, %1, %2" : "=v"(r) : "v"(lo), "v"(hi)); return r; }
typedef float f32x2 __attribute__((ext_vector_type(2)));
__device__ __forceinline__ f32x2 gelu_pk(f32x2 v) {
    const f32x2 av = __builtin_elementwise_abs(v), d = av * 0.2316418882f + 1.0f;
    f32x2 t; t.x = __builtin_amdgcn_rcpf(d.x); t.y = __builtin_amdgcn_rcpf(d.y);
    f32x2 q = t * 0.5307027145f + (-0.7265760135f); q = q * t + 0.7107068705f; q = q * t + (-0.142248368f); q = q * t + 0.127414796f; q = q * t;
    const f32x2 s = (v * v) * (-0.72134752044f);
    f32x2 e; e.x = __builtin_amdgcn_exp2f(s.x); e.y = __builtin_amdgcn_exp2f(s.y);
    const f32x2 m = v * (q * e), r = v - m;
    f32x2 o; o.x = v.x < 0.f ? m.x : r.x; o.y = v.y < 0.f ? m.y : r.y; return o;
}

template <int ACT  > struct EpiBf16 {
    static constexpr bool PERM = true, AFTER_DRAIN = false; static_assert(ACT == 0 || ACT == 1, "EpiBf16: ACT is 0 (none) or 1 (gelu_pk)");
    bf16_t* O; int ldc; const float* bias; int split_cols; size_t split_stride; float scale0;
    __device__ __forceinline__ void operator()(const f32x4 (&acc)[2][2][4][2], const Unit& u, int wr, int wc, int fr, int fq) const {
        const int row0 = u.pm * BM + wr * 64 + fr; int colt = u.pn * BM; bf16_t* base = O;
        float sc = 1.f; if (split_cols) { const int t = colt / split_cols; base += (size_t)t * split_stride; colt -= t * split_cols; if (t == 0) sc = scale0; }
        const int col0 = colt + wc * 32 + 8 * fq, bcol0 = u.pn * BM + wc * 32 + 8 * fq;
        f32x4 bv[2][2];
#pragma unroll
        for (int bj = 0; bj < 2; ++bj)
#pragma unroll
            for (int n = 0; n < 2; ++n) bv[bj][n] = bias ? *(const f32x4*)(bias + bcol0 + bj * HALF + 4 * n) : (f32x4){0.f, 0.f, 0.f, 0.f};
#pragma unroll
        for (int ai = 0; ai < 2; ++ai)
#pragma unroll
            for (int m = 0; m < 4; ++m) { bf16_t* rowp = base + (size_t)(row0 + ai * HALF + m * 16) * ldc + col0;
#pragma unroll
                for (int bj = 0; bj < 2; ++bj) { f32x4 v0 = acc[ai][bj][m][0] + bv[bj][0], v1 = acc[ai][bj][m][1] + bv[bj][1];
                    if (ACT == 1) { f32x2 a = gelu_pk((f32x2){v0[0], v0[1]}), b = gelu_pk((f32x2){v0[2], v0[3]}), c = gelu_pk((f32x2){v1[0], v1[1]}), d = gelu_pk((f32x2){v1[2], v1[3]});
                        v0 = (f32x4){a.x, a.y, b.x, b.y}; v1 = (f32x4){c.x, c.y, d.x, d.y}; }
                    v0 = v0 * sc; v1 = v1 * sc; u32x4 w; w.x = cvt_pk_bf16(v0[0], v0[1]); w.y = cvt_pk_bf16(v0[2], v0[3]); w.z = cvt_pk_bf16(v1[0], v1[1]); w.w = cvt_pk_bf16(v1[2], v1[3]);
                    *(u32x4*)(rowp + bj * HALF) = w; } }
    }
};

struct PanelStats {
    unsigned* xbuf;
    unsigned* cnt;
    unsigned* tmo;
    int ntn; float eps;
    unsigned code;
    __device__ __forceinline__ bool run(const f32x4 (&v)[2][2][4][2], const Unit& u, int wr, int wc, int fr, int fq, PG8_LAS unsigned char* lds, int wid, int lane) const {
        typedef float f32x2v __attribute__((ext_vector_type(2)));
        PG8_LAS f32x2v* P = (PG8_LAS f32x2v*)lds;
        PG8_LAS f32x2v* S = (PG8_LAS f32x2v*)(lds + 8192);
        PG8_LAS unsigned* flag = (PG8_LAS unsigned*)(lds + 8192 + 2048);
#pragma unroll
        for (int ai = 0; ai < 2; ++ai)
#pragma unroll
            for (int m = 0; m < 4; ++m) {
                float s = 0.f;
#pragma unroll
                for (int bj = 0; bj < 2; ++bj)
#pragma unroll
                    for (int n = 0; n < 2; ++n) { const f32x4 x = v[ai][bj][m][n]; s += (x[0] + x[1]) + (x[2] + x[3]); }
                s += __shfl_xor(s, 16); s += __shfl_xor(s, 32);
                const float mw = s * (1.0f / 64.0f); float q = 0.f;
#pragma unroll
                for (int bj = 0; bj < 2; ++bj)
#pragma unroll
                    for (int n = 0; n < 2; ++n) { const f32x4 d = v[ai][bj][m][n] - mw; q += (d[0] * d[0] + d[1] * d[1]) + (d[2] * d[2] + d[3] * d[3]); }
                q += __shfl_xor(q, 16); q += __shfl_xor(q, 32);
                if (fq == 0) P[(ai * HALF + wr * 64 + m * 16 + fr) * 4 + wc] = (f32x2v){mw, q};
            }
        asm volatile("s_waitcnt lgkmcnt(0)" ::: "memory"); __builtin_amdgcn_s_barrier(); asm volatile("" ::: "memory");
#if defined(BROKEN_EXCHANGE_NO_WAIT)
#warning BROKEN CONTROL BUILD: the row-statistics exchange does not wait; results are wrong by design
        if (blockIdx.x >= 64) { const long long t0_ = clock64(); while (clock64() - t0_ < 60000) __builtin_amdgcn_s_sleep(8); }
#endif
        const int row = wid * 32 + (lane & 31);
        if (lane < 32) {
            const f32x2v a = P[row * 4 + 0], b = P[row * 4 + 1], c = P[row * 4 + 2], d = P[row * 4 + 3];
            const float mt = (a.x + b.x + c.x + d.x) * 0.25f;
            const float da = a.x - mt, db = b.x - mt, dc = c.x - mt, dd = d.x - mt;
            const float m2 = (a.y + b.y) + (c.y + d.y) + 64.0f * ((da * da + db * db) + (dc * dc + dd * dd));
            unsigned long long* slot = (unsigned long long*)xbuf + ((size_t)(u.pm * BM + row) * 4 + u.pn);
            __hip_atomic_store(slot, ((unsigned long long)__float_as_uint(m2) << 32) | __float_as_uint(mt), __ATOMIC_RELAXED, __HIP_MEMORY_SCOPE_AGENT);
        }
        asm volatile("s_waitcnt vmcnt(0)" ::: "memory");
        if (lane == 0) __hip_atomic_fetch_add(cnt + 64 * u.pm, 1u, __ATOMIC_RELAXED, __HIP_MEMORY_SCOPE_AGENT);
        if (wid == 0) {
            bool dead = false; const unsigned long long t0 = __builtin_amdgcn_s_memrealtime(); const unsigned want = 8u * (unsigned)ntn;
            for (;;) {
#if defined(BROKEN_EXCHANGE_NO_WAIT)
                break;
#endif
                if ((unsigned)__builtin_amdgcn_readfirstlane(__hip_atomic_load(cnt + 64 * u.pm, __ATOMIC_RELAXED, __HIP_MEMORY_SCOPE_AGENT)) >= want) break;
                if (__builtin_amdgcn_s_memrealtime() - t0 > 2000000ull) {
                    if (lane == 0) { unsigned expect = 0u; __hip_atomic_compare_exchange_strong(tmo + 1, &expect, code | (unsigned)(u.pm & 0xff), __ATOMIC_RELAXED, __ATOMIC_RELAXED, __HIP_MEMORY_SCOPE_AGENT);
                                     __hip_atomic_store(tmo, 1u, __ATOMIC_RELAXED, __HIP_MEMORY_SCOPE_AGENT); }
                    dead = true; break; }
                __builtin_amdgcn_s_sleep(2);
            }
            __builtin_amdgcn_fence(__ATOMIC_ACQUIRE, "agent");
            if (lane == 0) flag[0] = dead ? 1u : 0u;
        }
        asm volatile("s_waitcnt vmcnt(0) lgkmcnt(0)" ::: "memory"); __builtin_amdgcn_s_barrier(); asm volatile("" ::: "memory");
        const bool bad = flag[0] != 0u;
        if (lane < 32) {
            const unsigned long long* slot = (const unsigned long long*)xbuf + (size_t)(u.pm * BM + row) * 4; float mt[4], m2[4]; float ms = 0.f;
#pragma unroll
            for (int t = 0; t < 4; ++t) { if (t < ntn) { const unsigned long long w = __hip_atomic_load(slot + t, __ATOMIC_RELAXED, __HIP_MEMORY_SCOPE_AGENT); mt[t] = __uint_as_float((unsigned)w); m2[t] = __uint_as_float((unsigned)(w >> 32)); } else { mt[t] = 0.f; m2[t] = 0.f; } ms += mt[t]; }
            const float mean = ms / (float)ntn; float q = 0.f;
#pragma unroll
            for (int t = 0; t < 4; ++t) if (t < ntn) { const float dm = mt[t] - mean; q += m2[t] + 256.0f * dm * dm; }
            S[row] = (f32x2v){mean, 1.0f / sqrtf(q / (256.0f * (float)ntn) + eps)};
        }
        asm volatile("s_waitcnt lgkmcnt(0)" ::: "memory"); __builtin_amdgcn_s_barrier(); asm volatile("" ::: "memory");
        return bad;
    }
};
struct EpiLnRes {
    static constexpr bool PERM = false, AFTER_DRAIN = true;
    const float* base; float* out; int ldc; const float* bias; PanelStats st; unsigned poison;
    __device__ __forceinline__ void fused(f32x4 (&acc)[2][2][4][2], const Unit& u, int wr, int wc, int fr, int fq, PG8_LAS unsigned char* lds, int wid, int lane) const {
        typedef float f32x2v __attribute__((ext_vector_type(2)));
        const PG8_LAS f32x2v* S = (const PG8_LAS f32x2v*)(lds + 8192);
        const int col0 = u.pn * BM + wc * 32 + 4 * fq;
#pragma unroll
        for (int bj = 0; bj < 2; ++bj)
#pragma unroll
            for (int n = 0; n < 2; ++n) { const f32x4 bv = bias ? *(const f32x4*)(bias + col0 + bj * HALF + n * 16) : (f32x4){0.f, 0.f, 0.f, 0.f};
#pragma unroll
                for (int ai = 0; ai < 2; ++ai)
#pragma unroll
                    for (int m = 0; m < 4; ++m) acc[ai][bj][m][n] += bv; }
        f32x4 pre[4][2][2];
#pragma unroll
        for (int m = 0; m < 4; ++m) { const size_t off = (size_t)(u.pm * BM + wr * 64 + m * 16 + fr) * ldc + col0;
#pragma unroll
            for (int bj = 0; bj < 2; ++bj)
#pragma unroll
                for (int n = 0; n < 2; ++n) pre[m][bj][n] = *(const f32x4*)(base + off + bj * HALF + n * 16); }
        const bool bad = st.run(acc, u, wr, wc, fr, fq, lds, wid, lane) || poison != 0u;
        const float qnan = __builtin_nanf("");
#pragma unroll
        for (int ai = 0; ai < 2; ++ai)
#pragma unroll
            for (int m = 0; m < 4; ++m) { const int r = ai * HALF + wr * 64 + m * 16 + fr; const f32x2v sr = S[r]; const size_t off = (size_t)(u.pm * BM + r) * ldc + col0;
#pragma unroll
                for (int bj = 0; bj < 2; ++bj)
#pragma unroll
                    for (int n = 0; n < 2; ++n) { const f32x4 bs = ai == 0 ? pre[m][bj][n] : *(const f32x4*)(base + off + bj * HALF + n * 16); f32x4 o = bs + (acc[ai][bj][m][n] - sr.x) * sr.y;
                        if (bad) o = (f32x4){qnan, qnan, qnan, qnan}; *(f32x4*)(out + off + bj * HALF + n * 16) = o; }
                if (m & 1) asm volatile("" ::: "memory"); }
    }
};
struct EpiLnResLn {
    static constexpr bool PERM = false, AFTER_DRAIN = true;
    const float* base; float* out; bf16_t* xn; int ldc; const float* bias; PanelStats st1, st2; unsigned poison;
    __device__ __forceinline__ void fused(f32x4 (&acc)[2][2][4][2], const Unit& u, int wr, int wc, int fr, int fq, PG8_LAS unsigned char* lds, int wid, int lane) const {
        typedef float f32x2v __attribute__((ext_vector_type(2))); typedef unsigned u32x2v __attribute__((ext_vector_type(2)));
        const PG8_LAS f32x2v* S = (const PG8_LAS f32x2v*)(lds + 8192);
        const int col0 = u.pn * BM + wc * 32 + 4 * fq;
#pragma unroll
        for (int bj = 0; bj < 2; ++bj)
#pragma unroll
            for (int n = 0; n < 2; ++n) { const f32x4 bv = bias ? *(const f32x4*)(bias + col0 + bj * HALF + n * 16) : (f32x4){0.f, 0.f, 0.f, 0.f};
#pragma unroll
                for (int ai = 0; ai < 2; ++ai)
#pragma unroll
                    for (int m = 0; m < 4; ++m) acc[ai][bj][m][n] += bv; }
        bool bad = st1.run(acc, u, wr, wc, fr, fq, lds, wid, lane) || poison != 0u;
        const float qnan = __builtin_nanf("");
#pragma unroll
        for (int ai = 0; ai < 2; ++ai)
#pragma unroll
            for (int m = 0; m < 4; ++m) { const int r = ai * HALF + wr * 64 + m * 16 + fr; const f32x2v sr = S[r]; const size_t off = (size_t)(u.pm * BM + r) * ldc + col0;
#pragma unroll
                for (int bj = 0; bj < 2; ++bj)
#pragma unroll
                    for (int n = 0; n < 2; ++n) { const f32x4 bs = *(const f32x4*)(base + off + bj * HALF + n * 16); acc[ai][bj][m][n] = bs + (acc[ai][bj][m][n] - sr.x) * sr.y; }
                asm volatile("" : "+v"(acc[ai][0][m][0]), "+v"(acc[ai][0][m][1]), "+v"(acc[ai][1][m][0]), "+v"(acc[ai][1][m][1]));
                if (m & 1) asm volatile("" ::: "memory"); }
        const bool bad1 = bad;
        bad = st2.run(acc, u, wr, wc, fr, fq, lds, wid, lane) || bad;
#pragma unroll
        for (int ai = 0; ai < 2; ++ai)
#pragma unroll
            for (int m = 0; m < 4; ++m) { const int r = ai * HALF + wr * 64 + m * 16 + fr; const f32x2v sr = S[r]; const size_t off = (size_t)(u.pm * BM + r) * ldc + col0;
#pragma unroll
                for (int bj = 0; bj < 2; ++bj)
#pragma unroll
                    for (int n = 0; n < 2; ++n) { const f32x4 x1 = acc[ai][bj][m][n]; *(f32x4*)(out + off + bj * HALF + n * 16) = bad1 ? (f32x4){qnan, qnan, qnan, qnan} : x1;
                        const f32x4 o = (x1 - sr.x) * sr.y; u32x2v w; w.x = cvt_pk_bf16(o[0], o[1]); w.y = cvt_pk_bf16(o[2], o[3]);
                        if (bad) { w.x = 0x7fc07fc0u; w.y = 0x7fc07fc0u; } *(u32x2v*)(xn + off + bj * HALF + n * 16) = w; }
                asm volatile("" ::: "memory"); }
    }
};

template <class Epi, class Sched, bool ALIGN_EPI = false, bool SP2 = false, bool GATHER = false>
__device__ __forceinline__ void gemm_phase(PG8_LAS unsigned char* lds, const Gemm g, const Sched& S, const Epi& E) {
    static_assert(!GATHER || SP2, "gathered A rows: SP2 loop only");
    int tid_o = threadIdx.x; asm volatile("" : "+v"(tid_o)); const int tid = tid_o, wid = __builtin_amdgcn_readfirstlane(tid >> 6), lane = tid & 63, wr = wid >> 2, wc = wid & 3, fr = lane & 15, fq = lane >> 4;
    const int K = g.K, nt = K / BK, lda = g.lda ? g.lda : K;
    unsigned voffA[2], voffB[2];
#pragma unroll
    for (int i = 0; i < 2; ++i) { int R, C; stage_rc(tid * 16 + i * 8192, R, C); const int Rb = Epi::PERM ? ((R & ~31) + perm32(R & 31)) : R;
        voffA[i] = (unsigned)(R * lda + C) * 2u; voffB[i] = (unsigned)(Rb * K + C) * 2u; }
    const size_t kstep = (size_t)(BK * 2);
    const size_t hstep = (size_t)HALF * K * 2;
    const size_t tstep = 2 * hstep;
    const size_t kstepA = g.kstepA ? (size_t)g.kstepA : kstep, hstepA = (size_t)HALF * lda * 2, tstepA = 2 * hstepA;
    const unsigned ldsw = (unsigned)wid * 1024u;
    const int aoff = lds_byte(wr * 64 + fr, fq * 8), boff = lds_byte(wc * 32 + fr, fq * 8);
#define PG8_SA(b, h) (((b) * 2 + (h)) * HTB)
#define PG8_SB(b, h) ((4 + (b) * 2 + (h)) * HTB)
#define PG8_STAGE(bufoff, gbase, voff) do { _Pragma("unroll") for (int _i = 0; _i < 2; ++_i) \
        __builtin_amdgcn_global_load_lds((const unsigned*)((const char*)(gbase) + (voff)[_i]), (PG8_LAS unsigned*)(lds + (bufoff) + ldsw + _i * 8192), 16, 0, 0); } while (0)
#define PG8_LDA(dst, b, h) do { _Pragma("unroll") for (int m = 0; m < 4; ++m) _Pragma("unroll") for (int k = 0; k < 2; ++k) dst[m][k] = *(const PG8_LAS bf16x8*)(lds + PG8_SA(b, h) + aoff + m * 2048 + k * 1024); } while (0)
#define PG8_LDB(dst, b, h) do { _Pragma("unroll") for (int n = 0; n < 2; ++n) _Pragma("unroll") for (int k = 0; k < 2; ++k) dst[n][k] = *(const PG8_LAS bf16x8*)(lds + PG8_SB(b, h) + boff + n * 2048 + k * 1024); } while (0)
#define PG8_MMA(ai, bj, At, Bt) do { __builtin_amdgcn_s_setprio(1); _Pragma("unroll") for (int m = 0; m < 4; ++m) _Pragma("unroll") for (int n = 0; n < 2; ++n) _Pragma("unroll") for (int k = 0; k < 2; ++k) \
        acc[ai][bj][m][n] = __builtin_amdgcn_mfma_f32_16x16x32_bf16(Bt[n][k], At[m][k], acc[ai][bj][m][n], 0, 0, 0); __builtin_amdgcn_s_setprio(0); } while (0)
#define PG8_WAIT_V(n) asm volatile("s_waitcnt vmcnt(" #n ")" ::: "memory")
#define PG8_WAIT_L(n) asm volatile("s_waitcnt lgkmcnt(" #n ")" ::: "memory")
#define PG8_BAR __builtin_amdgcn_s_barrier()
#define PG8_SCHED __builtin_amdgcn_sched_barrier(0)
    unsigned gcu[2][2] = {{0u, 0u}, {0u, 0u}}, gnx[2][2] = {{0u, 0u}, {0u, 0u}};
#define PG8_GOFF(dst, u) do { int t_ = tid; asm volatile("" : "+v"(t_));   \
        _Pragma("unroll") for (int _h = 0; _h < 2; ++_h) _Pragma("unroll") for (int _i = 0; _i < 2; ++_i) { int R_, C_; stage_rc(t_ * 16 + _i * 8192, R_, C_); \
        dst[_h][_i] = (unsigned)((g.gidx[(u).pm * BM + _h * HALF + R_] & 16383) * lda + C_) * 2u; } } while (0)
#define PG8_STAGE_A(bufoff, gbase, H, NEXT) do { if constexpr (GATHER) { if (NEXT) PG8_STAGE(bufoff, gbase, gnx[H]); else PG8_STAGE(bufoff, gbase, gcu[H]); } else { PG8_STAGE(bufoff, (gbase) + ((H) ? hstepA : 0), voffA); } } while (0)
    Unit cur, nxt; int ui = 0;
    if (!S.next(0, cur)) return;
    f32x4 acc[2][2][4][2];
#pragma unroll
    for (int a = 0; a < 2; ++a)
#pragma unroll
        for (int b = 0; b < 2; ++b)
#pragma unroll
            for (int m = 0; m < 4; ++m)
#pragma unroll
                for (int n = 0; n < 2; ++n) acc[a][b][m][n] = (f32x4){0.f, 0.f, 0.f, 0.f};
    bf16x8 At[4][2], B0[2][2], B1[2][2];
    if constexpr (GATHER) PG8_GOFF(gcu, cur);
    const char* cA = GATHER ? (const char*)g.A : (const char*)g.A + (size_t)cur.pm * tstepA + cur.aofs; const char* cB = (const char*)g.Bt + (size_t)cur.pn * tstep;
    S.a_ready(cur);
    if constexpr (SP2) {
        PG8_STAGE(PG8_SB(0, 0), cB, voffB); PG8_STAGE(PG8_SB(0, 1), cB + hstep, voffB); PG8_STAGE_A(PG8_SA(0, 0), cA, 0, false); PG8_STAGE_A(PG8_SA(0, 1), cA, 1, false);
        if (wr == 1) PG8_BAR;
        PG8_WAIT_V(2); PG8_BAR;
        PG8_STAGE(PG8_SB(1, 0), cB + kstep, voffB); PG8_STAGE_A(PG8_SA(1, 0), cA + kstepA, 0, false); PG8_STAGE(PG8_SB(1, 1), cB + hstep + kstep, voffB);
        PG8_WAIT_V(6); PG8_BAR;
    } else {
        PG8_STAGE(PG8_SB(0, 0), cB, voffB); PG8_STAGE(PG8_SA(0, 0), cA, voffA); PG8_STAGE(PG8_SB(0, 1), cB + hstep, voffB); PG8_STAGE(PG8_SA(0, 1), cA + hstepA, voffA);
        if (wr == 1) PG8_BAR;
        PG8_WAIT_V(4); PG8_BAR;
        PG8_STAGE(PG8_SB(1, 0), cB + kstep, voffB); PG8_STAGE(PG8_SA(1, 0), cA + kstepA, voffA); PG8_STAGE(PG8_SB(1, 1), cB + hstep + kstep, voffB);
        PG8_WAIT_V(6); PG8_BAR;
    }
    for (;;) {
        const bool has_next = S.next(ui + 1, nxt);
        const char* nA = GATHER ? cA : (has_next ? (const char*)g.A + (size_t)nxt.pm * tstepA + nxt.aofs : cA); const char* nB = has_next ? (const char*)g.Bt + (size_t)nxt.pn * tstep : cB;
        for (int t = 0; t < nt; t += 2) {
            const bool last = (t == nt - 2);
            const char* a1 = cA + (size_t)(t + 1) * kstepA;
            const char* a2 = last ? nA : cA + (size_t)(t + 2) * kstepA; const char* b2 = last ? nB : cB + (size_t)(t + 2) * kstep;
            const char* a3 = a2 + kstepA; const char* b3 = b2 + kstep;
            if (last && has_next) S.a_ready(nxt);
            if constexpr (GATHER) { if (t == (nt >= 4 ? nt - 4 : 0)) { if (has_next) PG8_GOFF(gnx, nxt); else { gnx[0][0] = gcu[0][0]; gnx[0][1] = gcu[0][1]; gnx[1][0] = gcu[1][0]; gnx[1][1] = gcu[1][1]; } } }
            if constexpr (SP2) {
            PG8_LDB(B0, 0, 0); PG8_LDB(B1, 0, 1); PG8_SCHED; PG8_LDA(At, 0, 0); PG8_STAGE_A(PG8_SA(1, 1), a1, 1, false);
            PG8_WAIT_V(8); PG8_WAIT_L(0); PG8_BAR; PG8_MMA(0, 0, At, B0); PG8_MMA(0, 1, At, B1); PG8_BAR; PG8_SCHED;
            PG8_LDA(At, 0, 1); PG8_STAGE(PG8_SB(0, 0), b2, voffB); PG8_STAGE(PG8_SB(0, 1), b2 + hstep, voffB); PG8_STAGE_A(PG8_SA(0, 0), a2, 0, last);
            PG8_WAIT_V(8); PG8_WAIT_L(0); PG8_BAR; PG8_MMA(1, 0, At, B0); PG8_MMA(1, 1, At, B1); PG8_BAR; PG8_SCHED;
            PG8_LDB(B0, 1, 0); PG8_LDB(B1, 1, 1); PG8_SCHED; PG8_LDA(At, 1, 0); PG8_STAGE_A(PG8_SA(0, 1), a2, 1, last);
            PG8_WAIT_V(8); PG8_WAIT_L(0); PG8_BAR; PG8_MMA(0, 0, At, B0); PG8_MMA(0, 1, At, B1); PG8_BAR; PG8_SCHED;
            PG8_LDA(At, 1, 1); PG8_STAGE(PG8_SB(1, 0), b3, voffB); PG8_STAGE(PG8_SB(1, 1), b3 + hstep, voffB); PG8_STAGE_A(PG8_SA(1, 0), a3, 0, last);
            PG8_WAIT_V(8); PG8_WAIT_L(0); PG8_BAR; PG8_MMA(1, 0, At, B0); PG8_MMA(1, 1, At, B1); PG8_BAR; PG8_SCHED;
            } else {
            PG8_LDB(B0, 0, 0); PG8_SCHED; PG8_LDA(At, 0, 0); PG8_STAGE(PG8_SA(1, 1), a1 + hstepA, voffA);
            PG8_WAIT_L(8); PG8_BAR; PG8_WAIT_L(0); PG8_MMA(0, 0, At, B0); PG8_BAR; PG8_SCHED;
            PG8_LDB(B1, 0, 1); PG8_STAGE(PG8_SB(0, 0), b2, voffB);
            PG8_BAR; PG8_WAIT_L(0); PG8_MMA(0, 1, At, B1); PG8_BAR;
            PG8_LDA(At, 0, 1); PG8_STAGE(PG8_SA(0, 0), a2, voffA);
            PG8_BAR; PG8_WAIT_L(0); PG8_MMA(1, 0, At, B0); PG8_BAR; PG8_SCHED;
            PG8_STAGE(PG8_SB(0, 1), b2 + hstep, voffB);
            PG8_WAIT_V(6); PG8_BAR; PG8_MMA(1, 1, At, B1); PG8_BAR;
            PG8_LDB(B0, 1, 0); PG8_SCHED; PG8_LDA(At, 1, 0); PG8_STAGE(PG8_SA(0, 1), a2 + hstepA, voffA);
            PG8_WAIT_L(8); PG8_BAR; PG8_WAIT_L(0); PG8_MMA(0, 0, At, B0); PG8_BAR; PG8_SCHED;
            PG8_LDB(B1, 1, 1); PG8_STAGE(PG8_SB(1, 0), b3, voffB);
            PG8_BAR; PG8_WAIT_L(0); PG8_MMA(0, 1, At, B1); PG8_BAR;
            PG8_LDA(At, 1, 1); PG8_STAGE(PG8_SA(1, 0), a3, voffA);
            PG8_BAR; PG8_WAIT_L(0); PG8_MMA(1, 0, At, B0); PG8_BAR; PG8_SCHED;
            PG8_STAGE(PG8_SB(1, 1), b3 + hstep, voffB);
            PG8_WAIT_V(6); PG8_BAR; PG8_MMA(1, 1, At, B1); PG8_BAR;
            }
        }
        if constexpr (ALIGN_EPI) { if (wr == 0) PG8_BAR; }
        if constexpr (!Epi::AFTER_DRAIN) { E(acc, cur, wr, wc, fr, fq); S.done(cur); }
        if (!has_next) break;
#pragma unroll
        for (int a = 0; a < 2; ++a)
#pragma unroll
            for (int b = 0; b < 2; ++b)
#pragma unroll
                for (int m = 0; m < 4; ++m)
#pragma unroll
                    for (int n = 0; n < 2; ++n) acc[a][b][m][n] = (f32x4){0.f, 0.f, 0.f, 0.f};
        cur = nxt; cA = nA; cB = nB; ++ui;
        if constexpr (GATHER) { gcu[0][0] = gnx[0][0]; gcu[0][1] = gnx[0][1]; gcu[1][0] = gnx[1][0]; gcu[1][1] = gnx[1][1]; }
        if constexpr (ALIGN_EPI) { if (wr == 1) PG8_BAR; }
    }
    PG8_WAIT_V(0);
    if constexpr (!ALIGN_EPI) { if (wr == 0) PG8_BAR; }
    PG8_BAR;
    if constexpr (Epi::AFTER_DRAIN) { E.fused(acc, cur, wr, wc, fr, fq, lds, wid, lane); S.done(cur); }
#undef PG8_SA
#undef PG8_SB
#undef PG8_STAGE
#undef PG8_STAGE_A
#undef PG8_GOFF
#undef PG8_LDA
#undef PG8_LDB
#undef PG8_MMA
#undef PG8_WAIT_V
#undef PG8_WAIT_L
#undef PG8_BAR
#undef PG8_SCHED
}
}
#include <hip/hip_bf16.h>
#include <cmath>
namespace gattn {
using bf16=__hip_bfloat16;
using bf16x8=__attribute__((ext_vector_type(8)))short;
using s16x4=__attribute__((ext_vector_type(4)))short;
using f32x16=__attribute__((ext_vector_type(16)))float;
using u32x4=__attribute__((ext_vector_type(4)))unsigned;
constexpr int BATCH=2,NHEAD=16,SEQ=8192,D=64,DM=NHEAD*D;
constexpr int NW=8,QBLK=32,QB=QBLK*NW,KVBLK=64,NQB=SEQ/QB;
constexpr int ATTN_PITCH=DM, ATTN_UNIT_ROWS=QB;
__device__ __forceinline__ int crow(int r,int hi){return (r&3)+8*(r>>2)+4*hi;}
#define SBAR() __builtin_amdgcn_sched_barrier(0)
constexpr float NEGM=-60000.f;
__device__ __forceinline__ void emask(f32x16&p0,f32x16&p1,int kb,int lo,int hi_){
  #pragma unroll
  for(int r=0;r<16;++r){const int kv=kb+(r&3)+8*(r>>2); if(kv<lo||kv>hi_)p0[r]=NEGM; if(kv+32<lo||kv+32>hi_)p1[r]=NEGM;}
}

constexpr int NSLOT=3, SLOTB=8192;
constexpr int LDS_K=0, LDS_V=NSLOT*SLOTB, LDS_WS=2*NSLOT*SLOTB, LDS_OST=LDS_WS+NW*64*4, LDS_BT=LDS_OST+NW*4096, LDS_BYTES=LDS_BT+SEQ*4;
constexpr float C2=0.125f*1.4426950408889634f;
__device__ __forceinline__ void glds16(const void*gsrc,unsigned lds_dst){unsigned keep;
  asm volatile("s_mov_b32 %0, m0\n\ts_mov_b32 m0, %2\n\ts_nop 0\n\tglobal_load_lds_dwordx4 %1, off\n\ts_mov_b32 m0, %0":"=&s"(keep):"v"(gsrc),"s"(lds_dst):"memory");}
__device__ __forceinline__ float max3f(float a,float b,float c){float r;asm("v_max3_f32 %0, %1, %2, %3":"=v"(r):"v"(a),"v"(b),"v"(c));return r;}
__device__ __forceinline__ float max2f(float a,float b){float r;asm("v_max_f32_e32 %0, %1, %2":"=v"(r):"v"(a),"v"(b));return r;}
__device__ __forceinline__ float fadd_s(float a,float b){float r;asm("v_add_f32_e32 %0, %1, %2":"=v"(r):"v"(a),"v"(b));return r;}
__device__ __forceinline__ float fsub_s(float a,float b){float r;asm("v_sub_f32_e32 %0, %1, %2":"=v"(r):"v"(a),"v"(b));return r;}
typedef float f32x2_t __attribute__((ext_vector_type(2))); typedef __bf16 bf16x2_t __attribute__((ext_vector_type(2)));
__device__ __forceinline__ unsigned cvtpk_s(float lo,float hi){f32x2_t v={lo,hi};bf16x2_t b=__builtin_convertvector(v,bf16x2_t);return __builtin_bit_cast(unsigned,b);}
#define WAIT_BAR(N) asm volatile("s_waitcnt vmcnt(" #N ") lgkmcnt(0)\n\ts_barrier":::"memory")

typedef unsigned u32x2b __attribute__((ext_vector_type(2)));
__device__ __forceinline__ s16x4 bfrag(unsigned w){ u32x2b v={w,0u}; return __builtin_bit_cast(s16x4,v); }
#define BMFMA(a,b,c) __builtin_amdgcn_mfma_f32_32x32x8bf16_1k(a,b,c,0,0,0)
__device__ __forceinline__ void qkt(f32x16&p0,f32x16&p1,const char*Kslot,const bf16x8*qr,int r32,int hi){
  const char*kb=Kslot+hi*1024+r32*16;
  #pragma unroll
  for(int d0=0;d0<4;++d0){
    const bf16x8 b0=*reinterpret_cast<const bf16x8*>(kb+d0*2048);
    const bf16x8 b1=*reinterpret_cast<const bf16x8*>(kb+d0*2048+512);
    if(d0==0){const f32x16 z={};p0=__builtin_amdgcn_mfma_f32_32x32x16_bf16(b0,qr[0],z,0,0,0);p1=__builtin_amdgcn_mfma_f32_32x32x16_bf16(b1,qr[0],z,0,0,0);}
    else{p0=__builtin_amdgcn_mfma_f32_32x32x16_bf16(b0,qr[d0],p0,0,0,0);p1=__builtin_amdgcn_mfma_f32_32x32x16_bf16(b1,qr[d0],p1,0,0,0);}}
}
typedef __attribute__((address_space(3))) const char* lds_cptr;
typedef short v4i16_t __attribute__((ext_vector_type(4)));
__device__ __forceinline__ void kload8(bf16x8*kf,lds_cptr kp){
  kf[0]=*(const __attribute__((address_space(3))) bf16x8*)(kp);      kf[1]=*(const __attribute__((address_space(3))) bf16x8*)(kp+512);
  kf[2]=*(const __attribute__((address_space(3))) bf16x8*)(kp+2048); kf[3]=*(const __attribute__((address_space(3))) bf16x8*)(kp+2560);
  kf[4]=*(const __attribute__((address_space(3))) bf16x8*)(kp+4096); kf[5]=*(const __attribute__((address_space(3))) bf16x8*)(kp+4608);
  kf[6]=*(const __attribute__((address_space(3))) bf16x8*)(kp+6144); kf[7]=*(const __attribute__((address_space(3))) bf16x8*)(kp+6656);
}
__device__ __forceinline__ void kload2(bf16x8*kf,lds_cptr kp,int j){ kf[2*j]=*(const __attribute__((address_space(3))) bf16x8*)(kp+j*2048); kf[2*j+1]=*(const __attribute__((address_space(3))) bf16x8*)(kp+j*2048+512); }
__device__ __forceinline__ s16x4 vtr(lds_cptr p){ return __builtin_bit_cast(s16x4,__builtin_amdgcn_ds_read_tr16_b64_v4i16((__attribute__((address_space(3))) v4i16_t*)p)); }
__device__ __forceinline__ float rowmax(const f32x16&p0,const f32x16&p1){
  float a=max3f(p0[0],p0[1],p1[0]),b=max3f(p0[2],p0[3],p1[1]);a=max3f(a,p1[2],p1[3]);
  #pragma unroll
  for(int r=4;r<16;r+=4){a=max3f(a,p0[r],p0[r+1]);b=max3f(b,p0[r+2],p0[r+3]);a=max3f(a,p1[r],p1[r+1]);b=max3f(b,p1[r+2],p1[r+3]);}
  const float m=max2f(a,b);
  auto rr=__builtin_amdgcn_permlane32_swap(__float_as_uint(m),__float_as_uint(m),false,false);
  return max2f(__uint_as_float(rr[0]),__uint_as_float(rr[1]));
}
__device__ __forceinline__ void pv(f32x16*o,int vb,bf16x8 pa0,bf16x8 pa1,bf16x8 pa2,bf16x8 pa3){
  #pragma unroll
  for(int d0=0;d0<2;++d0){s16x4 lo[4],hi[4];
    #pragma unroll
    for(int ks=0;ks<4;++ks){
      asm volatile("ds_read_b64_tr_b16 %0,%1 offset:%c2":"=&v"(lo[ks]):"v"(vb),"i"(d0*4096+ks*1024):"memory");
      asm volatile("ds_read_b64_tr_b16 %0,%1 offset:%c2":"=&v"(hi[ks]):"v"(vb),"i"(d0*4096+ks*1024+512):"memory");}
    asm volatile("s_waitcnt lgkmcnt(0)":::"memory");SBAR();
    #define PK(k) (bf16x8){lo[k][0],lo[k][1],lo[k][2],lo[k][3],hi[k][0],hi[k][1],hi[k][2],hi[k][3]}
    o[d0]=__builtin_amdgcn_mfma_f32_32x32x16_bf16(pa0,PK(0),o[d0],0,0,0);
    o[d0]=__builtin_amdgcn_mfma_f32_32x32x16_bf16(pa1,PK(1),o[d0],0,0,0);
    o[d0]=__builtin_amdgcn_mfma_f32_32x32x16_bf16(pa2,PK(2),o[d0],0,0,0);
    o[d0]=__builtin_amdgcn_mfma_f32_32x32x16_bf16(pa3,PK(3),o[d0],0,0,0);
    #undef PK
  }
}

#ifndef ATTN_STORE16
#define ATTN_STORE16(p,v) (*(u32x4*)(p)=(v))
#endif
template<int THRL,bool HAS_BIAS,int OMODE,int ORS,class U> __device__ __forceinline__ void gunit(char*shm,const U&un){
  int tid_o=threadIdx.x; asm volatile("":"+v"(tid_o)); const int tid=tid_o,lane=tid&63,r32=lane&31,hi=lane>>5; const int wid=__builtin_amdgcn_readfirstlane(tid>>6);
  const int kpitch=un.kpitch;
  const bf16*Qw=un.qrow(wid,r32);
  const bf16*Kh=un.Kb,*Vh=un.Vb;
  const unsigned lds0=(unsigned)(uintptr_t)shm;
  float*wsf=(float*)(shm+LDS_WS)+wid*64;
  const bf16*ksrc=Kh+(long)lane*kpitch+wid*8;
  const bf16*vsrc=Vh+(long)(16*(wid&3)+(lane>>2))*kpitch+(wid>>2)*32+(lane&3)*8;
  const unsigned kdst=lds0+LDS_K+wid*1024, vdst=lds0+LDS_V+wid*1024;
  #define TABS(t) min(max(un.t0+(t),0),un.tmax)
  #define DMA_K(t,slot) glds16(ksrc+(long)TABS(t)*KVBLK*kpitch,(unsigned)__builtin_amdgcn_readfirstlane(kdst+(slot)))
  #define DMA_V(t,slot) glds16(vsrc+(long)TABS(t)*KVBLK*kpitch,(unsigned)__builtin_amdgcn_readfirstlane(vdst+(slot)))
  const int vb0=(int)(lds0+LDS_V)+((lane>>4)&1)*32+(lane&3)*8+(4*hi+((lane&15)>>2))*64;
  const char*Kbase=shm+LDS_K; bf16x8 kf[8];
  const lds_cptr shm3=(lds_cptr)shm; const lds_cptr kp0=shm3+LDS_K+hi*1024+r32*16; const lds_cptr vp0=shm3+LDS_V+((lane>>4)&1)*32+(lane&3)*8+(4*hi+((lane&15)>>2))*64;
  const int NT=un.NT;
  typedef __attribute__((address_space(3))) unsigned lds_u32;
  lds_u32* const btab=(lds_u32*)(shm3+LDS_BT);
  if(HAS_BIAS){ const float*cum=un.cum; const float cq0=cum[un.q0]; const float*cumt=cum+(long)un.t0*KVBLK; for(int k=tid;k<NT*KVBLK;k+=NW*64){ const float be=(cq0-cumt[k])*1.4426950408889634f; unsigned ub=__builtin_bit_cast(unsigned,be); const unsigned hb=(ub+0x7fffu+((ub>>16)&1u))>>16;
      const float rl=be-__builtin_bit_cast(float,hb<<16); unsigned ul=__builtin_bit_cast(unsigned,rl); const unsigned lb=(ul+0x7fffu+((ul>>16)&1u))>>16; btab[k]=hb|(lb<<16); } }
  int bto=0;
  #define BIAS_MFMA(C0,C1) do{ unsigned ln_; asm volatile("v_mbcnt_lo_u32_b32 %0, -1, 0\n\tv_mbcnt_hi_u32_b32 %0, -1, %0":"=v"(ln_)); const bool up_=ln_>=32u; \
      unsigned w0_=0u, w1_=0u; if(HAS_BIAS){ const lds_u32* bp_=btab+bto+(ln_&31u); w0_=bp_[0]; w1_=bp_[32]; } \
      const unsigned tm_=un.term(wid,(int)(ln_&31u),un.t0+(bto>>6)); \
      u32x2b a0_, a1_, q_; a0_.x=up_?0x3F803F80u:w0_; a0_.y=up_?0u:0x3F803F80u; a1_.x=up_?0x3F803F80u:w1_; a1_.y=a0_.y; q_.x=qm0|(up_?(tm_<<16):0u); q_.y=qm1; \
      C0=BMFMA(__builtin_bit_cast(s16x4,a0_),__builtin_bit_cast(s16x4,q_),C0); C1=BMFMA(__builtin_bit_cast(s16x4,a1_),__builtin_bit_cast(s16x4,q_),C1); }while(0)
  DMA_K(0,0);DMA_V(0,0);DMA_K(1,SLOTB);
  bf16x8 qr[4];
  #pragma unroll
  for(int d0=0;d0<4;++d0)qr[d0]=*reinterpret_cast<const bf16x8*>(&Qw[d0*16+hi*8]);
  float mhat=0.f,l_reg=0.f;f32x16 o[2];o[0]=f32x16{};o[1]=f32x16{};unsigned qm0=hi?0u:0x3F803F80u,qm1=0u;
  #define UPDQM() do{ const float nm_=-mhat; const unsigned u0_=__builtin_bit_cast(unsigned,nm_); const unsigned h_=(u0_+0x7fffu+((u0_>>16)&1u))>>16; const float r1_=nm_-__builtin_bit_cast(float,h_<<16); \
      const unsigned u1_=__builtin_bit_cast(unsigned,r1_); const unsigned m_=(u1_+0x7fffu+((u1_>>16)&1u))>>16; const float r2_=r1_-__builtin_bit_cast(float,m_<<16); const unsigned l_=__builtin_bit_cast(unsigned,r2_)>>16; \
      qm0=hi?l_:0x3F803F80u; qm1=hi?0u:(h_|(m_<<16)); }while(0)
  const int klo=un.klo(wid,r32),khi=un.khi(wid,r32);
  #define CMASK(P0,P1,t) do{ if((t)==0||(t)>=NT-4) emask(P0,P1,(un.t0+(t))*KVBLK+4*hi,klo,khi); }while(0)
  bool resc=false;
  #define START(P0,P1) do{ const float rm=rowmax(P0,P1); resc=false; \
    { const float dl=rm; mhat=fadd_s(mhat,dl); \
      _Pragma("unroll") for(int r=0;r<16;++r){P0[r]=fsub_s(P0[r],dl);P1[r]=fsub_s(P1[r],dl);} \
      UPDQM(); } \
    _Pragma("unroll") for(int r=0;r<16;++r)P0[r]=__builtin_amdgcn_exp2f(P0[r]); }while(0)
  #define RESC() do{ if(resc){ asm volatile("s_waitcnt lgkmcnt(0)":::"memory"); \
      _Pragma("unroll") for(int d_=0;d_<2;++d_) _Pragma("unroll") for(int r=0;r<16;++r)o[d_][r]*=wsf[crow(r,hi)]; } }while(0)
  f32x16 pA0,pA1,pB0,pB1;
  int sl_prev=0,sl_cur=0,sl_next=SLOTB;
  #define ROT() do{sl_prev=sl_cur;sl_cur=sl_next;sl_next=(sl_next==(NSLOT-1)*SLOTB)?0:sl_next+SLOTB;bto+=KVBLK;}while(0)
  DMA_K(2,2*SLOTB);
  WAIT_BAR(3);
  qkt(pA0,pA1,Kbase,qr,r32,hi);BIAS_MFMA(pA0,pA1);asm volatile("s_nop 15\n\ts_nop 7":"+v"(pA0),"+v"(pA1));CMASK(pA0,pA1,0);
  START(pA0,pA1);
  _Pragma("unroll") for(int r=0;r<16;++r)pA1[r]=__builtin_amdgcn_exp2f(pA1[r]);
  WAIT_BAR(0);
  DMA_K(3,0);DMA_V(1,SLOTB);
  ROT();
  kload8(kf,kp0+sl_cur);
  WAIT_BAR(2);
  s16x4 vlo[8],vhi[8]; u32x4 pw0,pw1,pw2,pw3;
  #define PKW(P,B) cvtpk_s(P[B],P[B+1])
  #define PAF(k) __builtin_bit_cast(bf16x8,pw##k)
  #define VFR(i) (bf16x8){vlo[i][0],vlo[i][1],vlo[i][2],vlo[i][3],vhi[i][0],vhi[i][1],vhi[i][2],vhi[i][3]}
  #define PIN(x) asm volatile("":"+v"(x))
  #define MX3(a,b,c) __builtin_fmaxf(__builtin_fmaxf((a),(b)),(c))
  #define GAPA(MF,A0,A1,A2,A3,W0,W1,PW) do{ MF; sacc+=A0; sacc+=A1; sacc+=A2; sacc+=A3; PIN(sacc); W0; W1; PIN(PW); SBAR(); }while(0)
  #define EX(v) __builtin_amdgcn_exp2f(v)
  #define GAPB(MF,X,B) do{ MF; X[B]=EX(X[B]); X[B+1]=EX(X[B+1]); X[B+2]=EX(X[B+2]); X[B+3]=EX(X[B+3]); PIN(X); SBAR(); }while(0)
  #define VRD(i) do{ vlo[i]=vtr(vp_+(((i)>>2)*4096+((i)&3)*1024)); vhi[i]=vtr(vp_+(((i)>>2)*4096+((i)&3)*1024+512)); }while(0)
  #define KRD(G,j) do{ if(G){ kload2(kf,kp0+sl_next,j); SBAR(); } }while(0)
  #define STEP(C0,C1,P0,P1,t,GK,GV,GL) do{ SBAR(); \
    const lds_cptr vp_=vp0+sl_prev; \
    VRD(0); SBAR(); float sacc=(P0[0]+P0[1]); \
    GAPA(C0=__builtin_amdgcn_mfma_f32_32x32x16_bf16(kf[0],qr[0],(f32x16){},0,0,0), P0[2],P0[3],P0[4],P0[5],     pw0[0]=PKW(P0,0), pw0[1]=PKW(P0,2), pw0); \
    VRD(4); SBAR(); GAPA(C1=__builtin_amdgcn_mfma_f32_32x32x16_bf16(kf[1],qr[0],(f32x16){},0,0,0), P0[6],P0[7],P0[8],P0[9],     pw0[2]=PKW(P0,4), pw0[3]=PKW(P0,6), pw0); \
    VRD(1); SBAR(); GAPA(C0=__builtin_amdgcn_mfma_f32_32x32x16_bf16(kf[2],qr[1],C0,0,0,0),   P0[10],P0[11],P0[12],P0[13], pw1[0]=PKW(P0,8), pw1[1]=PKW(P0,10), pw1); \
    VRD(5); SBAR(); GAPA(C1=__builtin_amdgcn_mfma_f32_32x32x16_bf16(kf[3],qr[1],C1,0,0,0),   P0[14],P0[15],P1[0],P1[1],   pw1[2]=PKW(P0,12),pw1[3]=PKW(P0,14), pw1); \
    VRD(2); SBAR(); GAPA(C0=__builtin_amdgcn_mfma_f32_32x32x16_bf16(kf[4],qr[2],C0,0,0,0),   P1[2],P1[3],P1[4],P1[5],     pw2[0]=PKW(P1,0), pw2[1]=PKW(P1,2), pw2); \
    VRD(6); SBAR(); GAPA(C1=__builtin_amdgcn_mfma_f32_32x32x16_bf16(kf[5],qr[2],C1,0,0,0),   P1[6],P1[7],P1[8],P1[9],     pw2[2]=PKW(P1,4), pw2[3]=PKW(P1,6), pw2); \
    VRD(3); SBAR(); GAPA(C0=__builtin_amdgcn_mfma_f32_32x32x16_bf16(kf[6],qr[3],C0,0,0,0),   P1[10],P1[11],P1[12],P1[13], pw3[0]=PKW(P1,8), pw3[1]=PKW(P1,10), pw3); \
    VRD(7); SBAR(); GAPA(C1=__builtin_amdgcn_mfma_f32_32x32x16_bf16(kf[7],qr[3],C1,0,0,0),   P1[14],P1[15],0.f,0.f,       pw3[2]=PKW(P1,12),pw3[3]=PKW(P1,14), pw3); \
    BIAS_MFMA(C0,C1); \
    l_reg+=sacc; \
    if(GK){DMA_K((t)+3,sl_cur);} if(GV){DMA_V((t)+1,sl_next);} \
    CMASK(C0,C1,t); \
    { float a=MX3(C0[0],C0[1],C1[0]),b=MX3(C0[2],C0[3],C1[1]); a=MX3(a,C1[2],C1[3]); \
      _Pragma("unroll") for(int r=4;r<16;r+=4){a=MX3(a,C0[r],C0[r+1]);b=MX3(b,C0[r+2],C0[r+3]);a=MX3(a,C1[r],C1[r+1]);b=MX3(b,C1[r+2],C1[r+3]);} \
      float rm=__builtin_fmaxf(a,b); { auto rr=__builtin_amdgcn_permlane32_swap(__float_as_uint(rm),__float_as_uint(rm),false,false); rm=__builtin_fmaxf(__uint_as_float(rr[0]),__uint_as_float(rr[1])); } \
      resc=false; \
      if(__builtin_expect(__any(rm>(float)THRL),0)){ const float dl=__builtin_fmaxf(rm,0.f); mhat+=dl; \
        _Pragma("unroll") for(int r=0;r<16;++r){C0[r]-=dl;C1[r]-=dl;} \
        UPDQM(); \
        const float f=__builtin_amdgcn_exp2f(-dl); l_reg*=f; if(hi==0)wsf[r32]=f; resc=true; } } \
    SBAR(); \
    GAPB(o[0]=__builtin_amdgcn_mfma_f32_32x32x16_bf16(PAF(0),VFR(0),o[0],0,0,0), C0,0); \
    GAPB(o[1]=__builtin_amdgcn_mfma_f32_32x32x16_bf16(PAF(0),VFR(4),o[1],0,0,0), C0,4); \
    KRD(GL,0); GAPB(o[0]=__builtin_amdgcn_mfma_f32_32x32x16_bf16(PAF(1),VFR(1),o[0],0,0,0), C0,8); \
    KRD(GL,1); GAPB(o[1]=__builtin_amdgcn_mfma_f32_32x32x16_bf16(PAF(1),VFR(5),o[1],0,0,0), C0,12); \
    KRD(GL,2); GAPB(o[0]=__builtin_amdgcn_mfma_f32_32x32x16_bf16(PAF(2),VFR(2),o[0],0,0,0), C1,0); \
    KRD(GL,3); GAPB(o[1]=__builtin_amdgcn_mfma_f32_32x32x16_bf16(PAF(2),VFR(6),o[1],0,0,0), C1,4); \
    GAPB(o[0]=__builtin_amdgcn_mfma_f32_32x32x16_bf16(PAF(3),VFR(3),o[0],0,0,0), C1,8); \
    GAPB(o[1]=__builtin_amdgcn_mfma_f32_32x32x16_bf16(PAF(3),VFR(7),o[1],0,0,0), C1,12); \
    }while(0)
  int t=1;
  #undef CMASK
  #define CMASK(P0,P1,t) do{}while(0)
  for(;t+5<NT;t+=2){
    STEP(pB0,pB1,pA0,pA1,t,true,true,true);     WAIT_BAR(2); RESC(); ROT();
    STEP(pA0,pA1,pB0,pB1,t+1,true,true,true);   WAIT_BAR(2); RESC(); ROT();
  }
  #undef CMASK
  #define CMASK(P0,P1,t) do{ if((t)>=NT-4) emask(P0,P1,(un.t0+(t))*KVBLK+4*hi,klo,khi); }while(0)
  #define ENDW(tt) do{ if((tt)+3<NT){WAIT_BAR(2);} else if((tt)+2<NT){WAIT_BAR(1);} else {WAIT_BAR(0);} }while(0)
  for(;t+1<NT;t+=2){
    STEP(pB0,pB1,pA0,pA1,t,(t+3<NT),(t+1<NT),(t+1<NT));       ENDW(t);   RESC(); ROT();
    STEP(pA0,pA1,pB0,pB1,t+1,(t+4<NT),(t+2<NT),(t+2<NT));     ENDW(t+1); RESC(); ROT();
  }
  STEP(pB0,pB1,pA0,pA1,NT-1,false,false,false); RESC();
  { float sacc=pB0[0]+pB0[1]; _Pragma("unroll") for(int r=2;r<16;++r)sacc+=pB0[r]; _Pragma("unroll") for(int r=0;r<16;++r)sacc+=pB1[r]; l_reg+=sacc;
    pw0=(u32x4){PKW(pB0,0),PKW(pB0,2),PKW(pB0,4),PKW(pB0,6)};pw1=(u32x4){PKW(pB0,8),PKW(pB0,10),PKW(pB0,12),PKW(pB0,14)};pw2=(u32x4){PKW(pB1,0),PKW(pB1,2),PKW(pB1,4),PKW(pB1,6)};pw3=(u32x4){PKW(pB1,8),PKW(pB1,10),PKW(pB1,12),PKW(pB1,14)};
    SBAR(); pv(o,vb0+sl_cur,PAF(0),PAF(1),PAF(2),PAF(3)); }
  #undef PKW
  #undef PAF
  #undef VFR
  #undef PIN
  #undef MX3
  #undef GAPA
  #undef GAPB
  #undef EX
  #undef VRD
  #undef KRD
  #undef STEP
  #undef ENDW
  {auto rr=__builtin_amdgcn_permlane32_swap(__float_as_uint(l_reg),__float_as_uint(l_reg),false,false);l_reg=__uint_as_float(rr[0])+__uint_as_float(rr[1]);}
  if(hi==0)wsf[32+r32]=un.colscale(wid,r32)*__builtin_amdgcn_rcpf(l_reg);asm volatile("s_waitcnt lgkmcnt(0)":::"memory");
  float rli[16];
  #pragma unroll
  for(int r=0;r<16;++r)rli[r]=wsf[32+crow(r,hi)];
  bf16*Ow=un.Ob+(long)wid*un.owstride;
  { bf16*stg=(bf16*)(shm+LDS_OST)+wid*2048;
    #pragma unroll
    for(int r=0;r<16;++r){const int orow=crow(r,hi);
      #pragma unroll
      for(int d0=0;d0<2;++d0){ float v_=o[d0][r]*rli[r]; if(OMODE>=2) v_+=__bfloat162float(stg[orow*64+d0*32+r32]); stg[orow*64+d0*32+r32]=__float2bfloat16(v_);} }
    asm volatile("s_waitcnt lgkmcnt(0)":::"memory");
    if(OMODE==0||OMODE==3){
    #pragma unroll
    for(int i=0;i<4;++i){const int row=i*8+(lane>>3),ch=lane&7; const u32x4 v=*(const u32x4*)(stg+row*64+ch*8); bf16*gp=Ow+(long)(row>>ORS)*DM+(row&((1<<ORS)-1))*D+ch*8;
      ATTN_STORE16(gp,v);} } }
  asm volatile("s_waitcnt lgkmcnt(0)\n\ts_barrier":::"memory");
  #undef DMA_K
  #undef TABS
  #undef BIAS_MFMA
  #undef UPDQM
  #undef DMA_V
  #undef CMASK
  #undef START
  #undef RESC
  #undef ROT
}
constexpr int ATTN_LDS_BYTES=LDS_BYTES;
#undef SBAR
#undef WAIT_BAR
}
#define GAS __attribute__((address_space(1)))
#define LAS __attribute__((address_space(3)))
typedef unsigned short bf16;
typedef unsigned v4u __attribute__((ext_vector_type(4)));
typedef float f32x4 __attribute__((ext_vector_type(4)));
typedef short bf16x8 __attribute__((ext_vector_type(8)));
typedef GAS unsigned gu32;
typedef GAS unsigned long long gu64;
#define RLX_AGENT __ATOMIC_RELAXED, __HIP_MEMORY_SCOPE_AGENT
#define LDS_WAIT() asm volatile("s_waitcnt lgkmcnt(0)" ::: "memory")
#define VM_WAIT() asm volatile("s_waitcnt vmcnt(0)" ::: "memory")
__device__ __forceinline__ unsigned long long rt() { return __builtin_amdgcn_s_memrealtime(); }
__device__ __forceinline__ unsigned f2bf(float f) { unsigned u = __builtin_bit_cast(unsigned, f); return (u + 0x7fffu + ((u >> 16) & 1u)) >> 16; }
__device__ __forceinline__ unsigned pk2(float lo, float hi) { return f2bf(lo) | (f2bf(hi) << 16); }

#define XB_TMO      128
#define XB_XCNT(j)  (256  + 64 * (j))
#define XB_XSUB(j)  (1280 + 64 * (j))
#define XB_XGEN(j)  (2304 + 64 * (j))
#define XB_TOP      3328
#define XB_TOPGEN   3392
#define XCD_BAR_WORDS 3456
#define XB_SPIN_CAP (1u << 25)

__device__ __forceinline__ unsigned xb_ld(unsigned* p)              { return __hip_atomic_load(p, __ATOMIC_RELAXED, __HIP_MEMORY_SCOPE_AGENT); }
__device__ __forceinline__ unsigned xb_add(unsigned* p, unsigned v) { return __hip_atomic_fetch_add(p, v, __ATOMIC_RELAXED, __HIP_MEMORY_SCOPE_AGENT); }
__device__ __forceinline__ unsigned xb_xcc_id() { return (unsigned)__builtin_amdgcn_s_getreg((3 << 11) | 20) & 0xFu; }
#define XB_SPIN(cond, bar) do { unsigned _sp = 0; while (cond) { __builtin_amdgcn_s_sleep(1); \
    if ((++_sp & 255u) == 0u) { if (xb_ld(&(bar)[XB_TMO])) break; if (_sp > XB_SPIN_CAP) { atomicAdd(&(bar)[XB_TMO], 1u); break; } } } } while (0)

struct XcdBarrier {
    unsigned* bar; unsigned x;
    volatile LAS unsigned* st;
};

__device__ __forceinline__ XcdBarrier xcd_barrier_post(unsigned* bar, volatile LAS unsigned* st) {
    XcdBarrier b; b.bar = bar; b.x = xb_xcc_id(); b.st = st;
    if (threadIdx.x == 0) (void)xb_add(&bar[XB_XCNT(b.x)], 1u);
    return b;
}
__device__ __forceinline__ void xcd_barrier_complete(unsigned* bar, unsigned x, unsigned& nloc, unsigned& nx) {
    const unsigned G = gridDim.x * gridDim.y * gridDim.z;
    unsigned sum, cnt, mine, sp = 0u;
    for (;;) {
        sum = 0u; cnt = 0u; mine = 0u;
#pragma unroll
        for (unsigned j = 0; j < 16; ++j) { const unsigned c = xb_ld(&bar[XB_XCNT(j)]); sum += c; cnt += (c > 0u) ? 1u : 0u; mine = (j == x) ? c : mine; }
        if (sum == G) break;
        __builtin_amdgcn_s_sleep(1);
        if ((++sp & 255u) == 0u) { if (xb_ld(&bar[XB_TMO])) break; if (sp > XB_SPIN_CAP) { atomicAdd(&bar[XB_TMO], 1u); break; } }
    }
    nloc = mine > 0u ? mine : 1u; nx = cnt > 0u ? cnt : 1u;
}

__device__ __forceinline__ void xcd_barrier(const XcdBarrier& b) {
    asm volatile("s_waitcnt vmcnt(0)" ::: "memory");
    __syncthreads();
    if (threadIdx.x == 0) {
        unsigned* bar = b.bar;
        __builtin_amdgcn_s_waitcnt(0);
        unsigned nloc = b.st[0], nx = b.st[1];
        if (nloc == 0u) { xcd_barrier_complete(bar, b.x, nloc, nx); b.st[0] = nloc; b.st[1] = nx; }
        const unsigned old = xb_add(&bar[XB_XSUB(b.x)], 1u);
        const unsigned gen = old / nloc;
        if (old + 1u == (gen + 1u) * nloc) {
            __builtin_amdgcn_fence(__ATOMIC_RELEASE, "agent");
            asm volatile("s_waitcnt vmcnt(0)" ::: "memory");
            const unsigned og = xb_add(&bar[XB_TOP], 1u);
            const unsigned tg = og / nx;
            if (og + 1u == (tg + 1u) * nx) xb_add(&bar[XB_TOPGEN], 1u);
            else XB_SPIN(xb_ld(&bar[XB_TOPGEN]) == tg, bar);
            __builtin_amdgcn_fence(__ATOMIC_ACQUIRE, "agent");
            xb_add(&bar[XB_XGEN(b.x)], 1u);
            asm volatile("s_waitcnt vmcnt(0)" ::: "memory");
        } else {
            XB_SPIN(xb_ld(&bar[XB_XGEN(b.x)]) == gen, bar);
            __builtin_amdgcn_fence(__ATOMIC_ACQUIRE, "agent");
            asm volatile("s_waitcnt vmcnt(0)" ::: "memory");
        }
    }
    __syncthreads();
}
#include <type_traits>
#ifndef PH_MASK
#define PH_MASK 0xFFFF
#endif
#define PH_EN(n) ((PH_MASK >> (n)) & 1)
#ifndef TIME_LSEL
#define TIME_LSEL -1
#endif
#ifndef TIME_LSEL2
#define TIME_LSEL2 TIME_LSEL
#endif
#ifndef TIME_MUL
#define TIME_MUL 1.f
#endif
#ifndef MK_MULTI
#define MK_MULTI 0
#endif
constexpr int NWAVES = 8, NTHR = 512;
constexpr int Bn = 2, S = 8192, T = Bn * S, D = 1024, NH = 16, HD = 64, DEPTH = 4;
constexpr int NE = 64, ED = 256, TOPK = 8, PLE = 256;
constexpr int NSA_G = 4, NCMP = 512;
constexpr float LN_EPS = 1e-5f, NEGF = -1e30f;
constexpr float DN_ALPHA = 1.681792830507429f;
constexpr float ATT_SCALE = 0.125f, QSC = 0.6931471805599453f;
constexpr int NPH = 13;

constexpr size_t MiB = 1u << 20;
constexpr size_t WS_CTL = 0, CTL_ZERO_BYTES = 1 * MiB;
constexpr size_t WS_ROPE_C = 2 * MiB, WS_ROPE_S = 4 * MiB;
constexpr size_t WS_LOGF = 6 * MiB, WS_CUM = 7 * MiB;
constexpr size_t WS_GATES = 8 * MiB;
constexpr size_t WS_KMEAN = 11 * MiB;
constexpr size_t WS_KCMP = 12 * MiB, WS_VCMP = 13 * MiB;
constexpr size_t WS_VCT = 13 * MiB + 512 * 1024;
constexpr size_t WS_PEB = 11 * MiB + 512 * 1024;
constexpr size_t WS_WRT = 11 * MiB + 768 * 1024;
constexpr size_t WS_H1 = 20 * MiB;
constexpr size_t WS_WC1 = 278 * MiB;
constexpr size_t WS_ROWTOK = 24 * MiB;
constexpr size_t WS_LS32 = 18 * MiB + 512 * 1024;
constexpr size_t WS_SELMG = 18 * MiB;
constexpr size_t WS_TOKE = 14 * MiB, WS_TOKW = 15 * MiB, WS_TOKP = 16 * MiB;
constexpr size_t WS_ROWW = 17 * MiB;
constexpr size_t WS_X = 32 * MiB;
constexpr size_t WS_XBA = 96 * MiB, WS_XBB = 128 * MiB;
constexpr size_t WS_WIN = 160 * MiB, WS_WOUT = 166 * MiB, WS_WGU = 168 * MiB, WS_WDN = 233 * MiB, WS_WPG = 266 * MiB, WS_WPP = 268 * MiB;
constexpr size_t WS_PB = 270 * MiB;
constexpr size_t WS_Q = 280 * MiB, WS_K = 312 * MiB, WS_V = 344 * MiB;
constexpr size_t WS_AO = 376 * MiB;
constexpr size_t WS_PP = 408 * MiB;
constexpr size_t WS_QR = 504 * MiB;
constexpr size_t WS_H = 280 * MiB;
constexpr size_t WS_XG = 440 * MiB;
constexpr size_t WS_OUTR = 440 * MiB;
constexpr size_t WS_SET1 = 600 * MiB;
constexpr size_t WS_PEB1 = 11 * MiB + 512 * 1024 + 4096, WS_WRT1 = 11 * MiB + 256 * 1024;
constexpr size_t WS_END = 880 * MiB;
constexpr int R_PAD_TILES = 576, XG_TILE0 = (int)((WS_XG - WS_XBA) / (256 * 1024 * 2));
static_assert((WS_XG - WS_XBA) % (256 * 1024 * 2) == 0, "XG tile alignment");
constexpr int CW_TMO = 0, CW_CODE = 1, CW_BAR = 4096, CW_CNT = 16384  , CW_CHK = 9216, CW_TS = 10240, CW_NRM = 12288, CW_Q = 12800;

constexpr int RING_BYTES = 131072, TAB_OFF = RING_BYTES, MISC_OFF = RING_BYTES + 9216, LDS_BYTES = 147456;

typedef unsigned short bf16_t;
__device__ __forceinline__ float bf2f(unsigned short h) { return __uint_as_float(((unsigned)h) << 16); }
__device__ __forceinline__ float bflo(unsigned u) { return __uint_as_float(u << 16); }
__device__ __forceinline__ float bfhi(unsigned u) { return __uint_as_float(u & 0xffff0000u); }
template <int O> __device__ __forceinline__ float xor_f(float v) { return __int_as_float(__builtin_amdgcn_ds_swizzle(__float_as_int(v), 0x1F | (O << 10))); }
template <int O> __device__ __forceinline__ int xor_i(int v) { return __builtin_amdgcn_ds_swizzle(v, 0x1F | (O << 10)); }
__device__ __forceinline__ float bcast_f(float v, int srclane) { return __int_as_float(__builtin_amdgcn_readlane(__float_as_int(v), srclane)); }
__device__ __forceinline__ float wave_sum(float v) {
    v += xor_f<1>(v); v += xor_f<2>(v); v += xor_f<4>(v); v += xor_f<8>(v); v += xor_f<16>(v);
    auto rr = __builtin_amdgcn_permlane32_swap(__float_as_uint(v), __float_as_uint(v), false, false); return __uint_as_float(rr[0]) + __uint_as_float(rr[1]);
}
__device__ __forceinline__ float wave_max(float v) {
    v = fmaxf(v, xor_f<1>(v)); v = fmaxf(v, xor_f<2>(v)); v = fmaxf(v, xor_f<4>(v)); v = fmaxf(v, xor_f<8>(v)); v = fmaxf(v, xor_f<16>(v));
    auto rr = __builtin_amdgcn_permlane32_swap(__float_as_uint(v), __float_as_uint(v), false, false); return fmaxf(__uint_as_float(rr[0]), __uint_as_float(rr[1]));
}
#define WAVE_SYNC() do { asm volatile("s_waitcnt lgkmcnt(0)" ::: "memory"); __builtin_amdgcn_wave_barrier(); } while (0)

namespace epi {
using pg8::f32x4; using pg8::u32x4; using pg8::Unit; using pg8::cvt_pk_bf16; using pg8::HALF; using pg8::BM;
struct Qkv {
    static constexpr bool PERM = true, AFTER_DRAIN = false;
    bf16_t* O0; int ncq, ld0; bf16_t* O1; int w1, ld1; size_t stride1; float scale0;
    __device__ __forceinline__ void operator()(const f32x4 (&acc)[2][2][4][2], const Unit& u, int wr, int wc, int fr, int fq) const {
        const int row0 = u.pm * BM + wr * 64 + fr; int colt = u.pn * BM; bf16_t* base; int ldc; float sc = 1.f;
        if (colt < ncq) { base = O0; ldc = ld0; sc = scale0; } else { colt -= ncq; const int j = colt / w1; colt -= j * w1; base = O1 + (size_t)j * stride1; ldc = ld1; }
        const int col0 = colt + wc * 32 + 8 * fq;
#pragma unroll
        for (int ai = 0; ai < 2; ++ai)
#pragma unroll
            for (int m = 0; m < 4; ++m) { bf16_t* rowp = base + (size_t)(row0 + ai * HALF + m * 16) * ldc + col0;
#pragma unroll
                for (int bj = 0; bj < 2; ++bj) { const f32x4 v0 = acc[ai][bj][m][0] * sc, v1 = acc[ai][bj][m][1] * sc;
                    u32x4 w; w.x = cvt_pk_bf16(v0[0], v0[1]); w.y = cvt_pk_bf16(v0[2], v0[3]); w.z = cvt_pk_bf16(v1[0], v1[1]); w.w = cvt_pk_bf16(v1[2], v1[3]);
                    *(u32x4*)(rowp + bj * HALF) = w; } }
    }
};
template <bool BF> struct Res {
    static constexpr bool PERM = false, AFTER_DRAIN = false;
    _Float16* X; const void* base; int ldc; float alpha;
    __device__ __forceinline__ void operator()(const f32x4 (&acc)[2][2][4][2], const Unit& u, int wr, int wc, int fr, int fq) const {
        typedef unsigned u32x2 __attribute__((ext_vector_type(2)));
        const int row0 = u.pm * BM + wr * 64 + fr, col0 = u.pn * BM + wc * 32 + 4 * fq;
#pragma unroll
        for (int ai = 0; ai < 2; ++ai)
#pragma unroll
            for (int m = 0; m < 4; ++m) { const size_t ro = (size_t)(row0 + ai * HALF + m * 16) * ldc + col0;
#pragma unroll
                for (int bj = 0; bj < 2; ++bj)
#pragma unroll
                    for (int n = 0; n < 2; ++n) { const size_t off = ro + bj * HALF + n * 16; f32x4 x;
                        if (BF) { const u32x2 w = *(const u32x2*)((const bf16_t*)base + off); x = (f32x4){bflo(w.x), bfhi(w.x), bflo(w.y), bfhi(w.y)}; } else x = *(const f32x4*)((const float*)base + off);
                        const f32x4 o = x * alpha + acc[ai][bj][m][n]; typedef _Float16 h4 __attribute__((ext_vector_type(4)));
                        *(h4*)(X + off) = (h4){(_Float16)o[0], (_Float16)o[1], (_Float16)o[2], (_Float16)o[3]}; } }
    }
};
struct SwiGlu {
    static constexpr bool PERM = true, AFTER_DRAIN = false;
    bf16_t* Hh; int xg0;
    __device__ __forceinline__ void operator()(const f32x4 (&acc)[2][2][4][2], const Unit& u, int wr, int wc, int fr, int fq) const {
        const int ht = (int)u.aofs; const int row0 = ht * BM + wr * 64 + fr; const int col0 = (u.pn & 1) * 128 + wc * 32 + 8 * fq;
#pragma unroll
        for (int ai = 0; ai < 2; ++ai)
#pragma unroll
            for (int m = 0; m < 4; ++m) { bf16_t* rowp = Hh + (size_t)(row0 + ai * HALF + m * 16) * ED + col0;
                float h[8];
#pragma unroll
                for (int n = 0; n < 2; ++n)
#pragma unroll
                    for (int j = 0; j < 4; ++j) { const float g = acc[ai][0][m][n][j], up = acc[ai][1][m][n][j];
                        const float sg = g * __builtin_amdgcn_rcpf(1.f + __builtin_amdgcn_exp2f(-g * 1.4426950408889634f)); h[n * 4 + j] = sg * up; }
                u32x4 w; w.x = cvt_pk_bf16(h[0], h[1]); w.y = cvt_pk_bf16(h[2], h[3]); w.z = cvt_pk_bf16(h[4], h[5]); w.w = cvt_pk_bf16(h[6], h[7]);
                *(u32x4*)rowp = w; }
    }
};
struct Down {
    static constexpr bool PERM = true, AFTER_DRAIN = false;
    bf16_t* O;
    __device__ __forceinline__ void operator()(const f32x4 (&acc)[2][2][4][2], const Unit& u, int wr, int wc, int fr, int fq) const {
        const int row0 = u.pm * BM + wr * 64 + fr; const int col0 = (u.pn & 3) * BM + wc * 32 + 8 * fq;
#pragma unroll
        for (int ai = 0; ai < 2; ++ai)
#pragma unroll
            for (int m = 0; m < 4; ++m) { const int row = row0 + ai * HALF + m * 16; const float sc = 1.f;
#if defined(OUTR_FP8)
                typedef unsigned u32x2 __attribute__((ext_vector_type(2)));
                unsigned char* rowp = (unsigned char*)O + (size_t)row * D + col0;
#pragma unroll
                for (int bj = 0; bj < 2; ++bj) { f32x4 v0 = acc[ai][bj][m][0] * (64.f * sc), v1 = acc[ai][bj][m][1] * (64.f * sc);
#pragma unroll
                    for (int e = 0; e < 4; ++e) { v0[e] = fminf(fmaxf(v0[e], -440.f), 440.f); v1[e] = fminf(fmaxf(v1[e], -440.f), 440.f); }
                    u32x2 w; int t0 = __builtin_amdgcn_cvt_pk_fp8_f32(v0[0], v0[1], 0, false); t0 = __builtin_amdgcn_cvt_pk_fp8_f32(v0[2], v0[3], t0, true);
                    int t1 = __builtin_amdgcn_cvt_pk_fp8_f32(v1[0], v1[1], 0, false); t1 = __builtin_amdgcn_cvt_pk_fp8_f32(v1[2], v1[3], t1, true); w.x = (unsigned)t0; w.y = (unsigned)t1;
                    *(u32x2*)(rowp + bj * HALF) = w; } }
#else
                bf16_t* rowp = O + (size_t)row * D + col0;
#pragma unroll
                for (int bj = 0; bj < 2; ++bj) { const f32x4 v0 = acc[ai][bj][m][0] * sc, v1 = acc[ai][bj][m][1] * sc;
                    u32x4 w; w.x = cvt_pk_bf16(v0[0], v0[1]); w.y = cvt_pk_bf16(v0[2], v0[3]); w.z = cvt_pk_bf16(v1[0], v1[1]); w.w = cvt_pk_bf16(v1[2], v1[3]);
                    *(u32x4*)(rowp + bj * HALF) = w; } }
#endif
    }
};
struct StoreBf16 {
    static constexpr bool PERM = true, AFTER_DRAIN = false;
    bf16_t* O; int ldc;
    __device__ __forceinline__ void operator()(const f32x4 (&acc)[2][2][4][2], const Unit& u, int wr, int wc, int fr, int fq) const {
        const int row0 = u.pm * BM + wr * 64 + fr; const int col0 = u.pn * BM + wc * 32 + 8 * fq;
#pragma unroll
        for (int ai = 0; ai < 2; ++ai)
#pragma unroll
            for (int m = 0; m < 4; ++m) { bf16_t* rowp = O + (size_t)(row0 + ai * HALF + m * 16) * ldc + col0;
#pragma unroll
                for (int bj = 0; bj < 2; ++bj) { const f32x4 v0 = acc[ai][bj][m][0], v1 = acc[ai][bj][m][1];
                    u32x4 w; w.x = cvt_pk_bf16(v0[0], v0[1]); w.y = cvt_pk_bf16(v0[2], v0[3]); w.z = cvt_pk_bf16(v1[0], v1[1]); w.w = cvt_pk_bf16(v1[2], v1[3]);
                    *(u32x4*)(rowp + bj * HALF) = w; } }
    }
};
template <bool LAST> struct Ple {
    static constexpr bool PERM = false, AFTER_DRAIN = false;
    const bf16_t* XB; const bf16_t* PP; float* OutF; bf16_t* XBn;
    __device__ __forceinline__ void operator()(const f32x4 (&acc)[2][2][4][2], const Unit& u, int wr, int wc, int fr, int fq) const {
        typedef unsigned u32x2 __attribute__((ext_vector_type(2)));
        const int row0 = u.pm * BM + wr * 64 + fr, col0 = u.pn * BM + wc * 32 + 4 * fq;
#pragma unroll
        for (int ai = 0; ai < 2; ++ai)
#pragma unroll
            for (int m = 0; m < 4; ++m) { const size_t ro = (size_t)(row0 + ai * HALF + m * 16) * D + col0;
#pragma unroll
                for (int bj = 0; bj < 2; ++bj)
#pragma unroll
                    for (int n = 0; n < 2; ++n) { const size_t off = ro + bj * HALF + n * 16; const u32x2 xw = *(const u32x2*)(XB + off); const f32x4 x = {bflo(xw.x), bfhi(xw.x), bflo(xw.y), bfhi(xw.y)}; const u32x2 pp = *(const u32x2*)(PP + off);
                        const f32x4 a = acc[ai][bj][m][n]; f32x4 o;
                        o[0] = x[0] + bflo(pp.x) * __builtin_amdgcn_rcpf(1.f + __builtin_amdgcn_exp2f(-a[0] * 1.4426950408889634f));
                        o[1] = x[1] + bfhi(pp.x) * __builtin_amdgcn_rcpf(1.f + __builtin_amdgcn_exp2f(-a[1] * 1.4426950408889634f));
                        o[2] = x[2] + bflo(pp.y) * __builtin_amdgcn_rcpf(1.f + __builtin_amdgcn_exp2f(-a[2] * 1.4426950408889634f));
                        o[3] = x[3] + bfhi(pp.y) * __builtin_amdgcn_rcpf(1.f + __builtin_amdgcn_exp2f(-a[3] * 1.4426950408889634f));
                        if (LAST) *(f32x4*)(OutF + off) = o; else { u32x2 w; w.x = cvt_pk_bf16(o[0], o[1]); w.y = cvt_pk_bf16(o[2], o[3]); *(u32x2*)(XBn + off) = w; } } }
    }
};
}

struct MoeOrder {
    const LAS int* tstart;
    int NC, G, c, NU, lists;
    __device__ __forceinline__ bool next(int i, pg8::Unit& u) const {
        const int x = c & 7, npx = G >> 3; int li = i * npx + (c >> 3); int e, j, cc, rt;
        if (li < 8 * NC) { e = 64; j = x + 8 * (li / NC); cc = li % NC; rt = j; }
        else { li -= 8 * NC; e = -1; j = 0; cc = 0; rt = 0;
            for (int q = 0; q < 8; ++q) { const int eq = x + 8 * q; const int t0 = tstart[eq], n = (tstart[eq + 1] - t0) * NC;
                if (e < 0) { if (li < n) { e = eq; j = li / NC; cc = li % NC; rt = 64 + t0 + j; } else li -= n; } }
            if (e < 0) return false; }
        u.pm = lists ? e * 64 + j : rt; u.pn = e * NC + cc; u.aofs = lists ? rt : 0; return true; }
    __device__ __forceinline__ void a_ready(const pg8::Unit&) const {}
    __device__ __forceinline__ void done(const pg8::Unit&) const {}
};

struct CmpOrder {
    int G, c;
    __device__ __forceinline__ bool next(int i, pg8::Unit& u) const { const long L = (long)i * G + c; if (L >= 32) return false;
        const int kv = (int)L >> 4, bg = ((int)L >> 1) & 7, half = (int)L & 1, b = bg >> 2, g = bg & 3;
        u.pm = 0; u.pn = kv; u.aofs = (long)kv * (8 << 20) + (long)b * (4 << 20) + g * 128 + (long)half * (2 << 20); return true; }
    __device__ __forceinline__ void a_ready(const pg8::Unit&) const {}
    __device__ __forceinline__ void done(const pg8::Unit&) const {}
};
namespace epi {
struct H1Store {
    static constexpr bool PERM = false, AFTER_DRAIN = false;
    float* H;
    __device__ __forceinline__ void operator()(const f32x4 (&acc)[2][2][4][2], const Unit& u, int wr, int wc, int fr, int fq) const {
        const long a = u.aofs; const int kv = (int)(a >> 23), b = (int)(a >> 22) & 1, half = (int)(a >> 21) & 1, g = (int)(a >> 7) & 3;
        const size_t rowb = ((size_t)(kv * 8 + b * 4 + g) * 512 + half * 256 + wr * 64 + fr);
#pragma unroll
        for (int ai = 0; ai < 2; ++ai)
#pragma unroll
            for (int m = 0; m < 4; ++m) { float* rowp = H + (rowb + ai * HALF + m * 16) * 128 + wc * 32 + 4 * fq;
#pragma unroll
                for (int n = 0; n < 2; ++n) *(f32x4*)(rowp + n * 16) = acc[ai][0][m][n]; }
    }
};
}
__device__ __forceinline__ void transpose_item(const float* W, int ldw, int k0, int n0, bf16* WT, int K, int drow0, LAS float* scr, int lane) {
#pragma unroll 8
    for (int i = 0; i < 32; ++i) { const int kk = 2 * i + (lane >> 5); scr[kk * 33 + (lane & 31)] = W[(size_t)(k0 + kk) * ldw + n0 + (lane & 31)]; }
    LDS_WAIT(); asm volatile("" ::: "memory");
    const int c = lane & 7;
#pragma unroll
    for (int j = 0; j < 4; ++j) { const int n = (lane >> 3) + 8 * j; const LAS float* s = scr + (8 * c) * 33 + n;
        v4u o; o.x = pk2(s[0 * 33], s[1 * 33]); o.y = pk2(s[2 * 33], s[3 * 33]); o.z = pk2(s[4 * 33], s[5 * 33]); o.w = pk2(s[6 * 33], s[7 * 33]);
        *(GAS v4u*)(WT + (size_t)(drow0 + n) * K + k0 + 8 * c) = o; }
    LDS_WAIT(); asm volatile("" ::: "memory");
}

__device__ __forceinline__ void transpose_item64(const float* W, int ldw, int k0, int n0, bf16* WT, int K, int drow0, int lane) {
    const int n4 = lane & 15, kg = lane >> 4; const float* src = W + (size_t)(k0 + 16 * kg) * ldw + n0 + 4 * n4;
    f32x4 v[16];
#pragma unroll
    for (int i = 0; i < 16; ++i) v[i] = __builtin_nontemporal_load((const GAS f32x4*)(src + (size_t)i * ldw));
    bf16* dst = WT + (size_t)(drow0 + 4 * n4) * K + k0 + 16 * kg;
#pragma unroll
    for (int j = 0; j < 4; ++j) { v4u a, b;
        a.x = pk2(v[0][j], v[1][j]); a.y = pk2(v[2][j], v[3][j]); a.z = pk2(v[4][j], v[5][j]); a.w = pk2(v[6][j], v[7][j]);
        b.x = pk2(v[8][j], v[9][j]); b.y = pk2(v[10][j], v[11][j]); b.z = pk2(v[12][j], v[13][j]); b.w = pk2(v[14][j], v[15][j]);
        *(GAS v4u*)(dst + (size_t)j * K) = a; *(GAS v4u*)(dst + (size_t)j * K + 8) = b; }
}

__device__ __forceinline__ void titem_load(f32x4 (&v)[16], const float* W, int ldw, int lane) {
    const int n4 = lane & 15, kg = lane >> 4; const float* src = W + (size_t)(8 * kg) * ldw + 4 * n4;
#pragma unroll
    for (int i = 0; i < 16; ++i) v[i] = __builtin_nontemporal_load((const GAS f32x4*)(src + (size_t)((i & 7) + 32 * (i >> 3)) * ldw));
}
__device__ __forceinline__ void titem_store(const f32x4 (&v)[16], bf16* WT, int K, int lane) {
    const int n4 = lane & 15, kg = lane >> 4; bf16* dst = WT + (size_t)(4 * n4) * K + 8 * kg;
#pragma unroll
    for (int j = 0; j < 4; ++j) { v4u a, b;
        a.x = gattn::cvtpk_s(v[0][j], v[1][j]); a.y = gattn::cvtpk_s(v[2][j], v[3][j]); a.z = gattn::cvtpk_s(v[4][j], v[5][j]); a.w = gattn::cvtpk_s(v[6][j], v[7][j]);
        b.x = gattn::cvtpk_s(v[8][j], v[9][j]); b.y = gattn::cvtpk_s(v[10][j], v[11][j]); b.z = gattn::cvtpk_s(v[12][j], v[13][j]); b.w = gattn::cvtpk_s(v[14][j], v[15][j]);
        *(GAS v4u*)(dst + (size_t)j * K) = a; *(GAS v4u*)(dst + (size_t)j * K + 32) = b; }
}

__device__ __forceinline__ void nitem_load(f32x4 (&v)[8], const float* W, int ldw, int lane) {
    const int n8 = lane & 7, ko = lane >> 3; const float* src = W + (size_t)(8 * ko) * ldw + 4 * n8;
#pragma unroll
    for (int i = 0; i < 8; ++i) v[i] = __builtin_nontemporal_load((const GAS f32x4*)(src + (size_t)i * ldw));
}
__device__ __forceinline__ void nitem_store(const f32x4 (&v)[8], bf16* WT, int K, int lane) {
    const int n8 = lane & 7, ko = lane >> 3; bf16* dst = WT + (size_t)(4 * n8) * K + 8 * ko;
#pragma unroll
    for (int j = 0; j < 4; ++j) { v4u a;
        a.x = gattn::cvtpk_s(v[0][j], v[1][j]); a.y = gattn::cvtpk_s(v[2][j], v[3][j]); a.z = gattn::cvtpk_s(v[4][j], v[5][j]); a.w = gattn::cvtpk_s(v[6][j], v[7][j]);
        *(GAS v4u*)(dst + (size_t)j * K) = a; }
}

template <int NHq, class KeyFn, class BiasFn>
__device__ __forceinline__ void attend_chunk(const float* qs, float* pb, int* kb, const bf16_t* Kp, const bf16_t* Vp, int pitch, int nslots,
                                             KeyFn keyfn, BiasFn biasfn, float scale, float (&m)[NHq], float (&l)[NHq], float (&o)[NHq], int lane) {
    float cm[NHq];
#pragma unroll
    for (int h = 0; h < NHq; ++h) cm[h] = NEGF;
    for (int i = 0; i < 8; ++i) {
        const int slot = lane + 64 * i;
        const int key = (slot < nslots) ? keyfn(slot) : -1;
        float s[NHq];
#pragma unroll
        for (int h = 0; h < NHq; ++h) s[h] = NEGF;
        if (key >= 0) {
            const uint4* kr = (const uint4*)(Kp + (size_t)key * pitch);
#pragma unroll
            for (int h = 0; h < NHq; ++h) s[h] = 0.f;
#pragma unroll
            for (int c = 0; c < 8; ++c) {
                const uint4 kv = kr[c];
                const float k0 = bflo(kv.x), k1 = bfhi(kv.x), k2 = bflo(kv.y), k3 = bfhi(kv.y), k4 = bflo(kv.z), k5 = bfhi(kv.z), k6 = bflo(kv.w), k7 = bfhi(kv.w);
#pragma unroll
                for (int h = 0; h < NHq; ++h) { const float4 qa = *(const float4*)(qs + h * 64 + 8 * c), qb = *(const float4*)(qs + h * 64 + 8 * c + 4);
                    s[h] += qa.x * k0 + qa.y * k1 + qa.z * k2 + qa.w * k3 + qb.x * k4 + qb.y * k5 + qb.z * k6 + qb.w * k7; }
            }
            const float bs = biasfn(slot);
#pragma unroll
            for (int h = 0; h < NHq; ++h) { s[h] = s[h] * scale + bs; cm[h] = fmaxf(cm[h], s[h]); }
        }
#pragma unroll
        for (int h = 0; h < NHq; ++h) pb[h * 512 + slot] = s[h];
        kb[slot] = key;
    }
    float f[NHq], mn[NHq], ls[NHq];
#pragma unroll
    for (int h = 0; h < NHq; ++h) { mn[h] = fmaxf(m[h], wave_max(cm[h])); f[h] = __expf(m[h] - mn[h]); ls[h] = 0.f; }
    WAVE_SYNC();
    for (int i = 0; i < 8; ++i) {
        const int slot = lane + 64 * i; const bool ok = kb[slot] >= 0;
#pragma unroll
        for (int h = 0; h < NHq; ++h) { const float p = ok ? __expf(pb[h * 512 + slot] - mn[h]) : 0.f; pb[h * 512 + slot] = p; ls[h] += p; }
    }
#pragma unroll
    for (int h = 0; h < NHq; ++h) { l[h] = l[h] * f[h] + wave_sum(ls[h]); o[h] *= f[h]; m[h] = mn[h]; }
    WAVE_SYNC();
    const int ns8 = (nslots + 7) & ~7;
    for (int sl = 0; sl < ns8; sl += 8) {
#pragma unroll
        for (int u = 0; u < 8; ++u) { const int key = kb[sl + u]; const int kk = key < 0 ? 0 : key; const float v = bf2f(Vp[(size_t)kk * pitch + lane]);
#pragma unroll
            for (int h = 0; h < NHq; ++h) o[h] += pb[h * 512 + sl + u] * v; }
    }
    WAVE_SYNC();
}

typedef gattn::bf16 abf16;
struct FoxU {
    const abf16 *Kb, *Vb; int kpitch, t0, NT, tmax; const float* cum; int q0; abf16* Ob; long owstride; const abf16* Qb; const LAS unsigned* mtab;
    __device__ __forceinline__ const abf16* qrow(int wid, int r32) const { return Qb + (long)(wid * 32 + r32) * D; }
    __device__ __forceinline__ int klo(int, int) const { return -2147483647; }
    __device__ __forceinline__ int khi(int wid, int r32) const { return q0 + wid * 32 + r32; }
    __device__ __forceinline__ float colscale(int, int) const { return 1.f; }
    __device__ __forceinline__ unsigned term(int wid, int r32, int tabs) const { return mtab ? (((mtab[wid * 32 + r32] >> (tabs >> 2)) & 1u) ? 0u : 0xC700u) : 0u; }
};
__device__ __forceinline__ void fox_order(int vcu, int i, int& bh, int& qb) { const int s = vcu & 7; bh = vcu >> 3; qb = (i == 0) ? s : (i == 1) ? 15 - s : (i == 2) ? 16 + s : 31 - s; }

struct NsaU {
    const abf16 *Kb, *Vb; int kpitch, t0, NT, tmax; const float* cum; int q0; abf16* Ob; long owstride; const abf16* Qb; const LAS unsigned* selm; const float* gates; int br; int wlen;
    __device__ __forceinline__ const abf16* qrow(int wid, int r32) const { return Qb + (long)(wid * 8 + (r32 >> 2)) * D + (r32 & 3) * 64; }
    __device__ __forceinline__ int khi(int wid, int r32) const { return q0 + wid * 8 + (r32 >> 2); }
    __device__ __forceinline__ int klo(int wid, int r32) const { return wlen ? q0 + wid * 8 + (r32 >> 2) - (wlen - 1) : -2147483647; }
    __device__ __forceinline__ float colscale(int wid, int r32) const { return gates[(wid * 8 + (r32 >> 2)) * 48 + (r32 & 3) * 3 + br]; }
    __device__ __forceinline__ unsigned term(int wid, int r32, int tabs) const {
        if (selm) { const unsigned w = selm[(wid * 8 + (r32 >> 2)) * 4 + ((tabs >> 5) & 3)]; return (tabs < 128 && ((w >> (tabs & 31)) & 1u)) ? 0u : 0xC700u; }
        return tabs < 0 ? 0xC700u : 0u; }
};
constexpr int NSA_IMP_LD = 132;
constexpr int NSA_LDS_IMP = gattn::LDS_BT, NSA_LDS_SELM = NSA_LDS_IMP + 64 * NSA_IMP_LD * 4, NSA_LDS_PRI = NSA_LDS_SELM + 1024;
static_assert(NSA_LDS_PRI + 8 * 512 <= RING_BYTES, "NSA LDS map");
__device__ __forceinline__ int swapmid(int x) { return (x & 3) | ((x & 4) << 1) | ((x & 8) >> 1); }

__device__ __forceinline__ void nsa_cmp_select(char* shm, int b, int g, int q0, const bf16_t* QBs, const bf16_t* KCMPs, const bf16_t* VCTs, const float* GATESs, unsigned* selm_g) {
    using gattn::bf16x8; using gattn::f32x16; using gattn::u32x4; using gattn::crow; using gattn::cvtpk_s;
    int tid_o = threadIdx.x; asm volatile("" : "+v"(tid_o)); const int tid = tid_o, lane = tid & 63, r32 = lane & 31, hi = lane >> 5; const int wid = __builtin_amdgcn_readfirstlane(tid >> 6);
    const size_t rb = (size_t)b * S; const int bg = b * NSA_G + g;
    const int tl = r32 >> 2, hh = r32 & 3, tq = q0 + wid * 8 + tl;
    const int nv = tq >= 31 ? ((tq - 31) >> 4) + 1 : 0;
    const int nvmax = ((q0 + 63 - 31) >> 4) + 1, ntile = (nvmax + 63) >> 6;
    float* imp = (float*)(shm + NSA_LDS_IMP); unsigned* selm = (unsigned*)(shm + NSA_LDS_SELM); float* pri = (float*)(shm + NSA_LDS_PRI) + wid * 128;
    for (int i = lane; i < 8 * NSA_IMP_LD; i += 64) imp[wid * 8 * NSA_IMP_LD + i] = 0.f;
    const bf16_t* qp = QBs + (rb + tq) * D + (g * 4 + hh) * 64;
    bf16x8 qf[4];
#pragma unroll
    for (int d0 = 0; d0 < 4; ++d0) qf[d0] = *(const bf16x8*)(qp + d0 * 16 + hi * 8);
    const bf16_t* KC = KCMPs + (size_t)bg * NCMP * 64; const bf16_t* VC = VCTs + (size_t)bg * 8 * 64 * 64;
    bf16x8 ovf[4];
#pragma unroll
    for (int kk = 0; kk < 4; ++kk) { u32x4 w = {0u, 0u, 0u, 0u};
#pragma unroll
        for (int i = 0; i < 8; ++i) { const int nl = 16 * kk + swapmid(8 * hi + i); const unsigned one = (r32 <= 16 && nl >= 4 * r32 - 1 && nl <= 4 * r32 + 3) ? 0x3F80u : 0u; w[i >> 1] |= one << (16 * (i & 1)); }
        ovf[kk] = __builtin_bit_cast(bf16x8, w); }
#define NSA_KLD(KA, KB_, k) do { const bf16_t* kr0 = KC + (size_t)(64 * (k) + r32) * 64 + hi * 8; \
        _Pragma("unroll") for (int d0 = 0; d0 < 4; ++d0) { KA[d0] = *(const bf16x8*)(kr0 + d0 * 16); KB_[d0] = *(const bf16x8*)(kr0 + 32 * 64 + d0 * 16); } } while (0)
#define NSA_QK(P0, P1, KA, KB_) do { const f32x16 z = {}; P0 = z; P1 = z; \
        _Pragma("unroll") for (int d0 = 0; d0 < 4; ++d0) { P0 = __builtin_amdgcn_mfma_f32_32x32x16_bf16(KA[d0], qf[d0], P0, 0, 0, 0); P1 = __builtin_amdgcn_mfma_f32_32x32x16_bf16(KB_[d0], qf[d0], P1, 0, 0, 0); } } while (0)
    float m = -60000.f, l = 0.f;
    bf16x8 ka[4], kb[4], na[4], nb[4]; NSA_KLD(ka, kb, 0);
    for (int k = 0; k < ntile; ++k) { f32x16 p0, p1; NSA_KLD(na, nb, (k + 1 < ntile ? k + 1 : 0)); NSA_QK(p0, p1, ka, kb);
#pragma unroll
        for (int d0 = 0; d0 < 4; ++d0) { ka[d0] = na[d0]; kb[d0] = nb[d0]; }
        float tm = -60000.f;
#pragma unroll
        for (int r = 0; r < 16; ++r) { const int n = 64 * k + crow(r, hi); p0[r] = n < nv ? p0[r] : -60000.f; p1[r] = n + 32 < nv ? p1[r] : -60000.f; tm = fmaxf(tm, fmaxf(p0[r], p1[r])); }
        { auto rr = __builtin_amdgcn_permlane32_swap(__float_as_uint(tm), __float_as_uint(tm), false, false); tm = fmaxf(__uint_as_float(rr[0]), __uint_as_float(rr[1])); }
        const float mn = fmaxf(m, tm); float ls = 0.f;
#pragma unroll
        for (int r = 0; r < 16; ++r) { const int n = 64 * k + crow(r, hi); ls += (n < nv ? __builtin_amdgcn_exp2f(p0[r] - mn) : 0.f) + (n + 32 < nv ? __builtin_amdgcn_exp2f(p1[r] - mn) : 0.f); }
        l = l * __builtin_amdgcn_exp2f(m - mn) + ls; m = mn; }
    { auto rr = __builtin_amdgcn_permlane32_swap(__float_as_uint(l), __float_as_uint(l), false, false); l = __uint_as_float(rr[0]) + __uint_as_float(rr[1]); }
    const float il = 1.f / fmaxf(l, 1e-30f);
    NSA_KLD(ka, kb, 0);
    f32x16 o[2]; o[0] = f32x16{}; o[1] = f32x16{};
    for (int k = 0; k < ntile; ++k) { f32x16 p0, p1; NSA_KLD(na, nb, (k + 1 < ntile ? k + 1 : 0));
        bf16x8 vfr[4][2];
#pragma unroll
        for (int kk = 0; kk < 4; ++kk)
#pragma unroll
            for (int d0 = 0; d0 < 2; ++d0) vfr[kk][d0] = *(const bf16x8*)(VC + ((size_t)(k * 64 + d0 * 32 + r32)) * 64 + kk * 16 + hi * 8);
        NSA_QK(p0, p1, ka, kb);
#pragma unroll
        for (int d0 = 0; d0 < 4; ++d0) { ka[d0] = na[d0]; kb[d0] = nb[d0]; }
#pragma unroll
        for (int r = 0; r < 16; ++r) { const int n = 64 * k + crow(r, hi); p0[r] = n < nv ? __builtin_amdgcn_exp2f(p0[r] - m) * il : 0.f; p1[r] = n + 32 < nv ? __builtin_amdgcn_exp2f(p1[r] - m) * il : 0.f; }
        u32x4 pw[4];
        pw[0] = (u32x4){cvtpk_s(p0[0], p0[1]), cvtpk_s(p0[2], p0[3]), cvtpk_s(p0[4], p0[5]), cvtpk_s(p0[6], p0[7])};
        pw[1] = (u32x4){cvtpk_s(p0[8], p0[9]), cvtpk_s(p0[10], p0[11]), cvtpk_s(p0[12], p0[13]), cvtpk_s(p0[14], p0[15])};
        pw[2] = (u32x4){cvtpk_s(p1[0], p1[1]), cvtpk_s(p1[2], p1[3]), cvtpk_s(p1[4], p1[5]), cvtpk_s(p1[6], p1[7])};
        pw[3] = (u32x4){cvtpk_s(p1[8], p1[9]), cvtpk_s(p1[10], p1[11]), cvtpk_s(p1[12], p1[13]), cvtpk_s(p1[14], p1[15])};
        f32x16 u = f32x16{};
#pragma unroll
        for (int kk = 0; kk < 4; ++kk) { const bf16x8 pa = __builtin_bit_cast(bf16x8, pw[kk]);
#pragma unroll
            for (int d0 = 0; d0 < 2; ++d0) o[d0] = __builtin_amdgcn_mfma_f32_32x32x16_bf16(pa, vfr[kk][d0], o[d0], 0, 0, 0);
            u = __builtin_amdgcn_mfma_f32_32x32x16_bf16(pa, ovf[kk], u, 0, 0, 0); }
        if (r32 <= 16) {
#pragma unroll
            for (int c = 0; c < 4; ++c) { const float sgrp = (u[4 * c] + u[4 * c + 1]) + (u[4 * c + 2] + u[4 * c + 3]); float* ip = imp + (wid * 8 + 2 * c + hi) * NSA_IMP_LD + 16 * k + r32; *ip += sgrp; } }
        WAVE_SYNC(); }
#undef NSA_QK
#undef NSA_KLD
    { float* wsf = (float*)(shm + gattn::LDS_WS) + wid * 64; if (hi == 0) wsf[32 + r32] = GATESs[(rb + tq) * 48 + (g * 4 + hh) * 3 + 0]; WAVE_SYNC();
      abf16* stg = (abf16*)(shm + gattn::LDS_OST) + wid * 2048;
#pragma unroll
      for (int r = 0; r < 16; ++r) { const int orow = crow(r, hi); const float gsc = wsf[32 + orow];
#pragma unroll
          for (int d0 = 0; d0 < 2; ++d0) stg[orow * 64 + d0 * 32 + r32] = __float2bfloat16(o[d0][r] * gsc); } }
    WAVE_SYNC();
    const int cur = q0 >> 6;
    for (int t8 = 0; t8 < 8; ++t8) { const int tok = wid * 8 + t8; const float* ip = imp + tok * NSA_IMP_LD;
        const int j0 = lane, j1 = lane + 64; const float i0 = ip[j0], i1 = ip[j1];
        const bool f0 = (j0 == 0) || (j0 == cur) || (j0 == cur - 1), f1 = (j1 == 0) || (j1 == cur) || (j1 == cur - 1);
        float pr0 = f0 ? i0 + 1e4f : i0, pr1 = f1 ? i1 + 1e4f : i1; pr0 = j0 <= cur ? pr0 : NEGF; pr1 = j1 <= cur ? pr1 : NEGF;
        const unsigned ub0 = __float_as_uint(pr0), ub1 = __float_as_uint(pr1);
        const unsigned k0 = (ub0 & 0x80000000u) ? ~ub0 : (ub0 | 0x80000000u), k1 = (ub1 & 0x80000000u) ? ~ub1 : (ub1 | 0x80000000u);
        unsigned thr = 0u;
        for (int bit = 31; bit >= 0; --bit) { const unsigned cand = thr | (1u << bit);
            const int c = __popcll(__builtin_amdgcn_ballot_w64(k0 >= cand)) + __popcll(__builtin_amdgcn_ballot_w64(k1 >= cand));
            thr = c >= 16 ? cand : thr; }
        const unsigned long long g0 = __builtin_amdgcn_ballot_w64(k0 > thr), g1 = __builtin_amdgcn_ballot_w64(k1 > thr);
        const unsigned long long e0 = __builtin_amdgcn_ballot_w64(k0 == thr), e1 = __builtin_amdgcn_ballot_w64(k1 == thr);
        int need = 16 - (__popcll(g0) + __popcll(g1));
        unsigned long long t0m = 0ull, t1m = 0ull;
        { unsigned long long e = e0; while (need > 0 && e) { const unsigned long long lowb = e & (0ull - e); t0m |= lowb; e ^= lowb; --need; } }
        { unsigned long long e = e1; while (need > 0 && e) { const unsigned long long lowb = e & (0ull - e); t1m |= lowb; e ^= lowb; --need; } }
        const unsigned long long vm0 = cur >= 63 ? ~0ull : ((1ull << (cur + 1)) - 1ull), vm1 = cur >= 127 ? ~0ull : (cur >= 64 ? ((1ull << (cur - 63)) - 1ull) : 0ull);
        const unsigned long long b0 = (g0 | t0m) & vm0, b1 = (g1 | t1m) & vm1;
        if (lane == 0) { selm[tok * 4 + 0] = (unsigned)b0; selm[tok * 4 + 1] = (unsigned)(b0 >> 32); selm[tok * 4 + 2] = (unsigned)b1; selm[tok * 4 + 3] = (unsigned)(b1 >> 32);
            if (selm_g) { unsigned* sg = selm_g + ((size_t)(rb + q0 + tok) * NSA_G + g) * 4; sg[0] = (unsigned)b0; sg[1] = (unsigned)(b0 >> 32); sg[2] = (unsigned)b1; sg[3] = (unsigned)(b1 >> 32); } }
        WAVE_SYNC(); }
}

struct Args { const void* in[31]; float* out; unsigned char* ws; int ph_lo, ph_hi; };

__device__ __forceinline__ float sigmoidf_(float z) { return 1.f / (1.f + __expf(-z)); }
__device__ __forceinline__ float gelu_tanh(float x) { const float u = 0.7978845608028654f * (x + 0.044715f * x * x * x); const float e = __expf(2.f * u); return 0.5f * x * (1.f + (1.f - 2.f / (e + 1.f))); }

__device__ __forceinline__ void ln_row(f32x4 (&v)[4], const float* g, const float* b, int lane) {
    float s = 0.f;
#pragma unroll
    for (int j = 0; j < 4; ++j) s += (v[j].x + v[j].y) + (v[j].z + v[j].w);
    const float mean = wave_sum(s) * (1.f / D); float s2 = 0.f;
#pragma unroll
    for (int j = 0; j < 4; ++j) { v[j] = v[j] - mean; s2 += (v[j].x * v[j].x + v[j].y * v[j].y) + (v[j].z * v[j].z + v[j].w * v[j].w); }
    const float rstd = 1.f / sqrtf(wave_sum(s2) * (1.f / D) + LN_EPS);
#pragma unroll
    for (int j = 0; j < 4; ++j) { const f32x4 gg = *(const f32x4*)(g + 4 * lane + 256 * j), bb = *(const f32x4*)(b + 4 * lane + 256 * j); v[j] = v[j] * rstd * gg + bb; }
}

__global__ void __launch_bounds__(NTHR, 2) mk_fwd(Args args) {
    extern __shared__ __attribute__((aligned(16))) unsigned char lds[];
    const int G = gridDim.x, bx = blockIdx.x;
    const int NGW = G * NWAVES, NGT = G * NTHR;
#define PH_IDS() int tid_o = threadIdx.x; asm volatile("" : "+v"(tid_o)); const int tid = tid_o, lane = tid & 63, wave = __builtin_amdgcn_readfirstlane(tid >> 6); \
    const int gw = bx * NWAVES + wave, gtid = bx * NTHR + tid; (void)gw; (void)gtid; (void)lane; (void)wave;
    unsigned char* ws = args.ws;
    gu32* ctl = (gu32*)(ws + WS_CTL);
    LAS unsigned char* ldsl = (LAS unsigned char*)lds;
    volatile LAS unsigned* MISC = (volatile LAS unsigned*)(ldsl + MISC_OFF);
    LAS int* TAB = (LAS int*)(ldsl + TAB_OFF);
    for (int u = threadIdx.x; u < (LDS_BYTES - RING_BYTES) / 4; u += NTHR) ((LAS unsigned*)(ldsl + RING_BYTES))[u] = 0u;
    __syncthreads();
    XcdBarrier bar; bar.bar = (unsigned*)(ctl + CW_BAR); bar.x = 0; bar.st = nullptr;
    if (!MK_MULTI) bar = xcd_barrier_post((unsigned*)(ctl + CW_BAR), MISC + 8);
#if defined(TIME_P1)
#define SEAM_AT(k) do { xcd_barrier(bar); if (blockIdx.x == 0 && threadIdx.x == 0) { ((unsigned long long*)(ctl + CW_TS))[(k)] = __builtin_amdgcn_s_memrealtime(); } } while (0)
#else
#define SEAM_AT(k) do { xcd_barrier(bar); } while (0)
#endif
#define SEAM() SEAM_AT(0)
#define IN(gp) (args.ph_lo <= (gp) && (gp) < args.ph_hi)

    float* X = (float*)(ws + WS_X);
    bf16_t* XBA = (bf16_t*)(ws + WS_XBA); bf16_t* XBB = (bf16_t*)(ws + WS_XBB);
    float* ROPE_C = (float*)(ws + WS_ROPE_C); float* ROPE_S = (float*)(ws + WS_ROPE_S);
    float* LOGF = (float*)(ws + WS_LOGF); float* CUM = (float*)(ws + WS_CUM); float* GATES = (float*)(ws + WS_GATES); float* KMEAN = (float*)(ws + WS_KMEAN);
    bf16_t* KCMP = (bf16_t*)(ws + WS_KCMP); bf16_t* VCMP = (bf16_t*)(ws + WS_VCMP); bf16_t* VCT = (bf16_t*)(ws + WS_VCT); unsigned* SELMG = (unsigned*)(ws + WS_SELMG);
    int* ROWTOK = (int*)(ws + WS_ROWTOK); float* LS32 = (float*)(ws + WS_LS32); float* H1 = (float*)(ws + WS_H1);
    int* TOKE = (int*)(ws + WS_TOKE); float* TOKW = (float*)(ws + WS_TOKW); int* TOKP = (int*)(ws + WS_TOKP); float* ROWW = (float*)(ws + WS_ROWW);
#define WSET_PTRS(LL) constexpr size_t so_ = ((LL) & 1) ? WS_SET1 : 0; \
    bf16_t* const WIN_T = (bf16_t*)(ws + WS_WIN + so_); bf16_t* const WOUT_T = (bf16_t*)(ws + WS_WOUT + so_); bf16_t* const WGU_T = (bf16_t*)(ws + WS_WGU + so_); bf16_t* const WDN_T = (bf16_t*)(ws + WS_WDN + so_); \
    bf16_t* const WPG_T = (bf16_t*)(ws + WS_WPG + so_); bf16_t* const WPP_T = (bf16_t*)(ws + WS_WPP + so_); bf16_t* const PB = (bf16_t*)(ws + WS_PB + so_); bf16_t* const WC1_T = (bf16_t*)(ws + WS_WC1 + so_); \
    float* const PEB = (float*)(ws + (((LL) & 1) ? WS_PEB1 : WS_PEB)); bf16_t* const WRT = (bf16_t*)(ws + (((LL) & 1) ? WS_WRT1 : WS_WRT)); \
    (void)WIN_T; (void)WOUT_T; (void)WGU_T; (void)WDN_T; (void)WPG_T; (void)WPP_T; (void)PB; (void)WC1_T; (void)PEB; (void)WRT;
    bf16_t* QB = (bf16_t*)(ws + WS_Q); bf16_t* KB = (bf16_t*)(ws + WS_K); bf16_t* VB = (bf16_t*)(ws + WS_V); bf16_t* AO = (bf16_t*)(ws + WS_AO);
    bf16_t* PP = (bf16_t*)(ws + WS_PP); bf16_t* QR = (bf16_t*)(ws + WS_QR); bf16_t* HB = (bf16_t*)(ws + WS_H); bf16_t* XG = (bf16_t*)(ws + WS_XG); bf16_t* OUTR = (bf16_t*)(ws + WS_OUTR);
    const int* positions = (const int*)args.in[2];

    if (IN(0)) { PH_IDS();
        for (int i = gtid; i < T * 32; i += NGT) { const int t = i >> 5, f = i & 31;
            const float inv = __builtin_amdgcn_exp2f(-(float)f * (13.287712379549449f / 32.f));
            const double ang = (double)positions[t] * (double)inv; double rev = ang * 0.15915494309189535; rev = rev - floor(rev);
            ROPE_C[i] = __builtin_amdgcn_cosf((float)rev); ROPE_S[i] = __builtin_amdgcn_sinf((float)rev); }
        for (int i = gtid; i < T; i += NGT) ROWTOK[64 * 16384 + i] = i;
        const float* xin = (const float*)args.in[0];
        for (int i = gtid; i < T * D / 4; i += NGT) { const f32x4 v = ((const f32x4*)xin)[i];
            unsigned long long w = (unsigned long long)pk2(v.x, v.y) | ((unsigned long long)pk2(v.z, v.w) << 32); ((unsigned long long*)XBB)[i] = w; }
    }

    auto conv = [&](auto Ltc) __attribute__((always_inline)) {
        constexpr int LT = decltype(Ltc)::value; PH_IDS(); WSET_PTRS(LT);
        const int kind = LT % 3, jj = LT / 3;
        const float* w_in_src = kind == 0 ? (const float*)args.in[3] + (size_t)jj * D * 3088 : kind == 1 ? (const float*)args.in[6] : (const float*)args.in[15];
        const int ldw_in = kind == 0 ? 3088 : kind == 1 ? 2608 : 3072, ncol_in = kind == 1 ? 2560 : 3072;
        const float* w_out_src = kind == 0 ? (const float*)args.in[5] + (size_t)jj * D * D : kind == 1 ? (const float*)args.in[14] : (const float*)args.in[16];
        {
            const int n_win = 16 * (ncol_in / 64), n_wout = 256, n_gu = 65 * 128, n_dn = 65 * 64, n_pg = 256, n_pp = 64;
            const int NIT = n_win + n_wout + n_gu + n_dn + n_pg + n_pp;
            auto dec = [&](int r, const float*& sp, int& ldw, bf16*& dp, int& K) __attribute__((always_inline)) {
                if (r < n_win) { const int nblk = ncol_in / 64, kb = r / nblk, nb = r % nblk; sp = w_in_src + (size_t)(64 * kb) * ldw_in + 64 * nb; ldw = ldw_in; dp = WIN_T + (size_t)(64 * nb) * D + 64 * kb; K = D; return; } r -= n_win;
                if (r < n_wout) { const int kb = r / 16, nb = r % 16; sp = w_out_src + (size_t)(64 * kb) * D + 64 * nb; ldw = D; dp = WOUT_T + (size_t)(64 * nb) * D + 64 * kb; K = D; return; } r -= n_wout;
                if (r < n_gu) { const int e = r / 128, rr = r % 128, mat = rr / 64, kb = (rr % 64) / 4, nb = rr % 4, n0 = 64 * nb;
                    const float* W = e < 64 ? (const float*)args.in[mat ? 22 : 21] + ((size_t)(LT * 64 + e)) * D * ED : (const float*)args.in[mat ? 25 : 24] + (size_t)LT * D * ED;
                    sp = W + (size_t)(64 * kb) * ED + n0; ldw = ED; dp = WGU_T + (size_t)(e * 512 + (n0 / 128) * 256 + mat * 128 + (n0 % 128)) * D + 64 * kb; K = D; return; } r -= n_gu;
                if (r < n_dn) { const int e = r / 64, rr = r % 64, kb = rr / 16, nb = rr % 16;
                    const float* W = e < 64 ? (const float*)args.in[23] + ((size_t)(LT * 64 + e)) * ED * D : (const float*)args.in[26] + (size_t)LT * ED * D;
                    sp = W + (size_t)(64 * kb) * D + 64 * nb; ldw = D; dp = WDN_T + (size_t)(e * 1024 + 64 * nb) * ED + 64 * kb; K = ED; return; } r -= n_dn;
                if (r < n_pg) { const int kb = r / 16, nb = r % 16; sp = (const float*)args.in[29] + (size_t)LT * D * D + (size_t)(64 * kb) * D + 64 * nb; ldw = D; dp = WPG_T + (size_t)(64 * nb) * D + 64 * kb; K = D; return; } r -= n_pg;
                { const int kb = r / 16, nb = r % 16; sp = (const float*)args.in[30] + (size_t)LT * PLE * D + (size_t)(64 * kb) * D + 64 * nb; ldw = D; dp = WPP_T + (size_t)(64 * nb) * PLE + 64 * kb; K = PLE; }
            };
            for (int it = gw; it < 2 * NIT; it += 6 * NGW) {
                const float* sp[6]; bf16* dp[6]; int ld[6], Kd[6]; f32x4 v[6][8];
#pragma unroll
                for (int u = 0; u < 6; ++u) { const int i2 = it + u * NGW; if (i2 < 2 * NIT) { dec(i2 >> 1, sp[u], ld[u], dp[u], Kd[u]); sp[u] += 32 * (i2 & 1); dp[u] += (size_t)(32 * (i2 & 1)) * Kd[u]; nitem_load(v[u], sp[u], ld[u], lane); } }
#pragma unroll
                for (int u = 0; u < 6; ++u) { const int i2 = it + u * NGW; if (i2 < 2 * NIT) nitem_store(v[u], dp[u], Kd[u], lane); }
            }
            { const f32x4* ps = (const f32x4*)((const float*)args.in[1] + (size_t)LT * T * PLE); unsigned long long* pd = (unsigned long long*)PB; constexpr int NP = T * PLE / 4;
              for (int i0 = gtid; i0 < NP; i0 += 8 * NGT) { f32x4 v[8];
#pragma unroll
                  for (int u = 0; u < 8; ++u) { const int i = i0 + u * NGT; if (i < NP) v[u] = __builtin_nontemporal_load((const GAS f32x4*)(ps + i)); }
#pragma unroll
                  for (int u = 0; u < 8; ++u) { const int i = i0 + u * NGT; if (i < NP) pd[i] = (unsigned long long)gattn::cvtpk_s(v[u].x, v[u].y) | ((unsigned long long)gattn::cvtpk_s(v[u].z, v[u].w) << 32); } } }
            { const float* Wr = (const float*)args.in[19] + (size_t)LT * D * NE;
              for (int i = gtid; i < NE * D; i += NGT) { const int e = i >> 10, k = i & 1023; const float w = Wr[k * 64 + e]; const unsigned h = f2bf(w); const float r = w - __uint_as_float(h << 16);
                  WRT[i] = (bf16_t)h; WRT[NE * D + i] = (bf16_t)f2bf(r); } }
            if (kind == 1) {
                for (int it = gw; it < 2 * 64; it += NGW) { const int kv = it >> 6, r = it & 63, kb = r >> 1, nb = r & 1;
                    transpose_item64((const float*)args.in[kv ? 12 : 10], 128, 64 * kb, 64 * nb, WC1_T, 2048, kv * 256 + 64 * nb, lane); }
                for (int it = gw; it < 2 * 128; it += NGW) { const int kv = it >> 7, hu = it & 127; const float* pe = (const float*)args.in[kv ? 9 : 8]; const float* w1 = (const float*)args.in[kv ? 12 : 10];
                    float wv[32], a = 0.f;
#pragma unroll
                    for (int i = 0; i < 32; ++i) wv[i] = w1[(size_t)(lane + 64 * i) * 128 + hu];
#pragma unroll
                    for (int i = 0; i < 32; ++i) a += pe[lane + 64 * i] * wv[i];
                    a = wave_sum(a); if (lane == 0) PEB[kv * 128 + hu] = a; }
            }
        }
    };

    auto layer_body = [&](auto Lc) __attribute__((always_inline)) {
        constexpr int L = decltype(Lc)::value; WSET_PTRS(L);
        const int kind = L % 3, jj = L / 3, gp0 = 1 + L * NPH;
        const float* w_in_src = kind == 0 ? (const float*)args.in[3] + (size_t)jj * D * 3088 : kind == 1 ? (const float*)args.in[6] : (const float*)args.in[15];
        const int ldw_in = kind == 0 ? 3088 : kind == 1 ? 2608 : 3072, ncol_in = kind == 1 ? 2560 : 3072;
        (void)jj; (void)w_in_src; (void)ldw_in;

        auto gates = [&]() __attribute__((always_inline)) { PH_IDS();
            if constexpr (L % 3 != 2) {
                using gattn::bf16x8; using gattn::f32x16; using gattn::u32x4; using gattn::crow; using gattn::cvtpk_s;
                constexpr int NB = (L % 3 == 0) ? 1 : 2, NCOL = (L % 3 == 0) ? 16 : 48;
                const int colbase = kind == 0 ? 3072 : 2560;
                const float* bsrc = kind == 0 ? (const float*)args.in[4] + jj * 16 : (const float*)args.in[7];
                constexpr int XP = 1032;
                bf16_t* XH = (bf16_t*)lds; bf16_t* XL = XH + 32 * XP; float* PL = (float*)lds;
                const int r32 = lane & 31, hi = lane >> 5;
                bf16x8 wh[8][NB], wl[8][NB];
#pragma unroll
                for (int st = 0; st < 8; ++st)
#pragma unroll
                    for (int nb = 0; nb < NB; ++nb) { const int n = nb * 32 + r32; u32x4 ph = {0u, 0u, 0u, 0u}, pl = {0u, 0u, 0u, 0u};
                        if (n < NCOL) { float wv[8];
#pragma unroll
                            for (int i = 0; i < 8; ++i) wv[i] = w_in_src[(size_t)(wave * 128 + 16 * st + 8 * hi + i) * ldw_in + colbase + n];
#pragma unroll
                            for (int i = 0; i < 4; ++i) { const unsigned h2 = cvtpk_s(wv[2 * i], wv[2 * i + 1]); ph[i] = h2; pl[i] = cvtpk_s(wv[2 * i] - bflo(h2), wv[2 * i + 1] - bfhi(h2)); } }
                        wh[st][nb] = __builtin_bit_cast(bf16x8, ph); wl[st][nb] = __builtin_bit_cast(bf16x8, pl); }
                for (int pass = bx; pass < T / 32; pass += G) { const size_t row0 = (size_t)pass * 32;
                    __syncthreads();
#pragma unroll
                    for (int r = 0; r < 4; ++r) { const int rl = wave * 4 + r; const size_t row = row0 + rl;
#pragma unroll
                        for (int j = 0; j < 4; ++j) {
                            if constexpr (L == 0) { const f32x4 v = *(const f32x4*)((const float*)args.in[0] + row * D + 4 * lane + 256 * j);
                                const unsigned h0 = cvtpk_s(v.x, v.y), h1 = cvtpk_s(v.z, v.w); const unsigned l0 = cvtpk_s(v.x - bflo(h0), v.y - bfhi(h0)), l1 = cvtpk_s(v.z - bflo(h1), v.w - bfhi(h1));
                                *(uint2*)(XH + rl * XP + 4 * lane + 256 * j) = make_uint2(h0, h1); *(uint2*)(XL + rl * XP + 4 * lane + 256 * j) = make_uint2(l0, l1); }
                            else *(uint2*)(XH + rl * XP + 4 * lane + 256 * j) = *(const uint2*)(XBB + row * D + 4 * lane + 256 * j); } }
                    __syncthreads();
                    f32x16 acc[NB];
#pragma unroll
                    for (int nb = 0; nb < NB; ++nb) acc[nb] = f32x16{};
#pragma unroll
                    for (int st = 0; st < 8; ++st) { const int k = wave * 128 + 16 * st + 8 * hi; const bf16x8 xh = *(const bf16x8*)(XH + r32 * XP + k); bf16x8 xl = xh; if constexpr (L == 0) xl = *(const bf16x8*)(XL + r32 * XP + k);
#pragma unroll
                        for (int nb = 0; nb < NB; ++nb) { acc[nb] = __builtin_amdgcn_mfma_f32_32x32x16_bf16(xh, wh[st][nb], acc[nb], 0, 0, 0); if constexpr (L == 0) acc[nb] = __builtin_amdgcn_mfma_f32_32x32x16_bf16(xl, wh[st][nb], acc[nb], 0, 0, 0);
                            acc[nb] = __builtin_amdgcn_mfma_f32_32x32x16_bf16(xh, wl[st][nb], acc[nb], 0, 0, 0); } }
                    __syncthreads();
#pragma unroll
                    for (int nb = 0; nb < NB; ++nb)
#pragma unroll
                        for (int r = 0; r < 16; ++r) PL[(wave * 32 + crow(r, hi)) * 64 + nb * 32 + r32] = acc[nb][r];
                    __syncthreads();
                    for (int o = tid; o < 32 * NCOL; o += NTHR) { const int rl = o / NCOL, c = o % NCOL; float z = bsrc[c];
#pragma unroll
                        for (int w = 0; w < 8; ++w) z += PL[(w * 32 + rl) * 64 + c];
                        if (kind == 0) { const float lf = fminf(z, 0.f) - __logf(1.f + __expf(-fabsf(z))); LOGF[(row0 + rl) * 16 + c] = lf;
                            float s4 = lf; s4 += xor_f<16>(s4); { auto rr = __builtin_amdgcn_permlane32_swap(__float_as_uint(s4), __float_as_uint(s4), false, false); s4 = __uint_as_float(rr[0]) + __uint_as_float(rr[1]); }
                            if (lane < 16) PL[8 * 32 * 64 + wave * 16 + lane] = s4; }
                        else GATES[(row0 + rl) * 48 + c] = sigmoidf_(z); }
                    if (kind == 0) { __syncthreads(); if (tid < 16) { float s = 0.f;
#pragma unroll
                            for (int w = 0; w < 8; ++w) s += PL[8 * 32 * 64 + w * 16 + tid]; LS32[(size_t)pass * 16 + tid] = s; } }
                }
                __syncthreads();
            }
        };

        if (L == 0 && PH_EN(0) && IN(gp0 + 0)) {
            conv(std::integral_constant<int, 0>{}); gates();
            SEAM_AT(1 + L * NPH + 0);
        }

        if (PH_EN(1) && IN(gp0 + 1)) { PH_IDS();
            if constexpr (L > 0) gates();
            pg8::Gemm g{XBB, WIN_T, T, ncol_in, D, 0, 0, nullptr}; pg8::StaticOrder So; So.init(T, ncol_in, G, bx);
            epi::Qkv E{QB, 1024, D, KB, kind == 1 ? 256 : 1024, kind == 1 ? 256 : 1024, kind == 1 ? (size_t)(4 * MiB) : (size_t)(16 * MiB), gattn::C2};
            pg8::gemm_phase<epi::Qkv, pg8::StaticOrder, true, true>(ldsl, g, So, E);
            {
              int kpp = PLE; asm volatile("" : "+s"(kpp)); pg8::Gemm g{PB, WPP_T, T, D, kpp, 0, 0, nullptr}; pg8::StaticOrder So; So.init(T, D, G, bx);
              epi::StoreBf16 E{PP, D};
              pg8::gemm_phase<epi::StoreBf16, pg8::StaticOrder, true, true>(ldsl, g, So, E); }
            SEAM_AT(1 + L * NPH + 1);
        }

        if (PH_EN(2) && IN(gp0 + 2)) { PH_IDS();
            if (kind == 0) {
                for (int task = gw; task < Bn * NH * 32; task += NGW) { const int q = task & 31, bh = task >> 5, b = bh / NH, h = bh % NH;
                    double base = 0.0;
                    for (int p = lane; p < 8 * q; p += 64) base += (double)LS32[((size_t)b * 256 + p) * 16 + h];
#pragma unroll
                    for (int o = 1; o < 64; o <<= 1) { const unsigned long long sb = __builtin_bit_cast(unsigned long long, base); const int sl4 = (lane ^ o) << 2;
                        const unsigned ulo = (unsigned)__builtin_amdgcn_ds_bpermute(sl4, (int)(unsigned)sb), uhi = (unsigned)__builtin_amdgcn_ds_bpermute(sl4, (int)(unsigned)(sb >> 32));
                        base += __builtin_bit_cast(double, ((unsigned long long)uhi << 32) | ulo); }
                    const size_t t0 = (size_t)b * S + q * 256 + lane * 4; double loc[4]; double run = 0.0;
#pragma unroll
                    for (int i = 0; i < 4; ++i) { run += (double)LOGF[(t0 + i) * 16 + h]; loc[i] = run; }
                    double sc = run;
#pragma unroll
                    for (int o = 1; o < 64; o <<= 1) { const unsigned long long sb = __builtin_bit_cast(unsigned long long, sc); const int sl4 = ((lane - o) & 63) << 2;
                        const unsigned ulo = (unsigned)__builtin_amdgcn_ds_bpermute(sl4, (int)(unsigned)sb), uhi = (unsigned)__builtin_amdgcn_ds_bpermute(sl4, (int)(unsigned)(sb >> 32));
                        const double up = __builtin_bit_cast(double, ((unsigned long long)uhi << 32) | ulo); if (lane >= o) sc += up; }
                    const double pre = base + (sc - run);
#pragma unroll
                    for (int i = 0; i < 4; ++i) CUM[(size_t)bh * S + q * 256 + lane * 4 + i] = (float)(pre + loc[i]); }
                for (int b = 0; b < Bn; ++b) { float mq = 0.f, mk = 0.f;
                    for (int rbase = gw; rbase < S; rbase += 4 * NGW) { uint4 q0a[4], q1a[4], k0a[4], k1a[4];
#pragma unroll
                      for (int u4 = 0; u4 < 4; ++u4) { const int r = rbase + u4 * NGW; if (r < S) { const size_t off = ((size_t)b * S + r) * D + lane * 16;
                          q0a[u4] = *(const uint4*)(QB + off); q1a[u4] = *(const uint4*)(QB + off + 8); k0a[u4] = *(const uint4*)(KB + off); k1a[u4] = *(const uint4*)(KB + off + 8); } }
#pragma unroll
                      for (int u4 = 0; u4 < 4; ++u4) { const int r = rbase + u4 * NGW; if (r >= S) continue; const uint4 q0 = q0a[u4], q1 = q1a[u4], k0 = k0a[u4], k1 = k1a[u4];
                        float sq = 0.f, sk = 0.f;
#define SQ2(w) (bflo(w) * bflo(w) + bfhi(w) * bfhi(w))
                        sq = SQ2(q0.x) + SQ2(q0.y) + SQ2(q0.z) + SQ2(q0.w) + SQ2(q1.x) + SQ2(q1.y) + SQ2(q1.z) + SQ2(q1.w);
                        sk = SQ2(k0.x) + SQ2(k0.y) + SQ2(k0.z) + SQ2(k0.w) + SQ2(k1.x) + SQ2(k1.y) + SQ2(k1.z) + SQ2(k1.w);
#undef SQ2
                        sq += xor_f<1>(sq); sq += xor_f<2>(sq); sk += xor_f<1>(sk); sk += xor_f<2>(sk);
                        mq = fmaxf(mq, sq); mk = fmaxf(mk, sk); } }
                    LAS float* nl = (LAS float*)ldsl; __syncthreads();
                    if ((lane & 3) == 0) { nl[(wave * 16 + (lane >> 2)) * 2] = mq; nl[(wave * 16 + (lane >> 2)) * 2 + 1] = mk; }
                    __syncthreads();
                    if (tid < 32) { float m = 0.f;
#pragma unroll
                        for (int w = 0; w < 8; ++w) m = fmaxf(m, nl[(w * 16 + (tid >> 1)) * 2 + (tid & 1)]);
                        __hip_atomic_fetch_max((unsigned*)(ctl + CW_NRM + L * 64 + (b * NH + (tid >> 1)) * 2 + (tid & 1)), __float_as_uint(m), RLX_AGENT); } }
            } else {
                const size_t st6 = 4 * MiB;
                for (int pass = 0; pass < (kind == 1 ? 3 : 2); ++pass) {
                    const bf16_t* src; bf16_t* dst; int nhd;
                    if (kind == 1) { if (pass == 0) { src = QB; dst = QR; nhd = 16; } else if (pass == 1) { src = KB + 2 * st6; dst = KB + 2 * st6; nhd = 4; } else { src = KB + 4 * st6; dst = KB + 4 * st6; nhd = 4; } }
                    else { if (pass == 0) { src = QB; dst = QB; } else { src = KB; dst = KB; } nhd = 16; }
                    const int per_row = nhd * 4, total = T * per_row;
                    for (int i = gtid; i < total; i += NGT) { const int t = i / per_row, r = i % per_row, hd = r >> 2, fq = r & 3;
                        const size_t o1 = (size_t)t * (nhd * 64) + hd * 64 + 8 * fq;
                        const uint4 a = *(const uint4*)(src + o1), bq = *(const uint4*)(src + o1 + 32);
                        const f32x4 c0 = *(const f32x4*)(ROPE_C + t * 32 + 8 * fq), c1 = *(const f32x4*)(ROPE_C + t * 32 + 8 * fq + 4);
                        const f32x4 s0 = *(const f32x4*)(ROPE_S + t * 32 + 8 * fq), s1 = *(const f32x4*)(ROPE_S + t * 32 + 8 * fq + 4);
                        uint4 oa, ob;
#define ROPE2(W, CA, CB, SA, SB) { const float x1l = bflo(a.W), x1h = bfhi(a.W), x2l = bflo(bq.W), x2h = bfhi(bq.W); \
                            oa.W = pk2(x1l * CA - x2l * SA, x1h * CB - x2h * SB); ob.W = pk2(x2l * CA + x1l * SA, x2h * CB + x1h * SB); }
                        ROPE2(x, c0.x, c0.y, s0.x, s0.y) ROPE2(y, c0.z, c0.w, s0.z, s0.w) ROPE2(z, c1.x, c1.y, s1.x, s1.y) ROPE2(w, c1.z, c1.w, s1.z, s1.w)
#undef ROPE2
                        *(uint4*)(dst + o1) = oa; *(uint4*)(dst + o1 + 32) = ob; }
                }
            }
            SEAM_AT(1 + L * NPH + 2);
        }

        if (kind != 0 && PH_EN(3) && IN(gp0 + 3)) { PH_IDS();
            if (kind == 1) {
                { pg8::Gemm g{KB, WC1_T, 0, 0, 2048, 4096, 512, nullptr}; CmpOrder So{G, bx}; epi::H1Store E{H1};
                  pg8::gemm_phase<epi::H1Store, CmpOrder, true, true>(ldsl, g, So, E); }
                if (!MK_MULTI) xcd_barrier(bar);
                float* hb = (float*)(lds + wave * 1024);
                for (int task = gw; task < 2 * 8 * NCMP; task += NGW) { const int i = task & 511, bg = (task >> 9) & 7, kv = task >> 12;
                    const float* h1 = H1 + (size_t)task * 128; const float* w2 = (const float*)args.in[kv ? 13 : 11];
                    hb[lane] = gelu_tanh(h1[lane] + PEB[kv * 128 + lane]); hb[64 + lane] = gelu_tanh(h1[64 + lane] + PEB[kv * 128 + 64 + lane]);
                    WAVE_SYNC();
                    float o0 = 0.f;
#pragma unroll 8
                    for (int hu = 0; hu < 128; ++hu) o0 += hb[hu] * w2[hu * 64 + lane];
                    const bf16_t ob = (bf16_t)f2bf(o0);
                    if (kv == 0) KCMP[((size_t)bg * NCMP + i) * 64 + lane] = ob;
                    else { VCMP[((size_t)bg * NCMP + i) * 64 + lane] = ob; const int nl = i & 63; VCT[(((size_t)bg * 8 + (i >> 6)) * 64 + lane) * 64 + (nl & 48) + swapmid(nl & 15)] = ob; }
                    WAVE_SYNC(); }
            } else if (kind == 2) {
                for (int item = gw; item < Bn * NH * 32; item += NGW) { const int blk = item & 31, bh = item >> 5, b = bh / NH, h = bh % NH;
                    float s = 0.f; const bf16_t* kp = KB + ((size_t)b * S + blk * 256) * D + h * 64 + lane;
                    for (int r0 = 0; r0 < 256; r0 += 32) { bf16_t kv[32];
#pragma unroll
                        for (int r = 0; r < 32; ++r) kv[r] = kp[(size_t)(r0 + r) * D];
#pragma unroll
                        for (int r = 0; r < 32; ++r) s += bf2f(kv[r]); }
                    KMEAN[(size_t)item * 64 + lane] = s * (1.f / 256.f); }
            }
            SEAM_AT(1 + L * NPH + 3);
        }

        if (PH_EN(4) && IN(gp0 + 4)) { PH_IDS();
            float* wl = (float*)(lds + wave * 14336);
            float* qs = wl; float* qs2 = wl + 256; float* pb = wl + 512; int* kb = (int*)(wl + 512 + 2048); float* misc = wl + 512 + 2048 + 512;
#if defined(ZERO_KIND)
            if ((ZERO_KIND >> kind) & 1) { for (int i = gtid; i < T * D / 8; i += NGT) ((uint4*)AO)[i] = make_uint4(0u, 0u, 0u, 0u); } else {
#endif
            bf16_t* AOn = AO;
#if !defined(FOX_NAIVE)
            if (kind == 0) {
                volatile LAS int* qw = (volatile LAS int*)(ldsl + TAB_OFF);
                int nun = 0; const int cslot = bx & 3; (void)cslot;
                for (;; ++nun) {
                    if constexpr (L + 1 < DEPTH) { if (nun == cslot) conv(std::integral_constant<int, (L + 1 < DEPTH ? L + 1 : 0)>{}); }
                    if (tid == 0) { qw[100] = (int)__hip_atomic_fetch_add((unsigned*)(ctl + CW_Q + L), 1u, RLX_AGENT); qw[101] = 0; }
                    __syncthreads();
                    const int u = qw[100]; if (u >= Bn * NH * 32) break;
                    const int qb = 31 - (u >> 5), bh = u & 31, b = bh / NH, h = bh % NH; const size_t rb = (size_t)b * S; const int ntabs = 4 * qb + 4;
                    const float* cum = CUM + (size_t)bh * S;
                    { const unsigned* nr = (const unsigned*)(ctl + CW_NRM + L * 64 + bh * 2);
                      const float qk = sqrtf(__uint_as_float(__hip_atomic_load(nr, RLX_AGENT)) * __uint_as_float(__hip_atomic_load(nr + 1, RLX_AGENT)));
                      const float thr = -(30.f + 2.f * qk);
                      bool skip = false; if (tid < ntabs) skip = (cum[qb * 256] - cum[64 * tid + 63]) * 1.4426950408889634f < thr;
                      const int nsk = __popcll(__builtin_amdgcn_ballot_w64(skip)); if (lane == 0 && nsk) atomicAdd((int*)&qw[101], nsk); }
                    __syncthreads();
                    int t0 = qw[101]; t0 = t0 > ntabs - 4 ? ntabs - 4 : t0; t0 &= ~1;
                    __syncthreads();
                    FoxU un{(const abf16*)KB + rb * D + h * 64, (const abf16*)VB + rb * D + h * 64, D, t0, ntabs - t0, ntabs - 1, cum, qb * 256,
                            (abf16*)AO + (rb + qb * 256) * D + h * 64, 32L * D, (const abf16*)QB + (rb + qb * 256) * D + h * 64, nullptr};
                    gattn::gunit<8, true, 0, 0>((char*)lds, un); }
                if constexpr (L + 1 < DEPTH) { if (nun < cslot) conv(std::integral_constant<int, (L + 1 < DEPTH ? L + 1 : 0)>{}); }
            }
#endif
#if !defined(MOBA_NAIVE)
            if (kind == 2) {
                const int vcu = (bx % 8) * (G / 8) + bx / 8;
                LAS unsigned* mtab = (LAS unsigned*)(ldsl + gattn::LDS_BT); LAS float* kml = (LAS float*)(ldsl + gattn::LDS_BT + 1024);
                const int cslot = bx % 5;
                for (int ui = 0; ui < 4; ++ui) { int bh, qb; fox_order(vcu, ui, bh, qb); const int b = bh / NH, h = bh % NH; const size_t rb = (size_t)b * S;
                    if constexpr (L + 1 < DEPTH) { if (ui == cslot) conv(std::integral_constant<int, (L + 1 < DEPTH ? L + 1 : 0)>{}); }
                    for (int i = tid; i < qb * 64; i += NTHR) kml[i] = KMEAN[(size_t)bh * 32 * 64 + i];
                    __syncthreads();
                    if (tid < 256) { const uint4* qp = (const uint4*)(QB + (rb + qb * 256 + tid) * D + h * 64); float q[64];
#pragma unroll
                        for (int c = 0; c < 8; ++c) { const uint4 w = qp[c]; q[8 * c] = bflo(w.x); q[8 * c + 1] = bfhi(w.x); q[8 * c + 2] = bflo(w.y); q[8 * c + 3] = bfhi(w.y); q[8 * c + 4] = bflo(w.z); q[8 * c + 5] = bfhi(w.z); q[8 * c + 6] = bflo(w.w); q[8 * c + 7] = bfhi(w.w); }
                        float v0 = -3e38f, v1 = -3e38f, v2 = -3e38f; int i0 = -1, i1 = -1, i2 = -1;
                        for (int n = 0; n < qb; ++n) { float sacc = 0.f;
#pragma unroll
                            for (int d = 0; d < 64; ++d) sacc += q[d] * kml[n * 64 + d];
                            if (sacc > v0) { v2 = v1; i2 = i1; v1 = v0; i1 = i0; v0 = sacc; i0 = n; } else if (sacc > v1) { v2 = v1; i2 = i1; v1 = sacc; i1 = n; } else if (sacc > v2) { v2 = sacc; i2 = n; } }
                        unsigned mk = 1u << qb; if (i0 >= 0) mk |= 1u << i0; if (i1 >= 0) mk |= 1u << i1; if (i2 >= 0) mk |= 1u << i2;
                        mtab[tid] = mk; }
                    __syncthreads();
                    FoxU un{(const abf16*)KB + rb * D + h * 64, (const abf16*)VB + rb * D + h * 64, D, 0, 4 * qb + 4, 4 * qb + 3, nullptr, qb * 256,
                            (abf16*)AO + (rb + qb * 256) * D + h * 64, 32L * D, (const abf16*)QB + (rb + qb * 256) * D + h * 64, mtab};
                    gattn::gunit<8, false, 0, 0>((char*)lds, un); }
                if constexpr (L + 1 < DEPTH) { if (cslot == 4) conv(std::integral_constant<int, (L + 1 < DEPTH ? L + 1 : 0)>{}); }
            }
#endif
#if !defined(NSA_NAIVE)
            if (kind == 1) {
                const int vcu = (bx % 8) * (G / 8) + bx / 8; const size_t st6 = 4 * MiB;
                const int cslot = bx % 5;
                for (int ui = 0; ui < 4; ++ui) { const int bg = vcu >> 5, s5 = vcu & 31, b = bg / NSA_G, g = bg % NSA_G;
                    if constexpr (L + 1 < DEPTH) { if (ui == cslot) conv(std::integral_constant<int, (L + 1 < DEPTH ? L + 1 : 0)>{}); } const int qt = (ui == 0) ? s5 : (ui == 1) ? 63 - s5 : (ui == 2) ? 64 + s5 : 127 - s5;
                    const int q0 = qt * 64, cur = qt; const size_t rb = (size_t)b * S;
#if defined(CHECK_KIND)
                    unsigned* selg = SELMG;
#else
                    unsigned* selg = nullptr;
#endif
                    nsa_cmp_select((char*)lds, b, g, q0, QB, KCMP, VCT, GATES, selg);
                    const LAS unsigned* selm = (const LAS unsigned*)(ldsl + NSA_LDS_SELM);
                    { int nt = (cur + 2) & ~1; nt = nt < 4 ? 4 : nt;
                      NsaU un{(const abf16*)KB + 2 * st6 + rb * 256 + g * 64, (const abf16*)KB + 3 * st6 + rb * 256 + g * 64, 256, 0, nt, 127, nullptr, q0,
                              (abf16*)AO + (rb + q0) * D + g * 256, 8L * D, (const abf16*)QR + (rb + q0) * D + g * 256, selm, GATES + (rb + q0) * 48 + g * 12, 1, 0};
                      gattn::gunit<8, false, 2, 2>((char*)lds, un); }
                    { NsaU un{(const abf16*)KB + 4 * st6 + rb * 256 + g * 64, (const abf16*)KB + 5 * st6 + rb * 256 + g * 64, 256, cur - 8, 10, 127, nullptr, q0,
                              (abf16*)AO + (rb + q0) * D + g * 256, 8L * D, (const abf16*)QR + (rb + q0) * D + g * 256, nullptr, GATES + (rb + q0) * 48 + g * 12, 2, 512};
                      gattn::gunit<8, false, 3, 2>((char*)lds, un); }
                }
                if constexpr (L + 1 < DEPTH) { if (cslot == 4) conv(std::integral_constant<int, (L + 1 < DEPTH ? L + 1 : 0)>{}); }
            }
#endif
#if defined(CHECK_KIND)
            if (kind == CHECK_KIND) { AOn = XG; SEAM_AT(1 + L * NPH + 4); }
#endif
#if defined(FOX_NAIVE) || (defined(CHECK_KIND) && CHECK_KIND == 0)
            if (kind == 0) {
                for (int task = gw; task < T * NH; task += NGW) {
                    const int t = task % S, bh = task / S, h = bh % NH, b = bh / NH; const size_t row = (size_t)b * S + t;
                    qs[lane] = bf2f(QB[row * D + h * 64 + lane]);
                    const float* cum = CUM + (size_t)bh * S; const float cq = cum[t];
                    WAVE_SYNC();
                    float m[1] = {NEGF}, l[1] = {0.f}, o[1] = {0.f};
                    for (int c0 = 0; c0 <= t; c0 += 512) {
                        attend_chunk<1>(qs, pb, kb, KB + h * 64, VB + h * 64, D, 512,
                            [=](int slot) { const int kk = c0 + slot; return kk <= t ? (int)(b * S + kk) : -1; },
                            [=](int slot) { return cq - cum[c0 + slot]; }, QSC, m, l, o, lane);
                    }
                    AOn[row * D + h * 64 + lane] = (bf16_t)f2bf(o[0] / fmaxf(l[0], 1e-30f));
                }
            }
#endif
#if defined(NSA_NAIVE) || (defined(CHECK_KIND) && CHECK_KIND == 1)
            if (kind == 1) {
                const size_t st6 = 4 * MiB;
                float* Pn = misc;
                for (int task = gw; task < T * NSA_G; task += NGW) {
                    const int t = task % S, bg = task / S, g = bg % NSA_G, b = bg / NSA_G; const size_t row = (size_t)b * S + t;
#pragma unroll
                    for (int h = 0; h < 4; ++h) { qs[h * 64 + lane] = bf2f(QB[row * D + (g * 4 + h) * 64 + lane]); qs2[h * 64 + lane] = bf2f(QR[row * D + (g * 4 + h) * 64 + lane]); }
                    WAVE_SYNC();
                    float oc[4], os[4], ow[4];
                    const int nvalid = t >= 31 ? ((t - 31) >> 4) + 1 : 0;
                    {
                        float m[4] = {NEGF, NEGF, NEGF, NEGF}, l[4] = {0.f, 0.f, 0.f, 0.f}; oc[0] = oc[1] = oc[2] = oc[3] = 0.f;
                        attend_chunk<4>(qs, pb, kb, KCMP + (size_t)bg * NCMP * 64, VCMP + (size_t)bg * NCMP * 64, 64, 512,
                            [=](int slot) { return slot < nvalid ? slot : -1; }, [=](int) { return 0.f; }, QSC, m, l, oc, lane);
                        float il[4];
#pragma unroll
                        for (int h = 0; h < 4; ++h) { il[h] = 1.f / fmaxf(l[h], 1e-30f); oc[h] *= il[h]; }
                        for (int i = 0; i < 8; ++i) { const int n = lane + 64 * i; Pn[n] = pb[n] * il[0] + pb[512 + n] * il[1] + pb[1024 + n] * il[2] + pb[1536 + n] * il[3]; }
                        WAVE_SYNC();
                    }
                    const int cur = t >> 6;
                    float pri0, pri1;
                    {
                        float imp[2];
#pragma unroll
                        for (int c = 0; c < 2; ++c) { const int j = lane + 64 * c; float a = 0.f;
#pragma unroll
                            for (int dn = -1; dn <= 3; ++dn) { const int n = 4 * j + dn; if (n >= 0 && n < 511) a += Pn[n]; }
                            imp[c] = a; }
                        const int j0 = lane, j1 = lane + 64;
                        const bool f0 = (j0 == 0) || (j0 == cur) || (j0 == cur - 1), f1 = (j1 == 0) || (j1 == cur) || (j1 == cur - 1);
                        pri0 = f0 ? imp[0] + 1e4f : imp[0]; pri1 = f1 ? imp[1] + 1e4f : imp[1];
                        pri0 = j0 <= cur ? pri0 : NEGF; pri1 = j1 <= cur ? pri1 : NEGF;
                    }
                    float* pri = (float*)kb;
                    int* sidx = kb + 128;
                    pri[lane] = pri0; pri[lane + 64] = pri1;
                    WAVE_SYNC();
                    int rk0 = 0, rk1 = 0;
                    for (int i = 0; i < 128; ++i) { const float pi = pri[i]; rk0 += (pi > pri0 || (pi == pri0 && i < lane)) ? 1 : 0; rk1 += (pi > pri1 || (pi == pri1 && i < lane + 64)) ? 1 : 0; }
                    bool s0 = (lane <= cur) && rk0 < 16, s1 = (lane + 64 <= cur) && rk1 < 16;
#if defined(CHECK_KIND) && !defined(CHECK_OWNSEL)
                    { const unsigned* sg = SELMG + ((size_t)row * NSA_G + g) * 4; s0 = (sg[lane >> 5] >> (lane & 31)) & 1u; s1 = (sg[2 + (lane >> 5)] >> (lane & 31)) & 1u; }
#endif
                    const unsigned long long b0 = __ballot(s0), b1 = __ballot(s1);
                    const unsigned long long lt = (1ull << lane) - 1ull;
                    const int n0 = __popcll(b0);
                    WAVE_SYNC();
                    if (lane < 16) sidx[lane] = -1;
                    WAVE_SYNC();
                    if (s0) sidx[__popcll(b0 & lt)] = lane;
                    if (s1) sidx[n0 + __popcll(b1 & lt)] = lane + 64;
                    WAVE_SYNC();
                    int myblk = sidx[lane & 15];
                    {
                        float m[4] = {NEGF, NEGF, NEGF, NEGF}, l[4] = {0.f, 0.f, 0.f, 0.f}; os[0] = os[1] = os[2] = os[3] = 0.f;
                        const bf16_t* Ks = KB + 2 * st6 + g * 64; const bf16_t* Vs = KB + 3 * st6 + g * 64;
                        for (int c = 0; c < 2; ++c) {
                            attend_chunk<4>(qs2, pb, kb, Ks, Vs, 256, 512,
                                [=](int slot) { const int j = __shfl(myblk, c * 8 + (slot >> 6)); const int kk = j * 64 + (slot & 63); return (j >= 0 && kk <= t) ? (int)(b * S + kk) : -1; },
                                [=](int) { return 0.f; }, QSC, m, l, os, lane);
                        }
#pragma unroll
                        for (int h = 0; h < 4; ++h) os[h] /= fmaxf(l[h], 1e-30f);
                    }
                    {
                        float m[4] = {NEGF, NEGF, NEGF, NEGF}, l[4] = {0.f, 0.f, 0.f, 0.f}; ow[0] = ow[1] = ow[2] = ow[3] = 0.f;
                        const bf16_t* Kw = KB + 4 * st6 + g * 64; const bf16_t* Vw = KB + 5 * st6 + g * 64;
                        attend_chunk<4>(qs2, pb, kb, Kw, Vw, 256, 512,
                            [=](int slot) { const int kk = t - 511 + slot; return kk >= 0 ? (int)(b * S + kk) : -1; },
                            [=](int) { return 0.f; }, QSC, m, l, ow, lane);
#pragma unroll
                        for (int h = 0; h < 4; ++h) ow[h] /= fmaxf(l[h], 1e-30f);
                    }
#pragma unroll
                    for (int h = 0; h < 4; ++h) { const float* gt = GATES + row * 48 + (g * 4 + h) * 3;
                        AOn[row * D + (g * 4 + h) * 64 + lane] = (bf16_t)f2bf(gt[0] * oc[h] + gt[1] * os[h] + gt[2] * ow[h]); }
                }
            }
#endif
#if defined(MOBA_NAIVE) || (defined(CHECK_KIND) && CHECK_KIND == 2)
            if (kind == 2) {
                for (int task = gw; task < T * NH; task += NGW) {
                    const int t = task % S, bh = task / S, h = bh % NH, b = bh / NH; const size_t row = (size_t)b * S + t;
                    qs[lane] = bf2f(QB[row * D + h * 64 + lane]);
                    WAVE_SYNC();
                    const int cb = t >> 8;
                    float gs = NEGF;
                    if (lane < cb) { const float* km = KMEAN + ((size_t)bh * 32 + lane) * 64; float a = 0.f;
#pragma unroll 8
                        for (int d = 0; d < 64; ++d) a += qs[d] * km[d];
                        gs = a; }
                    if (lane >= 32) gs = -3e30f;
                    int sel[3];
#pragma unroll
                    for (int r = 0; r < 3; ++r) { const float mx = wave_max(gs); const unsigned long long bm = __ballot(gs == mx); const int win = __ffsll((long long)bm) - 1;
                        sel[r] = (win < cb) ? win : -1; if (lane == win) gs = -3e30f; }
                    float m[1] = {NEGF}, l[1] = {0.f}, o[1] = {0.f};
                    for (int c = 0; c < 2; ++c) {
                        const int blk0 = c == 0 ? sel[0] : sel[2], blk1 = c == 0 ? sel[1] : cb;
                        attend_chunk<1>(qs, pb, kb, KB + h * 64, VB + h * 64, D, 512,
                            [=](int slot) { const int blk = slot < 256 ? blk0 : blk1; const int kk = blk * 256 + (slot & 255); return (blk >= 0 && kk <= t) ? (int)(b * S + kk) : -1; },
                            [=](int) { return 0.f; }, QSC, m, l, o, lane);
                    }
                    AOn[row * D + h * 64 + lane] = (bf16_t)f2bf(o[0] / fmaxf(l[0], 1e-30f));
                }
            }
#endif
#if defined(ZERO_KIND)
            }
#endif
#if defined(CHECK_KIND)
            if (kind == CHECK_KIND) {
                SEAM_AT(1 + L * NPH + 4);
                float num = 0.f, den = 0.f;
                for (int i = gtid; i < T * D; i += NGT) { const float a = bf2f(AO[i]), b = bf2f(AOn[i]); num += (a - b) * (a - b); den += b * b; }
                num = wave_sum(num); den = wave_sum(den);
                if (lane == 0) { atomicAdd((float*)(ctl + CW_CHK), num); atomicAdd((float*)(ctl + CW_CHK + 1), den); }
            }
#endif
            SEAM_AT(1 + L * NPH + 4);
        }

        if (PH_EN(5) && IN(gp0 + 5)) { PH_IDS();
            pg8::Gemm g{AO, WOUT_T, T, D, D, 0, 0, nullptr}; pg8::StaticOrder So; So.init(T, D, G, bx);
            epi::Res<(L > 0)> E{(_Float16*)X, L == 0 ? args.in[0] : (const void*)XBB, D, DN_ALPHA};
            pg8::gemm_phase<epi::Res<(L > 0)>, pg8::StaticOrder, true, true>(ldsl, g, So, E);
            SEAM_AT(1 + L * NPH + 5);
        }

        if (PH_EN(6) && IN(gp0 + 6)) { PH_IDS();
            using gattn::bf16x8; using gattn::f32x16; using gattn::u32x4; using gattn::crow; using gattn::cvtpk_s;
            const float* g1 = (const float*)args.in[17] + L * D; const float* b1 = (const float*)args.in[18] + L * D;
            const float* rb = (const float*)args.in[20] + L * NE;
            unsigned* cnt = (unsigned*)(ctl + CW_CNT + L * 2048);
            constexpr int XP = 1032;
            bf16_t* XH = (bf16_t*)lds; bf16_t* XL = XH + 32 * XP;
            float* PL = (float*)lds;
            LAS int* lcnt = (LAS int*)(ldsl + 66048 * 2); LAS int* lbase = lcnt + 64;
            const int r32 = lane & 31, hi = lane >> 5;
            bf16x8 wh[8][2], wl[8][2];
#pragma unroll
            for (int st = 0; st < 8; ++st)
#pragma unroll
                for (int nb = 0; nb < 2; ++nb) { const size_t wo = (size_t)(nb * 32 + r32) * D + wave * 128 + 16 * st + 8 * hi; wh[st][nb] = *(const bf16x8*)(WRT + wo); wl[st][nb] = *(const bf16x8*)(WRT + (size_t)NE * D + wo); }
            for (int pass = bx; pass < T / 32; pass += G) {
                const size_t row0 = (size_t)pass * 32;
                if (tid < 64) lcnt[tid] = 0;
#pragma unroll
                for (int r = 0; r < 4; ++r) { const int rl = wave * 4 + r; const size_t row = row0 + rl; f32x4 v[4];
#pragma unroll
                    for (int j = 0; j < 4; ++j) { typedef _Float16 h4 __attribute__((ext_vector_type(4))); const h4 hv = *(const h4*)((const _Float16*)X + row * D + 4 * lane + 256 * j); v[j] = (f32x4){(float)hv[0], (float)hv[1], (float)hv[2], (float)hv[3]}; }
                    ln_row(v, g1, b1, lane);
#pragma unroll
                    for (int j = 0; j < 4; ++j) {
                        const unsigned h0 = cvtpk_s(v[j].x, v[j].y), h1 = cvtpk_s(v[j].z, v[j].w);
                        *(uint2*)(XBA + row * D + 4 * lane + 256 * j) = make_uint2(h0, h1);
                        const unsigned l0 = cvtpk_s(v[j].x - bflo(h0), v[j].y - bfhi(h0)), l1 = cvtpk_s(v[j].z - bflo(h1), v[j].w - bfhi(h1));
                        *(uint2*)(XH + rl * XP + 4 * lane + 256 * j) = make_uint2(h0, h1); *(uint2*)(XL + rl * XP + 4 * lane + 256 * j) = make_uint2(l0, l1); } }
                __syncthreads();
                f32x16 acc[2]; acc[0] = f32x16{}; acc[1] = f32x16{};
                {
#pragma unroll
                  for (int st = 0; st < 8; ++st) { const int k = wave * 128 + 16 * st + 8 * hi;
                      const bf16x8 xh = *(const bf16x8*)(XH + r32 * XP + k), xl = *(const bf16x8*)(XL + r32 * XP + k);
#pragma unroll
                      for (int nb = 0; nb < 2; ++nb) { acc[nb] = __builtin_amdgcn_mfma_f32_32x32x16_bf16(xh, wh[st][nb], acc[nb], 0, 0, 0); acc[nb] = __builtin_amdgcn_mfma_f32_32x32x16_bf16(xl, wh[st][nb], acc[nb], 0, 0, 0);
                          acc[nb] = __builtin_amdgcn_mfma_f32_32x32x16_bf16(xh, wl[st][nb], acc[nb], 0, 0, 0); } } }
                __syncthreads();
#pragma unroll
                for (int nb = 0; nb < 2; ++nb)
#pragma unroll
                    for (int r = 0; r < 16; ++r) PL[(wave * 32 + crow(r, hi)) * 64 + nb * 32 + r32] = acc[nb][r];
                __syncthreads();
                const float rbl = rb[lane]; float gws[4]; int rks[4], lps[4];
                float scv[4], bi[4], m1[4], m2[4]; int cand[4]; unsigned key[4], thr[4]; bool selv[4];
#pragma unroll
                for (int r = 0; r < 4; ++r) { const int rl = wave * 4 + r; float lg = 0.f;
#pragma unroll
                    for (int w = 0; w < 8; ++w) lg += PL[(w * 32 + rl) * 64 + lane];
                    scv[r] = sigmoidf_(lg); bi[r] = scv[r] + rbl; m1[r] = bi[r]; }
#pragma unroll
                for (int r = 0; r < 4; ++r) m1[r] = fmaxf(m1[r], xor_f<1>(m1[r]));
#pragma unroll
                for (int r = 0; r < 4; ++r) m1[r] = fmaxf(m1[r], xor_f<2>(m1[r]));
#pragma unroll
                for (int r = 0; r < 4; ++r) { m1[r] = fmaxf(m1[r], xor_f<4>(m1[r])); cand[r] = (bi[r] == m1[r]) ? lane : 64; }
#pragma unroll
                for (int r = 0; r < 4; ++r) cand[r] = min(cand[r], xor_i<1>(cand[r]));
#pragma unroll
                for (int r = 0; r < 4; ++r) cand[r] = min(cand[r], xor_i<2>(cand[r]));
#pragma unroll
                for (int r = 0; r < 4; ++r) { cand[r] = min(cand[r], xor_i<4>(cand[r])); m2[r] = (lane == cand[r]) ? -3e38f : bi[r]; }
#pragma unroll
                for (int r = 0; r < 4; ++r) m2[r] = fmaxf(m2[r], xor_f<1>(m2[r]));
#pragma unroll
                for (int r = 0; r < 4; ++r) m2[r] = fmaxf(m2[r], xor_f<2>(m2[r]));
#pragma unroll
                for (int r = 0; r < 4; ++r) { m2[r] = fmaxf(m2[r], xor_f<4>(m2[r]));
                    const float gsc = m1[r] + m2[r]; const int grp = lane >> 3; int grank = 0;
#pragma unroll
                    for (int gg = 0; gg < 8; ++gg) { const float og = bcast_f(gsc, gg * 8); grank += (og > gsc || (og == gsc && gg < grp)) ? 1 : 0; }
                    const float v = grank < 4 ? bi[r] : NEGF; const unsigned ub = __float_as_uint(v);
                    key[r] = (ub & 0x80000000u) ? ~ub : (ub | 0x80000000u); thr[r] = 0u; }
                for (int bit = 31; bit >= 0; --bit) {
#pragma unroll
                    for (int r = 0; r < 4; ++r) { const unsigned cd = thr[r] | (1u << bit); thr[r] = __popcll(__builtin_amdgcn_ballot_w64(key[r] >= cd)) >= 8 ? cd : thr[r]; } }
                const unsigned long long lt = (1ull << lane) - 1ull;
#pragma unroll
                for (int r = 0; r < 4; ++r) { const unsigned long long gm = __builtin_amdgcn_ballot_w64(key[r] > thr[r]); unsigned long long em = __builtin_amdgcn_ballot_w64(key[r] == thr[r]);
                    int need = 8 - __popcll(gm); unsigned long long tm = 0ull;
                    while (need > 0 && em) { const unsigned long long lowb = em & (0ull - em); tm |= lowb; em ^= lowb; --need; }
                    const unsigned long long m = gm | tm; selv[r] = (m >> lane) & 1ull; rks[r] = selv[r] ? __popcll(m & lt) : -1; }
                float ssum[4];
#pragma unroll
                for (int r = 0; r < 4; ++r) ssum[r] = selv[r] ? scv[r] : 0.f;
#pragma unroll
                for (int r = 0; r < 4; ++r) ssum[r] += xor_f<1>(ssum[r]);
#pragma unroll
                for (int r = 0; r < 4; ++r) ssum[r] += xor_f<2>(ssum[r]);
#pragma unroll
                for (int r = 0; r < 4; ++r) ssum[r] += xor_f<4>(ssum[r]);
#pragma unroll
                for (int r = 0; r < 4; ++r) ssum[r] += xor_f<8>(ssum[r]);
#pragma unroll
                for (int r = 0; r < 4; ++r) { ssum[r] += xor_f<16>(ssum[r]); auto rr = __builtin_amdgcn_permlane32_swap(__float_as_uint(ssum[r]), __float_as_uint(ssum[r]), false, false); ssum[r] = __uint_as_float(rr[0]) + __uint_as_float(rr[1]);
                    gws[r] = scv[r] / ssum[r] * 2.5f; }
#pragma unroll
                for (int r = 0; r < 4; ++r) lps[r] = selv[r] ? __hip_atomic_fetch_add((int*)(lcnt + lane), 1, __ATOMIC_RELAXED, __HIP_MEMORY_SCOPE_WORKGROUP) : 0;
                __syncthreads();
                if (tid < 64) { const int c = lcnt[tid]; lbase[tid] = c ? (int)atomicAdd(cnt + tid * 32, (unsigned)c) : 0; }
                __syncthreads();
                { const int base = lbase[lane];
#pragma unroll
                  for (int r = 0; r < 4; ++r) if (rks[r] >= 0) { const size_t rw = row0 + wave * 4 + r; const int pos = base + lps[r];
                      TOKE[rw * 8 + rks[r]] = lane; TOKW[rw * 8 + rks[r]] = gws[r]; TOKP[rw * 8 + rks[r]] = pos; ROWTOK[lane * 16384 + pos] = (int)rw; } }
                __syncthreads();
            }
            SEAM_AT(1 + L * NPH + 6);
        }

        if (PH_EN(8) && IN(gp0 + 8)) { PH_IDS();
            __syncthreads();
            { LAS int* ntl = (LAS int*)ldsl;
              if (tid < 64) ntl[tid] = (int)((__hip_atomic_load((const unsigned*)(ctl + CW_CNT + L * 2048) + tid * 32, RLX_AGENT) + 255u) >> 8);
              __syncthreads();
              if (tid <= 64) { int s = 0; for (int e = 0; e < tid; ++e) s += ntl[e]; TAB[tid] = s; } }
            __syncthreads();
            const int nrt = 64 + TAB[64];
            pg8::Gemm g{XBA, WGU_T, 0, 0, D, 0, 0, ROWTOK}; MoeOrder So{TAB, 2, G, bx, nrt * 2, 1};
            epi::SwiGlu E{HB, 0};
            pg8::gemm_phase<epi::SwiGlu, MoeOrder, true, true, true>(ldsl, g, So, E);
            SEAM_AT(1 + L * NPH + 8);
        }

        if (PH_EN(9) && IN(gp0 + 9)) { PH_IDS();
            const int nrt = 64 + TAB[64];
            int kdn = ED; asm volatile("" : "+s"(kdn)); pg8::Gemm g{HB, WDN_T, 0, 0, kdn, 0, 0, nullptr}; MoeOrder So{TAB, 4, G, bx, nrt * 4, 0};
            epi::Down E{OUTR};
            pg8::gemm_phase<epi::Down, MoeOrder, true, true>(ldsl, g, So, E);
            SEAM_AT(1 + L * NPH + 9);
        }

        if (PH_EN(10) && IN(gp0 + 10)) { PH_IDS();
            const float* g2 = (const float*)args.in[27] + L * D; const float* b2 = (const float*)args.in[28] + L * D;
#if defined(OUTR_FP8)
            for (int rowa = gw; rowa < T; rowa += 2 * NGW) {
                typedef float f32x2n __attribute__((ext_vector_type(2)));
                f32x4 v[2][4]; int ws_[2][4], wk[2][TOPK][4]; float gk[2][TOPK]; bool has[2];
#pragma unroll
                for (int u = 0; u < 2; ++u) { const int row = rowa + u * NGW; has[u] = row < T; if (!has[u]) continue;
#pragma unroll
                    for (int j = 0; j < 4; ++j) { const uint2 w = *(const uint2*)(XBA + (size_t)row * D + 4 * lane + 256 * j); v[u][j] = (f32x4){bflo(w.x), bfhi(w.x), bflo(w.y), bfhi(w.y)} * DN_ALPHA; }
                    const unsigned char* o = (const unsigned char*)OUTR + (size_t)row * D;
#pragma unroll
                    for (int j = 0; j < 4; ++j) ws_[u][j] = (int)__builtin_nontemporal_load((const unsigned*)(o + 4 * lane + 256 * j));
#pragma unroll
                    for (int k = 0; k < TOPK; ++k) { const int dest = TAB[TOKE[row * 8 + k]] * 256 + TOKP[row * 8 + k]; gk[u][k] = TOKW[row * 8 + k] * (1.f / 64.f); const unsigned char* ok = (const unsigned char*)OUTR + ((size_t)T + dest) * D;
#pragma unroll
                        for (int j = 0; j < 4; ++j) wk[u][k][j] = (int)__builtin_nontemporal_load((const unsigned*)(ok + 4 * lane + 256 * j)); } }
#pragma unroll
                for (int u = 0; u < 2; ++u) { const int row = rowa + u * NGW; if (!has[u]) continue;
#pragma unroll
                    for (int j = 0; j < 4; ++j) { const f32x2n a = __builtin_amdgcn_cvt_pk_f32_fp8(ws_[u][j], false), c = __builtin_amdgcn_cvt_pk_f32_fp8(ws_[u][j], true);
                        v[u][j].x += a.x * (1.f / 64.f); v[u][j].y += a.y * (1.f / 64.f); v[u][j].z += c.x * (1.f / 64.f); v[u][j].w += c.y * (1.f / 64.f); }
#pragma unroll
                    for (int k = 0; k < TOPK; ++k) { const float gwk = gk[u][k];
#pragma unroll
                        for (int j = 0; j < 4; ++j) { const f32x2n a = __builtin_amdgcn_cvt_pk_f32_fp8(wk[u][k][j], false), c = __builtin_amdgcn_cvt_pk_f32_fp8(wk[u][k][j], true);
                            v[u][j].x += gwk * a.x; v[u][j].y += gwk * a.y; v[u][j].z += gwk * c.x; v[u][j].w += gwk * c.y; } }
                    ln_row(v[u], g2, b2, lane);
#pragma unroll
                    for (int j = 0; j < 4; ++j)
                        *(unsigned long long*)(XBA + (size_t)row * D + 4 * lane + 256 * j) = (unsigned long long)pk2(v[u][j].x, v[u][j].y) | ((unsigned long long)pk2(v[u][j].z, v[u][j].w) << 32); }
            }
#else
            for (int row = gw; row < T; row += NGW) {
                f32x4 v[4];
#pragma unroll
                for (int j = 0; j < 4; ++j) { const uint2 w = *(const uint2*)(XBA + (size_t)row * D + 4 * lane + 256 * j); v[j] = (f32x4){bflo(w.x), bfhi(w.x), bflo(w.y), bfhi(w.y)} * DN_ALPHA; }
#if defined(OUTR_FP8)
                {   typedef float f32x2n __attribute__((ext_vector_type(2)));
                    const unsigned char* o = (const unsigned char*)OUTR + (size_t)row * D;
#pragma unroll
                    for (int j = 0; j < 4; ++j) { const int w = (int)__builtin_nontemporal_load((const unsigned*)(o + 4 * lane + 256 * j)); const f32x2n a = __builtin_amdgcn_cvt_pk_f32_fp8(w, false), c = __builtin_amdgcn_cvt_pk_f32_fp8(w, true);
                        v[j].x += a.x * (1.f / 64.f); v[j].y += a.y * (1.f / 64.f); v[j].z += c.x * (1.f / 64.f); v[j].w += c.y * (1.f / 64.f); }
                    for (int k = 0; k < TOPK; ++k) { const int dest = TAB[TOKE[row * 8 + k]] * 256 + TOKP[row * 8 + k]; const float gwk = TOKW[row * 8 + k] * (1.f / 64.f); const unsigned char* ok = (const unsigned char*)OUTR + ((size_t)T + dest) * D;
#pragma unroll
                        for (int j = 0; j < 4; ++j) { const int w = (int)__builtin_nontemporal_load((const unsigned*)(ok + 4 * lane + 256 * j)); const f32x2n a = __builtin_amdgcn_cvt_pk_f32_fp8(w, false), c = __builtin_amdgcn_cvt_pk_f32_fp8(w, true);
                            v[j].x += gwk * a.x; v[j].y += gwk * a.y; v[j].z += gwk * c.x; v[j].w += gwk * c.y; } } }
#else
                {
                    const bf16_t* o = OUTR + (size_t)row * D;
#pragma unroll
                    for (int j = 0; j < 4; ++j) { typedef unsigned u32x2n __attribute__((ext_vector_type(2))); const u32x2n w = __builtin_nontemporal_load((const u32x2n*)(o + 4 * lane + 256 * j)); v[j].x += bflo(w.x); v[j].y += bfhi(w.x); v[j].z += bflo(w.y); v[j].w += bfhi(w.y); }
                }
                for (int k = 0; k < TOPK; ++k) { const int dest = TAB[TOKE[row * 8 + k]] * 256 + TOKP[row * 8 + k]; const float gwk = TOKW[row * 8 + k]; const bf16_t* o = OUTR + ((size_t)T + dest) * D;
#pragma unroll
                    for (int j = 0; j < 4; ++j) { typedef unsigned u32x2n __attribute__((ext_vector_type(2))); const u32x2n w = __builtin_nontemporal_load((const u32x2n*)(o + 4 * lane + 256 * j)); v[j].x += gwk * bflo(w.x); v[j].y += gwk * bfhi(w.x); v[j].z += gwk * bflo(w.y); v[j].w += gwk * bfhi(w.y); } }
#endif
                ln_row(v, g2, b2, lane);
#pragma unroll
                for (int j = 0; j < 4; ++j) {
                    *(unsigned long long*)(XBA + (size_t)row * D + 4 * lane + 256 * j) = (unsigned long long)pk2(v[j].x, v[j].y) | ((unsigned long long)pk2(v[j].z, v[j].w) << 32); }
            }
#endif
            SEAM_AT(1 + L * NPH + 10);
        }

        if (PH_EN(12) && IN(gp0 + 12)) { PH_IDS();
            pg8::Gemm g{XBA, WPG_T, T, D, D, 0, 0, nullptr}; pg8::StaticOrder So; So.init(T, D, G, bx);
            epi::Ple<(L == DEPTH - 1)> E{XBA, PP, args.out, XBB};
            pg8::gemm_phase<epi::Ple<(L == DEPTH - 1)>, pg8::StaticOrder, true, true>(ldsl, g, So, E);
#if defined(TIME_P1)
            SEAM_AT(1 + L * NPH + 12);
#else
            if (L != DEPTH - 1) SEAM_AT(1 + L * NPH + 12);
#endif
        }
    };
    layer_body(std::integral_constant<int, 0>{}); layer_body(std::integral_constant<int, 1>{}); layer_body(std::integral_constant<int, 2>{}); layer_body(std::integral_constant<int, 3>{});
#if defined(TIME_P1)
    {   PH_IDS();
        xcd_barrier(bar);
        const unsigned long long* ts = (const unsigned long long*)(ctl + CW_TS);
        int dig[2];
        for (int q = 0; q < 2; ++q) { const int p = q ? TIME_P2 : TIME_P1; unsigned long long tot = 0;
            for (int L2 = 0; L2 < DEPTH; ++L2) { if (TIME_LSEL >= 0 && L2 != (q ? TIME_LSEL2 : TIME_LSEL)) continue; const int k = 1 + L2 * NPH + p; const unsigned long long te = __hip_atomic_load(ts + k, RLX_AGENT); if (te == 0ull) continue;
                unsigned long long tb = 0ull; for (int k2 = k - 1; k2 >= 0 && tb == 0ull; --k2) tb = __hip_atomic_load(ts + k2, RLX_AGENT);
                tot += te - tb; }
            const float us = (float)tot * 0.01f * TIME_MUL; int d = (int)floorf(log2f(fmaxf(us, 1.f))) - 3; dig[q] = d < 0 ? 0 : d > 9 ? 9 : d; }
        const float sc = 1.f + sqrtf(0.01f * (float)(10 * (dig[0] + 1) + dig[1]));
        for (int i = gtid; i < T * D; i += NGT) args.out[i] *= sc; }
#endif
#if defined(CHECK_KIND)
    {   PH_IDS(); SEAM();
        const float num = __hip_atomic_load((float*)(ctl + CW_CHK), RLX_AGENT), den = __hip_atomic_load((float*)(ctl + CW_CHK + 1), RLX_AGENT);
        const float sc = 1.f + 100.f * sqrtf(num / fmaxf(den, 1e-30f));
        for (int i = gtid; i < T * D; i += NGT) args.out[i] *= sc; }
#endif
#undef SEAM
#undef IN
}

extern "C" void kernel_launch(void* const* d_in, const int* in_sizes, int n_in, void* d_out, int out_size, void* d_ws, size_t ws_size, hipStream_t stream) {
    static int grid = 0;
    if (grid == 0) {
        if (n_in != 31 || out_size != T * D || ws_size < WS_END) { fprintf(stderr, "kernel_launch: unexpected problem (n_in %d, out %d, ws %zu < %zu)\n", n_in, out_size, ws_size, (size_t)WS_END); grid = -1; return; }
        int dev = 0, cus = 0, per_cu = 0;
        if (hipGetDevice(&dev) != hipSuccess || hipDeviceGetAttribute(&cus, hipDeviceAttributeMultiprocessorCount, dev) != hipSuccess) { grid = -1; return; }
        if (hipFuncSetAttribute((const void*)mk_fwd, hipFuncAttributeMaxDynamicSharedMemorySize, LDS_BYTES) != hipSuccess) { fprintf(stderr, "kernel_launch: hipFuncSetAttribute failed\n"); grid = -1; return; }
        if (hipOccupancyMaxActiveBlocksPerMultiprocessor(&per_cu, (const void*)mk_fwd, NTHR, LDS_BYTES) != hipSuccess || per_cu < 1) fprintf(stderr, "kernel_launch: occupancy query says %d\n", per_cu);
        (void)hipGetLastError();
        grid = cus;
    }
    if (grid < 0) return;
    (void)hipMemsetAsync((char*)d_ws + WS_CTL, 0, CTL_ZERO_BYTES, stream);
    Args a{};
    for (int i = 0; i < 31; ++i) a.in[i] = d_in[i];
    a.out = (float*)d_out; a.ws = (unsigned char*)d_ws;
#if MK_MULTI
    const int nph = 1 + DEPTH * NPH;
    for (int p = 0; p < nph; ++p) { a.ph_lo = p; a.ph_hi = p + 1; hipLaunchKernelGGL(mk_fwd, dim3(grid), dim3(NTHR), LDS_BYTES, stream, a); }
#else
    a.ph_lo = 0; a.ph_hi = 1 + DEPTH * NPH;
    hipLaunchKernelGGL(mk_fwd, dim3(grid), dim3(NTHR), LDS_BYTES, stream, a);
#endif
}
```

```cpp
#define MK_MULTI 0
#define OUTR_FP8 1
#include <hip/hip_runtime.h>
#include <cstdio>
#include <cstdint>
namespace pg8 {
#define PG8_LAS __attribute__((address_space(3)))
typedef unsigned short bf16_t;
typedef short bf16x8 __attribute__((ext_vector_type(8)));
typedef float f32x4 __attribute__((ext_vector_type(4)));
typedef unsigned u32x4 __attribute__((ext_vector_type(4)));
constexpr int BM = 256, BK = 64, HALF = 128, HTB = HALF * BK * 2  , STAGE_BYTES = 8 * HTB, NXCD = 8, WGM = 8;

__host__ __device__ __forceinline__ int lds_byte(int r, int c) { const int st = (r >> 4) * 2 + (c >> 5), rr = r & 15, cc = c & 31, ob = rr * 64 + cc * 2; return st * 1024 + (ob ^ (((ob >> 9) & 1) << 5)); }
__host__ __device__ __forceinline__ void stage_rc(int b, int& R, int& C) { const int st = b / 1024, sb = b % 1024, swz = sb ^ (((sb >> 9) & 1) << 5); R = (st >> 1) * 16 + swz / 64; C = (st & 1) * 32 + (swz % 64) / 2; }
__host__ __device__ __forceinline__ int perm32(int rho) { const int n = rho >> 4, i = rho & 15; return 8 * (i >> 2) + 4 * n + (i & 3); }

struct Unit { int pm, pn; long aofs; };
struct Gemm { const bf16_t* A; const bf16_t* Bt; int M, N, K; int lda, kstepA; const int* gidx; };

struct StaticOrder {
    int nM, nN, nwg, G, c;
    __host__ __device__ void init(int M, int N, int G_, int c_) { nM = M / BM; nN = N / BM; nwg = nM * nN; G = G_; c = c_; }
    __host__ __device__ bool next(int i, Unit& u) const {
        const long L = (long)i * G + c; if (L >= nwg) return false;
        int wgid = (int)L; { const int q = nwg / NXCD, r = nwg % NXCD, xcd = wgid % NXCD, off = wgid / NXCD; wgid = (xcd < r ? xcd * (q + 1) : r * (q + 1) + (xcd - r) * q) + off; }
        const int nig = WGM * nN, gid = wgid / nig, fm = gid * WGM, gsz = (nM - fm) < WGM ? (nM - fm) : WGM;
        u.pm = fm + ((wgid % nig) % gsz); u.pn = (wgid % nig) / gsz; u.aofs = 0; return true;
    }
    __device__ __forceinline__ void a_ready(const Unit&) const {}
    __device__ __forceinline__ void done(const Unit&) const {}
};

__device__ __forceinline__ unsigned cvt_pk_bf16(float lo, float hi) { unsigned r; asm volatile("v_cvt_pk_bf16_f32 %0, %1, %2" : "=v"(r) : "v"(lo), "v"(hi)); return r; }
typedef float f32x2 __attribute__((ext_vector_type(2)));
__device__ __forceinline__ f32x2 gelu_pk(f32x2 v) {
    const f32x2 av = __builtin_elementwise_abs(v), d = av * 0.2316418882f + 1.0f;
    f32x2 t; t.x = __builtin_amdgcn_rcpf(d.x); t.y = __builtin_amdgcn_rcpf(d.y);
    f32x2 q = t * 0.5307027145f + (-0.7265760135f); q = q * t + 0.7107068705f; q = q * t + (-0.142248368f); q = q * t + 0.127414796f; q = q * t;
    const f32x2 s = (v * v) * (-0.72134752044f);
    f32x2 e; e.x = __builtin_amdgcn_exp2f(s.x); e.y = __builtin_amdgcn_exp2f(s.y);
    const f32x2 m = v * (q * e), r = v - m;
    f32x2 o; o.x = v.x < 0.f ? m.x : r.x; o.y = v.y < 0.f ? m.y : r.y; return o;
}

template <int ACT  > struct EpiBf16 {
    static constexpr bool PERM = true, AFTER_DRAIN = false; static_assert(ACT == 0 || ACT == 1, "EpiBf16: ACT is 0 (none) or 1 (gelu_pk)");
    bf16_t* O; int ldc; const float* bias; int split_cols; size_t split_stride; float scale0;
    __device__ __forceinline__ void operator()(const f32x4 (&acc)[2][2][4][2], const Unit& u, int wr, int wc, int fr, int fq) const {
        const int row0 = u.pm * BM + wr * 64 + fr; int colt = u.pn * BM; bf16_t* base = O;
        float sc = 1.f; if (split_cols) { const int t = colt / split_cols; base += (size_t)t * split_stride; colt -= t * split_cols; if (t == 0) sc = scale0; }
        const int col0 = colt + wc * 32 + 8 * fq, bcol0 = u.pn * BM + wc * 32 + 8 * fq;
        f32x4 bv[2][2];
#pragma unroll
        for (int bj = 0; bj < 2; ++bj)
#pragma unroll
            for (int n = 0; n < 2; ++n) bv[bj][n] = bias ? *(const f32x4*)(bias + bcol0 + bj * HALF + 4 * n) : (f32x4){0.f, 0.f, 0.f, 0.f};
#pragma unroll
        for (int ai = 0; ai < 2; ++ai)
#pragma unroll
            for (int m = 0; m < 4; ++m) { bf16_t* rowp = base + (size_t)(row0 + ai * HALF + m * 16) * ldc + col0;
#pragma unroll
                for (int bj = 0; bj < 2; ++bj) { f32x4 v0 = acc[ai][bj][m][0] + bv[bj][0], v1 = acc[ai][bj][m][1] + bv[bj][1];
                    if (ACT == 1) { f32x2 a = gelu_pk((f32x2){v0[0], v0[1]}), b = gelu_pk((f32x2){v0[2], v0[3]}), c = gelu_pk((f32x2){v1[0], v1[1]}), d = gelu_pk((f32x2){v1[2], v1[3]});
                        v0 = (f32x4){a.x, a.y, b.x, b.y}; v1 = (f32x4){c.x, c.y, d.x, d.y}; }
                    v0 = v0 * sc; v1 = v1 * sc; u32x4 w; w.x = cvt_pk_bf16(v0[0], v0[1]); w.y = cvt_pk_bf16(v0[2], v0[3]); w.z = cvt_pk_bf16(v1[0], v1[1]); w.w = cvt_pk_bf16(v1[2], v1[3]);
                    *(u32x4*)(rowp + bj * HALF) = w; } }
    }
};

struct PanelStats {
    unsigned* xbuf;
    unsigned* cnt;
    unsigned* tmo;
    int ntn; float eps;
    unsigned code;
    __device__ __forceinline__ bool run(const f32x4 (&v)[2][2][4][2], const Unit& u, int wr, int wc, int fr, int fq, PG8_LAS unsigned char* lds, int wid, int lane) const {
        typedef float f32x2v __attribute__((ext_vector_type(2)));
        PG8_LAS f32x2v* P = (PG8_LAS f32x2v*)lds;
        PG8_LAS f32x2v* S = (PG8_LAS f32x2v*)(lds + 8192);
        PG8_LAS unsigned* flag = (PG8_LAS unsigned*)(lds + 8192 + 2048);
#pragma unroll
        for (int ai = 0; ai < 2; ++ai)
#pragma unroll
            for (int m = 0; m < 4; ++m) {
                float s = 0.f;
#pragma unroll
                for (int bj = 0; bj < 2; ++bj)
#pragma unroll
                    for (int n = 0; n < 2; ++n) { const f32x4 x = v[ai][bj][m][n]; s += (x[0] + x[1]) + (x[2] + x[3]); }
                s += __shfl_xor(s, 16); s += __shfl_xor(s, 32);
                const float mw = s * (1.0f / 64.0f); float q = 0.f;
#pragma unroll
                for (int bj = 0; bj < 2; ++bj)
#pragma unroll
                    for (int n = 0; n < 2; ++n) { const f32x4 d = v[ai][bj][m][n] - mw; q += (d[0] * d[0] + d[1] * d[1]) + (d[2] * d[2] + d[3] * d[3]); }
                q += __shfl_xor(q, 16); q += __shfl_xor(q, 32);
                if (fq == 0) P[(ai * HALF + wr * 64 + m * 16 + fr) * 4 + wc] = (f32x2v){mw, q};
            }
        asm volatile("s_waitcnt lgkmcnt(0)" ::: "memory"); __builtin_amdgcn_s_barrier(); asm volatile("" ::: "memory");
#if defined(BROKEN_EXCHANGE_NO_WAIT)
#warning BROKEN CONTROL BUILD: the row-statistics exchange does not wait; results are wrong by design
        if (blockIdx.x >= 64) { const long long t0_ = clock64(); while (clock64() - t0_ < 60000) __builtin_amdgcn_s_sleep(8); }
#endif
        const int row = wid * 32 + (lane & 31);
        if (lane < 32) {
            const f32x2v a = P[row * 4 + 0], b = P[row * 4 + 1], c = P[row * 4 + 2], d = P[row * 4 + 3];
            const float mt = (a.x + b.x + c.x + d.x) * 0.25f;
            const float da = a.x - mt, db = b.x - mt, dc = c.x - mt, dd = d.x - mt;
            const float m2 = (a.y + b.y) + (c.y + d.y) + 64.0f * ((da * da + db * db) + (dc * dc + dd * dd));
            unsigned long long* slot = (unsigned long long*)xbuf + ((size_t)(u.pm * BM + row) * 4 + u.pn);
            __hip_atomic_store(slot, ((unsigned long long)__float_as_uint(m2) << 32) | __float_as_uint(mt), __ATOMIC_RELAXED, __HIP_MEMORY_SCOPE_AGENT);
        }
        asm volatile("s_waitcnt vmcnt(0)" ::: "memory");
        if (lane == 0) __hip_atomic_fetch_add(cnt + 64 * u.pm, 1u, __ATOMIC_RELAXED, __HIP_MEMORY_SCOPE_AGENT);
        if (wid == 0) {
            bool dead = false; const unsigned long long t0 = __builtin_amdgcn_s_memrealtime(); const unsigned want = 8u * (unsigned)ntn;
            for (;;) {
#if defined(BROKEN_EXCHANGE_NO_WAIT)
                break;
#endif
                if ((unsigned)__builtin_amdgcn_readfirstlane(__hip_atomic_load(cnt + 64 * u.pm, __ATOMIC_RELAXED, __HIP_MEMORY_SCOPE_AGENT)) >= want) break;
                if (__builtin_amdgcn_s_memrealtime() - t0 > 2000000ull) {
                    if (lane == 0) { unsigned expect = 0u; __hip_atomic_compare_exchange_strong(tmo + 1, &expect, code | (unsigned)(u.pm & 0xff), __ATOMIC_RELAXED, __ATOMIC_RELAXED, __HIP_MEMORY_SCOPE_AGENT);
                                     __hip_atomic_store(tmo, 1u, __ATOMIC_RELAXED, __HIP_MEMORY_SCOPE_AGENT); }
                    dead = true; break; }
                __builtin_amdgcn_s_sleep(2);
            }
            __builtin_amdgcn_fence(__ATOMIC_ACQUIRE, "agent");
            if (lane == 0) flag[0] = dead ? 1u : 0u;
        }
        asm volatile("s_waitcnt vmcnt(0) lgkmcnt(0)" ::: "memory"); __builtin_amdgcn_s_barrier(); asm volatile("" ::: "memory");
        const bool bad = flag[0] != 0u;
        if (lane < 32) {
            const unsigned long long* slot = (const unsigned long long*)xbuf + (size_t)(u.pm * BM + row) * 4; float mt[4], m2[4]; float ms = 0.f;
#pragma unroll
            for (int t = 0; t < 4; ++t) { if (t < ntn) { const unsigned long long w = __hip_atomic_load(slot + t, __ATOMIC_RELAXED, __HIP_MEMORY_SCOPE_AGENT); mt[t] = __uint_as_float((unsigned)w); m2[t] = __uint_as_float((unsigned)(w >> 32)); } else { mt[t] = 0.f; m2[t] = 0.f; } ms += mt[t]; }
            const float mean = ms / (float)ntn; float q = 0.f;
#pragma unroll
            for (int t = 0; t < 4; ++t) if (t < ntn) { const float dm = mt[t] - mean; q += m2[t] + 256.0f * dm * dm; }
            S[row] = (f32x2v){mean, 1.0f / sqrtf(q / (256.0f * (float)ntn) + eps)};
        }
        asm volatile("s_waitcnt lgkmcnt(0)" ::: "memory"); __builtin_amdgcn_s_barrier(); asm volatile("" ::: "memory");
        return bad;
    }
};
struct EpiLnRes {
    static constexpr bool PERM = false, AFTER_DRAIN = true;
    const float* base; float* out; int ldc; const float* bias; PanelStats st; unsigned poison;
    __device__ __forceinline__ void fused(f32x4 (&acc)[2][2][4][2], const Unit& u, int wr, int wc, int fr, int fq, PG8_LAS unsigned char* lds, int wid, int lane) const {
        typedef float f32x2v __attribute__((ext_vector_type(2)));
        const PG8_LAS f32x2v* S = (const PG8_LAS f32x2v*)(lds + 8192);
        const int col0 = u.pn * BM + wc * 32 + 4 * fq;
#pragma unroll
        for (int bj = 0; bj < 2; ++bj)
#pragma unroll
            for (int n = 0; n < 2; ++n) { const f32x4 bv = bias ? *(const f32x4*)(bias + col0 + bj * HALF + n * 16) : (f32x4){0.f, 0.f, 0.f, 0.f};
#pragma unroll
                for (int ai = 0; ai < 2; ++ai)
#pragma unroll
                    for (int m = 0; m < 4; ++m) acc[ai][bj][m][n] += bv; }
        f32x4 pre[4][2][2];
#pragma unroll
        for (int m = 0; m < 4; ++m) { const size_t off = (size_t)(u.pm * BM + wr * 64 + m * 16 + fr) * ldc + col0;
#pragma unroll
            for (int bj = 0; bj < 2; ++bj)
#pragma unroll
                for (int n = 0; n < 2; ++n) pre[m][bj][n] = *(const f32x4*)(base + off + bj * HALF + n * 16); }
        const bool bad = st.run(acc, u, wr, wc, fr, fq, lds, wid, lane) || poison != 0u;
        const float qnan = __builtin_nanf("");
#pragma unroll
        for (int ai = 0; ai < 2; ++ai)
#pragma unroll
            for (int m = 0; m < 4; ++m) { const int r = ai * HALF + wr * 64 + m * 16 + fr; const f32x2v sr = S[r]; const size_t off = (size_t)(u.pm * BM + r) * ldc + col0;
#pragma unroll
                for (int bj = 0; bj < 2; ++bj)
#pragma unroll
                    for (int n = 0; n < 2; ++n) { const f32x4 bs = ai == 0 ? pre[m][bj][n] : *(const f32x4*)(base + off + bj * HALF + n * 16); f32x4 o = bs + (acc[ai][bj][m][n] - sr.x) * sr.y;
                        if (bad) o = (f32x4){qnan, qnan, qnan, qnan}; *(f32x4*)(out + off + bj * HALF + n * 16) = o; }
                if (m & 1) asm volatile("" ::: "memory"); }
    }
};
struct EpiLnResLn {
    static constexpr bool PERM = false, AFTER_DRAIN = true;
    const float* base; float* out; bf16_t* xn; int ldc; const float* bias; PanelStats st1, st2; unsigned poison;
    __device__ __forceinline__ void fused(f32x4 (&acc)[2][2][4][2], const Unit& u, int wr, int wc, int fr, int fq, PG8_LAS unsigned char* lds, int wid, int lane) const {
        typedef float f32x2v __attribute__((ext_vector_type(2))); typedef unsigned u32x2v __attribute__((ext_vector_type(2)));
        const PG8_LAS f32x2v* S = (const PG8_LAS f32x2v*)(lds + 8192);
        const int col0 = u.pn * BM + wc * 32 + 4 * fq;
#pragma unroll
        for (int bj = 0; bj < 2; ++bj)
#pragma unroll
            for (int n = 0; n < 2; ++n) { const f32x4 bv = bias ? *(const f32x4*)(bias + col0 + bj * HALF + n * 16) : (f32x4){0.f, 0.f, 0.f, 0.f};
#pragma unroll
                for (int ai = 0; ai < 2; ++ai)
#pragma unroll
                    for (int m = 0; m < 4; ++m) acc[ai][bj][m][n] += bv; }
        bool bad = st1.run(acc, u, wr, wc, fr, fq, lds, wid, lane) || poison != 0u;
        const float qnan = __builtin_nanf("");
#pragma unroll
        for (int ai = 0; ai < 2; ++ai)
#pragma unroll
            for (int m = 0; m < 4; ++m) { const int r = ai * HALF + wr * 64 + m * 16 + fr; const f32x2v sr = S[r]; const size_t off = (size_t)(u.pm * BM + r) * ldc + col0;
#pragma unroll
                for (int bj = 0; bj < 2; ++bj)
#pragma unroll
                    for (int n = 0; n < 2; ++n) { const f32x4 bs = *(const f32x4*)(base + off + bj * HALF + n * 16); acc[ai][bj][m][n] = bs + (acc[ai][bj][m][n] - sr.x) * sr.y; }
                asm volatile("" : "+v"(acc[ai][0][m][0]), "+v"(acc[ai][0][m][1]), "+v"(acc[ai][1][m][0]), "+v"(acc[ai][1][m][1]));
                if (m & 1) asm volatile("" ::: "memory"); }
        const bool bad1 = bad;
        bad = st2.run(acc, u, wr, wc, fr, fq, lds, wid, lane) || bad;
#pragma unroll
        for (int ai = 0; ai < 2; ++ai)
#pragma unroll
            for (int m = 0; m < 4; ++m) { const int r = ai * HALF + wr * 64 + m * 16 + fr; const f32x2v sr = S[r]; const size_t off = (size_t)(u.pm * BM + r) * ldc + col0;
#pragma unroll
                for (int bj = 0; bj < 2; ++bj)
#pragma unroll
                    for (int n = 0; n < 2; ++n) { const f32x4 x1 = acc[ai][bj][m][n]; *(f32x4*)(out + off + bj * HALF + n * 16) = bad1 ? (f32x4){qnan, qnan, qnan, qnan} : x1;
                        const f32x4 o = (x1 - sr.x) * sr.y; u32x2v w; w.x = cvt_pk_bf16(o[0], o[1]); w.y = cvt_pk_bf16(o[2], o[3]);
                        if (bad) { w.x = 0x7fc07fc0u; w.y = 0x7fc07fc0u; } *(u32x2v*)(xn + off + bj * HALF + n * 16) = w; }
                asm volatile("" ::: "memory"); }
    }
};

template <class Epi, class Sched, bool ALIGN_EPI = false, bool SP2 = false, bool GATHER = false>
__device__ __forceinline__ void gemm_phase(PG8_LAS unsigned char* lds, const Gemm g, const Sched& S, const Epi& E) {
    static_assert(!GATHER || SP2, "gathered A rows: SP2 loop only");
    int tid_o = threadIdx.x; asm volatile("" : "+v"(tid_o)); const int tid = tid_o, wid = __builtin_amdgcn_readfirstlane(tid >> 6), lane = tid & 63, wr = wid >> 2, wc = wid & 3, fr = lane & 15, fq = lane >> 4;
    const int K = g.K, nt = K / BK, lda = g.lda ? g.lda : K;
    unsigned voffA[2], voffB[2];
#pragma unroll
    for (int i = 0; i < 2; ++i) { int R, C; stage_rc(tid * 16 + i * 8192, R, C); const int Rb = Epi::PERM ? ((R & ~31) + perm32(R & 31)) : R;
        voffA[i] = (unsigned)(R * lda + C) * 2u; voffB[i] = (unsigned)(Rb * K + C) * 2u; }
    const size_t kstep = (size_t)(BK * 2);
    const size_t hstep = (size_t)HALF * K * 2;
    const size_t tstep = 2 * hstep;
    const size_t kstepA = g.kstepA ? (size_t)g.kstepA : kstep, hstepA = (size_t)HALF * lda * 2, tstepA = 2 * hstepA;
    const unsigned ldsw = (unsigned)wid * 1024u;
    const int aoff = lds_byte(wr * 64 + fr, fq * 8), boff = lds_byte(wc * 32 + fr, fq * 8);
#define PG8_SA(b, h) (((b) * 2 + (h)) * HTB)
#define PG8_SB(b, h) ((4 + (b) * 2 + (h)) * HTB)
#define PG8_STAGE(bufoff, gbase, voff) do { _Pragma("unroll") for (int _i = 0; _i < 2; ++_i) \
        __builtin_amdgcn_global_load_lds((const unsigned*)((const char*)(gbase) + (voff)[_i]), (PG8_LAS unsigned*)(lds + (bufoff) + ldsw + _i * 8192), 16, 0, 0); } while (0)
#define PG8_LDA(dst, b, h) do { _Pragma("unroll") for (int m = 0; m < 4; ++m) _Pragma("unroll") for (int k = 0; k < 2; ++k) dst[m][k] = *(const PG8_LAS bf16x8*)(lds + PG8_SA(b, h) + aoff + m * 2048 + k * 1024); } while (0)
#define PG8_LDB(dst, b, h) do { _Pragma("unroll") for (int n = 0; n < 2; ++n) _Pragma("unroll") for (int k = 0; k < 2; ++k) dst[n][k] = *(const PG8_LAS bf16x8*)(lds + PG8_SB(b, h) + boff + n * 2048 + k * 1024); } while (0)
#define PG8_MMA(ai, bj, At, Bt) do { __builtin_amdgcn_s_setprio(1); _Pragma("unroll") for (int m = 0; m < 4; ++m) _Pragma("unroll") for (int n = 0; n < 2; ++n) _Pragma("unroll") for (int k = 0; k < 2; ++k) \
        acc[ai][bj][m][n] = __builtin_amdgcn_mfma_f32_16x16x32_bf16(Bt[n][k], At[m][k], acc[ai][bj][m][n], 0, 0, 0); __builtin_amdgcn_s_setprio(0); } while (0)
#define PG8_WAIT_V(n) asm volatile("s_waitcnt vmcnt(" #n ")" ::: "memory")
#define PG8_WAIT_L(n) asm volatile("s_waitcnt lgkmcnt(" #n ")" ::: "memory")
#define PG8_BAR __builtin_amdgcn_s_barrier()
#define PG8_SCHED __builtin_amdgcn_sched_barrier(0)
    unsigned gcu[2][2] = {{0u, 0u}, {0u, 0u}}, gnx[2][2] = {{0u, 0u}, {0u, 0u}};
#define PG8_GOFF(dst, u) do { int t_ = tid; asm volatile("" : "+v"(t_));   \
        _Pragma("unroll") for (int _h = 0; _h < 2; ++_h) _Pragma("unroll") for (int _i = 0; _i < 2; ++_i) { int R_, C_; stage_rc(t_ * 16 + _i * 8192, R_, C_); \
        dst[_h][_i] = (unsigned)((g.gidx[(u).pm * BM + _h * HALF + R_] & 16383) * lda + C_) * 2u; } } while (0)
#define PG8_STAGE_A(bufoff, gbase, H, NEXT) do { if constexpr (GATHER) { if (NEXT) PG8_STAGE(bufoff, gbase, gnx[H]); else PG8_STAGE(bufoff, gbase, gcu[H]); } else { PG8_STAGE(bufoff, (gbase) + ((H) ? hstepA : 0), voffA); } } while (0)
    Unit cur, nxt; int ui = 0;
    if (!S.next(0, cur)) return;
    f32x4 acc[2][2][4][2];
#pragma unroll
    for (int a = 0; a < 2; ++a)
#pragma unroll
        for (int b = 0; b < 2; ++b)
#pragma unroll
            for (int m = 0; m < 4; ++m)
#pragma unroll
                for (int n = 0; n < 2; ++n) acc[a][b][m][n] = (f32x4){0.f, 0.f, 0.f, 0.f};
    bf16x8 At[4][2], B0[2][2], B1[2][2];
    if constexpr (GATHER) PG8_GOFF(gcu, cur);
    const char* cA = GATHER ? (const char*)g.A : (const char*)g.A + (size_t)cur.pm * tstepA + cur.aofs; const char* cB = (const char*)g.Bt + (size_t)cur.pn * tstep;
    S.a_ready(cur);
    if constexpr (SP2) {
        PG8_STAGE(PG8_SB(0, 0), cB, voffB); PG8_STAGE(PG8_SB(0, 1), cB + hstep, voffB); PG8_STAGE_A(PG8_SA(0, 0), cA, 0, false); PG8_STAGE_A(PG8_SA(0, 1), cA, 1, false);
        if (wr == 1) PG8_BAR;
        PG8_WAIT_V(2); PG8_BAR;
        PG8_STAGE(PG8_SB(1, 0), cB + kstep, voffB); PG8_STAGE_A(PG8_SA(1, 0), cA + kstepA, 0, false); PG8_STAGE(PG8_SB(1, 1), cB + hstep + kstep, voffB);
        PG8_WAIT_V(6); PG8_BAR;
    } else {
        PG8_STAGE(PG8_SB(0, 0), cB, voffB); PG8_STAGE(PG8_SA(0, 0), cA, voffA); PG8_STAGE(PG8_SB(0, 1), cB + hstep, voffB); PG8_STAGE(PG8_SA(0, 1), cA + hstepA, voffA);
        if (wr == 1) PG8_BAR;
        PG8_WAIT_V(4); PG8_BAR;
        PG8_STAGE(PG8_SB(1, 0), cB + kstep, voffB); PG8_STAGE(PG8_SA(1, 0), cA + kstepA, voffA); PG8_STAGE(PG8_SB(1, 1), cB + hstep + kstep, voffB);
        PG8_WAIT_V(6); PG8_BAR;
    }
    for (;;) {
        const bool has_next = S.next(ui + 1, nxt);
        const char* nA = GATHER ? cA : (has_next ? (const char*)g.A + (size_t)nxt.pm * tstepA + nxt.aofs : cA); const char* nB = has_next ? (const char*)g.Bt + (size_t)nxt.pn * tstep : cB;
        for (int t = 0; t < nt; t += 2) {
            const bool last = (t == nt - 2);
            const char* a1 = cA + (size_t)(t + 1) * kstepA;
            const char* a2 = last ? nA : cA + (size_t)(t + 2) * kstepA; const char* b2 = last ? nB : cB + (size_t)(t + 2) * kstep;
            const char* a3 = a2 + kstepA; const char* b3 = b2 + kstep;
            if (last && has_next) S.a_ready(nxt);
            if constexpr (GATHER) { if (t == (nt >= 4 ? nt - 4 : 0)) { if (has_next) PG8_GOFF(gnx, nxt); else { gnx[0][0] = gcu[0][0]; gnx[0][1] = gcu[0][1]; gnx[1][0] = gcu[1][0]; gnx[1][1] = gcu[1][1]; } } }
            if constexpr (SP2) {
            PG8_LDB(B0, 0, 0); PG8_LDB(B1, 0, 1); PG8_SCHED; PG8_LDA(At, 0, 0); PG8_STAGE_A(PG8_SA(1, 1), a1, 1, false);
            PG8_WAIT_V(8); PG8_WAIT_L(0); PG8_BAR; PG8_MMA(0, 0, At, B0); PG8_MMA(0, 1, At, B1); PG8_BAR; PG8_SCHED;
            PG8_LDA(At, 0, 1); PG8_STAGE(PG8_SB(0, 0), b2, voffB); PG8_STAGE(PG8_SB(0, 1), b2 + hstep, voffB); PG8_STAGE_A(PG8_SA(0, 0), a2, 0, last);
            PG8_WAIT_V(8); PG8_WAIT_L(0); PG8_BAR; PG8_MMA(1, 0, At, B0); PG8_MMA(1, 1, At, B1); PG8_BAR; PG8_SCHED;
            PG8_LDB(B0, 1, 0); PG8_LDB(B1, 1, 1); PG8_SCHED; PG8_LDA(At, 1, 0); PG8_STAGE_A(PG8_SA(0, 1), a2, 1, last);
            PG8_WAIT_V(8); PG8_WAIT_L(0); PG8_BAR; PG8_MMA(0, 0, At, B0); PG8_MMA(0, 1, At, B1); PG8_BAR; PG8_SCHED;
            PG8_LDA(At, 1, 1); PG8_STAGE(PG8_SB(1, 0), b3, voffB); PG8_STAGE(PG8_SB(1, 1), b3 + hstep, voffB); PG8_STAGE_A(PG8_SA(1, 0), a3, 0, last);
            PG8_WAIT_V(8); PG8_WAIT_L(0); PG8_BAR; PG8_MMA(1, 0, At, B0); PG8_MMA(1, 1, At, B1); PG8_BAR; PG8_SCHED;
            } else {
            PG8_LDB(B0, 0, 0); PG8_SCHED; PG8_LDA(At, 0, 0); PG8_STAGE(PG8_SA(1, 1), a1 + hstepA, voffA);
            PG8_WAIT_L(8); PG8_BAR; PG8_WAIT_L(0); PG8_MMA(0, 0, At, B0); PG8_BAR; PG8_SCHED;
            PG8_LDB(B1, 0, 1); PG8_STAGE(PG8_SB(0, 0), b2, voffB);
            PG8_BAR; PG8_WAIT_L(0); PG8_MMA(0, 1, At, B1); PG8_BAR;
            PG8_LDA(At, 0, 1); PG8_STAGE(PG8_SA(0, 0), a2, voffA);
            PG8_BAR; PG8_WAIT_L(0); PG8_MMA(1, 0, At, B0); PG8_BAR; PG8_SCHED;
            PG8_STAGE(PG8_SB(0, 1), b2 + hstep, voffB);
            PG8_WAIT_V(6); PG8_BAR; PG8_MMA(1, 1, At, B1); PG8_BAR;
            PG8_LDB(B0, 1, 0); PG8_SCHED; PG8_LDA(At, 1, 0); PG8_STAGE(PG8_SA(0, 1), a2 + hstepA, voffA);
            PG8_WAIT_L(8); PG8_BAR; PG8_WAIT_L(0); PG8_MMA(0, 0, At, B0); PG8_BAR; PG8_SCHED;
            PG8_LDB(B1, 1, 1); PG8_STAGE(PG8_SB(1, 0), b3, voffB);
            PG8_BAR; PG8_WAIT_L(0); PG8_MMA(0, 1, At, B1); PG8_BAR;
            PG8_LDA(At, 1, 1); PG8_STAGE(PG8_SA(1, 0), a3, voffA);
            PG8_BAR; PG8_WAIT_L(0); PG8_MMA(1, 0, At, B0); PG8_BAR; PG8_SCHED;
            PG8_STAGE(PG8_SB(1, 1), b3 + hstep, voffB);
            PG8_WAIT_V(6); PG8_BAR; PG8_MMA(1, 1, At, B1); PG8_BAR;
            }
        }
        if constexpr (ALIGN_EPI) { if (wr == 0) PG8_BAR; }
        if constexpr (!Epi::AFTER_DRAIN) { E(acc, cur, wr, wc, fr, fq); S.done(cur); }
        if (!has_next) break;
#pragma unroll
        for (int a = 0; a < 2; ++a)
#pragma unroll
            for (int b = 0; b < 2; ++b)
#pragma unroll
                for (int m = 0; m < 4; ++m)
#pragma unroll
                    for (int n = 0; n < 2; ++n) acc[a][b][m][n] = (f32x4){0.f, 0.f, 0.f, 0.f};
        cur = nxt; cA = nA; cB = nB; ++ui;
        if constexpr (GATHER) { gcu[0][0] = gnx[0][0]; gcu[0][1] = gnx[0][1]; gcu[1][0] = gnx[1][0]; gcu[1][1] = gnx[1][1]; }
        if constexpr (ALIGN_EPI) { if (wr == 1) PG8_BAR; }
    }
    PG8_WAIT_V(0);
    if constexpr (!ALIGN_EPI) { if (wr == 0) PG8_BAR; }
    PG8_BAR;
    if constexpr (Epi::AFTER_DRAIN) { E.fused(acc, cur, wr, wc, fr, fq, lds, wid, lane); S.done(cur); }
#undef PG8_SA
#undef PG8_SB
#undef PG8_STAGE
#undef PG8_STAGE_A
#undef PG8_GOFF
#undef PG8_LDA
#undef PG8_LDB
#undef PG8_MMA
#undef PG8_WAIT_V
#undef PG8_WAIT_L
#undef PG8_BAR
#undef PG8_SCHED
}
}
#include <hip/hip_bf16.h>
#include <cmath>
namespace gattn {
using bf16=__hip_bfloat16;
using bf16x8=__attribute__((ext_vector_type(8)))short;
using s16x4=__attribute__((ext_vector_type(4)))short;
using f32x16=__attribute__((ext_vector_type(16)))float;
using u32x4=__attribute__((ext_vector_type(4)))unsigned;
constexpr int BATCH=2,NHEAD=16,SEQ=8192,D=64,DM=NHEAD*D;
constexpr int NW=8,QBLK=32,QB=QBLK*NW,KVBLK=64,NQB=SEQ/QB;
constexpr int ATTN_PITCH=DM, ATTN_UNIT_ROWS=QB;
__device__ __forceinline__ int crow(int r,int hi){return (r&3)+8*(r>>2)+4*hi;}
#define SBAR() __builtin_amdgcn_sched_barrier(0)
constexpr float NEGM=-60000.f;
__device__ __forceinline__ void emask(f32x16&p0,f32x16&p1,int kb,int lo,int hi_){
  #pragma unroll
  for(int r=0;r<16;++r){const int kv=kb+(r&3)+8*(r>>2); if(kv<lo||kv>hi_)p0[r]=NEGM; if(kv+32<lo||kv+32>hi_)p1[r]=NEGM;}
}

constexpr int NSLOT=3, SLOTB=8192;
constexpr int LDS_K=0, LDS_V=NSLOT*SLOTB, LDS_WS=2*NSLOT*SLOTB, LDS_OST=LDS_WS+NW*64*4, LDS_BT=LDS_OST+NW*4096, LDS_BYTES=LDS_BT+SEQ*4;
constexpr float C2=0.125f*1.4426950408889634f;
__device__ __forceinline__ void glds16(const void*gsrc,unsigned lds_dst){unsigned keep;
  asm volatile("s_mov_b32 %0, m0\n\ts_mov_b32 m0, %2\n\ts_nop 0\n\tglobal_load_lds_dwordx4 %1, off\n\ts_mov_b32 m0, %0":"=&s"(keep):"v"(gsrc),"s"(lds_dst):"memory");}
__device__ __forceinline__ float max3f(float a,float b,float c){float r;asm("v_max3_f32 %0, %1, %2, %3":"=v"(r):"v"(a),"v"(b),"v"(c));return r;}
__device__ __forceinline__ float max2f(float a,float b){float r;asm("v_max_f32_e32 %0, %1, %2":"=v"(r):"v"(a),"v"(b));return r;}
__device__ __forceinline__ float fadd_s(float a,float b){float r;asm("v_add_f32_e32 %0, %1, %2":"=v"(r):"v"(a),"v"(b));return r;}
__device__ __forceinline__ float fsub_s(float a,float b){float r;asm("v_sub_f32_e32 %0, %1, %2":"=v"(r):"v"(a),"v"(b));return r;}
typedef float f32x2_t __attribute__((ext_vector_type(2))); typedef __bf16 bf16x2_t __attribute__((ext_vector_type(2)));
__device__ __forceinline__ unsigned cvtpk_s(float lo,float hi){f32x2_t v={lo,hi};bf16x2_t b=__builtin_convertvector(v,bf16x2_t);return __builtin_bit_cast(unsigned,b);}
#define WAIT_BAR(N) asm volatile("s_waitcnt vmcnt(" #N ") lgkmcnt(0)\n\ts_barrier":::"memory")

typedef unsigned u32x2b __attribute__((ext_vector_type(2)));
__device__ __forceinline__ s16x4 bfrag(unsigned w){ u32x2b v={w,0u}; return __builtin_bit_cast(s16x4,v); }
#define BMFMA(a,b,c) __builtin_amdgcn_mfma_f32_32x32x8bf16_1k(a,b,c,0,0,0)
__device__ __forceinline__ void qkt(f32x16&p0,f32x16&p1,const char*Kslot,const bf16x8*qr,int r32,int hi){
  const char*kb=Kslot+hi*1024+r32*16;
  #pragma unroll
  for(int d0=0;d0<4;++d0){
    const bf16x8 b0=*reinterpret_cast<const bf16x8*>(kb+d0*2048);
    const bf16x8 b1=*reinterpret_cast<const bf16x8*>(kb+d0*2048+512);
    if(d0==0){const f32x16 z={};p0=__builtin_amdgcn_mfma_f32_32x32x16_bf16(b0,qr[0],z,0,0,0);p1=__builtin_amdgcn_mfma_f32_32x32x16_bf16(b1,qr[0],z,0,0,0);}
    else{p0=__builtin_amdgcn_mfma_f32_32x32x16_bf16(b0,qr[d0],p0,0,0,0);p1=__builtin_amdgcn_mfma_f32_32x32x16_bf16(b1,qr[d0],p1,0,0,0);}}
}
typedef __attribute__((address_space(3))) const char* lds_cptr;
typedef short v4i16_t __attribute__((ext_vector_type(4)));
__device__ __forceinline__ void kload8(bf16x8*kf,lds_cptr kp){
  kf[0]=*(const __attribute__((address_space(3))) bf16x8*)(kp);      kf[1]=*(const __attribute__((address_space(3))) bf16x8*)(kp+512);
  kf[2]=*(const __attribute__((address_space(3))) bf16x8*)(kp+2048); kf[3]=*(const __attribute__((address_space(3))) bf16x8*)(kp+2560);
  kf[4]=*(const __attribute__((address_space(3))) bf16x8*)(kp+4096); kf[5]=*(const __attribute__((address_space(3))) bf16x8*)(kp+4608);
  kf[6]=*(const __attribute__((address_space(3))) bf16x8*)(kp+6144); kf[7]=*(const __attribute__((address_space(3))) bf16x8*)(kp+6656);
}
__device__ __forceinline__ void kload2(bf16x8*kf,lds_cptr kp,int j){ kf[2*j]=*(const __attribute__((address_space(3))) bf16x8*)(kp+j*2048); kf[2*j+1]=*(const __attribute__((address_space(3))) bf16x8*)(kp+j*2048+512); }
__device__ __forceinline__ s16x4 vtr(lds_cptr p){ return __builtin_bit_cast(s16x4,__builtin_amdgcn_ds_read_tr16_b64_v4i16((__attribute__((address_space(3))) v4i16_t*)p)); }
__device__ __forceinline__ float rowmax(const f32x16&p0,const f32x16&p1){
  float a=max3f(p0[0],p0[1],p1[0]),b=max3f(p0[2],p0[3],p1[1]);a=max3f(a,p1[2],p1[3]);
  #pragma unroll
  for(int r=4;r<16;r+=4){a=max3f(a,p0[r],p0[r+1]);b=max3f(b,p0[r+2],p0[r+3]);a=max3f(a,p1[r],p1[r+1]);b=max3f(b,p1[r+2],p1[r+3]);}
  const float m=max2f(a,b);
  auto rr=__builtin_amdgcn_permlane32_swap(__float_as_uint(m),__float_as_uint(m),false,false);
  return max2f(__uint_as_float(rr[0]),__uint_as_float(rr[1]));
}
__device__ __forceinline__ void pv(f32x16*o,int vb,bf16x8 pa0,bf16x8 pa1,bf16x8 pa2,bf16x8 pa3){
  #pragma unroll
  for(int d0=0;d0<2;++d0){s16x4 lo[4],hi[4];
    #pragma unroll
    for(int ks=0;ks<4;++ks){
      asm volatile("ds_read_b64_tr_b16 %0,%1 offset:%c2":"=&v"(lo[ks]):"v"(vb),"i"(d0*4096+ks*1024):"memory");
      asm volatile("ds_read_b64_tr_b16 %0,%1 offset:%c2":"=&v"(hi[ks]):"v"(vb),"i"(d0*4096+ks*1024+512):"memory");}
    asm volatile("s_waitcnt lgkmcnt(0)":::"memory");SBAR();
    #define PK(k) (bf16x8){lo[k][0],lo[k][1],lo[k][2],lo[k][3],hi[k][0],hi[k][1],hi[k][2],hi[k][3]}
    o[d0]=__builtin_amdgcn_mfma_f32_32x32x16_bf16(pa0,PK(0),o[d0],0,0,0);
    o[d0]=__builtin_amdgcn_mfma_f32_32x32x16_bf16(pa1,PK(1),o[d0],0,0,0);
    o[d0]=__builtin_amdgcn_mfma_f32_32x32x16_bf16(pa2,PK(2),o[d0],0,0,0);
    o[d0]=__builtin_amdgcn_mfma_f32_32x32x16_bf16(pa3,PK(3),o[d0],0,0,0);
    #undef PK
  }
}

#ifndef ATTN_STORE16
#define ATTN_STORE16(p,v) (*(u32x4*)(p)=(v))
#endif
template<int THRL,bool HAS_BIAS,int OMODE,int ORS,class U> __device__ __forceinline__ void gunit(char*shm,const U&un){
  int tid_o=threadIdx.x; asm volatile("":"+v"(tid_o)); const int tid=tid_o,lane=tid&63,r32=lane&31,hi=lane>>5; const int wid=__builtin_amdgcn_readfirstlane(tid>>6);
  const int kpitch=un.kpitch;
  const bf16*Qw=un.qrow(wid,r32);
  const bf16*Kh=un.Kb,*Vh=un.Vb;
  const unsigned lds0=(unsigned)(uintptr_t)shm;
  float*wsf=(float*)(shm+LDS_WS)+wid*64;
  const bf16*ksrc=Kh+(long)lane*kpitch+wid*8;
  const bf16*vsrc=Vh+(long)(16*(wid&3)+(lane>>2))*kpitch+(wid>>2)*32+(lane&3)*8;
  const unsigned kdst=lds0+LDS_K+wid*1024, vdst=lds0+LDS_V+wid*1024;
  #define TABS(t) min(max(un.t0+(t),0),un.tmax)
  #define DMA_K(t,slot) glds16(ksrc+(long)TABS(t)*KVBLK*kpitch,(unsigned)__builtin_amdgcn_readfirstlane(kdst+(slot)))
  #define DMA_V(t,slot) glds16(vsrc+(long)TABS(t)*KVBLK*kpitch,(unsigned)__builtin_amdgcn_readfirstlane(vdst+(slot)))
  const int vb0=(int)(lds0+LDS_V)+((lane>>4)&1)*32+(lane&3)*8+(4*hi+((lane&15)>>2))*64;
  const char*Kbase=shm+LDS_K; bf16x8 kf[8];
  const lds_cptr shm3=(lds_cptr)shm; const lds_cptr kp0=shm3+LDS_K+hi*1024+r32*16; const lds_cptr vp0=shm3+LDS_V+((lane>>4)&1)*32+(lane&3)*8+(4*hi+((lane&15)>>2))*64;
  const int NT=un.NT;
  typedef __attribute__((address_space(3))) unsigned lds_u32;
  lds_u32* const btab=(lds_u32*)(shm3+LDS_BT);
  if(HAS_BIAS){ const float*cum=un.cum; const float cq0=cum[un.q0]; const float*cumt=cum+(long)un.t0*KVBLK; for(int k=tid;k<NT*KVBLK;k+=NW*64){ const float be=(cq0-cumt[k])*1.4426950408889634f; unsigned ub=__builtin_bit_cast(unsigned,be); const unsigned hb=(ub+0x7fffu+((ub>>16)&1u))>>16;
      const float rl=be-__builtin_bit_cast(float,hb<<16); unsigned ul=__builtin_bit_cast(unsigned,rl); const unsigned lb=(ul+0x7fffu+((ul>>16)&1u))>>16; btab[k]=hb|(lb<<16); } }
  int bto=0;
  #define BIAS_MFMA(C0,C1) do{ unsigned ln_; asm volatile("v_mbcnt_lo_u32_b32 %0, -1, 0\n\tv_mbcnt_hi_u32_b32 %0, -1, %0":"=v"(ln_)); const bool up_=ln_>=32u; \
      unsigned w0_=0u, w1_=0u; if(HAS_BIAS){ const lds_u32* bp_=btab+bto+(ln_&31u); w0_=bp_[0]; w1_=bp_[32]; } \
      const unsigned tm_=un.term(wid,(int)(ln_&31u),un.t0+(bto>>6)); \
      u32x2b a0_, a1_, q_; a0_.x=up_?0x3F803F80u:w0_; a0_.y=up_?0u:0x3F803F80u; a1_.x=up_?0x3F803F80u:w1_; a1_.y=a0_.y; q_.x=qm0|(up_?(tm_<<16):0u); q_.y=qm1; \
      C0=BMFMA(__builtin_bit_cast(s16x4,a0_),__builtin_bit_cast(s16x4,q_),C0); C1=BMFMA(__builtin_bit_cast(s16x4,a1_),__builtin_bit_cast(s16x4,q_),C1); }while(0)
  DMA_K(0,0);DMA_V(0,0);DMA_K(1,SLOTB);
  bf16x8 qr[4];
  #pragma unroll
  for(int d0=0;d0<4;++d0)qr[d0]=*reinterpret_cast<const bf16x8*>(&Qw[d0*16+hi*8]);
  float mhat=0.f,l_reg=0.f;f32x16 o[2];o[0]=f32x16{};o[1]=f32x16{};unsigned qm0=hi?0u:0x3F803F80u,qm1=0u;
  #define UPDQM() do{ const float nm_=-mhat; const unsigned u0_=__builtin_bit_cast(unsigned,nm_); const unsigned h_=(u0_+0x7fffu+((u0_>>16)&1u))>>16; const float r1_=nm_-__builtin_bit_cast(float,h_<<16); \
      const unsigned u1_=__builtin_bit_cast(unsigned,r1_); const unsigned m_=(u1_+0x7fffu+((u1_>>16)&1u))>>16; const float r2_=r1_-__builtin_bit_cast(float,m_<<16); const unsigned l_=__builtin_bit_cast(unsigned,r2_)>>16; \
      qm0=hi?l_:0x3F803F80u; qm1=hi?0u:(h_|(m_<<16)); }while(0)
  const int klo=un.klo(wid,r32),khi=un.khi(wid,r32);
  #define CMASK(P0,P1,t) do{ if((t)==0||(t)>=NT-4) emask(P0,P1,(un.t0+(t))*KVBLK+4*hi,klo,khi); }while(0)
  bool resc=false;
  #define START(P0,P1) do{ const float rm=rowmax(P0,P1); resc=false; \
    { const float dl=rm; mhat=fadd_s(mhat,dl); \
      _Pragma("unroll") for(int r=0;r<16;++r){P0[r]=fsub_s(P0[r],dl);P1[r]=fsub_s(P1[r],dl);} \
      UPDQM(); } \
    _Pragma("unroll") for(int r=0;r<16;++r)P0[r]=__builtin_amdgcn_exp2f(P0[r]); }while(0)
  #define RESC() do{ if(resc){ asm volatile("s_waitcnt lgkmcnt(0)":::"memory"); \
      _Pragma("unroll") for(int d_=0;d_<2;++d_) _Pragma("unroll") for(int r=0;r<16;++r)o[d_][r]*=wsf[crow(r,hi)]; } }while(0)
  f32x16 pA0,pA1,pB0,pB1;
  int sl_prev=0,sl_cur=0,sl_next=SLOTB;
  #define ROT() do{sl_prev=sl_cur;sl_cur=sl_next;sl_next=(sl_next==(NSLOT-1)*SLOTB)?0:sl_next+SLOTB;bto+=KVBLK;}while(0)
  DMA_K(2,2*SLOTB);
  WAIT_BAR(3);
  qkt(pA0,pA1,Kbase,qr,r32,hi);BIAS_MFMA(pA0,pA1);asm volatile("s_nop 15\n\ts_nop 7":"+v"(pA0),"+v"(pA1));CMASK(pA0,pA1,0);
  START(pA0,pA1);
  _Pragma("unroll") for(int r=0;r<16;++r)pA1[r]=__builtin_amdgcn_exp2f(pA1[r]);
  WAIT_BAR(0);
  DMA_K(3,0);DMA_V(1,SLOTB);
  ROT();
  kload8(kf,kp0+sl_cur);
  WAIT_BAR(2);
  s16x4 vlo[8],vhi[8]; u32x4 pw0,pw1,pw2,pw3;
  #define PKW(P,B) cvtpk_s(P[B],P[B+1])
  #define PAF(k) __builtin_bit_cast(bf16x8,pw##k)
  #define VFR(i) (bf16x8){vlo[i][0],vlo[i][1],vlo[i][2],vlo[i][3],vhi[i][0],vhi[i][1],vhi[i][2],vhi[i][3]}
  #define PIN(x) asm volatile("":"+v"(x))
  #define MX3(a,b,c) __builtin_fmaxf(__builtin_fmaxf((a),(b)),(c))
  #define GAPA(MF,A0,A1,A2,A3,W0,W1,PW) do{ MF; sacc+=A0; sacc+=A1; sacc+=A2; sacc+=A3; PIN(sacc); W0; W1; PIN(PW); SBAR(); }while(0)
  #define EX(v) __builtin_amdgcn_exp2f(v)
  #define GAPB(MF,X,B) do{ MF; X[B]=EX(X[B]); X[B+1]=EX(X[B+1]); X[B+2]=EX(X[B+2]); X[B+3]=EX(X[B+3]); PIN(X); SBAR(); }while(0)
  #define VRD(i) do{ vlo[i]=vtr(vp_+(((i)>>2)*4096+((i)&3)*1024)); vhi[i]=vtr(vp_+(((i)>>2)*4096+((i)&3)*1024+512)); }while(0)
  #define KRD(G,j) do{ if(G){ kload2(kf,kp0+sl_next,j); SBAR(); } }while(0)
  #define STEP(C0,C1,P0,P1,t,GK,GV,GL) do{ SBAR(); \
    const lds_cptr vp_=vp0+sl_prev; \
    VRD(0); SBAR(); float sacc=(P0[0]+P0[1]); \
    GAPA(C0=__builtin_amdgcn_mfma_f32_32x32x16_bf16(kf[0],qr[0],(f32x16){},0,0,0), P0[2],P0[3],P0[4],P0[5],     pw0[0]=PKW(P0,0), pw0[1]=PKW(P0,2), pw0); \
    VRD(4); SBAR(); GAPA(C1=__builtin_amdgcn_mfma_f32_32x32x16_bf16(kf[1],qr[0],(f32x16){},0,0,0), P0[6],P0[7],P0[8],P0[9],     pw0[2]=PKW(P0,4), pw0[3]=PKW(P0,6), pw0); \
    VRD(1); SBAR(); GAPA(C0=__builtin_amdgcn_mfma_f32_32x32x16_bf16(kf[2],qr[1],C0,0,0,0),   P0[10],P0[11],P0[12],P0[13], pw1[0]=PKW(P0,8), pw1[1]=PKW(P0,10), pw1); \
    VRD(5); SBAR(); GAPA(C1=__builtin_amdgcn_mfma_f32_32x32x16_bf16(kf[3],qr[1],C1,0,0,0),   P0[14],P0[15],P1[0],P1[1],   pw1[2]=PKW(P0,12),pw1[3]=PKW(P0,14), pw1); \
    VRD(2); SBAR(); GAPA(C0=__builtin_amdgcn_mfma_f32_32x32x16_bf16(kf[4],qr[2],C0,0,0,0),   P1[2],P1[3],P1[4],P1[5],     pw2[0]=PKW(P1,0), pw2[1]=PKW(P1,2), pw2); \
    VRD(6); SBAR(); GAPA(C1=__builtin_amdgcn_mfma_f32_32x32x16_bf16(kf[5],qr[2],C1,0,0,0),   P1[6],P1[7],P1[8],P1[9],     pw2[2]=PKW(P1,4), pw2[3]=PKW(P1,6), pw2); \
    VRD(3); SBAR(); GAPA(C0=__builtin_amdgcn_mfma_f32_32x32x16_bf16(kf[6],qr[3],C0,0,0,0),   P1[10],P1[11],P1[12],P1[13], pw3[0]=PKW(P1,8), pw3[1]=PKW(P1,10), pw3); \
    VRD(7); SBAR(); GAPA(C1=__builtin_amdgcn_mfma_f32_32x32x16_bf16(kf[7],qr[3],C1,0,0,0),   P1[14],P1[15],0.f,0.f,       pw3[2]=PKW(P1,12),pw3[3]=PKW(P1,14), pw3); \
    BIAS_MFMA(C0,C1); \
    l_reg+=sacc; \
    if(GK){DMA_K((t)+3,sl_cur);} if(GV){DMA_V((t)+1,sl_next);} \
    CMASK(C0,C1,t); \
    { float a=MX3(C0[0],C0[1],C1[0]),b=MX3(C0[2],C0[3],C1[1]); a=MX3(a,C1[2],C1[3]); \
      _Pragma("unroll") for(int r=4;r<16;r+=4){a=MX3(a,C0[r],C0[r+1]);b=MX3(b,C0[r+2],C0[r+3]);a=MX3(a,C1[r],C1[r+1]);b=MX3(b,C1[r+2],C1[r+3]);} \
      float rm=__builtin_fmaxf(a,b); { auto rr=__builtin_amdgcn_permlane32_swap(__float_as_uint(rm),__float_as_uint(rm),false,false); rm=__builtin_fmaxf(__uint_as_float(rr[0]),__uint_as_float(rr[1])); } \
      resc=false; \
      if(__builtin_expect(__any(rm>(float)THRL),0)){ const float dl=__builtin_fmaxf(rm,0.f); mhat+=dl; \
        _Pragma("unroll") for(int r=0;r<16;++r){C0[r]-=dl;C1[r]-=dl;} \
        UPDQM(); \
        const float f=__builtin_amdgcn_exp2f(-dl); l_reg*=f; if(hi==0)wsf[r32]=f; resc=true; } } \
    SBAR(); \
    GAPB(o[0]=__builtin_amdgcn_mfma_f32_32x32x16_bf16(PAF(0),VFR(0),o[0],0,0,0), C0,0); \
    GAPB(o[1]=__builtin_amdgcn_mfma_f32_32x32x16_bf16(PAF(0),VFR(4),o[1],0,0,0), C0,4); \
    KRD(GL,0); GAPB(o[0]=__builtin_amdgcn_mfma_f32_32x32x16_bf16(PAF(1),VFR(1),o[0],0,0,0), C0,8); \
    KRD(GL,1); GAPB(o[1]=__builtin_amdgcn_mfma_f32_32x32x16_bf16(PAF(1),VFR(5),o[1],0,0,0), C0,12); \
    KRD(GL,2); GAPB(o[0]=__builtin_amdgcn_mfma_f32_32x32x16_bf16(PAF(2),VFR(2),o[0],0,0,0), C1,0); \
    KRD(GL,3); GAPB(o[1]=__builtin_amdgcn_mfma_f32_32x32x16_bf16(PAF(2),VFR(6),o[1],0,0,0), C1,4); \
    GAPB(o[0]=__builtin_amdgcn_mfma_f32_32x32x16_bf16(PAF(3),VFR(3),o[0],0,0,0), C1,8); \
    GAPB(o[1]=__builtin_amdgcn_mfma_f32_32x32x16_bf16(PAF(3),VFR(7),o[1],0,0,0), C1,12); \
    }while(0)
  int t=1;
  #undef CMASK
  #define CMASK(P0,P1,t) do{}while(0)
  for(;t+5<NT;t+=2){
    STEP(pB0,pB1,pA0,pA1,t,true,true,true);     WAIT_BAR(2); RESC(); ROT();
    STEP(pA0,pA1,pB0,pB1,t+1,true,true,true);   WAIT_BAR(2); RESC(); ROT();
  }
  #undef CMASK
  #define CMASK(P0,P1,t) do{ if((t)>=NT-4) emask(P0,P1,(un.t0+(t))*KVBLK+4*hi,klo,khi); }while(0)
  #define ENDW(tt) do{ if((tt)+3<NT){WAIT_BAR(2);} else if((tt)+2<NT){WAIT_BAR(1);} else {WAIT_BAR(0);} }while(0)
  for(;t+1<NT;t+=2){
    STEP(pB0,pB1,pA0,pA1,t,(t+3<NT),(t+1<NT),(t+1<NT));       ENDW(t);   RESC(); ROT();
    STEP(pA0,pA1,pB0,pB1,t+1,(t+4<NT),(t+2<NT),(t+2<NT));     ENDW(t+1); RESC(); ROT();
  }
  STEP(pB0,pB1,pA0,pA1,NT-1,false,false,false); RESC();
  { float sacc=pB0[0]+pB0[1]; _Pragma("unroll") for(int r=2;r<16;++r)sacc+=pB0[r]; _Pragma("unroll") for(int r=0;r<16;++r)sacc+=pB1[r]; l_reg+=sacc;
    pw0=(u32x4){PKW(pB0,0),PKW(pB0,2),PKW(pB0,4),PKW(pB0,6)};pw1=(u32x4){PKW(pB0,8),PKW(pB0,10),PKW(pB0,12),PKW(pB0,14)};pw2=(u32x4){PKW(pB1,0),PKW(pB1,2),PKW(pB1,4),PKW(pB1,6)};pw3=(u32x4){PKW(pB1,8),PKW(pB1,10),PKW(pB1,12),PKW(pB1,14)};
    SBAR(); pv(o,vb0+sl_cur,PAF(0),PAF(1),PAF(2),PAF(3)); }
  #undef PKW
  #undef PAF
  #undef VFR
  #undef PIN
  #undef MX3
  #undef GAPA
  #undef GAPB
  #undef EX
  #undef VRD
  #undef KRD
  #undef STEP
  #undef ENDW
  {auto rr=__builtin_amdgcn_permlane32_swap(__float_as_uint(l_reg),__float_as_uint(l_reg),false,false);l_reg=__uint_as_float(rr[0])+__uint_as_float(rr[1]);}
  if(hi==0)wsf[32+r32]=un.colscale(wid,r32)*__builtin_amdgcn_rcpf(l_reg);asm volatile("s_waitcnt lgkmcnt(0)":::"memory");
  float rli[16];
  #pragma unroll
  for(int r=0;r<16;++r)rli[r]=wsf[32+crow(r,hi)];
  bf16*Ow=un.Ob+(long)wid*un.owstride;
  { bf16*stg=(bf16*)(shm+LDS_OST)+wid*2048;
    #pragma unroll
    for(int r=0;r<16;++r){const int orow=crow(r,hi);
      #pragma unroll
      for(int d0=0;d0<2;++d0){ float v_=o[d0][r]*rli[r]; if(OMODE>=2) v_+=__bfloat162float(stg[orow*64+d0*32+r32]); stg[orow*64+d0*32+r32]=__float2bfloat16(v_);} }
    asm volatile("s_waitcnt lgkmcnt(0)":::"memory");
    if(OMODE==0||OMODE==3){
    #pragma unroll
    for(int i=0;i<4;++i){const int row=i*8+(lane>>3),ch=lane&7; const u32x4 v=*(const u32x4*)(stg+row*64+ch*8); bf16*gp=Ow+(long)(row>>ORS)*DM+(row&((1<<ORS)-1))*D+ch*8;
      ATTN_STORE16(gp,v);} } }
  asm volatile("s_waitcnt lgkmcnt(0)\n\ts_barrier":::"memory");
  #undef DMA_K
  #undef TABS
  #undef BIAS_MFMA
  #undef UPDQM
  #undef DMA_V
  #undef CMASK
  #undef START
  #undef RESC
  #undef ROT
}
constexpr int ATTN_LDS_BYTES=LDS_BYTES;
#undef SBAR
#undef WAIT_BAR
}
#define GAS __attribute__((address_space(1)))
#define LAS __attribute__((address_space(3)))
typedef unsigned short bf16;
typedef unsigned v4u __attribute__((ext_vector_type(4)));
typedef float f32x4 __attribute__((ext_vector_type(4)));
typedef short bf16x8 __attribute__((ext_vector_type(8)));
typedef GAS unsigned gu32;
typedef GAS unsigned long long gu64;
#define RLX_AGENT __ATOMIC_RELAXED, __HIP_MEMORY_SCOPE_AGENT
#define LDS_WAIT() asm volatile("s_waitcnt lgkmcnt(0)" ::: "memory")
#define VM_WAIT() asm volatile("s_waitcnt vmcnt(0)" ::: "memory")
__device__ __forceinline__ unsigned long long rt() { return __builtin_amdgcn_s_memrealtime(); }
__device__ __forceinline__ unsigned f2bf(float f) { unsigned u = __builtin_bit_cast(unsigned, f); return (u + 0x7fffu + ((u >> 16) & 1u)) >> 16; }
__device__ __forceinline__ unsigned pk2(float lo, float hi) { return f2bf(lo) | (f2bf(hi) << 16); }

#define XB_TMO      128
#define XB_XCNT(j)  (256  + 64 * (j))
#define XB_XSUB(j)  (1280 + 64 * (j))
#define XB_XGEN(j)  (2304 + 64 * (j))
#define XB_TOP      3328
#define XB_TOPGEN   3392
#define XCD_BAR_WORDS 3456
#define XB_SPIN_CAP (1u << 25)

__device__ __forceinline__ unsigned xb_ld(unsigned* p)              { return __hip_atomic_load(p, __ATOMIC_RELAXED, __HIP_MEMORY_SCOPE_AGENT); }
__device__ __forceinline__ unsigned xb_add(unsigned* p, unsigned v) { return __hip_atomic_fetch_add(p, v, __ATOMIC_RELAXED, __HIP_MEMORY_SCOPE_AGENT); }
__device__ __forceinline__ unsigned xb_xcc_id() { return (unsigned)__builtin_amdgcn_s_getreg((3 << 11) | 20) & 0xFu; }
#define XB_SPIN(cond, bar) do { unsigned _sp = 0; while (cond) { __builtin_amdgcn_s_sleep(1); \
    if ((++_sp & 255u) == 0u) { if (xb_ld(&(bar)[XB_TMO])) break; if (_sp > XB_SPIN_CAP) { atomicAdd(&(bar)[XB_TMO], 1u); break; } } } } while (0)

struct XcdBarrier {
    unsigned* bar; unsigned x;
    volatile LAS unsigned* st;
};

__device__ __forceinline__ XcdBarrier xcd_barrier_post(unsigned* bar, volatile LAS unsigned* st) {
    XcdBarrier b; b.bar = bar; b.x = xb_xcc_id(); b.st = st;
    if (threadIdx.x == 0) (void)xb_add(&bar[XB_XCNT(b.x)], 1u);
    return b;
}
__device__ __forceinline__ void xcd_barrier_complete(unsigned* bar, unsigned x, unsigned& nloc, unsigned& nx) {
    const unsigned G = gridDim.x * gridDim.y * gridDim.z;
    unsigned sum, cnt, mine, sp = 0u;
    for (;;) {
        sum = 0u; cnt = 0u; mine = 0u;
#pragma unroll
        for (unsigned j = 0; j < 16; ++j) { const unsigned c = xb_ld(&bar[XB_XCNT(j)]); sum += c; cnt += (c > 0u) ? 1u : 0u; mine = (j == x) ? c : mine; }
        if (sum == G) break;
        __builtin_amdgcn_s_sleep(1);
        if ((++sp & 255u) == 0u) { if (xb_ld(&bar[XB_TMO])) break; if (sp > XB_SPIN_CAP) { atomicAdd(&bar[XB_TMO], 1u); break; } }
    }
    nloc = mine > 0u ? mine : 1u; nx = cnt > 0u ? cnt : 1u;
}

__device__ __forceinline__ void xcd_barrier(const XcdBarrier& b) {
    asm volatile("s_waitcnt vmcnt(0)" ::: "memory");
    __syncthreads();
    if (threadIdx.x == 0) {
        unsigned* bar = b.bar;
        __builtin_amdgcn_s_waitcnt(0);
        unsigned nloc = b.st[0], nx = b.st[1];
        if (nloc == 0u) { xcd_barrier_complete(bar, b.x, nloc, nx); b.st[0] = nloc; b.st[1] = nx; }
        const unsigned old = xb_add(&bar[XB_XSUB(b.x)], 1u);
        const unsigned gen = old / nloc;
        if (old + 1u == (gen + 1u) * nloc) {
            __builtin_amdgcn_fence(__ATOMIC_RELEASE, "agent");
            asm volatile("s_waitcnt vmcnt(0)" ::: "memory");
            const unsigned og = xb_add(&bar[XB_TOP], 1u);
            const unsigned tg = og / nx;
            if (og + 1u == (tg + 1u) * nx) xb_add(&bar[XB_TOPGEN], 1u);
            else XB_SPIN(xb_ld(&bar[XB_TOPGEN]) == tg, bar);
            __builtin_amdgcn_fence(__ATOMIC_ACQUIRE, "agent");
            xb_add(&bar[XB_XGEN(b.x)], 1u);
            asm volatile("s_waitcnt vmcnt(0)" ::: "memory");
        } else {
            XB_SPIN(xb_ld(&bar[XB_XGEN(b.x)]) == gen, bar);
            __builtin_amdgcn_fence(__ATOMIC_ACQUIRE, "agent");
            asm volatile("s_waitcnt vmcnt(0)" ::: "memory");
        }
    }
    __syncthreads();
}
#include <type_traits>
#ifndef PH_MASK
#define PH_MASK 0xFFFF
#endif
#define PH_EN(n) ((PH_MASK >> (n)) & 1)
#ifndef TIME_LSEL
#define TIME_LSEL -1
#endif
#ifndef TIME_LSEL2
#define TIME_LSEL2 TIME_LSEL
#endif
#ifndef TIME_MUL
#define TIME_MUL 1.f
#endif
#ifndef MK_MULTI
#define MK_MULTI 0
#endif
constexpr int NWAVES = 8, NTHR = 512;
constexpr int Bn = 2, S = 8192, T = Bn * S, D = 1024, NH = 16, HD = 64, DEPTH = 4;
constexpr int NE = 64, ED = 256, TOPK = 8, PLE = 256;
constexpr int NSA_G = 4, NCMP = 512;
constexpr float LN_EPS = 1e-5f, NEGF = -1e30f;
constexpr float DN_ALPHA = 1.681792830507429f;
constexpr float ATT_SCALE = 0.125f, QSC = 0.6931471805599453f;
constexpr int NPH = 13;

constexpr size_t MiB = 1u << 20;
constexpr size_t WS_CTL = 0, CTL_ZERO_BYTES = 1 * MiB;
constexpr size_t WS_ROPE_C = 2 * MiB, WS_ROPE_S = 4 * MiB;
constexpr size_t WS_LOGF = 6 * MiB, WS_CUM = 7 * MiB;
constexpr size_t WS_GATES = 8 * MiB;
constexpr size_t WS_KMEAN = 11 * MiB;
constexpr size_t WS_KCMP = 12 * MiB, WS_VCMP = 13 * MiB;
constexpr size_t WS_VCT = 13 * MiB + 512 * 1024;
constexpr size_t WS_PEB = 11 * MiB + 512 * 1024;
constexpr size_t WS_WRT = 11 * MiB + 768 * 1024;
constexpr size_t WS_H1 = 20 * MiB;
constexpr size_t WS_WC1 = 278 * MiB;
constexpr size_t WS_ROWTOK = 24 * MiB;
constexpr size_t WS_LS32 = 18 * MiB + 512 * 1024;
constexpr size_t WS_SELMG = 18 * MiB;
constexpr size_t WS_TOKE = 14 * MiB, WS_TOKW = 15 * MiB, WS_TOKP = 16 * MiB;
constexpr size_t WS_ROWW = 17 * MiB;
constexpr size_t WS_X = 32 * MiB;
constexpr size_t WS_XBA = 96 * MiB, WS_XBB = 128 * MiB;
constexpr size_t WS_WIN = 160 * MiB, WS_WOUT = 166 * MiB, WS_WGU = 168 * MiB, WS_WDN = 233 * MiB, WS_WPG = 266 * MiB, WS_WPP = 268 * MiB;
constexpr size_t WS_PB = 270 * MiB;
constexpr size_t WS_Q = 280 * MiB, WS_K = 312 * MiB, WS_V = 344 * MiB;
constexpr size_t WS_AO = 376 * MiB;
constexpr size_t WS_PP = 408 * MiB;
constexpr size_t WS_QR = 504 * MiB;
constexpr size_t WS_H = 280 * MiB;
constexpr size_t WS_XG = 440 * MiB;
constexpr size_t WS_OUTR = 440 * MiB;
constexpr size_t WS_SET1 = 600 * MiB;
constexpr size_t WS_PEB1 = 11 * MiB + 512 * 1024 + 4096, WS_WRT1 = 11 * MiB + 256 * 1024;
constexpr size_t WS_END = 880 * MiB;
constexpr int R_PAD_TILES = 576, XG_TILE0 = (int)((WS_XG - WS_XBA) / (256 * 1024 * 2));
static_assert((WS_XG - WS_XBA) % (256 * 1024 * 2) == 0, "XG tile alignment");
constexpr int CW_TMO = 0, CW_CODE = 1, CW_BAR = 4096, CW_CNT = 16384  , CW_CHK = 9216, CW_TS = 10240, CW_NRM = 12288, CW_Q = 12800;

constexpr int RING_BYTES = 131072, TAB_OFF = RING_BYTES, MISC_OFF = RING_BYTES + 9216, LDS_BYTES = 147456;

typedef unsigned short bf16_t;
__device__ __forceinline__ float bf2f(unsigned short h) { return __uint_as_float(((unsigned)h) << 16); }
__device__ __forceinline__ float bflo(unsigned u) { return __uint_as_float(u << 16); }
__device__ __forceinline__ float bfhi(unsigned u) { return __uint_as_float(u & 0xffff0000u); }
template <int O> __device__ __forceinline__ float xor_f(float v) { return __int_as_float(__builtin_amdgcn_ds_swizzle(__float_as_int(v), 0x1F | (O << 10))); }
template <int O> __device__ __forceinline__ int xor_i(int v) { return __builtin_amdgcn_ds_swizzle(v, 0x1F | (O << 10)); }
__device__ __forceinline__ float bcast_f(float v, int srclane) { return __int_as_float(__builtin_amdgcn_readlane(__float_as_int(v), srclane)); }
__device__ __forceinline__ float wave_sum(float v) {
    v += xor_f<1>(v); v += xor_f<2>(v); v += xor_f<4>(v); v += xor_f<8>(v); v += xor_f<16>(v);
    auto rr = __builtin_amdgcn_permlane32_swap(__float_as_uint(v), __float_as_uint(v), false, false); return __uint_as_float(rr[0]) + __uint_as_float(rr[1]);
}
__device__ __forceinline__ float wave_max(float v) {
    v = fmaxf(v, xor_f<1>(v)); v = fmaxf(v, xor_f<2>(v)); v = fmaxf(v, xor_f<4>(v)); v = fmaxf(v, xor_f<8>(v)); v = fmaxf(v, xor_f<16>(v));
    auto rr = __builtin_amdgcn_permlane32_swap(__float_as_uint(v), __float_as_uint(v), false, false); return fmaxf(__uint_as_float(rr[0]), __uint_as_float(rr[1]));
}
#define WAVE_SYNC() do { asm volatile("s_waitcnt lgkmcnt(0)" ::: "memory"); __builtin_amdgcn_wave_barrier(); } while (0)

namespace epi {
using pg8::f32x4; using pg8::u32x4; using pg8::Unit; using pg8::cvt_pk_bf16; using pg8::HALF; using pg8::BM;
struct Qkv {
    static constexpr bool PERM = true, AFTER_DRAIN = false;
    bf16_t* O0; int ncq, ld0; bf16_t* O1; int w1, ld1; size_t stride1; float scale0;
    __device__ __forceinline__ void operator()(const f32x4 (&acc)[2][2][4][2], const Unit& u, int wr, int wc, int fr, int fq) const {
        const int row0 = u.pm * BM + wr * 64 + fr; int colt = u.pn * BM; bf16_t* base; int ldc; float sc = 1.f;
        if (colt < ncq) { base = O0; ldc = ld0; sc = scale0; } else { colt -= ncq; const int j = colt / w1; colt -= j * w1; base = O1 + (size_t)j * stride1; ldc = ld1; }
        const int col0 = colt + wc * 32 + 8 * fq;
#pragma unroll
        for (int ai = 0; ai < 2; ++ai)
#pragma unroll
            for (int m = 0; m < 4; ++m) { bf16_t* rowp = base + (size_t)(row0 + ai * HALF + m * 16) * ldc + col0;
#pragma unroll
                for (int bj = 0; bj < 2; ++bj) { const f32x4 v0 = acc[ai][bj][m][0] * sc, v1 = acc[ai][bj][m][1] * sc;
                    u32x4 w; w.x = cvt_pk_bf16(v0[0], v0[1]); w.y = cvt_pk_bf16(v0[2], v0[3]); w.z = cvt_pk_bf16(v1[0], v1[1]); w.w = cvt_pk_bf16(v1[2], v1[3]);
                    *(u32x4*)(rowp + bj * HALF) = w; } }
    }
};
template <bool BF> struct Res {
    static constexpr bool PERM = true, AFTER_DRAIN = false;
    _Float16* X; const void* base; int ldc; float alpha;
    __device__ __forceinline__ void operator()(const f32x4 (&acc)[2][2][4][2], const Unit& u, int wr, int wc, int fr, int fq) const {
        typedef _Float16 h8 __attribute__((ext_vector_type(8)));
        const int row0 = u.pm * BM + wr * 64 + fr, col0 = u.pn * BM + wc * 32 + 8 * fq;
#pragma unroll
        for (int ai = 0; ai < 2; ++ai)
#pragma unroll
            for (int m = 0; m < 4; ++m) { const size_t ro = (size_t)(row0 + ai * HALF + m * 16) * ldc + col0;
#pragma unroll
                for (int bj = 0; bj < 2; ++bj) { const size_t off = ro + bj * HALF; f32x4 x0, x1;
                    if (BF) { const u32x4 w = *(const u32x4*)((const bf16_t*)base + off); x0 = (f32x4){bflo(w.x), bfhi(w.x), bflo(w.y), bfhi(w.y)}; x1 = (f32x4){bflo(w.z), bfhi(w.z), bflo(w.w), bfhi(w.w)}; }
                    else { x0 = *(const f32x4*)((const float*)base + off); x1 = *(const f32x4*)((const float*)base + off + 4); }
                    const f32x4 o0 = x0 * alpha + acc[ai][bj][m][0], o1 = x1 * alpha + acc[ai][bj][m][1];
                    *(h8*)(X + off) = (h8){(_Float16)o0[0], (_Float16)o0[1], (_Float16)o0[2], (_Float16)o0[3], (_Float16)o1[0], (_Float16)o1[1], (_Float16)o1[2], (_Float16)o1[3]}; } }
    }
};
struct SwiGlu {
    static constexpr bool PERM = true, AFTER_DRAIN = false;
    bf16_t* Hh; int xg0;
    __device__ __forceinline__ void operator()(const f32x4 (&acc)[2][2][4][2], const Unit& u, int wr, int wc, int fr, int fq) const {
        const int ht = (int)u.aofs; const int row0 = ht * BM + wr * 64 + fr; const int col0 = (u.pn & 1) * 128 + wc * 32 + 8 * fq;
#pragma unroll
        for (int ai = 0; ai < 2; ++ai)
#pragma unroll
            for (int m = 0; m < 4; ++m) { bf16_t* rowp = Hh + (size_t)(row0 + ai * HALF + m * 16) * ED + col0;
                float h[8];
#pragma unroll
                for (int n = 0; n < 2; ++n)
#pragma unroll
                    for (int j = 0; j < 4; ++j) { const float g = acc[ai][0][m][n][j], up = acc[ai][1][m][n][j];
                        const float sg = g * __builtin_amdgcn_rcpf(1.f + __builtin_amdgcn_exp2f(-g * 1.4426950408889634f)); h[n * 4 + j] = sg * up; }
                u32x4 w; w.x = cvt_pk_bf16(h[0], h[1]); w.y = cvt_pk_bf16(h[2], h[3]); w.z = cvt_pk_bf16(h[4], h[5]); w.w = cvt_pk_bf16(h[6], h[7]);
                *(u32x4*)rowp = w; }
    }
};
struct Down {
    static constexpr bool PERM = true, AFTER_DRAIN = false;
    bf16_t* O;
    __device__ __forceinline__ void operator()(const f32x4 (&acc)[2][2][4][2], const Unit& u, int wr, int wc, int fr, int fq) const {
        const int row0 = u.pm * BM + wr * 64 + fr; const int col0 = (u.pn & 3) * BM + wc * 32 + 8 * fq;
#pragma unroll
        for (int ai = 0; ai < 2; ++ai)
#pragma unroll
            for (int m = 0; m < 4; ++m) { const int row = row0 + ai * HALF + m * 16; const float sc = 1.f;
#if defined(OUTR_FP8)
                typedef unsigned u32x2 __attribute__((ext_vector_type(2)));
                unsigned char* rowp = (unsigned char*)O + (size_t)row * D + col0;
#pragma unroll
                for (int bj = 0; bj < 2; ++bj) { f32x4 v0 = acc[ai][bj][m][0] * (64.f * sc), v1 = acc[ai][bj][m][1] * (64.f * sc);
#pragma unroll
                    for (int e = 0; e < 4; ++e) { v0[e] = fminf(fmaxf(v0[e], -440.f), 440.f); v1[e] = fminf(fmaxf(v1[e], -440.f), 440.f); }
                    u32x2 w; int t0 = __builtin_amdgcn_cvt_pk_fp8_f32(v0[0], v0[1], 0, false); t0 = __builtin_amdgcn_cvt_pk_fp8_f32(v0[2], v0[3], t0, true);
                    int t1 = __builtin_amdgcn_cvt_pk_fp8_f32(v1[0], v1[1], 0, false); t1 = __builtin_amdgcn_cvt_pk_fp8_f32(v1[2], v1[3], t1, true); w.x = (unsigned)t0; w.y = (unsigned)t1;
                    *(u32x2*)(rowp + bj * HALF) = w; } }
#else
                bf16_t* rowp = O + (size_t)row * D + col0;
#pragma unroll
                for (int bj = 0; bj < 2; ++bj) { const f32x4 v0 = acc[ai][bj][m][0] * sc, v1 = acc[ai][bj][m][1] * sc;
                    u32x4 w; w.x = cvt_pk_bf16(v0[0], v0[1]); w.y = cvt_pk_bf16(v0[2], v0[3]); w.z = cvt_pk_bf16(v1[0], v1[1]); w.w = cvt_pk_bf16(v1[2], v1[3]);
                    *(u32x4*)(rowp + bj * HALF) = w; } }
#endif
    }
};
struct StoreBf16 {
    static constexpr bool PERM = true, AFTER_DRAIN = false;
    bf16_t* O; int ldc;
    __device__ __forceinline__ void operator()(const f32x4 (&acc)[2][2][4][2], const Unit& u, int wr, int wc, int fr, int fq) const {
        const int row0 = u.pm * BM + wr * 64 + fr; const int col0 = u.pn * BM + wc * 32 + 8 * fq;
#pragma unroll
        for (int ai = 0; ai < 2; ++ai)
#pragma unroll
            for (int m = 0; m < 4; ++m) { bf16_t* rowp = O + (size_t)(row0 + ai * HALF + m * 16) * ldc + col0;
#pragma unroll
                for (int bj = 0; bj < 2; ++bj) { const f32x4 v0 = acc[ai][bj][m][0], v1 = acc[ai][bj][m][1];
                    u32x4 w; w.x = cvt_pk_bf16(v0[0], v0[1]); w.y = cvt_pk_bf16(v0[2], v0[3]); w.z = cvt_pk_bf16(v1[0], v1[1]); w.w = cvt_pk_bf16(v1[2], v1[3]);
                    *(u32x4*)(rowp + bj * HALF) = w; } }
    }
};
template <bool LAST> struct Ple {
    static constexpr bool PERM = true, AFTER_DRAIN = false;
    const bf16_t* XB; const bf16_t* PP; float* OutF; bf16_t* XBn;
    __device__ __forceinline__ void operator()(const f32x4 (&acc)[2][2][4][2], const Unit& u, int wr, int wc, int fr, int fq) const {
        const int row0 = u.pm * BM + wr * 64 + fr, col0 = u.pn * BM + wc * 32 + 8 * fq;
#pragma unroll
        for (int ai = 0; ai < 2; ++ai)
#pragma unroll
            for (int m = 0; m < 4; ++m) { const size_t ro = (size_t)(row0 + ai * HALF + m * 16) * D + col0;
#pragma unroll
                for (int bj = 0; bj < 2; ++bj) { const size_t off = ro + bj * HALF; const u32x4 xw = *(const u32x4*)(XB + off), pw = *(const u32x4*)(PP + off); f32x4 o[2];
#pragma unroll
                    for (int n = 0; n < 2; ++n) { const unsigned xa = n ? xw.z : xw.x, xb = n ? xw.w : xw.y, pa = n ? pw.z : pw.x, pb = n ? pw.w : pw.y; const f32x4 a = acc[ai][bj][m][n];
                        o[n][0] = bflo(xa) + bflo(pa) * __builtin_amdgcn_rcpf(1.f + __builtin_amdgcn_exp2f(-a[0] * 1.4426950408889634f));
                        o[n][1] = bfhi(xa) + bfhi(pa) * __builtin_amdgcn_rcpf(1.f + __builtin_amdgcn_exp2f(-a[1] * 1.4426950408889634f));
                        o[n][2] = bflo(xb) + bflo(pb) * __builtin_amdgcn_rcpf(1.f + __builtin_amdgcn_exp2f(-a[2] * 1.4426950408889634f));
                        o[n][3] = bfhi(xb) + bfhi(pb) * __builtin_amdgcn_rcpf(1.f + __builtin_amdgcn_exp2f(-a[3] * 1.4426950408889634f)); }
                    if (LAST) { *(f32x4*)(OutF + off) = o[0]; *(f32x4*)(OutF + off + 4) = o[1]; }
                    else { u32x4 w; w.x = cvt_pk_bf16(o[0][0], o[0][1]); w.y = cvt_pk_bf16(o[0][2], o[0][3]); w.z = cvt_pk_bf16(o[1][0], o[1][1]); w.w = cvt_pk_bf16(o[1][2], o[1][3]); *(u32x4*)(XBn + off) = w; } } }
    }
};
}

struct MoeOrder {
    const LAS int* tstart;
    int NC, G, c, NU, lists;
    __device__ __forceinline__ bool next(int i, pg8::Unit& u) const {
        const int x = c & 7, npx = G >> 3; int li = i * npx + (c >> 3); int e, j, cc, rt;
        if (li < 8 * NC) { e = 64; j = x + 8 * (li / NC); cc = li % NC; rt = j; }
        else { li -= 8 * NC; e = -1; j = 0; cc = 0; rt = 0;
            for (int q = 0; q < 8; ++q) { const int eq = x + 8 * q; const int t0 = tstart[eq], n = (tstart[eq + 1] - t0) * NC;
                if (e < 0) { if (li < n) { e = eq; j = li / NC; cc = li % NC; rt = 64 + t0 + j; } else li -= n; } }
            if (e < 0) return false; }
        u.pm = lists ? e * 64 + j : rt; u.pn = e * NC + cc; u.aofs = lists ? rt : 0; return true; }
    __device__ __forceinline__ void a_ready(const pg8::Unit&) const {}
    __device__ __forceinline__ void done(const pg8::Unit&) const {}
};

struct CmpOrder {
    int G, c;
    __device__ __forceinline__ bool next(int i, pg8::Unit& u) const { const long L = (long)i * G + c; if (L >= 32) return false;
        const int kv = (int)L >> 4, bg = ((int)L >> 1) & 7, half = (int)L & 1, b = bg >> 2, g = bg & 3;
        u.pm = 0; u.pn = kv; u.aofs = (long)kv * (8 << 20) + (long)b * (4 << 20) + g * 128 + (long)half * (2 << 20); return true; }
    __device__ __forceinline__ void a_ready(const pg8::Unit&) const {}
    __device__ __forceinline__ void done(const pg8::Unit&) const {}
};
namespace epi {
struct H1Store {
    static constexpr bool PERM = false, AFTER_DRAIN = false;
    float* H;
    __device__ __forceinline__ void operator()(const f32x4 (&acc)[2][2][4][2], const Unit& u, int wr, int wc, int fr, int fq) const {
        const long a = u.aofs; const int kv = (int)(a >> 23), b = (int)(a >> 22) & 1, half = (int)(a >> 21) & 1, g = (int)(a >> 7) & 3;
        const size_t rowb = ((size_t)(kv * 8 + b * 4 + g) * 512 + half * 256 + wr * 64 + fr);
#pragma unroll
        for (int ai = 0; ai < 2; ++ai)
#pragma unroll
            for (int m = 0; m < 4; ++m) { float* rowp = H + (rowb + ai * HALF + m * 16) * 128 + wc * 32 + 4 * fq;
#pragma unroll
                for (int n = 0; n < 2; ++n) *(f32x4*)(rowp + n * 16) = acc[ai][0][m][n]; }
    }
};
}
__device__ __forceinline__ void transpose_item(const float* W, int ldw, int k0, int n0, bf16* WT, int K, int drow0, LAS float* scr, int lane) {
#pragma unroll 8
    for (int i = 0; i < 32; ++i) { const int kk = 2 * i + (lane >> 5); scr[kk * 33 + (lane & 31)] = W[(size_t)(k0 + kk) * ldw + n0 + (lane & 31)]; }
    LDS_WAIT(); asm volatile("" ::: "memory");
    const int c = lane & 7;
#pragma unroll
    for (int j = 0; j < 4; ++j) { const int n = (lane >> 3) + 8 * j; const LAS float* s = scr + (8 * c) * 33 + n;
        v4u o; o.x = pk2(s[0 * 33], s[1 * 33]); o.y = pk2(s[2 * 33], s[3 * 33]); o.z = pk2(s[4 * 33], s[5 * 33]); o.w = pk2(s[6 * 33], s[7 * 33]);
        *(GAS v4u*)(WT + (size_t)(drow0 + n) * K + k0 + 8 * c) = o; }
    LDS_WAIT(); asm volatile("" ::: "memory");
}

__device__ __forceinline__ void transpose_item64(const float* W, int ldw, int k0, int n0, bf16* WT, int K, int drow0, int lane) {
    const int n4 = lane & 15, kg = lane >> 4; const float* src = W + (size_t)(k0 + 16 * kg) * ldw + n0 + 4 * n4;
    f32x4 v[16];
#pragma unroll
    for (int i = 0; i < 16; ++i) v[i] = __builtin_nontemporal_load((const GAS f32x4*)(src + (size_t)i * ldw));
    bf16* dst = WT + (size_t)(drow0 + 4 * n4) * K + k0 + 16 * kg;
#pragma unroll
    for (int j = 0; j < 4; ++j) { v4u a, b;
        a.x = pk2(v[0][j], v[1][j]); a.y = pk2(v[2][j], v[3][j]); a.z = pk2(v[4][j], v[5][j]); a.w = pk2(v[6][j], v[7][j]);
        b.x = pk2(v[8][j], v[9][j]); b.y = pk2(v[10][j], v[11][j]); b.z = pk2(v[12][j], v[13][j]); b.w = pk2(v[14][j], v[15][j]);
        *(GAS v4u*)(dst + (size_t)j * K) = a; *(GAS v4u*)(dst + (size_t)j * K + 8) = b; }
}

__device__ __forceinline__ void titem_load(f32x4 (&v)[16], const float* W, int ldw, int lane) {
    const int n4 = lane & 15, kg = lane >> 4; const float* src = W + (size_t)(8 * kg) * ldw + 4 * n4;
#pragma unroll
    for (int i = 0; i < 16; ++i) v[i] = __builtin_nontemporal_load((const GAS f32x4*)(src + (size_t)((i & 7) + 32 * (i >> 3)) * ldw));
}
__device__ __forceinline__ void titem_store(const f32x4 (&v)[16], bf16* WT, int K, int lane) {
    const int n4 = lane & 15, kg = lane >> 4; bf16* dst = WT + (size_t)(4 * n4) * K + 8 * kg;
#pragma unroll
    for (int j = 0; j < 4; ++j) { v4u a, b;
        a.x = gattn::cvtpk_s(v[0][j], v[1][j]); a.y = gattn::cvtpk_s(v[2][j], v[3][j]); a.z = gattn::cvtpk_s(v[4][j], v[5][j]); a.w = gattn::cvtpk_s(v[6][j], v[7][j]);
        b.x = gattn::cvtpk_s(v[8][j], v[9][j]); b.y = gattn::cvtpk_s(v[10][j], v[11][j]); b.z = gattn::cvtpk_s(v[12][j], v[13][j]); b.w = gattn::cvtpk_s(v[14][j], v[15][j]);
        *(GAS v4u*)(dst + (size_t)j * K) = a; *(GAS v4u*)(dst + (size_t)j * K + 32) = b; }
}

__device__ __forceinline__ void nitem_load(f32x4 (&v)[8], const float* W, int ldw, int lane) {
    const int n8 = lane & 7, ko = lane >> 3; const float* src = W + (size_t)(8 * ko) * ldw + 4 * n8;
#pragma unroll
    for (int i = 0; i < 8; ++i) v[i] = __builtin_nontemporal_load((const GAS f32x4*)(src + (size_t)i * ldw));
}
__device__ __forceinline__ void nitem_store(const f32x4 (&v)[8], bf16* WT, int K, int lane) {
    const int n8 = lane & 7, ko = lane >> 3; bf16* dst = WT + (size_t)(4 * n8) * K + 8 * ko;
#pragma unroll
    for (int j = 0; j < 4; ++j) { v4u a;
        a.x = gattn::cvtpk_s(v[0][j], v[1][j]); a.y = gattn::cvtpk_s(v[2][j], v[3][j]); a.z = gattn::cvtpk_s(v[4][j], v[5][j]); a.w = gattn::cvtpk_s(v[6][j], v[7][j]);
        *(GAS v4u*)(dst + (size_t)j * K) = a; }
}

template <int NHq, class KeyFn, class BiasFn>
__device__ __forceinline__ void attend_chunk(const float* qs, float* pb, int* kb, const bf16_t* Kp, const bf16_t* Vp, int pitch, int nslots,
                                             KeyFn keyfn, BiasFn biasfn, float scale, float (&m)[NHq], float (&l)[NHq], float (&o)[NHq], int lane) {
    float cm[NHq];
#pragma unroll
    for (int h = 0; h < NHq; ++h) cm[h] = NEGF;
    for (int i = 0; i < 8; ++i) {
        const int slot = lane + 64 * i;
        const int key = (slot < nslots) ? keyfn(slot) : -1;
        float s[NHq];
#pragma unroll
        for (int h = 0; h < NHq; ++h) s[h] = NEGF;
        if (key >= 0) {
            const uint4* kr = (const uint4*)(Kp + (size_t)key * pitch);
#pragma unroll
            for (int h = 0; h < NHq; ++h) s[h] = 0.f;
#pragma unroll
            for (int c = 0; c < 8; ++c) {
                const uint4 kv = kr[c];
                const float k0 = bflo(kv.x), k1 = bfhi(kv.x), k2 = bflo(kv.y), k3 = bfhi(kv.y), k4 = bflo(kv.z), k5 = bfhi(kv.z), k6 = bflo(kv.w), k7 = bfhi(kv.w);
#pragma unroll
                for (int h = 0; h < NHq; ++h) { const float4 qa = *(const float4*)(qs + h * 64 + 8 * c), qb = *(const float4*)(qs + h * 64 + 8 * c + 4);
                    s[h] += qa.x * k0 + qa.y * k1 + qa.z * k2 + qa.w * k3 + qb.x * k4 + qb.y * k5 + qb.z * k6 + qb.w * k7; }
            }
            const float bs = biasfn(slot);
#pragma unroll
            for (int h = 0; h < NHq; ++h) { s[h] = s[h] * scale + bs; cm[h] = fmaxf(cm[h], s[h]); }
        }
#pragma unroll
        for (int h = 0; h < NHq; ++h) pb[h * 512 + slot] = s[h];
        kb[slot] = key;
    }
    float f[NHq], mn[NHq], ls[NHq];
#pragma unroll
    for (int h = 0; h < NHq; ++h) { mn[h] = fmaxf(m[h], wave_max(cm[h])); f[h] = __expf(m[h] - mn[h]); ls[h] = 0.f; }
    WAVE_SYNC();
    for (int i = 0; i < 8; ++i) {
        const int slot = lane + 64 * i; const bool ok = kb[slot] >= 0;
#pragma unroll
        for (int h = 0; h < NHq; ++h) { const float p = ok ? __expf(pb[h * 512 + slot] - mn[h]) : 0.f; pb[h * 512 + slot] = p; ls[h] += p; }
    }
#pragma unroll
    for (int h = 0; h < NHq; ++h) { l[h] = l[h] * f[h] + wave_sum(ls[h]); o[h] *= f[h]; m[h] = mn[h]; }
    WAVE_SYNC();
    const int ns8 = (nslots + 7) & ~7;
    for (int sl = 0; sl < ns8; sl += 8) {
#pragma unroll
        for (int u = 0; u < 8; ++u) { const int key = kb[sl + u]; const int kk = key < 0 ? 0 : key; const float v = bf2f(Vp[(size_t)kk * pitch + lane]);
#pragma unroll
            for (int h = 0; h < NHq; ++h) o[h] += pb[h * 512 + sl + u] * v; }
    }
    WAVE_SYNC();
}

typedef gattn::bf16 abf16;
struct FoxU {
    const abf16 *Kb, *Vb; int kpitch, t0, NT, tmax; const float* cum; int q0; abf16* Ob; long owstride; const abf16* Qb; const LAS unsigned* mtab;
    __device__ __forceinline__ const abf16* qrow(int wid, int r32) const { return Qb + (long)(wid * 32 + r32) * D; }
    __device__ __forceinline__ int klo(int, int) const { return -2147483647; }
    __device__ __forceinline__ int khi(int wid, int r32) const { return q0 + wid * 32 + r32; }
    __device__ __forceinline__ float colscale(int, int) const { return 1.f; }
    __device__ __forceinline__ unsigned term(int wid, int r32, int tabs) const { return mtab ? (((mtab[wid * 32 + r32] >> (tabs >> 2)) & 1u) ? 0u : 0xC700u) : 0u; }
};
__device__ __forceinline__ void fox_order(int vcu, int i, int& bh, int& qb) { const int s = vcu & 7; bh = vcu >> 3; qb = (i == 0) ? s : (i == 1) ? 15 - s : (i == 2) ? 16 + s : 31 - s; }

struct NsaU {
    const abf16 *Kb, *Vb; int kpitch, t0, NT, tmax; const float* cum; int q0; abf16* Ob; long owstride; const abf16* Qb; const LAS unsigned* selm; const float* gates; int br; int wlen;
    __device__ __forceinline__ const abf16* qrow(int wid, int r32) const { return Qb + (long)(wid * 8 + (r32 >> 2)) * D + (r32 & 3) * 64; }
    __device__ __forceinline__ int khi(int wid, int r32) const { return q0 + wid * 8 + (r32 >> 2); }
    __device__ __forceinline__ int klo(int wid, int r32) const { return wlen ? q0 + wid * 8 + (r32 >> 2) - (wlen - 1) : -2147483647; }
    __device__ __forceinline__ float colscale(int wid, int r32) const { return gates[(wid * 8 + (r32 >> 2)) * 48 + (r32 & 3) * 3 + br]; }
    __device__ __forceinline__ unsigned term(int wid, int r32, int tabs) const {
        if (selm) { const unsigned w = selm[(wid * 8 + (r32 >> 2)) * 4 + ((tabs >> 5) & 3)]; return (tabs < 128 && ((w >> (tabs & 31)) & 1u)) ? 0u : 0xC700u; }
        return tabs < 0 ? 0xC700u : 0u; }
};
constexpr int NSA_IMP_LD = 132;
constexpr int NSA_LDS_IMP = gattn::LDS_BT, NSA_LDS_SELM = NSA_LDS_IMP + 64 * NSA_IMP_LD * 4, NSA_LDS_PRI = NSA_LDS_SELM + 1024;
static_assert(NSA_LDS_PRI + 8 * 512 <= RING_BYTES, "NSA LDS map");
__device__ __forceinline__ int swapmid(int x) { return (x & 3) | ((x & 4) << 1) | ((x & 8) >> 1); }

__device__ __forceinline__ void nsa_cmp_select(char* shm, int b, int g, int q0, const bf16_t* QBs, const bf16_t* KCMPs, const bf16_t* VCTs, const float* GATESs, unsigned* selm_g) {
    using gattn::bf16x8; using gattn::f32x16; using gattn::u32x4; using gattn::crow; using gattn::cvtpk_s;
    int tid_o = threadIdx.x; asm volatile("" : "+v"(tid_o)); const int tid = tid_o, lane = tid & 63, r32 = lane & 31, hi = lane >> 5; const int wid = __builtin_amdgcn_readfirstlane(tid >> 6);
    const size_t rb = (size_t)b * S; const int bg = b * NSA_G + g;
    const int tl = r32 >> 2, hh = r32 & 3, tq = q0 + wid * 8 + tl;
    const int nv = tq >= 31 ? ((tq - 31) >> 4) + 1 : 0;
    const int nvmax = ((q0 + 63 - 31) >> 4) + 1, ntile = (nvmax + 63) >> 6;
    float* imp = (float*)(shm + NSA_LDS_IMP); unsigned* selm = (unsigned*)(shm + NSA_LDS_SELM); float* pri = (float*)(shm + NSA_LDS_PRI) + wid * 128;
    for (int i = lane; i < 8 * NSA_IMP_LD; i += 64) imp[wid * 8 * NSA_IMP_LD + i] = 0.f;
    const bf16_t* qp = QBs + (rb + tq) * D + (g * 4 + hh) * 64;
    bf16x8 qf[4];
#pragma unroll
    for (int d0 = 0; d0 < 4; ++d0) qf[d0] = *(const bf16x8*)(qp + d0 * 16 + hi * 8);
    const bf16_t* KC = KCMPs + (size_t)bg * NCMP * 64; const bf16_t* VC = VCTs + (size_t)bg * 8 * 64 * 64;
    bf16x8 ovf[4];
#pragma unroll
    for (int kk = 0; kk < 4; ++kk) { u32x4 w = {0u, 0u, 0u, 0u};
#pragma unroll
        for (int i = 0; i < 8; ++i) { const int nl = 16 * kk + swapmid(8 * hi + i); const unsigned one = (r32 <= 16 && nl >= 4 * r32 - 1 && nl <= 4 * r32 + 3) ? 0x3F80u : 0u; w[i >> 1] |= one << (16 * (i & 1)); }
        ovf[kk] = __builtin_bit_cast(bf16x8, w); }
#define NSA_KLD(KA, KB_, k) do { const bf16_t* kr0 = KC + (size_t)(64 * (k) + r32) * 64 + hi * 8; \
        _Pragma("unroll") for (int d0 = 0; d0 < 4; ++d0) { KA[d0] = *(const bf16x8*)(kr0 + d0 * 16); KB_[d0] = *(const bf16x8*)(kr0 + 32 * 64 + d0 * 16); } } while (0)
#define NSA_QK(P0, P1, KA, KB_) do { const f32x16 z = {}; P0 = z; P1 = z; \
        _Pragma("unroll") for (int d0 = 0; d0 < 4; ++d0) { P0 = __builtin_amdgcn_mfma_f32_32x32x16_bf16(KA[d0], qf[d0], P0, 0, 0, 0); P1 = __builtin_amdgcn_mfma_f32_32x32x16_bf16(KB_[d0], qf[d0], P1, 0, 0, 0); } } while (0)
    float m = -60000.f, l = 0.f;
    bf16x8 ka[4], kb[4], na[4], nb[4]; NSA_KLD(ka, kb, 0);
    for (int k = 0; k < ntile; ++k) { f32x16 p0, p1; NSA_KLD(na, nb, (k + 1 < ntile ? k + 1 : 0)); NSA_QK(p0, p1, ka, kb);
#pragma unroll
        for (int d0 = 0; d0 < 4; ++d0) { ka[d0] = na[d0]; kb[d0] = nb[d0]; }
        float tm = -60000.f;
#pragma unroll
        for (int r = 0; r < 16; ++r) { const int n = 64 * k + crow(r, hi); p0[r] = n < nv ? p0[r] : -60000.f; p1[r] = n + 32 < nv ? p1[r] : -60000.f; tm = fmaxf(tm, fmaxf(p0[r], p1[r])); }
        { auto rr = __builtin_amdgcn_permlane32_swap(__float_as_uint(tm), __float_as_uint(tm), false, false); tm = fmaxf(__uint_as_float(rr[0]), __uint_as_float(rr[1])); }
        const float mn = fmaxf(m, tm); float ls = 0.f;
#pragma unroll
        for (int r = 0; r < 16; ++r) { const int n = 64 * k + crow(r, hi); ls += (n < nv ? __builtin_amdgcn_exp2f(p0[r] - mn) : 0.f) + (n + 32 < nv ? __builtin_amdgcn_exp2f(p1[r] - mn) : 0.f); }
        l = l * __builtin_amdgcn_exp2f(m - mn) + ls; m = mn; }
    { auto rr = __builtin_amdgcn_permlane32_swap(__float_as_uint(l), __float_as_uint(l), false, false); l = __uint_as_float(rr[0]) + __uint_as_float(rr[1]); }
    const float il = 1.f / fmaxf(l, 1e-30f);
    NSA_KLD(ka, kb, 0);
    f32x16 o[2]; o[0] = f32x16{}; o[1] = f32x16{};
    for (int k = 0; k < ntile; ++k) { f32x16 p0, p1; NSA_KLD(na, nb, (k + 1 < ntile ? k + 1 : 0));
        bf16x8 vfr[4][2];
#pragma unroll
        for (int kk = 0; kk < 4; ++kk)
#pragma unroll
            for (int d0 = 0; d0 < 2; ++d0) vfr[kk][d0] = *(const bf16x8*)(VC + ((size_t)(k * 64 + d0 * 32 + r32)) * 64 + kk * 16 + hi * 8);
        NSA_QK(p0, p1, ka, kb);
#pragma unroll
        for (int d0 = 0; d0 < 4; ++d0) { ka[d0] = na[d0]; kb[d0] = nb[d0]; }
#pragma unroll
        for (int r = 0; r < 16; ++r) { const int n = 64 * k + crow(r, hi); p0[r] = n < nv ? __builtin_amdgcn_exp2f(p0[r] - m) * il : 0.f; p1[r] = n + 32 < nv ? __builtin_amdgcn_exp2f(p1[r] - m) * il : 0.f; }
        u32x4 pw[4];
        pw[0] = (u32x4){cvtpk_s(p0[0], p0[1]), cvtpk_s(p0[2], p0[3]), cvtpk_s(p0[4], p0[5]), cvtpk_s(p0[6], p0[7])};
        pw[1] = (u32x4){cvtpk_s(p0[8], p0[9]), cvtpk_s(p0[10], p0[11]), cvtpk_s(p0[12], p0[13]), cvtpk_s(p0[14], p0[15])};
        pw[2] = (u32x4){cvtpk_s(p1[0], p1[1]), cvtpk_s(p1[2], p1[3]), cvtpk_s(p1[4], p1[5]), cvtpk_s(p1[6], p1[7])};
        pw[3] = (u32x4){cvtpk_s(p1[8], p1[9]), cvtpk_s(p1[10], p1[11]), cvtpk_s(p1[12], p1[13]), cvtpk_s(p1[14], p1[15])};
        f32x16 u = f32x16{};
#pragma unroll
        for (int kk = 0; kk < 4; ++kk) { const bf16x8 pa = __builtin_bit_cast(bf16x8, pw[kk]);
#pragma unroll
            for (int d0 = 0; d0 < 2; ++d0) o[d0] = __builtin_amdgcn_mfma_f32_32x32x16_bf16(pa, vfr[kk][d0], o[d0], 0, 0, 0);
            u = __builtin_amdgcn_mfma_f32_32x32x16_bf16(pa, ovf[kk], u, 0, 0, 0); }
        if (r32 <= 16) {
#pragma unroll
            for (int c = 0; c < 4; ++c) { const float sgrp = (u[4 * c] + u[4 * c + 1]) + (u[4 * c + 2] + u[4 * c + 3]); float* ip = imp + (wid * 8 + 2 * c + hi) * NSA_IMP_LD + 16 * k + r32; *ip += sgrp; } }
        WAVE_SYNC(); }
#undef NSA_QK
#undef NSA_KLD
    { float* wsf = (float*)(shm + gattn::LDS_WS) + wid * 64; if (hi == 0) wsf[32 + r32] = GATESs[(rb + tq) * 48 + (g * 4 + hh) * 3 + 0]; WAVE_SYNC();
      abf16* stg = (abf16*)(shm + gattn::LDS_OST) + wid * 2048;
#pragma unroll
      for (int r = 0; r < 16; ++r) { const int orow = crow(r, hi); const float gsc = wsf[32 + orow];
#pragma unroll
          for (int d0 = 0; d0 < 2; ++d0) stg[orow * 64 + d0 * 32 + r32] = __float2bfloat16(o[d0][r] * gsc); } }
    WAVE_SYNC();
    const int cur = q0 >> 6;
    for (int t8 = 0; t8 < 8; ++t8) { const int tok = wid * 8 + t8; const float* ip = imp + tok * NSA_IMP_LD;
        const int j0 = lane, j1 = lane + 64; const float i0 = ip[j0], i1 = ip[j1];
        const bool f0 = (j0 == 0) || (j0 == cur) || (j0 == cur - 1), f1 = (j1 == 0) || (j1 == cur) || (j1 == cur - 1);
        float pr0 = f0 ? i0 + 1e4f : i0, pr1 = f1 ? i1 + 1e4f : i1; pr0 = j0 <= cur ? pr0 : NEGF; pr1 = j1 <= cur ? pr1 : NEGF;
        const unsigned ub0 = __float_as_uint(pr0), ub1 = __float_as_uint(pr1);
        const unsigned k0 = (ub0 & 0x80000000u) ? ~ub0 : (ub0 | 0x80000000u), k1 = (ub1 & 0x80000000u) ? ~ub1 : (ub1 | 0x80000000u);
        unsigned thr = 0u;
        for (int bit = 31; bit >= 0; --bit) { const unsigned cand = thr | (1u << bit);
            const int c = __popcll(__builtin_amdgcn_ballot_w64(k0 >= cand)) + __popcll(__builtin_amdgcn_ballot_w64(k1 >= cand));
            thr = c >= 16 ? cand : thr; }
        const unsigned long long g0 = __builtin_amdgcn_ballot_w64(k0 > thr), g1 = __builtin_amdgcn_ballot_w64(k1 > thr);
        const unsigned long long e0 = __builtin_amdgcn_ballot_w64(k0 == thr), e1 = __builtin_amdgcn_ballot_w64(k1 == thr);
        int need = 16 - (__popcll(g0) + __popcll(g1));
        unsigned long long t0m = 0ull, t1m = 0ull;
        { unsigned long long e = e0; while (need > 0 && e) { const unsigned long long lowb = e & (0ull - e); t0m |= lowb; e ^= lowb; --need; } }
        { unsigned long long e = e1; while (need > 0 && e) { const unsigned long long lowb = e & (0ull - e); t1m |= lowb; e ^= lowb; --need; } }
        const unsigned long long vm0 = cur >= 63 ? ~0ull : ((1ull << (cur + 1)) - 1ull), vm1 = cur >= 127 ? ~0ull : (cur >= 64 ? ((1ull << (cur - 63)) - 1ull) : 0ull);
        const unsigned long long b0 = (g0 | t0m) & vm0, b1 = (g1 | t1m) & vm1;
        if (lane == 0) { selm[tok * 4 + 0] = (unsigned)b0; selm[tok * 4 + 1] = (unsigned)(b0 >> 32); selm[tok * 4 + 2] = (unsigned)b1; selm[tok * 4 + 3] = (unsigned)(b1 >> 32);
            if (selm_g) { unsigned* sg = selm_g + ((size_t)(rb + q0 + tok) * NSA_G + g) * 4; sg[0] = (unsigned)b0; sg[1] = (unsigned)(b0 >> 32); sg[2] = (unsigned)b1; sg[3] = (unsigned)(b1 >> 32); } }
        WAVE_SYNC(); }
}

struct Args { const void* in[31]; float* out; unsigned char* ws; int ph_lo, ph_hi; };

__device__ __forceinline__ float sigmoidf_(float z) { return 1.f / (1.f + __expf(-z)); }
__device__ __forceinline__ float gelu_tanh(float x) { const float u = 0.7978845608028654f * (x + 0.044715f * x * x * x); const float e = __expf(2.f * u); return 0.5f * x * (1.f + (1.f - 2.f / (e + 1.f))); }

__device__ __forceinline__ void ln_row(f32x4 (&v)[4], const float* g, const float* b, int lane) {
    float s = 0.f;
#pragma unroll
    for (int j = 0; j < 4; ++j) s += (v[j].x + v[j].y) + (v[j].z + v[j].w);
    const float mean = wave_sum(s) * (1.f / D); float s2 = 0.f;
#pragma unroll
    for (int j = 0; j < 4; ++j) { v[j] = v[j] - mean; s2 += (v[j].x * v[j].x + v[j].y * v[j].y) + (v[j].z * v[j].z + v[j].w * v[j].w); }
    const float rstd = 1.f / sqrtf(wave_sum(s2) * (1.f / D) + LN_EPS);
#pragma unroll
    for (int j = 0; j < 4; ++j) { const f32x4 gg = *(const f32x4*)(g + 4 * lane + 256 * j), bb = *(const f32x4*)(b + 4 * lane + 256 * j); v[j] = v[j] * rstd * gg + bb; }
}

__global__ void __launch_bounds__(NTHR, 2) mk_fwd(Args args) {
    extern __shared__ __attribute__((aligned(16))) unsigned char lds[];
    const int G = gridDim.x, bx = blockIdx.x;
    const int NGW = G * NWAVES, NGT = G * NTHR;
#define PH_IDS() int tid_o = threadIdx.x; asm volatile("" : "+v"(tid_o)); const int tid = tid_o, lane = tid & 63, wave = __builtin_amdgcn_readfirstlane(tid >> 6); \
    const int gw = bx * NWAVES + wave, gtid = bx * NTHR + tid; (void)gw; (void)gtid; (void)lane; (void)wave;
    unsigned char* ws = args.ws;
    gu32* ctl = (gu32*)(ws + WS_CTL);
    LAS unsigned char* ldsl = (LAS unsigned char*)lds;
    volatile LAS unsigned* MISC = (volatile LAS unsigned*)(ldsl + MISC_OFF);
    LAS int* TAB = (LAS int*)(ldsl + TAB_OFF);
    for (int u = threadIdx.x; u < (LDS_BYTES - RING_BYTES) / 4; u += NTHR) ((LAS unsigned*)(ldsl + RING_BYTES))[u] = 0u;
    __syncthreads();
    XcdBarrier bar; bar.bar = (unsigned*)(ctl + CW_BAR); bar.x = 0; bar.st = nullptr;
    if (!MK_MULTI) bar = xcd_barrier_post((unsigned*)(ctl + CW_BAR), MISC + 8);
#if defined(TIME_P1)
#define SEAM_AT(k) do { xcd_barrier(bar); if (blockIdx.x == 0 && threadIdx.x == 0) { ((unsigned long long*)(ctl + CW_TS))[(k)] = __builtin_amdgcn_s_memrealtime(); } } while (0)
#else
#define SEAM_AT(k) do { xcd_barrier(bar); } while (0)
#endif
#define SEAM() SEAM_AT(0)
#define IN(gp) (args.ph_lo <= (gp) && (gp) < args.ph_hi)

    float* X = (float*)(ws + WS_X);
    bf16_t* XBA = (bf16_t*)(ws + WS_XBA); bf16_t* XBB = (bf16_t*)(ws + WS_XBB);
    float* ROPE_C = (float*)(ws + WS_ROPE_C); float* ROPE_S = (float*)(ws + WS_ROPE_S);
    float* LOGF = (float*)(ws + WS_LOGF); float* CUM = (float*)(ws + WS_CUM); float* GATES = (float*)(ws + WS_GATES); float* KMEAN = (float*)(ws + WS_KMEAN);
    bf16_t* KCMP = (bf16_t*)(ws + WS_KCMP); bf16_t* VCMP = (bf16_t*)(ws + WS_VCMP); bf16_t* VCT = (bf16_t*)(ws + WS_VCT); unsigned* SELMG = (unsigned*)(ws + WS_SELMG);
    int* ROWTOK = (int*)(ws + WS_ROWTOK); float* LS32 = (float*)(ws + WS_LS32); float* H1 = (float*)(ws + WS_H1);
    int* TOKE = (int*)(ws + WS_TOKE); float* TOKW = (float*)(ws + WS_TOKW); int* TOKP = (int*)(ws + WS_TOKP); float* ROWW = (float*)(ws + WS_ROWW);
#define WSET_PTRS(LL) constexpr size_t so_ = ((LL) & 1) ? WS_SET1 : 0; \
    bf16_t* const WIN_T = (bf16_t*)(ws + WS_WIN + so_); bf16_t* const WOUT_T = (bf16_t*)(ws + WS_WOUT + so_); bf16_t* const WGU_T = (bf16_t*)(ws + WS_WGU + so_); bf16_t* const WDN_T = (bf16_t*)(ws + WS_WDN + so_); \
    bf16_t* const WPG_T = (bf16_t*)(ws + WS_WPG + so_); bf16_t* const WPP_T = (bf16_t*)(ws + WS_WPP + so_); bf16_t* const PB = (bf16_t*)(ws + WS_PB + so_); bf16_t* const WC1_T = (bf16_t*)(ws + WS_WC1 + so_); \
    float* const PEB = (float*)(ws + (((LL) & 1) ? WS_PEB1 : WS_PEB)); bf16_t* const WRT = (bf16_t*)(ws + (((LL) & 1) ? WS_WRT1 : WS_WRT)); \
    (void)WIN_T; (void)WOUT_T; (void)WGU_T; (void)WDN_T; (void)WPG_T; (void)WPP_T; (void)PB; (void)WC1_T; (void)PEB; (void)WRT;
    bf16_t* QB = (bf16_t*)(ws + WS_Q); bf16_t* KB = (bf16_t*)(ws + WS_K); bf16_t* VB = (bf16_t*)(ws + WS_V); bf16_t* AO = (bf16_t*)(ws + WS_AO);
    bf16_t* PP = (bf16_t*)(ws + WS_PP); bf16_t* QR = (bf16_t*)(ws + WS_QR); bf16_t* HB = (bf16_t*)(ws + WS_H); bf16_t* XG = (bf16_t*)(ws + WS_XG); bf16_t* OUTR = (bf16_t*)(ws + WS_OUTR);
    const int* positions = (const int*)args.in[2];

    if (IN(0)) { PH_IDS();
        for (int i = gtid; i < T * 32; i += NGT) { const int t = i >> 5, f = i & 31;
            const float inv = __builtin_amdgcn_exp2f(-(float)f * (13.287712379549449f / 32.f));
            const double ang = (double)positions[t] * (double)inv; double rev = ang * 0.15915494309189535; rev = rev - floor(rev);
            ROPE_C[i] = __builtin_amdgcn_cosf((float)rev); ROPE_S[i] = __builtin_amdgcn_sinf((float)rev); }
        for (int i = gtid; i < T; i += NGT) ROWTOK[64 * 16384 + i] = i;
        const float* xin = (const float*)args.in[0];
        for (int i = gtid; i < T * D / 4; i += NGT) { const f32x4 v = ((const f32x4*)xin)[i];
            unsigned long long w = (unsigned long long)pk2(v.x, v.y) | ((unsigned long long)pk2(v.z, v.w) << 32); ((unsigned long long*)XBB)[i] = w; }
    }

    auto conv = [&](auto Ltc) __attribute__((always_inline)) {
        constexpr int LT = decltype(Ltc)::value; PH_IDS(); WSET_PTRS(LT);
        const int kind = LT % 3, jj = LT / 3;
        const float* w_in_src = kind == 0 ? (const float*)args.in[3] + (size_t)jj * D * 3088 : kind == 1 ? (const float*)args.in[6] : (const float*)args.in[15];
        const int ldw_in = kind == 0 ? 3088 : kind == 1 ? 2608 : 3072, ncol_in = kind == 1 ? 2560 : 3072;
        const float* w_out_src = kind == 0 ? (const float*)args.in[5] + (size_t)jj * D * D : kind == 1 ? (const float*)args.in[14] : (const float*)args.in[16];
        {
            const int n_win = 16 * (ncol_in / 64), n_wout = 256, n_gu = 65 * 128, n_dn = 65 * 64, n_pg = 256, n_pp = 64;
            const int NIT = n_win + n_wout + n_gu + n_dn + n_pg + n_pp;
            auto dec = [&](int r, const float*& sp, int& ldw, bf16*& dp, int& K) __attribute__((always_inline)) {
                if (r < n_win) { const int nblk = ncol_in / 64, kb = r / nblk, nb = r % nblk; sp = w_in_src + (size_t)(64 * kb) * ldw_in + 64 * nb; ldw = ldw_in; dp = WIN_T + (size_t)(64 * nb) * D + 64 * kb; K = D; return; } r -= n_win;
                if (r < n_wout) { const int kb = r / 16, nb = r % 16; sp = w_out_src + (size_t)(64 * kb) * D + 64 * nb; ldw = D; dp = WOUT_T + (size_t)(64 * nb) * D + 64 * kb; K = D; return; } r -= n_wout;
                if (r < n_gu) { const int e = r / 128, rr = r % 128, mat = rr / 64, kb = (rr % 64) / 4, nb = rr % 4, n0 = 64 * nb;
                    const float* W = e < 64 ? (const float*)args.in[mat ? 22 : 21] + ((size_t)(LT * 64 + e)) * D * ED : (const float*)args.in[mat ? 25 : 24] + (size_t)LT * D * ED;
                    sp = W + (size_t)(64 * kb) * ED + n0; ldw = ED; dp = WGU_T + (size_t)(e * 512 + (n0 / 128) * 256 + mat * 128 + (n0 % 128)) * D + 64 * kb; K = D; return; } r -= n_gu;
                if (r < n_dn) { const int e = r / 64, rr = r % 64, kb = rr / 16, nb = rr % 16;
                    const float* W = e < 64 ? (const float*)args.in[23] + ((size_t)(LT * 64 + e)) * ED * D : (const float*)args.in[26] + (size_t)LT * ED * D;
                    sp = W + (size_t)(64 * kb) * D + 64 * nb; ldw = D; dp = WDN_T + (size_t)(e * 1024 + 64 * nb) * ED + 64 * kb; K = ED; return; } r -= n_dn;
                if (r < n_pg) { const int kb = r / 16, nb = r % 16; sp = (const float*)args.in[29] + (size_t)LT * D * D + (size_t)(64 * kb) * D + 64 * nb; ldw = D; dp = WPG_T + (size_t)(64 * nb) * D + 64 * kb; K = D; return; } r -= n_pg;
                { const int kb = r / 16, nb = r % 16; sp = (const float*)args.in[30] + (size_t)LT * PLE * D + (size_t)(64 * kb) * D + 64 * nb; ldw = D; dp = WPP_T + (size_t)(64 * nb) * PLE + 64 * kb; K = PLE; }
            };
            for (int it = gw; it < 2 * NIT; it += 6 * NGW) {
                const float* sp[6]; bf16* dp[6]; int ld[6], Kd[6]; f32x4 v[6][8];
#pragma unroll
                for (int u = 0; u < 6; ++u) { const int i2 = it + u * NGW; if (i2 < 2 * NIT) { dec(i2 >> 1, sp[u], ld[u], dp[u], Kd[u]); sp[u] += 32 * (i2 & 1); dp[u] += (size_t)(32 * (i2 & 1)) * Kd[u]; nitem_load(v[u], sp[u], ld[u], lane); } }
#pragma unroll
                for (int u = 0; u < 6; ++u) { const int i2 = it + u * NGW; if (i2 < 2 * NIT) nitem_store(v[u], dp[u], Kd[u], lane); }
            }
            { const f32x4* ps = (const f32x4*)((const float*)args.in[1] + (size_t)LT * T * PLE); unsigned long long* pd = (unsigned long long*)PB; constexpr int NP = T * PLE / 4;
              for (int i0 = gtid; i0 < NP; i0 += 8 * NGT) { f32x4 v[8];
#pragma unroll
                  for (int u = 0; u < 8; ++u) { const int i = i0 + u * NGT; if (i < NP) v[u] = __builtin_nontemporal_load((const GAS f32x4*)(ps + i)); }
#pragma unroll
                  for (int u = 0; u < 8; ++u) { const int i = i0 + u * NGT; if (i < NP) pd[i] = (unsigned long long)gattn::cvtpk_s(v[u].x, v[u].y) | ((unsigned long long)gattn::cvtpk_s(v[u].z, v[u].w) << 32); } } }
            { const float* Wr = (const float*)args.in[19] + (size_t)LT * D * NE;
              for (int i = gtid; i < NE * D; i += NGT) { const int e = i >> 10, k = i & 1023; const float w = Wr[k * 64 + e]; const unsigned h = f2bf(w); const float r = w - __uint_as_float(h << 16);
                  WRT[i] = (bf16_t)h; WRT[NE * D + i] = (bf16_t)f2bf(r); } }
            if (kind == 1) {
                for (int it = gw; it < 2 * 64; it += NGW) { const int kv = it >> 6, r = it & 63, kb = r >> 1, nb = r & 1;
                    transpose_item64((const float*)args.in[kv ? 12 : 10], 128, 64 * kb, 64 * nb, WC1_T, 2048, kv * 256 + 64 * nb, lane); }
                for (int it = gw; it < 2 * 128; it += NGW) { const int kv = it >> 7, hu = it & 127; const float* pe = (const float*)args.in[kv ? 9 : 8]; const float* w1 = (const float*)args.in[kv ? 12 : 10];
                    float wv[32], a = 0.f;
#pragma unroll
                    for (int i = 0; i < 32; ++i) wv[i] = w1[(size_t)(lane + 64 * i) * 128 + hu];
#pragma unroll
                    for (int i = 0; i < 32; ++i) a += pe[lane + 64 * i] * wv[i];
                    a = wave_sum(a); if (lane == 0) PEB[kv * 128 + hu] = a; }
            }
        }
    };

    auto layer_body = [&](auto Lc) __attribute__((always_inline)) {
        constexpr int L = decltype(Lc)::value; WSET_PTRS(L);
        const int kind = L % 3, jj = L / 3, gp0 = 1 + L * NPH;
        const float* w_in_src = kind == 0 ? (const float*)args.in[3] + (size_t)jj * D * 3088 : kind == 1 ? (const float*)args.in[6] : (const float*)args.in[15];
        const int ldw_in = kind == 0 ? 3088 : kind == 1 ? 2608 : 3072, ncol_in = kind == 1 ? 2560 : 3072;
        (void)jj; (void)w_in_src; (void)ldw_in;

        auto gates = [&]() __attribute__((always_inline)) { PH_IDS();
            if constexpr (L % 3 != 2) {
                using gattn::bf16x8; using gattn::f32x16; using gattn::u32x4; using gattn::crow; using gattn::cvtpk_s;
                constexpr int NB = (L % 3 == 0) ? 1 : 2, NCOL = (L % 3 == 0) ? 16 : 48;
                const int colbase = kind == 0 ? 3072 : 2560;
                const float* bsrc = kind == 0 ? (const float*)args.in[4] + jj * 16 : (const float*)args.in[7];
                constexpr int XP = 1032;
                bf16_t* XH = (bf16_t*)lds; bf16_t* XL = XH + 32 * XP; float* PL = (float*)lds;
                const int r32 = lane & 31, hi = lane >> 5;
                bf16x8 wh[8][NB], wl[8][NB];
#pragma unroll
                for (int st = 0; st < 8; ++st)
#pragma unroll
                    for (int nb = 0; nb < NB; ++nb) { const int n = nb * 32 + r32; u32x4 ph = {0u, 0u, 0u, 0u}, pl = {0u, 0u, 0u, 0u};
                        if (n < NCOL) { float wv[8];
#pragma unroll
                            for (int i = 0; i < 8; ++i) wv[i] = w_in_src[(size_t)(wave * 128 + 16 * st + 8 * hi + i) * ldw_in + colbase + n];
#pragma unroll
                            for (int i = 0; i < 4; ++i) { const unsigned h2 = cvtpk_s(wv[2 * i], wv[2 * i + 1]); ph[i] = h2; pl[i] = cvtpk_s(wv[2 * i] - bflo(h2), wv[2 * i + 1] - bfhi(h2)); } }
                        wh[st][nb] = __builtin_bit_cast(bf16x8, ph); wl[st][nb] = __builtin_bit_cast(bf16x8, pl); }
                for (int pass = bx; pass < T / 32; pass += G) { const size_t row0 = (size_t)pass * 32;
                    __syncthreads();
#pragma unroll
                    for (int r = 0; r < 4; ++r) { const int rl = wave * 4 + r; const size_t row = row0 + rl;
#pragma unroll
                        for (int j = 0; j < 4; ++j) {
                            if constexpr (L == 0) { const f32x4 v = *(const f32x4*)((const float*)args.in[0] + row * D + 4 * lane + 256 * j);
                                const unsigned h0 = cvtpk_s(v.x, v.y), h1 = cvtpk_s(v.z, v.w); const unsigned l0 = cvtpk_s(v.x - bflo(h0), v.y - bfhi(h0)), l1 = cvtpk_s(v.z - bflo(h1), v.w - bfhi(h1));
                                *(uint2*)(XH + rl * XP + 4 * lane + 256 * j) = make_uint2(h0, h1); *(uint2*)(XL + rl * XP + 4 * lane + 256 * j) = make_uint2(l0, l1); }
                            else *(uint2*)(XH + rl * XP + 4 * lane + 256 * j) = *(const uint2*)(XBB + row * D + 4 * lane + 256 * j); } }
                    __syncthreads();
                    f32x16 acc[NB];
#pragma unroll
                    for (int nb = 0; nb < NB; ++nb) acc[nb] = f32x16{};
#pragma unroll
                    for (int st = 0; st < 8; ++st) { const int k = wave * 128 + 16 * st + 8 * hi; const bf16x8 xh = *(const bf16x8*)(XH + r32 * XP + k); bf16x8 xl = xh; if constexpr (L == 0) xl = *(const bf16x8*)(XL + r32 * XP + k);
#pragma unroll
                        for (int nb = 0; nb < NB; ++nb) { acc[nb] = __builtin_amdgcn_mfma_f32_32x32x16_bf16(xh, wh[st][nb], acc[nb], 0, 0, 0); if constexpr (L == 0) acc[nb] = __builtin_amdgcn_mfma_f32_32x32x16_bf16(xl, wh[st][nb], acc[nb], 0, 0, 0);
                            acc[nb] = __builtin_amdgcn_mfma_f32_32x32x16_bf16(xh, wl[st][nb], acc[nb], 0, 0, 0); } }
                    __syncthreads();
#pragma unroll
                    for (int nb = 0; nb < NB; ++nb)
#pragma unroll
                        for (int r = 0; r < 16; ++r) PL[(wave * 32 + crow(r, hi)) * 64 + nb * 32 + r32] = acc[nb][r];
                    __syncthreads();
                    for (int o = tid; o < 32 * NCOL; o += NTHR) { const int rl = o / NCOL, c = o % NCOL; float z = bsrc[c];
#pragma unroll
                        for (int w = 0; w < 8; ++w) z += PL[(w * 32 + rl) * 64 + c];
                        if (kind == 0) { const float lf = fminf(z, 0.f) - __logf(1.f + __expf(-fabsf(z))); LOGF[(row0 + rl) * 16 + c] = lf;
                            float s4 = lf; s4 += xor_f<16>(s4); { auto rr = __builtin_amdgcn_permlane32_swap(__float_as_uint(s4), __float_as_uint(s4), false, false); s4 = __uint_as_float(rr[0]) + __uint_as_float(rr[1]); }
                            if (lane < 16) PL[8 * 32 * 64 + wave * 16 + lane] = s4; }
                        else GATES[(row0 + rl) * 48 + c] = sigmoidf_(z); }
                    if (kind == 0) { __syncthreads(); if (tid < 16) { float s = 0.f;
#pragma unroll
                            for (int w = 0; w < 8; ++w) s += PL[8 * 32 * 64 + w * 16 + tid]; LS32[(size_t)pass * 16 + tid] = s; } }
                }
                __syncthreads();
            }
        };

        if (L == 0 && PH_EN(0) && IN(gp0 + 0)) {
            conv(std::integral_constant<int, 0>{}); gates();
            SEAM_AT(1 + L * NPH + 0);
        }

        if (PH_EN(1) && IN(gp0 + 1)) { PH_IDS();
            if constexpr (L > 0) gates();
            pg8::Gemm g{XBB, WIN_T, T, ncol_in, D, 0, 0, nullptr}; pg8::StaticOrder So; So.init(T, ncol_in, G, bx);
            epi::Qkv E{QB, 1024, D, KB, kind == 1 ? 256 : 1024, kind == 1 ? 256 : 1024, kind == 1 ? (size_t)(4 * MiB) : (size_t)(16 * MiB), gattn::C2};
            pg8::gemm_phase<epi::Qkv, pg8::StaticOrder, true, true>(ldsl, g, So, E);
            {
              int kpp = PLE; asm volatile("" : "+s"(kpp)); pg8::Gemm g{PB, WPP_T, T, D, kpp, 0, 0, nullptr}; pg8::StaticOrder So; So.init(T, D, G, bx);
              epi::StoreBf16 E{PP, D};
              pg8::gemm_phase<epi::StoreBf16, pg8::StaticOrder, true, true>(ldsl, g, So, E); }
            SEAM_AT(1 + L * NPH + 1);
        }

        if (PH_EN(2) && IN(gp0 + 2)) { PH_IDS();
            if (kind == 0) {
                for (int task = gw; task < Bn * NH * 32; task += NGW) { const int q = task & 31, bh = task >> 5, b = bh / NH, h = bh % NH;
                    double base = 0.0;
                    for (int p = lane; p < 8 * q; p += 64) base += (double)LS32[((size_t)b * 256 + p) * 16 + h];
#pragma unroll
                    for (int o = 1; o < 64; o <<= 1) { const unsigned long long sb = __builtin_bit_cast(unsigned long long, base); const int sl4 = (lane ^ o) << 2;
                        const unsigned ulo = (unsigned)__builtin_amdgcn_ds_bpermute(sl4, (int)(unsigned)sb), uhi = (unsigned)__builtin_amdgcn_ds_bpermute(sl4, (int)(unsigned)(sb >> 32));
                        base += __builtin_bit_cast(double, ((unsigned long long)uhi << 32) | ulo); }
                    const size_t t0 = (size_t)b * S + q * 256 + lane * 4; double loc[4]; double run = 0.0;
#pragma unroll
                    for (int i = 0; i < 4; ++i) { run += (double)LOGF[(t0 + i) * 16 + h]; loc[i] = run; }
                    double sc = run;
#pragma unroll
                    for (int o = 1; o < 64; o <<= 1) { const unsigned long long sb = __builtin_bit_cast(unsigned long long, sc); const int sl4 = ((lane - o) & 63) << 2;
                        const unsigned ulo = (unsigned)__builtin_amdgcn_ds_bpermute(sl4, (int)(unsigned)sb), uhi = (unsigned)__builtin_amdgcn_ds_bpermute(sl4, (int)(unsigned)(sb >> 32));
                        const double up = __builtin_bit_cast(double, ((unsigned long long)uhi << 32) | ulo); if (lane >= o) sc += up; }
                    const double pre = base + (sc - run);
#pragma unroll
                    for (int i = 0; i < 4; ++i) CUM[(size_t)bh * S + q * 256 + lane * 4 + i] = (float)(pre + loc[i]); }
                for (int b = 0; b < Bn; ++b) { float mq = 0.f, mk = 0.f;
                    for (int rbase = gw; rbase < S; rbase += 4 * NGW) { uint4 q0a[4], q1a[4], k0a[4], k1a[4];
#pragma unroll
                      for (int u4 = 0; u4 < 4; ++u4) { const int r = rbase + u4 * NGW; if (r < S) { const size_t off = ((size_t)b * S + r) * D + lane * 16;
                          q0a[u4] = *(const uint4*)(QB + off); q1a[u4] = *(const uint4*)(QB + off + 8); k0a[u4] = *(const uint4*)(KB + off); k1a[u4] = *(const uint4*)(KB + off + 8); } }
#pragma unroll
                      for (int u4 = 0; u4 < 4; ++u4) { const int r = rbase + u4 * NGW; if (r >= S) continue; const uint4 q0 = q0a[u4], q1 = q1a[u4], k0 = k0a[u4], k1 = k1a[u4];
                        float sq = 0.f, sk = 0.f;
#define SQ2(w) (bflo(w) * bflo(w) + bfhi(w) * bfhi(w))
                        sq = SQ2(q0.x) + SQ2(q0.y) + SQ2(q0.z) + SQ2(q0.w) + SQ2(q1.x) + SQ2(q1.y) + SQ2(q1.z) + SQ2(q1.w);
                        sk = SQ2(k0.x) + SQ2(k0.y) + SQ2(k0.z) + SQ2(k0.w) + SQ2(k1.x) + SQ2(k1.y) + SQ2(k1.z) + SQ2(k1.w);
#undef SQ2
                        sq += xor_f<1>(sq); sq += xor_f<2>(sq); sk += xor_f<1>(sk); sk += xor_f<2>(sk);
                        mq = fmaxf(mq, sq); mk = fmaxf(mk, sk); } }
                    LAS float* nl = (LAS float*)ldsl; __syncthreads();
                    if ((lane & 3) == 0) { nl[(wave * 16 + (lane >> 2)) * 2] = mq; nl[(wave * 16 + (lane >> 2)) * 2 + 1] = mk; }
                    __syncthreads();
                    if (tid < 32) { float m = 0.f;
#pragma unroll
                        for (int w = 0; w < 8; ++w) m = fmaxf(m, nl[(w * 16 + (tid >> 1)) * 2 + (tid & 1)]);
                        __hip_atomic_fetch_max((unsigned*)(ctl + CW_NRM + L * 64 + (b * NH + (tid >> 1)) * 2 + (tid & 1)), __float_as_uint(m), RLX_AGENT); } }
            } else {
                const size_t st6 = 4 * MiB;
                for (int pass = 0; pass < (kind == 1 ? 3 : 2); ++pass) {
                    const bf16_t* src; bf16_t* dst; int nhd;
                    if (kind == 1) { if (pass == 0) { src = QB; dst = QR; nhd = 16; } else if (pass == 1) { src = KB + 2 * st6; dst = KB + 2 * st6; nhd = 4; } else { src = KB + 4 * st6; dst = KB + 4 * st6; nhd = 4; } }
                    else { if (pass == 0) { src = QB; dst = QB; } else { src = KB; dst = KB; } nhd = 16; }
                    const int per_row = nhd * 4, total = T * per_row;
                    for (int i = gtid; i < total; i += NGT) { const int t = i / per_row, r = i % per_row, hd = r >> 2, fq = r & 3;
                        const size_t o1 = (size_t)t * (nhd * 64) + hd * 64 + 8 * fq;
                        const uint4 a = *(const uint4*)(src + o1), bq = *(const uint4*)(src + o1 + 32);
                        const f32x4 c0 = *(const f32x4*)(ROPE_C + t * 32 + 8 * fq), c1 = *(const f32x4*)(ROPE_C + t * 32 + 8 * fq + 4);
                        const f32x4 s0 = *(const f32x4*)(ROPE_S + t * 32 + 8 * fq), s1 = *(const f32x4*)(ROPE_S + t * 32 + 8 * fq + 4);
                        uint4 oa, ob;
#define ROPE2(W, CA, CB, SA, SB) { const float x1l = bflo(a.W), x1h = bfhi(a.W), x2l = bflo(bq.W), x2h = bfhi(bq.W); \
                            oa.W = pk2(x1l * CA - x2l * SA, x1h * CB - x2h * SB); ob.W = pk2(x2l * CA + x1l * SA, x2h * CB + x1h * SB); }
                        ROPE2(x, c0.x, c0.y, s0.x, s0.y) ROPE2(y, c0.z, c0.w, s0.z, s0.w) ROPE2(z, c1.x, c1.y, s1.x, s1.y) ROPE2(w, c1.z, c1.w, s1.z, s1.w)
#undef ROPE2
                        *(uint4*)(dst + o1) = oa; *(uint4*)(dst + o1 + 32) = ob; }
                }
            }
            SEAM_AT(1 + L * NPH + 2);
        }

        if (kind != 0 && PH_EN(3) && IN(gp0 + 3)) { PH_IDS();
            if (kind == 1) {
                { pg8::Gemm g{KB, WC1_T, 0, 0, 2048, 4096, 512, nullptr}; CmpOrder So{G, bx}; epi::H1Store E{H1};
                  pg8::gemm_phase<epi::H1Store, CmpOrder, true, true>(ldsl, g, So, E); }
                if (!MK_MULTI) xcd_barrier(bar);
                float* hb = (float*)(lds + wave * 1024);
                for (int task = gw; task < 2 * 8 * NCMP; task += NGW) { const int i = task & 511, bg = (task >> 9) & 7, kv = task >> 12;
                    const float* h1 = H1 + (size_t)task * 128; const float* w2 = (const float*)args.in[kv ? 13 : 11];
                    hb[lane] = gelu_tanh(h1[lane] + PEB[kv * 128 + lane]); hb[64 + lane] = gelu_tanh(h1[64 + lane] + PEB[kv * 128 + 64 + lane]);
                    WAVE_SYNC();
                    float o0 = 0.f;
#pragma unroll 8
                    for (int hu = 0; hu < 128; ++hu) o0 += hb[hu] * w2[hu * 64 + lane];
                    const bf16_t ob = (bf16_t)f2bf(o0);
                    if (kv == 0) KCMP[((size_t)bg * NCMP + i) * 64 + lane] = ob;
                    else { VCMP[((size_t)bg * NCMP + i) * 64 + lane] = ob; const int nl = i & 63; VCT[(((size_t)bg * 8 + (i >> 6)) * 64 + lane) * 64 + (nl & 48) + swapmid(nl & 15)] = ob; }
                    WAVE_SYNC(); }
            } else if (kind == 2) {
                for (int item = gw; item < Bn * NH * 32; item += NGW) { const int blk = item & 31, bh = item >> 5, b = bh / NH, h = bh % NH;
                    float s = 0.f; const bf16_t* kp = KB + ((size_t)b * S + blk * 256) * D + h * 64 + lane;
                    for (int r0 = 0; r0 < 256; r0 += 32) { bf16_t kv[32];
#pragma unroll
                        for (int r = 0; r < 32; ++r) kv[r] = kp[(size_t)(r0 + r) * D];
#pragma unroll
                        for (int r = 0; r < 32; ++r) s += bf2f(kv[r]); }
                    KMEAN[(size_t)item * 64 + lane] = s * (1.f / 256.f); }
            }
            SEAM_AT(1 + L * NPH + 3);
        }

        if (PH_EN(4) && IN(gp0 + 4)) { PH_IDS();
            float* wl = (float*)(lds + wave * 14336);
            float* qs = wl; float* qs2 = wl + 256; float* pb = wl + 512; int* kb = (int*)(wl + 512 + 2048); float* misc = wl + 512 + 2048 + 512;
#if defined(ZERO_KIND)
            if ((ZERO_KIND >> kind) & 1) { for (int i = gtid; i < T * D / 8; i += NGT) ((uint4*)AO)[i] = make_uint4(0u, 0u, 0u, 0u); } else {
#endif
            bf16_t* AOn = AO;
#if !defined(FOX_NAIVE)
            if (kind == 0) {
                volatile LAS int* qw = (volatile LAS int*)(ldsl + TAB_OFF);
                int nun = 0; const int cslot = bx & 3; (void)cslot;
                for (;; ++nun) {
                    if constexpr (L + 1 < DEPTH) { if (nun == cslot) conv(std::integral_constant<int, (L + 1 < DEPTH ? L + 1 : 0)>{}); }
                    if (tid == 0) { qw[100] = (int)__hip_atomic_fetch_add((unsigned*)(ctl + CW_Q + L), 1u, RLX_AGENT); qw[101] = 0; }
                    __syncthreads();
                    const int u = qw[100]; if (u >= Bn * NH * 32) break;
                    const int qb = 31 - (u >> 5), bh = u & 31, b = bh / NH, h = bh % NH; const size_t rb = (size_t)b * S; const int ntabs = 4 * qb + 4;
                    const float* cum = CUM + (size_t)bh * S;
                    { const unsigned* nr = (const unsigned*)(ctl + CW_NRM + L * 64 + bh * 2);
                      const float qk = sqrtf(__uint_as_float(__hip_atomic_load(nr, RLX_AGENT)) * __uint_as_float(__hip_atomic_load(nr + 1, RLX_AGENT)));
                      const float thr = -(30.f + 2.f * qk);
                      bool skip = false; if (tid < ntabs) skip = (cum[qb * 256] - cum[64 * tid + 63]) * 1.4426950408889634f < thr;
                      const int nsk = __popcll(__builtin_amdgcn_ballot_w64(skip)); if (lane == 0 && nsk) atomicAdd((int*)&qw[101], nsk); }
                    __syncthreads();
                    int t0 = qw[101]; t0 = t0 > ntabs - 4 ? ntabs - 4 : t0; t0 &= ~1;
                    __syncthreads();
                    FoxU un{(const abf16*)KB + rb * D + h * 64, (const abf16*)VB + rb * D + h * 64, D, t0, ntabs - t0, ntabs - 1, cum, qb * 256,
                            (abf16*)AO + (rb + qb * 256) * D + h * 64, 32L * D, (const abf16*)QB + (rb + qb * 256) * D + h * 64, nullptr};
                    gattn::gunit<8, true, 0, 0>((char*)lds, un); }
                if constexpr (L + 1 < DEPTH) { if (nun < cslot) conv(std::integral_constant<int, (L + 1 < DEPTH ? L + 1 : 0)>{}); }
            }
#endif
#if !defined(MOBA_NAIVE)
            if (kind == 2) {
                const int vcu = (bx % 8) * (G / 8) + bx / 8;
                LAS unsigned* mtab = (LAS unsigned*)(ldsl + gattn::LDS_BT); LAS float* kml = (LAS float*)(ldsl + gattn::LDS_BT + 1024);
                const int cslot = bx % 5;
                for (int ui = 0; ui < 4; ++ui) { int bh, qb; fox_order(vcu, ui, bh, qb); const int b = bh / NH, h = bh % NH; const size_t rb = (size_t)b * S;
                    if constexpr (L + 1 < DEPTH) { if (ui == cslot) conv(std::integral_constant<int, (L + 1 < DEPTH ? L + 1 : 0)>{}); }
                    for (int i = tid; i < qb * 64; i += NTHR) kml[i] = KMEAN[(size_t)bh * 32 * 64 + i];
                    __syncthreads();
                    if (tid < 256) { const uint4* qp = (const uint4*)(QB + (rb + qb * 256 + tid) * D + h * 64); float q[64];
#pragma unroll
                        for (int c = 0; c < 8; ++c) { const uint4 w = qp[c]; q[8 * c] = bflo(w.x); q[8 * c + 1] = bfhi(w.x); q[8 * c + 2] = bflo(w.y); q[8 * c + 3] = bfhi(w.y); q[8 * c + 4] = bflo(w.z); q[8 * c + 5] = bfhi(w.z); q[8 * c + 6] = bflo(w.w); q[8 * c + 7] = bfhi(w.w); }
                        float v0 = -3e38f, v1 = -3e38f, v2 = -3e38f; int i0 = -1, i1 = -1, i2 = -1;
                        for (int n = 0; n < qb; ++n) { float sacc = 0.f;
#pragma unroll
                            for (int d = 0; d < 64; ++d) sacc += q[d] * kml[n * 64 + d];
                            if (sacc > v0) { v2 = v1; i2 = i1; v1 = v0; i1 = i0; v0 = sacc; i0 = n; } else if (sacc > v1) { v2 = v1; i2 = i1; v1 = sacc; i1 = n; } else if (sacc > v2) { v2 = sacc; i2 = n; } }
                        unsigned mk = 1u << qb; if (i0 >= 0) mk |= 1u << i0; if (i1 >= 0) mk |= 1u << i1; if (i2 >= 0) mk |= 1u << i2;
                        mtab[tid] = mk; }
                    __syncthreads();
                    FoxU un{(const abf16*)KB + rb * D + h * 64, (const abf16*)VB + rb * D + h * 64, D, 0, 4 * qb + 4, 4 * qb + 3, nullptr, qb * 256,
                            (abf16*)AO + (rb + qb * 256) * D + h * 64, 32L * D, (const abf16*)QB + (rb + qb * 256) * D + h * 64, mtab};
                    gattn::gunit<8, false, 0, 0>((char*)lds, un); }
                if constexpr (L + 1 < DEPTH) { if (cslot == 4) conv(std::integral_constant<int, (L + 1 < DEPTH ? L + 1 : 0)>{}); }
            }
#endif
#if !defined(NSA_NAIVE)
            if (kind == 1) {
                const int vcu = (bx % 8) * (G / 8) + bx / 8; const size_t st6 = 4 * MiB;
                const int cslot = bx % 5;
                for (int ui = 0; ui < 4; ++ui) { const int bg = vcu >> 5, s5 = vcu & 31, b = bg / NSA_G, g = bg % NSA_G;
                    if constexpr (L + 1 < DEPTH) { if (ui == cslot) conv(std::integral_constant<int, (L + 1 < DEPTH ? L + 1 : 0)>{}); } const int qt = (ui == 0) ? s5 : (ui == 1) ? 63 - s5 : (ui == 2) ? 64 + s5 : 127 - s5;
                    const int q0 = qt * 64, cur = qt; const size_t rb = (size_t)b * S;
#if defined(CHECK_KIND)
                    unsigned* selg = SELMG;
#else
                    unsigned* selg = nullptr;
#endif
                    nsa_cmp_select((char*)lds, b, g, q0, QB, KCMP, VCT, GATES, selg);
                    const LAS unsigned* selm = (const LAS unsigned*)(ldsl + NSA_LDS_SELM);
                    { int nt = (cur + 2) & ~1; nt = nt < 4 ? 4 : nt;
                      NsaU un{(const abf16*)KB + 2 * st6 + rb * 256 + g * 64, (const abf16*)KB + 3 * st6 + rb * 256 + g * 64, 256, 0, nt, 127, nullptr, q0,
                              (abf16*)AO + (rb + q0) * D + g * 256, 8L * D, (const abf16*)QR + (rb + q0) * D + g * 256, selm, GATES + (rb + q0) * 48 + g * 12, 1, 0};
                      gattn::gunit<8, false, 2, 2>((char*)lds, un); }
                    { NsaU un{(const abf16*)KB + 4 * st6 + rb * 256 + g * 64, (const abf16*)KB + 5 * st6 + rb * 256 + g * 64, 256, cur - 8, 10, 127, nullptr, q0,
                              (abf16*)AO + (rb + q0) * D + g * 256, 8L * D, (const abf16*)QR + (rb + q0) * D + g * 256, nullptr, GATES + (rb + q0) * 48 + g * 12, 2, 512};
                      gattn::gunit<8, false, 3, 2>((char*)lds, un); }
                }
                if constexpr (L + 1 < DEPTH) { if (cslot == 4) conv(std::integral_constant<int, (L + 1 < DEPTH ? L + 1 : 0)>{}); }
            }
#endif
#if defined(CHECK_KIND)
            if (kind == CHECK_KIND) { AOn = XG; SEAM_AT(1 + L * NPH + 4); }
#endif
#if defined(FOX_NAIVE) || (defined(CHECK_KIND) && CHECK_KIND == 0)
            if (kind == 0) {
                for (int task = gw; task < T * NH; task += NGW) {
                    const int t = task % S, bh = task / S, h = bh % NH, b = bh / NH; const size_t row = (size_t)b * S + t;
                    qs[lane] = bf2f(QB[row * D + h * 64 + lane]);
                    const float* cum = CUM + (size_t)bh * S; const float cq = cum[t];
                    WAVE_SYNC();
                    float m[1] = {NEGF}, l[1] = {0.f}, o[1] = {0.f};
                    for (int c0 = 0; c0 <= t; c0 += 512) {
                        attend_chunk<1>(qs, pb, kb, KB + h * 64, VB + h * 64, D, 512,
                            [=](int slot) { const int kk = c0 + slot; return kk <= t ? (int)(b * S + kk) : -1; },
                            [=](int slot) { return cq - cum[c0 + slot]; }, QSC, m, l, o, lane);
                    }
                    AOn[row * D + h * 64 + lane] = (bf16_t)f2bf(o[0] / fmaxf(l[0], 1e-30f));
                }
            }
#endif
#if defined(NSA_NAIVE) || (defined(CHECK_KIND) && CHECK_KIND == 1)
            if (kind == 1) {
                const size_t st6 = 4 * MiB;
                float* Pn = misc;
                for (int task = gw; task < T * NSA_G; task += NGW) {
                    const int t = task % S, bg = task / S, g = bg % NSA_G, b = bg / NSA_G; const size_t row = (size_t)b * S + t;
#pragma unroll
                    for (int h = 0; h < 4; ++h) { qs[h * 64 + lane] = bf2f(QB[row * D + (g * 4 + h) * 64 + lane]); qs2[h * 64 + lane] = bf2f(QR[row * D + (g * 4 + h) * 64 + lane]); }
                    WAVE_SYNC();
                    float oc[4], os[4], ow[4];
                    const int nvalid = t >= 31 ? ((t - 31) >> 4) + 1 : 0;
                    {
                        float m[4] = {NEGF, NEGF, NEGF, NEGF}, l[4] = {0.f, 0.f, 0.f, 0.f}; oc[0] = oc[1] = oc[2] = oc[3] = 0.f;
                        attend_chunk<4>(qs, pb, kb, KCMP + (size_t)bg * NCMP * 64, VCMP + (size_t)bg * NCMP * 64, 64, 512,
                            [=](int slot) { return slot < nvalid ? slot : -1; }, [=](int) { return 0.f; }, QSC, m, l, oc, lane);
                        float il[4];
#pragma unroll
                        for (int h = 0; h < 4; ++h) { il[h] = 1.f / fmaxf(l[h], 1e-30f); oc[h] *= il[h]; }
                        for (int i = 0; i < 8; ++i) { const int n = lane + 64 * i; Pn[n] = pb[n] * il[0] + pb[512 + n] * il[1] + pb[1024 + n] * il[2] + pb[1536 + n] * il[3]; }
                        WAVE_SYNC();
                    }
                    const int cur = t >> 6;
                    float pri0, pri1;
                    {
                        float imp[2];
#pragma unroll
                        for (int c = 0; c < 2; ++c) { const int j = lane + 64 * c; float a = 0.f;
#pragma unroll
                            for (int dn = -1; dn <= 3; ++dn) { const int n = 4 * j + dn; if (n >= 0 && n < 511) a += Pn[n]; }
                            imp[c] = a; }
                        const int j0 = lane, j1 = lane + 64;
                        const bool f0 = (j0 == 0) || (j0 == cur) || (j0 == cur - 1), f1 = (j1 == 0) || (j1 == cur) || (j1 == cur - 1);
                        pri0 = f0 ? imp[0] + 1e4f : imp[0]; pri1 = f1 ? imp[1] + 1e4f : imp[1];
                        pri0 = j0 <= cur ? pri0 : NEGF; pri1 = j1 <= cur ? pri1 : NEGF;
                    }
                    float* pri = (float*)kb;
                    int* sidx = kb + 128;
                    pri[lane] = pri0; pri[lane + 64] = pri1;
                    WAVE_SYNC();
                    int rk0 = 0, rk1 = 0;
                    for (int i = 0; i < 128; ++i) { const float pi = pri[i]; rk0 += (pi > pri0 || (pi == pri0 && i < lane)) ? 1 : 0; rk1 += (pi > pri1 || (pi == pri1 && i < lane + 64)) ? 1 : 0; }
                    bool s0 = (lane <= cur) && rk0 < 16, s1 = (lane + 64 <= cur) && rk1 < 16;
#if defined(CHECK_KIND) && !defined(CHECK_OWNSEL)
                    { const unsigned* sg = SELMG + ((size_t)row * NSA_G + g) * 4; s0 = (sg[lane >> 5] >> (lane & 31)) & 1u; s1 = (sg[2 + (lane >> 5)] >> (lane & 31)) & 1u; }
#endif
                    const unsigned long long b0 = __ballot(s0), b1 = __ballot(s1);
                    const unsigned long long lt = (1ull << lane) - 1ull;
                    const int n0 = __popcll(b0);
                    WAVE_SYNC();
                    if (lane < 16) sidx[lane] = -1;
                    WAVE_SYNC();
                    if (s0) sidx[__popcll(b0 & lt)] = lane;
                    if (s1) sidx[n0 + __popcll(b1 & lt)] = lane + 64;
                    WAVE_SYNC();
                    int myblk = sidx[lane & 15];
                    {
                        float m[4] = {NEGF, NEGF, NEGF, NEGF}, l[4] = {0.f, 0.f, 0.f, 0.f}; os[0] = os[1] = os[2] = os[3] = 0.f;
                        const bf16_t* Ks = KB + 2 * st6 + g * 64; const bf16_t* Vs = KB + 3 * st6 + g * 64;
                        for (int c = 0; c < 2; ++c) {
                            attend_chunk<4>(qs2, pb, kb, Ks, Vs, 256, 512,
                                [=](int slot) { const int j = __shfl(myblk, c * 8 + (slot >> 6)); const int kk = j * 64 + (slot & 63); return (j >= 0 && kk <= t) ? (int)(b * S + kk) : -1; },
                                [=](int) { return 0.f; }, QSC, m, l, os, lane);
                        }
#pragma unroll
                        for (int h = 0; h < 4; ++h) os[h] /= fmaxf(l[h], 1e-30f);
                    }
                    {
                        float m[4] = {NEGF, NEGF, NEGF, NEGF}, l[4] = {0.f, 0.f, 0.f, 0.f}; ow[0] = ow[1] = ow[2] = ow[3] = 0.f;
                        const bf16_t* Kw = KB + 4 * st6 + g * 64; const bf16_t* Vw = KB + 5 * st6 + g * 64;
                        attend_chunk<4>(qs2, pb, kb, Kw, Vw, 256, 512,
                            [=](int slot) { const int kk = t - 511 + slot; return kk >= 0 ? (int)(b * S + kk) : -1; },
                            [=](int) { return 0.f; }, QSC, m, l, ow, lane);
#pragma unroll
                        for (int h = 0; h < 4; ++h) ow[h] /= fmaxf(l[h], 1e-30f);
                    }
#pragma unroll
                    for (int h = 0; h < 4; ++h) { const float* gt = GATES + row * 48 + (g * 4 + h) * 3;
                        AOn[row * D + (g * 4 + h) * 64 + lane] = (bf16_t)f2bf(gt[0] * oc[h] + gt[1] * os[h] + gt[2] * ow[h]); }
                }
            }
#endif
#if defined(MOBA_NAIVE) || (defined(CHECK_KIND) && CHECK_KIND == 2)
            if (kind == 2) {
                for (int task = gw; task < T * NH; task += NGW) {
                    const int t = task % S, bh = task / S, h = bh % NH, b = bh / NH; const size_t row = (size_t)b * S + t;
                    qs[lane] = bf2f(QB[row * D + h * 64 + lane]);
                    WAVE_SYNC();
                    const int cb = t >> 8;
                    float gs = NEGF;
                    if (lane < cb) { const float* km = KMEAN + ((size_t)bh * 32 + lane) * 64; float a = 0.f;
#pragma unroll 8
                        for (int d = 0; d < 64; ++d) a += qs[d] * km[d];
                        gs = a; }
                    if (lane >= 32) gs = -3e30f;
                    int sel[3];
#pragma unroll
                    for (int r = 0; r < 3; ++r) { const float mx = wave_max(gs); const unsigned long long bm = __ballot(gs == mx); const int win = __ffsll((long long)bm) - 1;
                        sel[r] = (win < cb) ? win : -1; if (lane == win) gs = -3e30f; }
                    float m[1] = {NEGF}, l[1] = {0.f}, o[1] = {0.f};
                    for (int c = 0; c < 2; ++c) {
                        const int blk0 = c == 0 ? sel[0] : sel[2], blk1 = c == 0 ? sel[1] : cb;
                        attend_chunk<1>(qs, pb, kb, KB + h * 64, VB + h * 64, D, 512,
                            [=](int slot) { const int blk = slot < 256 ? blk0 : blk1; const int kk = blk * 256 + (slot & 255); return (blk >= 0 && kk <= t) ? (int)(b * S + kk) : -1; },
                            [=](int) { return 0.f; }, QSC, m, l, o, lane);
                    }
                    AOn[row * D + h * 64 + lane] = (bf16_t)f2bf(o[0] / fmaxf(l[0], 1e-30f));
                }
            }
#endif
#if defined(ZERO_KIND)
            }
#endif
#if defined(CHECK_KIND)
            if (kind == CHECK_KIND) {
                SEAM_AT(1 + L * NPH + 4);
                float num = 0.f, den = 0.f;
                for (int i = gtid; i < T * D; i += NGT) { const float a = bf2f(AO[i]), b = bf2f(AOn[i]); num += (a - b) * (a - b); den += b * b; }
                num = wave_sum(num); den = wave_sum(den);
                if (lane == 0) { atomicAdd((float*)(ctl + CW_CHK), num); atomicAdd((float*)(ctl + CW_CHK + 1), den); }
            }
#endif
            SEAM_AT(1 + L * NPH + 4);
        }

        if (PH_EN(5) && IN(gp0 + 5)) { PH_IDS();
            pg8::Gemm g{AO, WOUT_T, T, D, D, 0, 0, nullptr}; pg8::StaticOrder So; So.init(T, D, G, bx);
            epi::Res<(L > 0)> E{(_Float16*)X, L == 0 ? args.in[0] : (const void*)XBB, D, DN_ALPHA};
            pg8::gemm_phase<epi::Res<(L > 0)>, pg8::StaticOrder, true, true>(ldsl, g, So, E);
            SEAM_AT(1 + L * NPH + 5);
        }

        if (PH_EN(6) && IN(gp0 + 6)) { PH_IDS();
            using gattn::bf16x8; using gattn::f32x16; using gattn::u32x4; using gattn::crow; using gattn::cvtpk_s;
            const float* g1 = (const float*)args.in[17] + L * D; const float* b1 = (const float*)args.in[18] + L * D;
            const float* rb = (const float*)args.in[20] + L * NE;
            unsigned* cnt = (unsigned*)(ctl + CW_CNT + L * 2048);
            constexpr int XP = 1032;
            bf16_t* XH = (bf16_t*)lds; bf16_t* XL = XH + 32 * XP;
            float* PL = (float*)lds;
            LAS int* lcnt = (LAS int*)(ldsl + 66048 * 2); LAS int* lbase = lcnt + 64;
            const int r32 = lane & 31, hi = lane >> 5;
            bf16x8 wh[8][2], wl[8][2];
#pragma unroll
            for (int st = 0; st < 8; ++st)
#pragma unroll
                for (int nb = 0; nb < 2; ++nb) { const size_t wo = (size_t)(nb * 32 + r32) * D + wave * 128 + 16 * st + 8 * hi; wh[st][nb] = *(const bf16x8*)(WRT + wo); wl[st][nb] = *(const bf16x8*)(WRT + (size_t)NE * D + wo); }
            for (int pass = bx; pass < T / 32; pass += G) {
                const size_t row0 = (size_t)pass * 32;
                if (tid < 64) lcnt[tid] = 0;
#pragma unroll
                for (int r = 0; r < 4; ++r) { const int rl = wave * 4 + r; const size_t row = row0 + rl; f32x4 v[4];
#pragma unroll
                    for (int j = 0; j < 4; ++j) { typedef _Float16 h4 __attribute__((ext_vector_type(4))); const h4 hv = *(const h4*)((const _Float16*)X + row * D + 4 * lane + 256 * j); v[j] = (f32x4){(float)hv[0], (float)hv[1], (float)hv[2], (float)hv[3]}; }
                    ln_row(v, g1, b1, lane);
#pragma unroll
                    for (int j = 0; j < 4; ++j) {
                        const unsigned h0 = cvtpk_s(v[j].x, v[j].y), h1 = cvtpk_s(v[j].z, v[j].w);
                        *(uint2*)(XBA + row * D + 4 * lane + 256 * j) = make_uint2(h0, h1);
                        const unsigned l0 = cvtpk_s(v[j].x - bflo(h0), v[j].y - bfhi(h0)), l1 = cvtpk_s(v[j].z - bflo(h1), v[j].w - bfhi(h1));
                        *(uint2*)(XH + rl * XP + 4 * lane + 256 * j) = make_uint2(h0, h1); *(uint2*)(XL + rl * XP + 4 * lane + 256 * j) = make_uint2(l0, l1); } }
                __syncthreads();
                f32x16 acc[2]; acc[0] = f32x16{}; acc[1] = f32x16{};
                {
#pragma unroll
                  for (int st = 0; st < 8; ++st) { const int k = wave * 128 + 16 * st + 8 * hi;
                      const bf16x8 xh = *(const bf16x8*)(XH + r32 * XP + k), xl = *(const bf16x8*)(XL + r32 * XP + k);
#pragma unroll
                      for (int nb = 0; nb < 2; ++nb) { acc[nb] = __builtin_amdgcn_mfma_f32_32x32x16_bf16(xh, wh[st][nb], acc[nb], 0, 0, 0); acc[nb] = __builtin_amdgcn_mfma_f32_32x32x16_bf16(xl, wh[st][nb], acc[nb], 0, 0, 0);
                          acc[nb] = __builtin_amdgcn_mfma_f32_32x32x16_bf16(xh, wl[st][nb], acc[nb], 0, 0, 0); } } }
                __syncthreads();
#pragma unroll
                for (int nb = 0; nb < 2; ++nb)
#pragma unroll
                    for (int r = 0; r < 16; ++r) PL[(wave * 32 + crow(r, hi)) * 64 + nb * 32 + r32] = acc[nb][r];
                __syncthreads();
                const float rbl = rb[lane]; float gws[4]; int rks[4], lps[4];
                float scv[4], bi[4], m1[4], m2[4]; int cand[4]; unsigned key[4], thr[4]; bool selv[4];
#pragma unroll
                for (int r = 0; r < 4; ++r) { const int rl = wave * 4 + r; float lg = 0.f;
#pragma unroll
                    for (int w = 0; w < 8; ++w) lg += PL[(w * 32 + rl) * 64 + lane];
                    scv[r] = sigmoidf_(lg); bi[r] = scv[r] + rbl; m1[r] = bi[r]; }
#pragma unroll
                for (int r = 0; r < 4; ++r) m1[r] = fmaxf(m1[r], xor_f<1>(m1[r]));
#pragma unroll
                for (int r = 0; r < 4; ++r) m1[r] = fmaxf(m1[r], xor_f<2>(m1[r]));
#pragma unroll
                for (int r = 0; r < 4; ++r) { m1[r] = fmaxf(m1[r], xor_f<4>(m1[r])); cand[r] = (bi[r] == m1[r]) ? lane : 64; }
#pragma unroll
                for (int r = 0; r < 4; ++r) cand[r] = min(cand[r], xor_i<1>(cand[r]));
#pragma unroll
                for (int r = 0; r < 4; ++r) cand[r] = min(cand[r], xor_i<2>(cand[r]));
#pragma unroll
                for (int r = 0; r < 4; ++r) { cand[r] = min(cand[r], xor_i<4>(cand[r])); m2[r] = (lane == cand[r]) ? -3e38f : bi[r]; }
#pragma unroll
                for (int r = 0; r < 4; ++r) m2[r] = fmaxf(m2[r], xor_f<1>(m2[r]));
#pragma unroll
                for (int r = 0; r < 4; ++r) m2[r] = fmaxf(m2[r], xor_f<2>(m2[r]));
#pragma unroll
                for (int r = 0; r < 4; ++r) { m2[r] = fmaxf(m2[r], xor_f<4>(m2[r]));
                    const float gsc = m1[r] + m2[r]; const int grp = lane >> 3; int grank = 0;
#pragma unroll
                    for (int gg = 0; gg < 8; ++gg) { const float og = bcast_f(gsc, gg * 8); grank += (og > gsc || (og == gsc && gg < grp)) ? 1 : 0; }
                    const float v = grank < 4 ? bi[r] : NEGF; const unsigned ub = __float_as_uint(v);
                    key[r] = (ub & 0x80000000u) ? ~ub : (ub | 0x80000000u); thr[r] = 0u; }
                for (int bit = 31; bit >= 0; --bit) {
#pragma unroll
                    for (int r = 0; r < 4; ++r) { const unsigned cd = thr[r] | (1u << bit); thr[r] = __popcll(__builtin_amdgcn_ballot_w64(key[r] >= cd)) >= 8 ? cd : thr[r]; } }
                const unsigned long long lt = (1ull << lane) - 1ull;
#pragma unroll
                for (int r = 0; r < 4; ++r) { const unsigned long long gm = __builtin_amdgcn_ballot_w64(key[r] > thr[r]); unsigned long long em = __builtin_amdgcn_ballot_w64(key[r] == thr[r]);
                    int need = 8 - __popcll(gm); unsigned long long tm = 0ull;
                    while (need > 0 && em) { const unsigned long long lowb = em & (0ull - em); tm |= lowb; em ^= lowb; --need; }
                    const unsigned long long m = gm | tm; selv[r] = (m >> lane) & 1ull; rks[r] = selv[r] ? __popcll(m & lt) : -1; }
                float ssum[4];
#pragma unroll
                for (int r = 0; r < 4; ++r) ssum[r] = selv[r] ? scv[r] : 0.f;
#pragma unroll
                for (int r = 0; r < 4; ++r) ssum[r] += xor_f<1>(ssum[r]);
#pragma unroll
                for (int r = 0; r < 4; ++r) ssum[r] += xor_f<2>(ssum[r]);
#pragma unroll
                for (int r = 0; r < 4; ++r) ssum[r] += xor_f<4>(ssum[r]);
#pragma unroll
                for (int r = 0; r < 4; ++r) ssum[r] += xor_f<8>(ssum[r]);
#pragma unroll
                for (int r = 0; r < 4; ++r) { ssum[r] += xor_f<16>(ssum[r]); auto rr = __builtin_amdgcn_permlane32_swap(__float_as_uint(ssum[r]), __float_as_uint(ssum[r]), false, false); ssum[r] = __uint_as_float(rr[0]) + __uint_as_float(rr[1]);
                    gws[r] = scv[r] / ssum[r] * 2.5f; }
#pragma unroll
                for (int r = 0; r < 4; ++r) lps[r] = selv[r] ? __hip_atomic_fetch_add((int*)(lcnt + lane), 1, __ATOMIC_RELAXED, __HIP_MEMORY_SCOPE_WORKGROUP) : 0;
                __syncthreads();
                if (tid < 64) { const int c = lcnt[tid]; lbase[tid] = c ? (int)atomicAdd(cnt + tid * 32, (unsigned)c) : 0; }
                __syncthreads();
                { const int base = lbase[lane];
#pragma unroll
                  for (int r = 0; r < 4; ++r) if (rks[r] >= 0) { const size_t rw = row0 + wave * 4 + r; const int pos = base + lps[r];
                      TOKE[rw * 8 + rks[r]] = lane; TOKW[rw * 8 + rks[r]] = gws[r]; TOKP[rw * 8 + rks[r]] = pos; ROWTOK[lane * 16384 + pos] = (int)rw; } }
                __syncthreads();
            }
            SEAM_AT(1 + L * NPH + 6);
        }

        if (PH_EN(8) && IN(gp0 + 8)) { PH_IDS();
            __syncthreads();
            { LAS int* ntl = (LAS int*)ldsl;
              if (tid < 64) ntl[tid] = (int)((__hip_atomic_load((const unsigned*)(ctl + CW_CNT + L * 2048) + tid * 32, RLX_AGENT) + 255u) >> 8);
              __syncthreads();
              if (tid <= 64) { int s = 0; for (int e = 0; e < tid; ++e) s += ntl[e]; TAB[tid] = s; } }
            __syncthreads();
            const int nrt = 64 + TAB[64];
            pg8::Gemm g{XBA, WGU_T, 0, 0, D, 0, 0, ROWTOK}; MoeOrder So{TAB, 2, G, bx, nrt * 2, 1};
            epi::SwiGlu E{HB, 0};
            pg8::gemm_phase<epi::SwiGlu, MoeOrder, true, true, true>(ldsl, g, So, E);
            SEAM_AT(1 + L * NPH + 8);
        }

        if (PH_EN(9) && IN(gp0 + 9)) { PH_IDS();
            const int nrt = 64 + TAB[64];
            int kdn = ED; asm volatile("" : "+s"(kdn)); pg8::Gemm g{HB, WDN_T, 0, 0, kdn, 0, 0, nullptr}; MoeOrder So{TAB, 4, G, bx, nrt * 4, 0};
            epi::Down E{OUTR};
            pg8::gemm_phase<epi::Down, MoeOrder, true, true>(ldsl, g, So, E);
            SEAM_AT(1 + L * NPH + 9);
        }

        if (PH_EN(10) && IN(gp0 + 10)) { PH_IDS();
            const float* g2 = (const float*)args.in[27] + L * D; const float* b2 = (const float*)args.in[28] + L * D;
#if defined(OUTR_FP8)
            for (int rowa = gw; rowa < T; rowa += 2 * NGW) {
                typedef float f32x2n __attribute__((ext_vector_type(2)));
                f32x4 v[2][4]; int ws_[2][4], wk[2][TOPK][4]; float gk[2][TOPK]; bool has[2];
#pragma unroll
                for (int u = 0; u < 2; ++u) { const int row = rowa + u * NGW; has[u] = row < T; if (!has[u]) continue;
#pragma unroll
                    for (int j = 0; j < 4; ++j) { const uint2 w = *(const uint2*)(XBA + (size_t)row * D + 4 * lane + 256 * j); v[u][j] = (f32x4){bflo(w.x), bfhi(w.x), bflo(w.y), bfhi(w.y)} * DN_ALPHA; }
                    const unsigned char* o = (const unsigned char*)OUTR + (size_t)row * D;
#pragma unroll
                    for (int j = 0; j < 4; ++j) ws_[u][j] = (int)__builtin_nontemporal_load((const unsigned*)(o + 4 * lane + 256 * j));
#pragma unroll
                    for (int k = 0; k < TOPK; ++k) { const int dest = TAB[TOKE[row * 8 + k]] * 256 + TOKP[row * 8 + k]; gk[u][k] = TOKW[row * 8 + k] * (1.f / 64.f); const unsigned char* ok = (const unsigned char*)OUTR + ((size_t)T + dest) * D;
#pragma unroll
                        for (int j = 0; j < 4; ++j) wk[u][k][j] = (int)__builtin_nontemporal_load((const unsigned*)(ok + 4 * lane + 256 * j)); } }
#pragma unroll
                for (int u = 0; u < 2; ++u) { const int row = rowa + u * NGW; if (!has[u]) continue;
#pragma unroll
                    for (int j = 0; j < 4; ++j) { const f32x2n a = __builtin_amdgcn_cvt_pk_f32_fp8(ws_[u][j], false), c = __builtin_amdgcn_cvt_pk_f32_fp8(ws_[u][j], true);
                        v[u][j].x += a.x * (1.f / 64.f); v[u][j].y += a.y * (1.f / 64.f); v[u][j].z += c.x * (1.f / 64.f); v[u][j].w += c.y * (1.f / 64.f); }
#pragma unroll
                    for (int k = 0; k < TOPK; ++k) { const float gwk = gk[u][k];
#pragma unroll
                        for (int j = 0; j < 4; ++j) { const f32x2n a = __builtin_amdgcn_cvt_pk_f32_fp8(wk[u][k][j], false), c = __builtin_amdgcn_cvt_pk_f32_fp8(wk[u][k][j], true);
                            v[u][j].x += gwk * a.x; v[u][j].y += gwk * a.y; v[u][j].z += gwk * c.x; v[u][j].w += gwk * c.y; } }
                    ln_row(v[u], g2, b2, lane);
#pragma unroll
                    for (int j = 0; j < 4; ++j)
                        *(unsigned long long*)(XBA + (size_t)row * D + 4 * lane + 256 * j) = (unsigned long long)pk2(v[u][j].x, v[u][j].y) | ((unsigned long long)pk2(v[u][j].z, v[u][j].w) << 32); }
            }
#else
            for (int row = gw; row < T; row += NGW) {
                f32x4 v[4];
#pragma unroll
                for (int j = 0; j < 4; ++j) { const uint2 w = *(const uint2*)(XBA + (size_t)row * D + 4 * lane + 256 * j); v[j] = (f32x4){bflo(w.x), bfhi(w.x), bflo(w.y), bfhi(w.y)} * DN_ALPHA; }
#if defined(OUTR_FP8)
                {   typedef float f32x2n __attribute__((ext_vector_type(2)));
                    const unsigned char* o = (const unsigned char*)OUTR + (size_t)row * D;
#pragma unroll
                    for (int j = 0; j < 4; ++j) { const int w = (int)__builtin_nontemporal_load((const unsigned*)(o + 4 * lane + 256 * j)); const f32x2n a = __builtin_amdgcn_cvt_pk_f32_fp8(w, false), c = __builtin_amdgcn_cvt_pk_f32_fp8(w, true);
                        v[j].x += a.x * (1.f / 64.f); v[j].y += a.y * (1.f / 64.f); v[j].z += c.x * (1.f / 64.f); v[j].w += c.y * (1.f / 64.f); }
                    for (int k = 0; k < TOPK; ++k) { const int dest = TAB[TOKE[row * 8 + k]] * 256 + TOKP[row * 8 + k]; const float gwk = TOKW[row * 8 + k] * (1.f / 64.f); const unsigned char* ok = (const unsigned char*)OUTR + ((size_t)T + dest) * D;
#pragma unroll
                        for (int j = 0; j < 4; ++j) { const int w = (int)__builtin_nontemporal_load((const unsigned*)(ok + 4 * lane + 256 * j)); const f32x2n a = __builtin_amdgcn_cvt_pk_f32_fp8(w, false), c = __builtin_amdgcn_cvt_pk_f32_fp8(w, true);
                            v[j].x += gwk * a.x; v[j].y += gwk * a.y; v[j].z += gwk * c.x; v[j].w += gwk * c.y; } } }
#else
                {
                    const bf16_t* o = OUTR + (size_t)row * D;
#pragma unroll
                    for (int j = 0; j < 4; ++j) { typedef unsigned u32x2n __attribute__((ext_vector_type(2))); const u32x2n w = __builtin_nontemporal_load((const u32x2n*)(o + 4 * lane + 256 * j)); v[j].x += bflo(w.x); v[j].y += bfhi(w.x); v[j].z += bflo(w.y); v[j].w += bfhi(w.y); }
                }
                for (int k = 0; k < TOPK; ++k) { const int dest = TAB[TOKE[row * 8 + k]] * 256 + TOKP[row * 8 + k]; const float gwk = TOKW[row * 8 + k]; const bf16_t* o = OUTR + ((size_t)T + dest) * D;
#pragma unroll
                    for (int j = 0; j < 4; ++j) { typedef unsigned u32x2n __attribute__((ext_vector_type(2))); const u32x2n w = __builtin_nontemporal_load((const u32x2n*)(o + 4 * lane + 256 * j)); v[j].x += gwk * bflo(w.x); v[j].y += gwk * bfhi(w.x); v[j].z += gwk * bflo(w.y); v[j].w += gwk * bfhi(w.y); } }
#endif
                ln_row(v, g2, b2, lane);
#pragma unroll
                for (int j = 0; j < 4; ++j) {
                    *(unsigned long long*)(XBA + (size_t)row * D + 4 * lane + 256 * j) = (unsigned long long)pk2(v[j].x, v[j].y) | ((unsigned long long)pk2(v[j].z, v[j].w) << 32); }
            }
#endif
            SEAM_AT(1 + L * NPH + 10);
        }

        if (PH_EN(12) && IN(gp0 + 12)) { PH_IDS();
            pg8::Gemm g{XBA, WPG_T, T, D, D, 0, 0, nullptr}; pg8::StaticOrder So; So.init(T, D, G, bx);
            epi::Ple<(L == DEPTH - 1)> E{XBA, PP, args.out, XBB};
            pg8::gemm_phase<epi::Ple<(L == DEPTH - 1)>, pg8::StaticOrder, true, true>(ldsl, g, So, E);
#if defined(TIME_P1)
            SEAM_AT(1 + L * NPH + 12);
#else
            if (L != DEPTH - 1) SEAM_AT(1 + L * NPH + 12);
#endif
        }
    };
    layer_body(std::integral_constant<int, 0>{}); layer_body(std::integral_constant<int, 1>{}); layer_body(std::integral_constant<int, 2>{}); layer_body(std::integral_constant<int, 3>{});
#if defined(TIME_P1)
    {   PH_IDS();
        xcd_barrier(bar);
        const unsigned long long* ts = (const unsigned long long*)(ctl + CW_TS);
        int dig[2];
        for (int q = 0; q < 2; ++q) { const int p = q ? TIME_P2 : TIME_P1; unsigned long long tot = 0;
            for (int L2 = 0; L2 < DEPTH; ++L2) { if (TIME_LSEL >= 0 && L2 != (q ? TIME_LSEL2 : TIME_LSEL)) continue; const int k = 1 + L2 * NPH + p; const unsigned long long te = __hip_atomic_load(ts + k, RLX_AGENT); if (te == 0ull) continue;
                unsigned long long tb = 0ull; for (int k2 = k - 1; k2 >= 0 && tb == 0ull; --k2) tb = __hip_atomic_load(ts + k2, RLX_AGENT);
                tot += te - tb; }
            const float us = (float)tot * 0.01f * TIME_MUL; int d = (int)floorf(log2f(fmaxf(us, 1.f))) - 3; dig[q] = d < 0 ? 0 : d > 9 ? 9 : d; }
        const float sc = 1.f + sqrtf(0.01f * (float)(10 * (dig[0] + 1) + dig[1]));
        for (int i = gtid; i < T * D; i += NGT) args.out[i] *= sc; }
#endif
#if defined(CHECK_KIND)
    {   PH_IDS(); SEAM();
        const float num = __hip_atomic_load((float*)(ctl + CW_CHK), RLX_AGENT), den = __hip_atomic_load((float*)(ctl + CW_CHK + 1), RLX_AGENT);
        const float sc = 1.f + 100.f * sqrtf(num / fmaxf(den, 1e-30f));
        for (int i = gtid; i < T * D; i += NGT) args.out[i] *= sc; }
#endif
#undef SEAM
#undef IN
}

extern "C" void kernel_launch(void* const* d_in, const int* in_sizes, int n_in, void* d_out, int out_size, void* d_ws, size_t ws_size, hipStream_t stream) {
    static int grid = 0;
    if (grid == 0) {
        if (n_in != 31 || out_size != T * D || ws_size < WS_END) { fprintf(stderr, "kernel_launch: unexpected problem (n_in %d, out %d, ws %zu < %zu)\n", n_in, out_size, ws_size, (size_t)WS_END); grid = -1; return; }
        int dev = 0, cus = 0, per_cu = 0;
        if (hipGetDevice(&dev) != hipSuccess || hipDeviceGetAttribute(&cus, hipDeviceAttributeMultiprocessorCount, dev) != hipSuccess) { grid = -1; return; }
        if (hipFuncSetAttribute((const void*)mk_fwd, hipFuncAttributeMaxDynamicSharedMemorySize, LDS_BYTES) != hipSuccess) { fprintf(stderr, "kernel_launch: hipFuncSetAttribute failed\n"); grid = -1; return; }
        if (hipOccupancyMaxActiveBlocksPerMultiprocessor(&per_cu, (const void*)mk_fwd, NTHR, LDS_BYTES) != hipSuccess || per_cu < 1) fprintf(stderr, "kernel_launch: occupancy query says %d\n", per_cu);
        (void)hipGetLastError();
        grid = cus;
    }
    if (grid < 0) return;
    (void)hipMemsetAsync((char*)d_ws + WS_CTL, 0, CTL_ZERO_BYTES, stream);
    Args a{};
    for (int i = 0; i < 31; ++i) a.in[i] = d_in[i];
    a.out = (float*)d_out; a.ws = (unsigned char*)d_ws;
#if MK_MULTI
    const int nph = 1 + DEPTH * NPH;
    for (int p = 0; p < nph; ++p) { a.ph_lo = p; a.ph_hi = p + 1; hipLaunchKernelGGL(mk_fwd, dim3(grid), dim3(NTHR), LDS_BYTES, stream, a); }
#else
    a.ph_lo = 0; a.ph_hi = 1 + DEPTH * NPH;
    hipLaunchKernelGGL(mk_fwd, dim3(grid), dim3(NTHR), LDS_BYTES, stream, a);
#endif
}
```

```cpp
#define MK_MULTI 0
#define OUTR_FP8 1
#define DOWN_LDS 1
#include <hip/hip_runtime.h>
#include <cstdio>
#include <cstdint>
namespace pg8 {
#define PG8_LAS __attribute__((address_space(3)))
typedef unsigned short bf16_t;
typedef short bf16x8 __attribute__((ext_vector_type(8)));
typedef float f32x4 __attribute__((ext_vector_type(4)));
typedef unsigned u32x4 __attribute__((ext_vector_type(4)));
constexpr int BM = 256, BK = 64, HALF = 128, HTB = HALF * BK * 2  , STAGE_BYTES = 8 * HTB, NXCD = 8, WGM = 8;

__host__ __device__ __forceinline__ int lds_byte(int r, int c) { const int st = (r >> 4) * 2 + (c >> 5), rr = r & 15, cc = c & 31, ob = rr * 64 + cc * 2; return st * 1024 + (ob ^ (((ob >> 9) & 1) << 5)); }
__host__ __device__ __forceinline__ void stage_rc(int b, int& R, int& C) { const int st = b / 1024, sb = b % 1024, swz = sb ^ (((sb >> 9) & 1) << 5); R = (st >> 1) * 16 + swz / 64; C = (st & 1) * 32 + (swz % 64) / 2; }
__host__ __device__ __forceinline__ int perm32(int rho) { const int n = rho >> 4, i = rho & 15; return 8 * (i >> 2) + 4 * n + (i & 3); }

struct Unit { int pm, pn; long aofs; };
struct Gemm { const bf16_t* A; const bf16_t* Bt; int M, N, K; int lda, kstepA; const int* gidx; };

struct StaticOrder {
    int nM, nN, nwg, G, c;
    __host__ __device__ void init(int M, int N, int G_, int c_) { nM = M / BM; nN = N / BM; nwg = nM * nN; G = G_; c = c_; }
    __host__ __device__ bool next(int i, Unit& u) const {
        const long L = (long)i * G + c; if (L >= nwg) return false;
        int wgid = (int)L; { const int q = nwg / NXCD, r = nwg % NXCD, xcd = wgid % NXCD, off = wgid / NXCD; wgid = (xcd < r ? xcd * (q + 1) : r * (q + 1) + (xcd - r) * q) + off; }
        const int nig = WGM * nN, gid = wgid / nig, fm = gid * WGM, gsz = (nM - fm) < WGM ? (nM - fm) : WGM;
        u.pm = fm + ((wgid % nig) % gsz); u.pn = (wgid % nig) / gsz; u.aofs = 0; return true;
    }
    __device__ __forceinline__ void a_ready(const Unit&) const {}
    __device__ __forceinline__ void done(const Unit&) const {}
};

__device__ __forceinline__ unsigned cvt_pk_bf16(float lo, float hi) { unsigned r; asm volatile("v_cvt_pk_bf16_f32 %0, %1, %2" : "=v"(r) : "v"(lo), "v"(hi)); return r; }
typedef float f32x2 __attribute__((ext_vector_type(2)));
__device__ __forceinline__ f32x2 gelu_pk(f32x2 v) {
    const f32x2 av = __builtin_elementwise_abs(v), d = av * 0.2316418882f + 1.0f;
    f32x2 t; t.x = __builtin_amdgcn_rcpf(d.x); t.y = __builtin_amdgcn_rcpf(d.y);
    f32x2 q = t * 0.5307027145f + (-0.7265760135f); q = q * t + 0.7107068705f; q = q * t + (-0.142248368f); q = q * t + 0.127414796f; q = q * t;
    const f32x2 s = (v * v) * (-0.72134752044f);
    f32x2 e; e.x = __builtin_amdgcn_exp2f(s.x); e.y = __builtin_amdgcn_exp2f(s.y);
    const f32x2 m = v * (q * e), r = v - m;
    f32x2 o; o.x = v.x < 0.f ? m.x : r.x; o.y = v.y < 0.f ? m.y : r.y; return o;
}

template <int ACT  > struct EpiBf16 {
    static constexpr bool PERM = true, AFTER_DRAIN = false; static_assert(ACT == 0 || ACT == 1, "EpiBf16: ACT is 0 (none) or 1 (gelu_pk)");
    bf16_t* O; int ldc; const float* bias; int split_cols; size_t split_stride; float scale0;
    __device__ __forceinline__ void operator()(const f32x4 (&acc)[2][2][4][2], const Unit& u, int wr, int wc, int fr, int fq) const {
        const int row0 = u.pm * BM + wr * 64 + fr; int colt = u.pn * BM; bf16_t* base = O;
        float sc = 1.f; if (split_cols) { const int t = colt / split_cols; base += (size_t)t * split_stride; colt -= t * split_cols; if (t == 0) sc = scale0; }
        const int col0 = colt + wc * 32 + 8 * fq, bcol0 = u.pn * BM + wc * 32 + 8 * fq;
        f32x4 bv[2][2];
#pragma unroll
        for (int bj = 0; bj < 2; ++bj)
#pragma unroll
            for (int n = 0; n < 2; ++n) bv[bj][n] = bias ? *(const f32x4*)(bias + bcol0 + bj * HALF + 4 * n) : (f32x4){0.f, 0.f, 0.f, 0.f};
#pragma unroll
        for (int ai = 0; ai < 2; ++ai)
#pragma unroll
            for (int m = 0; m < 4; ++m) { bf16_t* rowp = base + (size_t)(row0 + ai * HALF + m * 16) * ldc + col0;
#pragma unroll
                for (int bj = 0; bj < 2; ++bj) { f32x4 v0 = acc[ai][bj][m][0] + bv[bj][0], v1 = acc[ai][bj][m][1] + bv[bj][1];
                    if (ACT == 1) { f32x2 a = gelu_pk((f32x2){v0[0], v0[1]}), b = gelu_pk((f32x2){v0[2], v0[3]}), c = gelu_pk((f32x2){v1[0], v1[1]}), d = gelu_pk((f32x2){v1[2], v1[3]});
                        v0 = (f32x4){a.x, a.y, b.x, b.y}; v1 = (f32x4){c.x, c.y, d.x, d.y}; }
                    v0 = v0 * sc; v1 = v1 * sc; u32x4 w; w.x = cvt_pk_bf16(v0[0], v0[1]); w.y = cvt_pk_bf16(v0[2], v0[3]); w.z = cvt_pk_bf16(v1[0], v1[1]); w.w = cvt_pk_bf16(v1[2], v1[3]);
                    *(u32x4*)(rowp + bj * HALF) = w; } }
    }
};

struct PanelStats {
    unsigned* xbuf;
    unsigned* cnt;
    unsigned* tmo;
    int ntn; float eps;
    unsigned code;
    __device__ __forceinline__ bool run(const f32x4 (&v)[2][2][4][2], const Unit& u, int wr, int wc, int fr, int fq, PG8_LAS unsigned char* lds, int wid, int lane) const {
        typedef float f32x2v __attribute__((ext_vector_type(2)));
        PG8_LAS f32x2v* P = (PG8_LAS f32x2v*)lds;
        PG8_LAS f32x2v* S = (PG8_LAS f32x2v*)(lds + 8192);
        PG8_LAS unsigned* flag = (PG8_LAS unsigned*)(lds + 8192 + 2048);
#pragma unroll
        for (int ai = 0; ai < 2; ++ai)
#pragma unroll
            for (int m = 0; m < 4; ++m) {
                float s = 0.f;
#pragma unroll
                for (int bj = 0; bj < 2; ++bj)
#pragma unroll
                    for (int n = 0; n < 2; ++n) { const f32x4 x = v[ai][bj][m][n]; s += (x[0] + x[1]) + (x[2] + x[3]); }
                s += __shfl_xor(s, 16); s += __shfl_xor(s, 32);
                const float mw = s * (1.0f / 64.0f); float q = 0.f;
#pragma unroll
                for (int bj = 0; bj < 2; ++bj)
#pragma unroll
                    for (int n = 0; n < 2; ++n) { const f32x4 d = v[ai][bj][m][n] - mw; q += (d[0] * d[0] + d[1] * d[1]) + (d[2] * d[2] + d[3] * d[3]); }
                q += __shfl_xor(q, 16); q += __shfl_xor(q, 32);
                if (fq == 0) P[(ai * HALF + wr * 64 + m * 16 + fr) * 4 + wc] = (f32x2v){mw, q};
            }
        asm volatile("s_waitcnt lgkmcnt(0)" ::: "memory"); __builtin_amdgcn_s_barrier(); asm volatile("" ::: "memory");
#if defined(BROKEN_EXCHANGE_NO_WAIT)
#warning BROKEN CONTROL BUILD: the row-statistics exchange does not wait; results are wrong by design
        if (blockIdx.x >= 64) { const long long t0_ = clock64(); while (clock64() - t0_ < 60000) __builtin_amdgcn_s_sleep(8); }
#endif
        const int row = wid * 32 + (lane & 31);
        if (lane < 32) {
            const f32x2v a = P[row * 4 + 0], b = P[row * 4 + 1], c = P[row * 4 + 2], d = P[row * 4 + 3];
            const float mt = (a.x + b.x + c.x + d.x) * 0.25f;
            const float da = a.x - mt, db = b.x - mt, dc = c.x - mt, dd = d.x - mt;
            const float m2 = (a.y + b.y) + (c.y + d.y) + 64.0f * ((da * da + db * db) + (dc * dc + dd * dd));
            unsigned long long* slot = (unsigned long long*)xbuf + ((size_t)(u.pm * BM + row) * 4 + u.pn);
            __hip_atomic_store(slot, ((unsigned long long)__float_as_uint(m2) << 32) | __float_as_uint(mt), __ATOMIC_RELAXED, __HIP_MEMORY_SCOPE_AGENT);
        }
        asm volatile("s_waitcnt vmcnt(0)" ::: "memory");
        if (lane == 0) __hip_atomic_fetch_add(cnt + 64 * u.pm, 1u, __ATOMIC_RELAXED, __HIP_MEMORY_SCOPE_AGENT);
        if (wid == 0) {
            bool dead = false; const unsigned long long t0 = __builtin_amdgcn_s_memrealtime(); const unsigned want = 8u * (unsigned)ntn;
            for (;;) {
#if defined(BROKEN_EXCHANGE_NO_WAIT)
                break;
#endif
                if ((unsigned)__builtin_amdgcn_readfirstlane(__hip_atomic_load(cnt + 64 * u.pm, __ATOMIC_RELAXED, __HIP_MEMORY_SCOPE_AGENT)) >= want) break;
                if (__builtin_amdgcn_s_memrealtime() - t0 > 2000000ull) {
                    if (lane == 0) { unsigned expect = 0u; __hip_atomic_compare_exchange_strong(tmo + 1, &expect, code | (unsigned)(u.pm & 0xff), __ATOMIC_RELAXED, __ATOMIC_RELAXED, __HIP_MEMORY_SCOPE_AGENT);
                                     __hip_atomic_store(tmo, 1u, __ATOMIC_RELAXED, __HIP_MEMORY_SCOPE_AGENT); }
                    dead = true; break; }
                __builtin_amdgcn_s_sleep(2);
            }
            __builtin_amdgcn_fence(__ATOMIC_ACQUIRE, "agent");
            if (lane == 0) flag[0] = dead ? 1u : 0u;
        }
        asm volatile("s_waitcnt vmcnt(0) lgkmcnt(0)" ::: "memory"); __builtin_amdgcn_s_barrier(); asm volatile("" ::: "memory");
        const bool bad = flag[0] != 0u;
        if (lane < 32) {
            const unsigned long long* slot = (const unsigned long long*)xbuf + (size_t)(u.pm * BM + row) * 4; float mt[4], m2[4]; float ms = 0.f;
#pragma unroll
            for (int t = 0; t < 4; ++t) { if (t < ntn) { const unsigned long long w = __hip_atomic_load(slot + t, __ATOMIC_RELAXED, __HIP_MEMORY_SCOPE_AGENT); mt[t] = __uint_as_float((unsigned)w); m2[t] = __uint_as_float((unsigned)(w >> 32)); } else { mt[t] = 0.f; m2[t] = 0.f; } ms += mt[t]; }
            const float mean = ms / (float)ntn; float q = 0.f;
#pragma unroll
            for (int t = 0; t < 4; ++t) if (t < ntn) { const float dm = mt[t] - mean; q += m2[t] + 256.0f * dm * dm; }
            S[row] = (f32x2v){mean, 1.0f / sqrtf(q / (256.0f * (float)ntn) + eps)};
        }
        asm volatile("s_waitcnt lgkmcnt(0)" ::: "memory"); __builtin_amdgcn_s_barrier(); asm volatile("" ::: "memory");
        return bad;
    }
};
struct EpiLnRes {
    static constexpr bool PERM = false, AFTER_DRAIN = true;
    const float* base; float* out; int ldc; const float* bias; PanelStats st; unsigned poison;
    __device__ __forceinline__ void fused(f32x4 (&acc)[2][2][4][2], const Unit& u, int wr, int wc, int fr, int fq, PG8_LAS unsigned char* lds, int wid, int lane) const {
        typedef float f32x2v __attribute__((ext_vector_type(2)));
        const PG8_LAS f32x2v* S = (const PG8_LAS f32x2v*)(lds + 8192);
        const int col0 = u.pn * BM + wc * 32 + 4 * fq;
#pragma unroll
        for (int bj = 0; bj < 2; ++bj)
#pragma unroll
            for (int n = 0; n < 2; ++n) { const f32x4 bv = bias ? *(const f32x4*)(bias + col0 + bj * HALF + n * 16) : (f32x4){0.f, 0.f, 0.f, 0.f};
#pragma unroll
                for (int ai = 0; ai < 2; ++ai)
#pragma unroll
                    for (int m = 0; m < 4; ++m) acc[ai][bj][m][n] += bv; }
        f32x4 pre[4][2][2];
#pragma unroll
        for (int m = 0; m < 4; ++m) { const size_t off = (size_t)(u.pm * BM + wr * 64 + m * 16 + fr) * ldc + col0;
#pragma unroll
            for (int bj = 0; bj < 2; ++bj)
#pragma unroll
                for (int n = 0; n < 2; ++n) pre[m][bj][n] = *(const f32x4*)(base + off + bj * HALF + n * 16); }
        const bool bad = st.run(acc, u, wr, wc, fr, fq, lds, wid, lane) || poison != 0u;
        const float qnan = __builtin_nanf("");
#pragma unroll
        for (int ai = 0; ai < 2; ++ai)
#pragma unroll
            for (int m = 0; m < 4; ++m) { const int r = ai * HALF + wr * 64 + m * 16 + fr; const f32x2v sr = S[r]; const size_t off = (size_t)(u.pm * BM + r) * ldc + col0;
#pragma unroll
                for (int bj = 0; bj < 2; ++bj)
#pragma unroll
                    for (int n = 0; n < 2; ++n) { const f32x4 bs = ai == 0 ? pre[m][bj][n] : *(const f32x4*)(base + off + bj * HALF + n * 16); f32x4 o = bs + (acc[ai][bj][m][n] - sr.x) * sr.y;
                        if (bad) o = (f32x4){qnan, qnan, qnan, qnan}; *(f32x4*)(out + off + bj * HALF + n * 16) = o; }
                if (m & 1) asm volatile("" ::: "memory"); }
    }
};
struct EpiLnResLn {
    static constexpr bool PERM = false, AFTER_DRAIN = true;
    const float* base; float* out; bf16_t* xn; int ldc; const float* bias; PanelStats st1, st2; unsigned poison;
    __device__ __forceinline__ void fused(f32x4 (&acc)[2][2][4][2], const Unit& u, int wr, int wc, int fr, int fq, PG8_LAS unsigned char* lds, int wid, int lane) const {
        typedef float f32x2v __attribute__((ext_vector_type(2))); typedef unsigned u32x2v __attribute__((ext_vector_type(2)));
        const PG8_LAS f32x2v* S = (const PG8_LAS f32x2v*)(lds + 8192);
        const int col0 = u.pn * BM + wc * 32 + 4 * fq;
#pragma unroll
        for (int bj = 0; bj < 2; ++bj)
#pragma unroll
            for (int n = 0; n < 2; ++n) { const f32x4 bv = bias ? *(const f32x4*)(bias + col0 + bj * HALF + n * 16) : (f32x4){0.f, 0.f, 0.f, 0.f};
#pragma unroll
                for (int ai = 0; ai < 2; ++ai)
#pragma unroll
                    for (int m = 0; m < 4; ++m) acc[ai][bj][m][n] += bv; }
        bool bad = st1.run(acc, u, wr, wc, fr, fq, lds, wid, lane) || poison != 0u;
        const float qnan = __builtin_nanf("");
#pragma unroll
        for (int ai = 0; ai < 2; ++ai)
#pragma unroll
            for (int m = 0; m < 4; ++m) { const int r = ai * HALF + wr * 64 + m * 16 + fr; const f32x2v sr = S[r]; const size_t off = (size_t)(u.pm * BM + r) * ldc + col0;
#pragma unroll
                for (int bj = 0; bj < 2; ++bj)
#pragma unroll
                    for (int n = 0; n < 2; ++n) { const f32x4 bs = *(const f32x4*)(base + off + bj * HALF + n * 16); acc[ai][bj][m][n] = bs + (acc[ai][bj][m][n] - sr.x) * sr.y; }
                asm volatile("" : "+v"(acc[ai][0][m][0]), "+v"(acc[ai][0][m][1]), "+v"(acc[ai][1][m][0]), "+v"(acc[ai][1][m][1]));
                if (m & 1) asm volatile("" ::: "memory"); }
        const bool bad1 = bad;
        bad = st2.run(acc, u, wr, wc, fr, fq, lds, wid, lane) || bad;
#pragma unroll
        for (int ai = 0; ai < 2; ++ai)
#pragma unroll
            for (int m = 0; m < 4; ++m) { const int r = ai * HALF + wr * 64 + m * 16 + fr; const f32x2v sr = S[r]; const size_t off = (size_t)(u.pm * BM + r) * ldc + col0;
#pragma unroll
                for (int bj = 0; bj < 2; ++bj)
#pragma unroll
                    for (int n = 0; n < 2; ++n) { const f32x4 x1 = acc[ai][bj][m][n]; *(f32x4*)(out + off + bj * HALF + n * 16) = bad1 ? (f32x4){qnan, qnan, qnan, qnan} : x1;
                        const f32x4 o = (x1 - sr.x) * sr.y; u32x2v w; w.x = cvt_pk_bf16(o[0], o[1]); w.y = cvt_pk_bf16(o[2], o[3]);
                        if (bad) { w.x = 0x7fc07fc0u; w.y = 0x7fc07fc0u; } *(u32x2v*)(xn + off + bj * HALF + n * 16) = w; }
                asm volatile("" ::: "memory"); }
    }
};

template <class Epi, class Sched, bool ALIGN_EPI = false, bool SP2 = false, bool GATHER = false>
__device__ __forceinline__ void gemm_phase(PG8_LAS unsigned char* lds, const Gemm g, const Sched& S, const Epi& E) {
    static_assert(!GATHER || SP2, "gathered A rows: SP2 loop only");
    int tid_o = threadIdx.x; asm volatile("" : "+v"(tid_o)); const int tid = tid_o, wid = __builtin_amdgcn_readfirstlane(tid >> 6), lane = tid & 63, wr = wid >> 2, wc = wid & 3, fr = lane & 15, fq = lane >> 4;
    const int K = g.K, nt = K / BK, lda = g.lda ? g.lda : K;
    unsigned voffA[2], voffB[2];
#pragma unroll
    for (int i = 0; i < 2; ++i) { int R, C; stage_rc(tid * 16 + i * 8192, R, C); const int Rb = Epi::PERM ? ((R & ~31) + perm32(R & 31)) : R;
        voffA[i] = (unsigned)(R * lda + C) * 2u; voffB[i] = (unsigned)(Rb * K + C) * 2u; }
    const size_t kstep = (size_t)(BK * 2);
    const size_t hstep = (size_t)HALF * K * 2;
    const size_t tstep = 2 * hstep;
    const size_t kstepA = g.kstepA ? (size_t)g.kstepA : kstep, hstepA = (size_t)HALF * lda * 2, tstepA = 2 * hstepA;
    const unsigned ldsw = (unsigned)wid * 1024u;
    const int aoff = lds_byte(wr * 64 + fr, fq * 8), boff = lds_byte(wc * 32 + fr, fq * 8);
#define PG8_SA(b, h) (((b) * 2 + (h)) * HTB)
#define PG8_SB(b, h) ((4 + (b) * 2 + (h)) * HTB)
#define PG8_STAGE(bufoff, gbase, voff) do { _Pragma("unroll") for (int _i = 0; _i < 2; ++_i) \
        __builtin_amdgcn_global_load_lds((const unsigned*)((const char*)(gbase) + (voff)[_i]), (PG8_LAS unsigned*)(lds + (bufoff) + ldsw + _i * 8192), 16, 0, 0); } while (0)
#define PG8_LDA(dst, b, h) do { _Pragma("unroll") for (int m = 0; m < 4; ++m) _Pragma("unroll") for (int k = 0; k < 2; ++k) dst[m][k] = *(const PG8_LAS bf16x8*)(lds + PG8_SA(b, h) + aoff + m * 2048 + k * 1024); } while (0)
#define PG8_LDB(dst, b, h) do { _Pragma("unroll") for (int n = 0; n < 2; ++n) _Pragma("unroll") for (int k = 0; k < 2; ++k) dst[n][k] = *(const PG8_LAS bf16x8*)(lds + PG8_SB(b, h) + boff + n * 2048 + k * 1024); } while (0)
#define PG8_MMA(ai, bj, At, Bt) do { __builtin_amdgcn_s_setprio(1); _Pragma("unroll") for (int m = 0; m < 4; ++m) _Pragma("unroll") for (int n = 0; n < 2; ++n) _Pragma("unroll") for (int k = 0; k < 2; ++k) \
        acc[ai][bj][m][n] = __builtin_amdgcn_mfma_f32_16x16x32_bf16(Bt[n][k], At[m][k], acc[ai][bj][m][n], 0, 0, 0); __builtin_amdgcn_s_setprio(0); } while (0)
#define PG8_WAIT_V(n) asm volatile("s_waitcnt vmcnt(" #n ")" ::: "memory")
#define PG8_WAIT_L(n) asm volatile("s_waitcnt lgkmcnt(" #n ")" ::: "memory")
#define PG8_BAR __builtin_amdgcn_s_barrier()
#define PG8_SCHED __builtin_amdgcn_sched_barrier(0)
    unsigned gcu[2][2] = {{0u, 0u}, {0u, 0u}}, gnx[2][2] = {{0u, 0u}, {0u, 0u}};
#define PG8_GOFF(dst, u) do { int t_ = tid; asm volatile("" : "+v"(t_));   \
        _Pragma("unroll") for (int _h = 0; _h < 2; ++_h) _Pragma("unroll") for (int _i = 0; _i < 2; ++_i) { int R_, C_; stage_rc(t_ * 16 + _i * 8192, R_, C_); \
        dst[_h][_i] = (unsigned)((g.gidx[(u).pm * BM + _h * HALF + R_] & 16383) * lda + C_) * 2u; } } while (0)
#define PG8_STAGE_A(bufoff, gbase, H, NEXT) do { if constexpr (GATHER) { if (NEXT) PG8_STAGE(bufoff, gbase, gnx[H]); else PG8_STAGE(bufoff, gbase, gcu[H]); } else { PG8_STAGE(bufoff, (gbase) + ((H) ? hstepA : 0), voffA); } } while (0)
    Unit cur, nxt; int ui = 0;
    if (!S.next(0, cur)) return;
    f32x4 acc[2][2][4][2];
#pragma unroll
    for (int a = 0; a < 2; ++a)
#pragma unroll
        for (int b = 0; b < 2; ++b)
#pragma unroll
            for (int m = 0; m < 4; ++m)
#pragma unroll
                for (int n = 0; n < 2; ++n) acc[a][b][m][n] = (f32x4){0.f, 0.f, 0.f, 0.f};
    bf16x8 At[4][2], B0[2][2], B1[2][2];
    if constexpr (GATHER) PG8_GOFF(gcu, cur);
    const char* cA = GATHER ? (const char*)g.A : (const char*)g.A + (size_t)cur.pm * tstepA + cur.aofs; const char* cB = (const char*)g.Bt + (size_t)cur.pn * tstep;
    S.a_ready(cur);
    if constexpr (SP2) {
        PG8_STAGE(PG8_SB(0, 0), cB, voffB); PG8_STAGE(PG8_SB(0, 1), cB + hstep, voffB); PG8_STAGE_A(PG8_SA(0, 0), cA, 0, false); PG8_STAGE_A(PG8_SA(0, 1), cA, 1, false);
        if (wr == 1) PG8_BAR;
        PG8_WAIT_V(2); PG8_BAR;
        PG8_STAGE(PG8_SB(1, 0), cB + kstep, voffB); PG8_STAGE_A(PG8_SA(1, 0), cA + kstepA, 0, false); PG8_STAGE(PG8_SB(1, 1), cB + hstep + kstep, voffB);
        PG8_WAIT_V(6); PG8_BAR;
    } else {
        PG8_STAGE(PG8_SB(0, 0), cB, voffB); PG8_STAGE(PG8_SA(0, 0), cA, voffA); PG8_STAGE(PG8_SB(0, 1), cB + hstep, voffB); PG8_STAGE(PG8_SA(0, 1), cA + hstepA, voffA);
        if (wr == 1) PG8_BAR;
        PG8_WAIT_V(4); PG8_BAR;
        PG8_STAGE(PG8_SB(1, 0), cB + kstep, voffB); PG8_STAGE(PG8_SA(1, 0), cA + kstepA, voffA); PG8_STAGE(PG8_SB(1, 1), cB + hstep + kstep, voffB);
        PG8_WAIT_V(6); PG8_BAR;
    }
    for (;;) {
        const bool has_next = S.next(ui + 1, nxt);
        const char* nA = GATHER ? cA : (has_next ? (const char*)g.A + (size_t)nxt.pm * tstepA + nxt.aofs : cA); const char* nB = has_next ? (const char*)g.Bt + (size_t)nxt.pn * tstep : cB;
        for (int t = 0; t < nt; t += 2) {
            const bool last = (t == nt - 2);
            const char* a1 = cA + (size_t)(t + 1) * kstepA;
            const char* a2 = last ? nA : cA + (size_t)(t + 2) * kstepA; const char* b2 = last ? nB : cB + (size_t)(t + 2) * kstep;
            const char* a3 = a2 + kstepA; const char* b3 = b2 + kstep;
            if (last && has_next) S.a_ready(nxt);
            if constexpr (GATHER) { if (t == (nt >= 4 ? nt - 4 : 0)) { if (has_next) PG8_GOFF(gnx, nxt); else { gnx[0][0] = gcu[0][0]; gnx[0][1] = gcu[0][1]; gnx[1][0] = gcu[1][0]; gnx[1][1] = gcu[1][1]; } } }
            if constexpr (SP2) {
            PG8_LDB(B0, 0, 0); PG8_LDB(B1, 0, 1); PG8_SCHED; PG8_LDA(At, 0, 0); PG8_STAGE_A(PG8_SA(1, 1), a1, 1, false);
            PG8_WAIT_V(8); PG8_WAIT_L(0); PG8_BAR; PG8_MMA(0, 0, At, B0); PG8_MMA(0, 1, At, B1); PG8_BAR; PG8_SCHED;
            PG8_LDA(At, 0, 1); PG8_STAGE(PG8_SB(0, 0), b2, voffB); PG8_STAGE(PG8_SB(0, 1), b2 + hstep, voffB); PG8_STAGE_A(PG8_SA(0, 0), a2, 0, last);
            PG8_WAIT_V(8); PG8_WAIT_L(0); PG8_BAR; PG8_MMA(1, 0, At, B0); PG8_MMA(1, 1, At, B1); PG8_BAR; PG8_SCHED;
            PG8_LDB(B0, 1, 0); PG8_LDB(B1, 1, 1); PG8_SCHED; PG8_LDA(At, 1, 0); PG8_STAGE_A(PG8_SA(0, 1), a2, 1, last);
            PG8_WAIT_V(8); PG8_WAIT_L(0); PG8_BAR; PG8_MMA(0, 0, At, B0); PG8_MMA(0, 1, At, B1); PG8_BAR; PG8_SCHED;
            PG8_LDA(At, 1, 1); PG8_STAGE(PG8_SB(1, 0), b3, voffB); PG8_STAGE(PG8_SB(1, 1), b3 + hstep, voffB); PG8_STAGE_A(PG8_SA(1, 0), a3, 0, last);
            PG8_WAIT_V(8); PG8_WAIT_L(0); PG8_BAR; PG8_MMA(1, 0, At, B0); PG8_MMA(1, 1, At, B1); PG8_BAR; PG8_SCHED;
            } else {
            PG8_LDB(B0, 0, 0); PG8_SCHED; PG8_LDA(At, 0, 0); PG8_STAGE(PG8_SA(1, 1), a1 + hstepA, voffA);
            PG8_WAIT_L(8); PG8_BAR; PG8_WAIT_L(0); PG8_MMA(0, 0, At, B0); PG8_BAR; PG8_SCHED;
            PG8_LDB(B1, 0, 1); PG8_STAGE(PG8_SB(0, 0), b2, voffB);
            PG8_BAR; PG8_WAIT_L(0); PG8_MMA(0, 1, At, B1); PG8_BAR;
            PG8_LDA(At, 0, 1); PG8_STAGE(PG8_SA(0, 0), a2, voffA);
            PG8_BAR; PG8_WAIT_L(0); PG8_MMA(1, 0, At, B0); PG8_BAR; PG8_SCHED;
            PG8_STAGE(PG8_SB(0, 1), b2 + hstep, voffB);
            PG8_WAIT_V(6); PG8_BAR; PG8_MMA(1, 1, At, B1); PG8_BAR;
            PG8_LDB(B0, 1, 0); PG8_SCHED; PG8_LDA(At, 1, 0); PG8_STAGE(PG8_SA(0, 1), a2 + hstepA, voffA);
            PG8_WAIT_L(8); PG8_BAR; PG8_WAIT_L(0); PG8_MMA(0, 0, At, B0); PG8_BAR; PG8_SCHED;
            PG8_LDB(B1, 1, 1); PG8_STAGE(PG8_SB(1, 0), b3, voffB);
            PG8_BAR; PG8_WAIT_L(0); PG8_MMA(0, 1, At, B1); PG8_BAR;
            PG8_LDA(At, 1, 1); PG8_STAGE(PG8_SA(1, 0), a3, voffA);
            PG8_BAR; PG8_WAIT_L(0); PG8_MMA(1, 0, At, B0); PG8_BAR; PG8_SCHED;
            PG8_STAGE(PG8_SB(1, 1), b3 + hstep, voffB);
            PG8_WAIT_V(6); PG8_BAR; PG8_MMA(1, 1, At, B1); PG8_BAR;
            }
        }
        if constexpr (ALIGN_EPI) { if (wr == 0) PG8_BAR; }
        if constexpr (!Epi::AFTER_DRAIN) { E(acc, cur, wr, wc, fr, fq); S.done(cur); }
        if (!has_next) break;
#pragma unroll
        for (int a = 0; a < 2; ++a)
#pragma unroll
            for (int b = 0; b < 2; ++b)
#pragma unroll
                for (int m = 0; m < 4; ++m)
#pragma unroll
                    for (int n = 0; n < 2; ++n) acc[a][b][m][n] = (f32x4){0.f, 0.f, 0.f, 0.f};
        cur = nxt; cA = nA; cB = nB; ++ui;
        if constexpr (GATHER) { gcu[0][0] = gnx[0][0]; gcu[0][1] = gnx[0][1]; gcu[1][0] = gnx[1][0]; gcu[1][1] = gnx[1][1]; }
        if constexpr (ALIGN_EPI) { if (wr == 1) PG8_BAR; }
    }
    PG8_WAIT_V(0);
    if constexpr (!ALIGN_EPI) { if (wr == 0) PG8_BAR; }
    PG8_BAR;
    if constexpr (Epi::AFTER_DRAIN) { E.fused(acc, cur, wr, wc, fr, fq, lds, wid, lane); S.done(cur); }
#undef PG8_SA
#undef PG8_SB
#undef PG8_STAGE
#undef PG8_STAGE_A
#undef PG8_GOFF
#undef PG8_LDA
#undef PG8_LDB
#undef PG8_MMA
#undef PG8_WAIT_V
#undef PG8_WAIT_L
#undef PG8_BAR
#undef PG8_SCHED
}
}
#include <hip/hip_bf16.h>
#include <cmath>
namespace gattn {
using bf16=__hip_bfloat16;
using bf16x8=__attribute__((ext_vector_type(8)))short;
using s16x4=__attribute__((ext_vector_type(4)))short;
using f32x16=__attribute__((ext_vector_type(16)))float;
using u32x4=__attribute__((ext_vector_type(4)))unsigned;
constexpr int BATCH=2,NHEAD=16,SEQ=8192,D=64,DM=NHEAD*D;
constexpr int NW=8,QBLK=32,QB=QBLK*NW,KVBLK=64,NQB=SEQ/QB;
constexpr int ATTN_PITCH=DM, ATTN_UNIT_ROWS=QB;
__device__ __forceinline__ int crow(int r,int hi){return (r&3)+8*(r>>2)+4*hi;}
#define SBAR() __builtin_amdgcn_sched_barrier(0)
constexpr float NEGM=-60000.f;
__device__ __forceinline__ void emask(f32x16&p0,f32x16&p1,int kb,int lo,int hi_){
  #pragma unroll
  for(int r=0;r<16;++r){const int kv=kb+(r&3)+8*(r>>2); if(kv<lo||kv>hi_)p0[r]=NEGM; if(kv+32<lo||kv+32>hi_)p1[r]=NEGM;}
}

constexpr int NSLOT=3, SLOTB=8192;
constexpr int LDS_K=0, LDS_V=NSLOT*SLOTB, LDS_WS=2*NSLOT*SLOTB, LDS_OST=LDS_WS+NW*64*4, LDS_BT=LDS_OST+NW*4096, LDS_BYTES=LDS_BT+SEQ*4;
constexpr float C2=0.125f*1.4426950408889634f;
__device__ __forceinline__ void glds16(const void*gsrc,unsigned lds_dst){unsigned keep;
  asm volatile("s_mov_b32 %0, m0\n\ts_mov_b32 m0, %2\n\ts_nop 0\n\tglobal_load_lds_dwordx4 %1, off\n\ts_mov_b32 m0, %0":"=&s"(keep):"v"(gsrc),"s"(lds_dst):"memory");}
__device__ __forceinline__ float max3f(float a,float b,float c){float r;asm("v_max3_f32 %0, %1, %2, %3":"=v"(r):"v"(a),"v"(b),"v"(c));return r;}
__device__ __forceinline__ float max2f(float a,float b){float r;asm("v_max_f32_e32 %0, %1, %2":"=v"(r):"v"(a),"v"(b));return r;}
__device__ __forceinline__ float fadd_s(float a,float b){float r;asm("v_add_f32_e32 %0, %1, %2":"=v"(r):"v"(a),"v"(b));return r;}
__device__ __forceinline__ float fsub_s(float a,float b){float r;asm("v_sub_f32_e32 %0, %1, %2":"=v"(r):"v"(a),"v"(b));return r;}
typedef float f32x2_t __attribute__((ext_vector_type(2))); typedef __bf16 bf16x2_t __attribute__((ext_vector_type(2)));
__device__ __forceinline__ unsigned cvtpk_s(float lo,float hi){f32x2_t v={lo,hi};bf16x2_t b=__builtin_convertvector(v,bf16x2_t);return __builtin_bit_cast(unsigned,b);}
#define WAIT_BAR(N) asm volatile("s_waitcnt vmcnt(" #N ") lgkmcnt(0)\n\ts_barrier":::"memory")

typedef unsigned u32x2b __attribute__((ext_vector_type(2)));
__device__ __forceinline__ s16x4 bfrag(unsigned w){ u32x2b v={w,0u}; return __builtin_bit_cast(s16x4,v); }
#define BMFMA(a,b,c) __builtin_amdgcn_mfma_f32_32x32x8bf16_1k(a,b,c,0,0,0)
__device__ __forceinline__ void qkt(f32x16&p0,f32x16&p1,const char*Kslot,const bf16x8*qr,int r32,int hi){
  const char*kb=Kslot+hi*1024+r32*16;
  #pragma unroll
  for(int d0=0;d0<4;++d0){
    const bf16x8 b0=*reinterpret_cast<const bf16x8*>(kb+d0*2048);
    const bf16x8 b1=*reinterpret_cast<const bf16x8*>(kb+d0*2048+512);
    if(d0==0){const f32x16 z={};p0=__builtin_amdgcn_mfma_f32_32x32x16_bf16(b0,qr[0],z,0,0,0);p1=__builtin_amdgcn_mfma_f32_32x32x16_bf16(b1,qr[0],z,0,0,0);}
    else{p0=__builtin_amdgcn_mfma_f32_32x32x16_bf16(b0,qr[d0],p0,0,0,0);p1=__builtin_amdgcn_mfma_f32_32x32x16_bf16(b1,qr[d0],p1,0,0,0);}}
}
typedef __attribute__((address_space(3))) const char* lds_cptr;
typedef short v4i16_t __attribute__((ext_vector_type(4)));
__device__ __forceinline__ void kload8(bf16x8*kf,lds_cptr kp){
  kf[0]=*(const __attribute__((address_space(3))) bf16x8*)(kp);      kf[1]=*(const __attribute__((address_space(3))) bf16x8*)(kp+512);
  kf[2]=*(const __attribute__((address_space(3))) bf16x8*)(kp+2048); kf[3]=*(const __attribute__((address_space(3))) bf16x8*)(kp+2560);
  kf[4]=*(const __attribute__((address_space(3))) bf16x8*)(kp+4096); kf[5]=*(const __attribute__((address_space(3))) bf16x8*)(kp+4608);
  kf[6]=*(const __attribute__((address_space(3))) bf16x8*)(kp+6144); kf[7]=*(const __attribute__((address_space(3))) bf16x8*)(kp+6656);
}
__device__ __forceinline__ void kload2(bf16x8*kf,lds_cptr kp,int j){ kf[2*j]=*(const __attribute__((address_space(3))) bf16x8*)(kp+j*2048); kf[2*j+1]=*(const __attribute__((address_space(3))) bf16x8*)(kp+j*2048+512); }
__device__ __forceinline__ s16x4 vtr(lds_cptr p){ return __builtin_bit_cast(s16x4,__builtin_amdgcn_ds_read_tr16_b64_v4i16((__attribute__((address_space(3))) v4i16_t*)p)); }
__device__ __forceinline__ float rowmax(const f32x16&p0,const f32x16&p1){
  float a=max3f(p0[0],p0[1],p1[0]),b=max3f(p0[2],p0[3],p1[1]);a=max3f(a,p1[2],p1[3]);
  #pragma unroll
  for(int r=4;r<16;r+=4){a=max3f(a,p0[r],p0[r+1]);b=max3f(b,p0[r+2],p0[r+3]);a=max3f(a,p1[r],p1[r+1]);b=max3f(b,p1[r+2],p1[r+3]);}
  const float m=max2f(a,b);
  auto rr=__builtin_amdgcn_permlane32_swap(__float_as_uint(m),__float_as_uint(m),false,false);
  return max2f(__uint_as_float(rr[0]),__uint_as_float(rr[1]));
}
__device__ __forceinline__ void pv(f32x16*o,int vb,bf16x8 pa0,bf16x8 pa1,bf16x8 pa2,bf16x8 pa3){
  #pragma unroll
  for(int d0=0;d0<2;++d0){s16x4 lo[4],hi[4];
    #pragma unroll
    for(int ks=0;ks<4;++ks){
      asm volatile("ds_read_b64_tr_b16 %0,%1 offset:%c2":"=&v"(lo[ks]):"v"(vb),"i"(d0*4096+ks*1024):"memory");
      asm volatile("ds_read_b64_tr_b16 %0,%1 offset:%c2":"=&v"(hi[ks]):"v"(vb),"i"(d0*4096+ks*1024+512):"memory");}
    asm volatile("s_waitcnt lgkmcnt(0)":::"memory");SBAR();
    #define PK(k) (bf16x8){lo[k][0],lo[k][1],lo[k][2],lo[k][3],hi[k][0],hi[k][1],hi[k][2],hi[k][3]}
    o[d0]=__builtin_amdgcn_mfma_f32_32x32x16_bf16(pa0,PK(0),o[d0],0,0,0);
    o[d0]=__builtin_amdgcn_mfma_f32_32x32x16_bf16(pa1,PK(1),o[d0],0,0,0);
    o[d0]=__builtin_amdgcn_mfma_f32_32x32x16_bf16(pa2,PK(2),o[d0],0,0,0);
    o[d0]=__builtin_amdgcn_mfma_f32_32x32x16_bf16(pa3,PK(3),o[d0],0,0,0);
    #undef PK
  }
}

#ifndef ATTN_STORE16
#define ATTN_STORE16(p,v) (*(u32x4*)(p)=(v))
#endif
template<int THRL,bool HAS_BIAS,int OMODE,int ORS,class U> __device__ __forceinline__ void gunit(char*shm,const U&un){
  int tid_o=threadIdx.x; asm volatile("":"+v"(tid_o)); const int tid=tid_o,lane=tid&63,r32=lane&31,hi=lane>>5; const int wid=__builtin_amdgcn_readfirstlane(tid>>6);
  const int kpitch=un.kpitch;
  const bf16*Qw=un.qrow(wid,r32);
  const bf16*Kh=un.Kb,*Vh=un.Vb;
  const unsigned lds0=(unsigned)(uintptr_t)shm;
  float*wsf=(float*)(shm+LDS_WS)+wid*64;
  const bf16*ksrc=Kh+(long)lane*kpitch+wid*8;
  const bf16*vsrc=Vh+(long)(16*(wid&3)+(lane>>2))*kpitch+(wid>>2)*32+(lane&3)*8;
  const unsigned kdst=lds0+LDS_K+wid*1024, vdst=lds0+LDS_V+wid*1024;
  #define TABS(t) min(max(un.t0+(t),0),un.tmax)
  #define DMA_K(t,slot) glds16(ksrc+(long)TABS(t)*KVBLK*kpitch,(unsigned)__builtin_amdgcn_readfirstlane(kdst+(slot)))
  #define DMA_V(t,slot) glds16(vsrc+(long)TABS(t)*KVBLK*kpitch,(unsigned)__builtin_amdgcn_readfirstlane(vdst+(slot)))
  const int vb0=(int)(lds0+LDS_V)+((lane>>4)&1)*32+(lane&3)*8+(4*hi+((lane&15)>>2))*64;
  const char*Kbase=shm+LDS_K; bf16x8 kf[8];
  const lds_cptr shm3=(lds_cptr)shm; const lds_cptr kp0=shm3+LDS_K+hi*1024+r32*16; const lds_cptr vp0=shm3+LDS_V+((lane>>4)&1)*32+(lane&3)*8+(4*hi+((lane&15)>>2))*64;
  const int NT=un.NT;
  typedef __attribute__((address_space(3))) unsigned lds_u32;
  lds_u32* const btab=(lds_u32*)(shm3+LDS_BT);
  if(HAS_BIAS){ const float*cum=un.cum; const float cq0=cum[un.q0]; const float*cumt=cum+(long)un.t0*KVBLK; for(int k=tid;k<NT*KVBLK;k+=NW*64){ const float be=(cq0-cumt[k])*1.4426950408889634f; unsigned ub=__builtin_bit_cast(unsigned,be); const unsigned hb=(ub+0x7fffu+((ub>>16)&1u))>>16;
      const float rl=be-__builtin_bit_cast(float,hb<<16); unsigned ul=__builtin_bit_cast(unsigned,rl); const unsigned lb=(ul+0x7fffu+((ul>>16)&1u))>>16; btab[k]=hb|(lb<<16); } }
  int bto=0;
  #define BIAS_MFMA(C0,C1) do{ unsigned ln_; asm volatile("v_mbcnt_lo_u32_b32 %0, -1, 0\n\tv_mbcnt_hi_u32_b32 %0, -1, %0":"=v"(ln_)); const bool up_=ln_>=32u; \
      unsigned w0_=0u, w1_=0u; if(HAS_BIAS){ const lds_u32* bp_=btab+bto+(ln_&31u); w0_=bp_[0]; w1_=bp_[32]; } \
      const unsigned tm_=un.term(wid,(int)(ln_&31u),un.t0+(bto>>6)); \
      u32x2b a0_, a1_, q_; a0_.x=up_?0x3F803F80u:w0_; a0_.y=up_?0u:0x3F803F80u; a1_.x=up_?0x3F803F80u:w1_; a1_.y=a0_.y; q_.x=qm0|(up_?(tm_<<16):0u); q_.y=qm1; \
      C0=BMFMA(__builtin_bit_cast(s16x4,a0_),__builtin_bit_cast(s16x4,q_),C0); C1=BMFMA(__builtin_bit_cast(s16x4,a1_),__builtin_bit_cast(s16x4,q_),C1); }while(0)
  DMA_K(0,0);DMA_V(0,0);DMA_K(1,SLOTB);
  bf16x8 qr[4];
  #pragma unroll
  for(int d0=0;d0<4;++d0)qr[d0]=*reinterpret_cast<const bf16x8*>(&Qw[d0*16+hi*8]);
  float mhat=0.f,l_reg=0.f;f32x16 o[2];o[0]=f32x16{};o[1]=f32x16{};unsigned qm0=hi?0u:0x3F803F80u,qm1=0u;
  #define UPDQM() do{ const float nm_=-mhat; const unsigned u0_=__builtin_bit_cast(unsigned,nm_); const unsigned h_=(u0_+0x7fffu+((u0_>>16)&1u))>>16; const float r1_=nm_-__builtin_bit_cast(float,h_<<16); \
      const unsigned u1_=__builtin_bit_cast(unsigned,r1_); const unsigned m_=(u1_+0x7fffu+((u1_>>16)&1u))>>16; const float r2_=r1_-__builtin_bit_cast(float,m_<<16); const unsigned l_=__builtin_bit_cast(unsigned,r2_)>>16; \
      qm0=hi?l_:0x3F803F80u; qm1=hi?0u:(h_|(m_<<16)); }while(0)
  const int klo=un.klo(wid,r32),khi=un.khi(wid,r32);
  #define CMASK(P0,P1,t) do{ if((t)==0||(t)>=NT-4) emask(P0,P1,(un.t0+(t))*KVBLK+4*hi,klo,khi); }while(0)
  bool resc=false;
  #define START(P0,P1) do{ const float rm=rowmax(P0,P1); resc=false; \
    { const float dl=rm; mhat=fadd_s(mhat,dl); \
      _Pragma("unroll") for(int r=0;r<16;++r){P0[r]=fsub_s(P0[r],dl);P1[r]=fsub_s(P1[r],dl);} \
      UPDQM(); } \
    _Pragma("unroll") for(int r=0;r<16;++r)P0[r]=__builtin_amdgcn_exp2f(P0[r]); }while(0)
  #define RESC() do{ if(resc){ asm volatile("s_waitcnt lgkmcnt(0)":::"memory"); \
      _Pragma("unroll") for(int d_=0;d_<2;++d_) _Pragma("unroll") for(int r=0;r<16;++r)o[d_][r]*=wsf[crow(r,hi)]; } }while(0)
  f32x16 pA0,pA1,pB0,pB1;
  int sl_prev=0,sl_cur=0,sl_next=SLOTB;
  #define ROT() do{sl_prev=sl_cur;sl_cur=sl_next;sl_next=(sl_next==(NSLOT-1)*SLOTB)?0:sl_next+SLOTB;bto+=KVBLK;}while(0)
  DMA_K(2,2*SLOTB);
  WAIT_BAR(3);
  qkt(pA0,pA1,Kbase,qr,r32,hi);BIAS_MFMA(pA0,pA1);asm volatile("s_nop 15\n\ts_nop 7":"+v"(pA0),"+v"(pA1));CMASK(pA0,pA1,0);
  START(pA0,pA1);
  _Pragma("unroll") for(int r=0;r<16;++r)pA1[r]=__builtin_amdgcn_exp2f(pA1[r]);
  WAIT_BAR(0);
  DMA_K(3,0);DMA_V(1,SLOTB);
  ROT();
  kload8(kf,kp0+sl_cur);
  WAIT_BAR(2);
  s16x4 vlo[8],vhi[8]; u32x4 pw0,pw1,pw2,pw3;
  #define PKW(P,B) cvtpk_s(P[B],P[B+1])
  #define PAF(k) __builtin_bit_cast(bf16x8,pw##k)
  #define VFR(i) (bf16x8){vlo[i][0],vlo[i][1],vlo[i][2],vlo[i][3],vhi[i][0],vhi[i][1],vhi[i][2],vhi[i][3]}
  #define PIN(x) asm volatile("":"+v"(x))
  #define MX3(a,b,c) __builtin_fmaxf(__builtin_fmaxf((a),(b)),(c))
  #define GAPA(MF,A0,A1,A2,A3,W0,W1,PW) do{ MF; sacc+=A0; sacc+=A1; sacc+=A2; sacc+=A3; PIN(sacc); W0; W1; PIN(PW); SBAR(); }while(0)
  #define EX(v) __builtin_amdgcn_exp2f(v)
  #define GAPB(MF,X,B) do{ MF; X[B]=EX(X[B]); X[B+1]=EX(X[B+1]); X[B+2]=EX(X[B+2]); X[B+3]=EX(X[B+3]); PIN(X); SBAR(); }while(0)
  #define VRD(i) do{ vlo[i]=vtr(vp_+(((i)>>2)*4096+((i)&3)*1024)); vhi[i]=vtr(vp_+(((i)>>2)*4096+((i)&3)*1024+512)); }while(0)
  #define KRD(G,j) do{ if(G){ kload2(kf,kp0+sl_next,j); SBAR(); } }while(0)
  #define STEP(C0,C1,P0,P1,t,GK,GV,GL) do{ SBAR(); \
    const lds_cptr vp_=vp0+sl_prev; \
    VRD(0); SBAR(); float sacc=(P0[0]+P0[1]); \
    GAPA(C0=__builtin_amdgcn_mfma_f32_32x32x16_bf16(kf[0],qr[0],(f32x16){},0,0,0), P0[2],P0[3],P0[4],P0[5],     pw0[0]=PKW(P0,0), pw0[1]=PKW(P0,2), pw0); \
    VRD(4); SBAR(); GAPA(C1=__builtin_amdgcn_mfma_f32_32x32x16_bf16(kf[1],qr[0],(f32x16){},0,0,0), P0[6],P0[7],P0[8],P0[9],     pw0[2]=PKW(P0,4), pw0[3]=PKW(P0,6), pw0); \
    VRD(1); SBAR(); GAPA(C0=__builtin_amdgcn_mfma_f32_32x32x16_bf16(kf[2],qr[1],C0,0,0,0),   P0[10],P0[11],P0[12],P0[13], pw1[0]=PKW(P0,8), pw1[1]=PKW(P0,10), pw1); \
    VRD(5); SBAR(); GAPA(C1=__builtin_amdgcn_mfma_f32_32x32x16_bf16(kf[3],qr[1],C1,0,0,0),   P0[14],P0[15],P1[0],P1[1],   pw1[2]=PKW(P0,12),pw1[3]=PKW(P0,14), pw1); \
    VRD(2); SBAR(); GAPA(C0=__builtin_amdgcn_mfma_f32_32x32x16_bf16(kf[4],qr[2],C0,0,0,0),   P1[2],P1[3],P1[4],P1[5],     pw2[0]=PKW(P1,0), pw2[1]=PKW(P1,2), pw2); \
    VRD(6); SBAR(); GAPA(C1=__builtin_amdgcn_mfma_f32_32x32x16_bf16(kf[5],qr[2],C1,0,0,0),   P1[6],P1[7],P1[8],P1[9],     pw2[2]=PKW(P1,4), pw2[3]=PKW(P1,6), pw2); \
    VRD(3); SBAR(); GAPA(C0=__builtin_amdgcn_mfma_f32_32x32x16_bf16(kf[6],qr[3],C0,0,0,0),   P1[10],P1[11],P1[12],P1[13], pw3[0]=PKW(P1,8), pw3[1]=PKW(P1,10), pw3); \
    VRD(7); SBAR(); GAPA(C1=__builtin_amdgcn_mfma_f32_32x32x16_bf16(kf[7],qr[3],C1,0,0,0),   P1[14],P1[15],0.f,0.f,       pw3[2]=PKW(P1,12),pw3[3]=PKW(P1,14), pw3); \
    BIAS_MFMA(C0,C1); \
    l_reg+=sacc; \
    if(GK){DMA_K((t)+3,sl_cur);} if(GV){DMA_V((t)+1,sl_next);} \
    CMASK(C0,C1,t); \
    { float a=MX3(C0[0],C0[1],C1[0]),b=MX3(C0[2],C0[3],C1[1]); a=MX3(a,C1[2],C1[3]); \
      _Pragma("unroll") for(int r=4;r<16;r+=4){a=MX3(a,C0[r],C0[r+1]);b=MX3(b,C0[r+2],C0[r+3]);a=MX3(a,C1[r],C1[r+1]);b=MX3(b,C1[r+2],C1[r+3]);} \
      float rm=__builtin_fmaxf(a,b); { auto rr=__builtin_amdgcn_permlane32_swap(__float_as_uint(rm),__float_as_uint(rm),false,false); rm=__builtin_fmaxf(__uint_as_float(rr[0]),__uint_as_float(rr[1])); } \
      resc=false; \
      if(__builtin_expect(__any(rm>(float)THRL),0)){ const float dl=__builtin_fmaxf(rm,0.f); mhat+=dl; \
        _Pragma("unroll") for(int r=0;r<16;++r){C0[r]-=dl;C1[r]-=dl;} \
        UPDQM(); \
        const float f=__builtin_amdgcn_exp2f(-dl); l_reg*=f; if(hi==0)wsf[r32]=f; resc=true; } } \
    SBAR(); \
    GAPB(o[0]=__builtin_amdgcn_mfma_f32_32x32x16_bf16(PAF(0),VFR(0),o[0],0,0,0), C0,0); \
    GAPB(o[1]=__builtin_amdgcn_mfma_f32_32x32x16_bf16(PAF(0),VFR(4),o[1],0,0,0), C0,4); \
    KRD(GL,0); GAPB(o[0]=__builtin_amdgcn_mfma_f32_32x32x16_bf16(PAF(1),VFR(1),o[0],0,0,0), C0,8); \
    KRD(GL,1); GAPB(o[1]=__builtin_amdgcn_mfma_f32_32x32x16_bf16(PAF(1),VFR(5),o[1],0,0,0), C0,12); \
    KRD(GL,2); GAPB(o[0]=__builtin_amdgcn_mfma_f32_32x32x16_bf16(PAF(2),VFR(2),o[0],0,0,0), C1,0); \
    KRD(GL,3); GAPB(o[1]=__builtin_amdgcn_mfma_f32_32x32x16_bf16(PAF(2),VFR(6),o[1],0,0,0), C1,4); \
    GAPB(o[0]=__builtin_amdgcn_mfma_f32_32x32x16_bf16(PAF(3),VFR(3),o[0],0,0,0), C1,8); \
    GAPB(o[1]=__builtin_amdgcn_mfma_f32_32x32x16_bf16(PAF(3),VFR(7),o[1],0,0,0), C1,12); \
    }while(0)
  int t=1;
  #undef CMASK
  #define CMASK(P0,P1,t) do{}while(0)
  for(;t+5<NT;t+=2){
    STEP(pB0,pB1,pA0,pA1,t,true,true,true);     WAIT_BAR(2); RESC(); ROT();
    STEP(pA0,pA1,pB0,pB1,t+1,true,true,true);   WAIT_BAR(2); RESC(); ROT();
  }
  #undef CMASK
  #define CMASK(P0,P1,t) do{ if((t)>=NT-4) emask(P0,P1,(un.t0+(t))*KVBLK+4*hi,klo,khi); }while(0)
  #define ENDW(tt) do{ if((tt)+3<NT){WAIT_BAR(2);} else if((tt)+2<NT){WAIT_BAR(1);} else {WAIT_BAR(0);} }while(0)
  for(;t+1<NT;t+=2){
    STEP(pB0,pB1,pA0,pA1,t,(t+3<NT),(t+1<NT),(t+1<NT));       ENDW(t);   RESC(); ROT();
    STEP(pA0,pA1,pB0,pB1,t+1,(t+4<NT),(t+2<NT),(t+2<NT));     ENDW(t+1); RESC(); ROT();
  }
  STEP(pB0,pB1,pA0,pA1,NT-1,false,false,false); RESC();
  { float sacc=pB0[0]+pB0[1]; _Pragma("unroll") for(int r=2;r<16;++r)sacc+=pB0[r]; _Pragma("unroll") for(int r=0;r<16;++r)sacc+=pB1[r]; l_reg+=sacc;
    pw0=(u32x4){PKW(pB0,0),PKW(pB0,2),PKW(pB0,4),PKW(pB0,6)};pw1=(u32x4){PKW(pB0,8),PKW(pB0,10),PKW(pB0,12),PKW(pB0,14)};pw2=(u32x4){PKW(pB1,0),PKW(pB1,2),PKW(pB1,4),PKW(pB1,6)};pw3=(u32x4){PKW(pB1,8),PKW(pB1,10),PKW(pB1,12),PKW(pB1,14)};
    SBAR(); pv(o,vb0+sl_cur,PAF(0),PAF(1),PAF(2),PAF(3)); }
  #undef PKW
  #undef PAF
  #undef VFR
  #undef PIN
  #undef MX3
  #undef GAPA
  #undef GAPB
  #undef EX
  #undef VRD
  #undef KRD
  #undef STEP
  #undef ENDW
  {auto rr=__builtin_amdgcn_permlane32_swap(__float_as_uint(l_reg),__float_as_uint(l_reg),false,false);l_reg=__uint_as_float(rr[0])+__uint_as_float(rr[1]);}
  if(hi==0)wsf[32+r32]=un.colscale(wid,r32)*__builtin_amdgcn_rcpf(l_reg);asm volatile("s_waitcnt lgkmcnt(0)":::"memory");
  float rli[16];
  #pragma unroll
  for(int r=0;r<16;++r)rli[r]=wsf[32+crow(r,hi)];
  bf16*Ow=un.Ob+(long)wid*un.owstride;
  { bf16*stg=(bf16*)(shm+LDS_OST)+wid*2048;
    #pragma unroll
    for(int r=0;r<16;++r){const int orow=crow(r,hi);
      #pragma unroll
      for(int d0=0;d0<2;++d0){ float v_=o[d0][r]*rli[r]; if(OMODE>=2) v_+=__bfloat162float(stg[orow*64+d0*32+r32]); stg[orow*64+d0*32+r32]=__float2bfloat16(v_);} }
    asm volatile("s_waitcnt lgkmcnt(0)":::"memory");
    if(OMODE==0||OMODE==3){
    #pragma unroll
    for(int i=0;i<4;++i){const int row=i*8+(lane>>3),ch=lane&7; const u32x4 v=*(const u32x4*)(stg+row*64+ch*8); bf16*gp=Ow+(long)(row>>ORS)*DM+(row&((1<<ORS)-1))*D+ch*8;
      ATTN_STORE16(gp,v);} } }
  asm volatile("s_waitcnt lgkmcnt(0)\n\ts_barrier":::"memory");
  #undef DMA_K
  #undef TABS
  #undef BIAS_MFMA
  #undef UPDQM
  #undef DMA_V
  #undef CMASK
  #undef START
  #undef RESC
  #undef ROT
}
constexpr int ATTN_LDS_BYTES=LDS_BYTES;
#undef SBAR
#undef WAIT_BAR
}
#define GAS __attribute__((address_space(1)))
#define LAS __attribute__((address_space(3)))
typedef unsigned short bf16;
typedef unsigned v4u __attribute__((ext_vector_type(4)));
typedef float f32x4 __attribute__((ext_vector_type(4)));
typedef short bf16x8 __attribute__((ext_vector_type(8)));
typedef GAS unsigned gu32;
typedef GAS unsigned long long gu64;
#define RLX_AGENT __ATOMIC_RELAXED, __HIP_MEMORY_SCOPE_AGENT
#define LDS_WAIT() asm volatile("s_waitcnt lgkmcnt(0)" ::: "memory")
#define VM_WAIT() asm volatile("s_waitcnt vmcnt(0)" ::: "memory")
__device__ __forceinline__ unsigned long long rt() { return __builtin_amdgcn_s_memrealtime(); }
__device__ __forceinline__ unsigned f2bf(float f) { unsigned u = __builtin_bit_cast(unsigned, f); return (u + 0x7fffu + ((u >> 16) & 1u)) >> 16; }
__device__ __forceinline__ unsigned pk2(float lo, float hi) { return f2bf(lo) | (f2bf(hi) << 16); }

#define XB_TMO      128
#define XB_XCNT(j)  (256  + 64 * (j))
#define XB_XSUB(j)  (1280 + 64 * (j))
#define XB_XGEN(j)  (2304 + 64 * (j))
#define XB_TOP      3328
#define XB_TOPGEN   3392
#define XCD_BAR_WORDS 3456
#define XB_SPIN_CAP (1u << 25)

__device__ __forceinline__ unsigned xb_ld(unsigned* p)              { return __hip_atomic_load(p, __ATOMIC_RELAXED, __HIP_MEMORY_SCOPE_AGENT); }
__device__ __forceinline__ unsigned xb_add(unsigned* p, unsigned v) { return __hip_atomic_fetch_add(p, v, __ATOMIC_RELAXED, __HIP_MEMORY_SCOPE_AGENT); }
__device__ __forceinline__ unsigned xb_xcc_id() { return (unsigned)__builtin_amdgcn_s_getreg((3 << 11) | 20) & 0xFu; }
#define XB_SPIN(cond, bar) do { unsigned _sp = 0; while (cond) { __builtin_amdgcn_s_sleep(1); \
    if ((++_sp & 255u) == 0u) { if (xb_ld(&(bar)[XB_TMO])) break; if (_sp > XB_SPIN_CAP) { atomicAdd(&(bar)[XB_TMO], 1u); break; } } } } while (0)

struct XcdBarrier {
    unsigned* bar; unsigned x;
    volatile LAS unsigned* st;
};

__device__ __forceinline__ XcdBarrier xcd_barrier_post(unsigned* bar, volatile LAS unsigned* st) {
    XcdBarrier b; b.bar = bar; b.x = xb_xcc_id(); b.st = st;
    if (threadIdx.x == 0) (void)xb_add(&bar[XB_XCNT(b.x)], 1u);
    return b;
}
__device__ __forceinline__ void xcd_barrier_complete(unsigned* bar, unsigned x, unsigned& nloc, unsigned& nx) {
    const unsigned G = gridDim.x * gridDim.y * gridDim.z;
    unsigned sum, cnt, mine, sp = 0u;
    for (;;) {
        sum = 0u; cnt = 0u; mine = 0u;
#pragma unroll
        for (unsigned j = 0; j < 16; ++j) { const unsigned c = xb_ld(&bar[XB_XCNT(j)]); sum += c; cnt += (c > 0u) ? 1u : 0u; mine = (j == x) ? c : mine; }
        if (sum == G) break;
        __builtin_amdgcn_s_sleep(1);
        if ((++sp & 255u) == 0u) { if (xb_ld(&bar[XB_TMO])) break; if (sp > XB_SPIN_CAP) { atomicAdd(&bar[XB_TMO], 1u); break; } }
    }
    nloc = mine > 0u ? mine : 1u; nx = cnt > 0u ? cnt : 1u;
}

__device__ __forceinline__ void xcd_barrier(const XcdBarrier& b) {
    asm volatile("s_waitcnt vmcnt(0)" ::: "memory");
    __syncthreads();
    if (threadIdx.x == 0) {
        unsigned* bar = b.bar;
        __builtin_amdgcn_s_waitcnt(0);
        unsigned nloc = b.st[0], nx = b.st[1];
        if (nloc == 0u) { xcd_barrier_complete(bar, b.x, nloc, nx); b.st[0] = nloc; b.st[1] = nx; }
        const unsigned old = xb_add(&bar[XB_XSUB(b.x)], 1u);
        const unsigned gen = old / nloc;
        if (old + 1u == (gen + 1u) * nloc) {
            __builtin_amdgcn_fence(__ATOMIC_RELEASE, "agent");
            asm volatile("s_waitcnt vmcnt(0)" ::: "memory");
            const unsigned og = xb_add(&bar[XB_TOP], 1u);
            const unsigned tg = og / nx;
            if (og + 1u == (tg + 1u) * nx) xb_add(&bar[XB_TOPGEN], 1u);
            else XB_SPIN(xb_ld(&bar[XB_TOPGEN]) == tg, bar);
            __builtin_amdgcn_fence(__ATOMIC_ACQUIRE, "agent");
            xb_add(&bar[XB_XGEN(b.x)], 1u);
            asm volatile("s_waitcnt vmcnt(0)" ::: "memory");
        } else {
            XB_SPIN(xb_ld(&bar[XB_XGEN(b.x)]) == gen, bar);
            __builtin_amdgcn_fence(__ATOMIC_ACQUIRE, "agent");
            asm volatile("s_waitcnt vmcnt(0)" ::: "memory");
        }
    }
    __syncthreads();
}
#include <type_traits>
#ifndef PH_MASK
#define PH_MASK 0xFFFF
#endif
#define PH_EN(n) ((PH_MASK >> (n)) & 1)
#ifndef TIME_LSEL
#define TIME_LSEL -1
#endif
#ifndef TIME_LSEL2
#define TIME_LSEL2 TIME_LSEL
#endif
#ifndef TIME_MUL
#define TIME_MUL 1.f
#endif
#ifndef MK_MULTI
#define MK_MULTI 0
#endif
constexpr int NWAVES = 8, NTHR = 512;
constexpr int Bn = 2, S = 8192, T = Bn * S, D = 1024, NH = 16, HD = 64, DEPTH = 4;
constexpr int NE = 64, ED = 256, TOPK = 8, PLE = 256;
constexpr int NSA_G = 4, NCMP = 512;
constexpr float LN_EPS = 1e-5f, NEGF = -1e30f;
constexpr float DN_ALPHA = 1.681792830507429f;
constexpr float ATT_SCALE = 0.125f, QSC = 0.6931471805599453f;
constexpr int NPH = 13;

constexpr size_t MiB = 1u << 20;
constexpr size_t WS_CTL = 0, CTL_ZERO_BYTES = 1 * MiB;
constexpr size_t WS_ROPE_C = 2 * MiB, WS_ROPE_S = 4 * MiB;
constexpr size_t WS_LOGF = 6 * MiB, WS_CUM = 7 * MiB;
constexpr size_t WS_GATES = 8 * MiB;
constexpr size_t WS_KMEAN = 11 * MiB;
constexpr size_t WS_KCMP = 12 * MiB, WS_VCMP = 13 * MiB;
constexpr size_t WS_VCT = 13 * MiB + 512 * 1024;
constexpr size_t WS_PEB = 11 * MiB + 512 * 1024;
constexpr size_t WS_WRT = 11 * MiB + 768 * 1024;
constexpr size_t WS_H1 = 20 * MiB;
constexpr size_t WS_WC1 = 278 * MiB;
constexpr size_t WS_ROWTOK = 24 * MiB;
constexpr size_t WS_LS32 = 18 * MiB + 512 * 1024;
constexpr size_t WS_SELMG = 18 * MiB;
constexpr size_t WS_TOKE = 14 * MiB, WS_TOKW = 15 * MiB, WS_TOKP = 16 * MiB;
constexpr size_t WS_ROWW = 17 * MiB;
constexpr size_t WS_X = 32 * MiB;
constexpr size_t WS_XBA = 96 * MiB, WS_XBB = 128 * MiB;
constexpr size_t WS_WIN = 160 * MiB, WS_WOUT = 166 * MiB, WS_WGU = 168 * MiB, WS_WDN = 233 * MiB, WS_WPG = 266 * MiB, WS_WPP = 268 * MiB;
constexpr size_t WS_PB = 270 * MiB;
constexpr size_t WS_Q = 280 * MiB, WS_K = 312 * MiB, WS_V = 344 * MiB;
constexpr size_t WS_AO = 376 * MiB;
constexpr size_t WS_PP = 408 * MiB;
constexpr size_t WS_QR = 504 * MiB;
constexpr size_t WS_H = 280 * MiB;
constexpr size_t WS_XG = 440 * MiB;
constexpr size_t WS_OUTR = 440 * MiB;
constexpr size_t WS_SET1 = 600 * MiB;
constexpr size_t WS_PEB1 = 11 * MiB + 512 * 1024 + 4096, WS_WRT1 = 11 * MiB + 256 * 1024;
constexpr size_t WS_END = 880 * MiB;
constexpr int R_PAD_TILES = 576, XG_TILE0 = (int)((WS_XG - WS_XBA) / (256 * 1024 * 2));
static_assert((WS_XG - WS_XBA) % (256 * 1024 * 2) == 0, "XG tile alignment");
constexpr int CW_TMO = 0, CW_CODE = 1, CW_BAR = 4096, CW_CNT = 16384  , CW_CHK = 9216, CW_TS = 10240, CW_NRM = 12288, CW_Q = 12800;

constexpr int RING_BYTES = 131072, TAB_OFF = RING_BYTES, MISC_OFF = RING_BYTES + 9216, LDS_BYTES = 147456 + 8704, DSTG0 = RING_BYTES + 512, DSTG1 = 147456;

typedef unsigned short bf16_t;
__device__ __forceinline__ float bf2f(unsigned short h) { return __uint_as_float(((unsigned)h) << 16); }
__device__ __forceinline__ float bflo(unsigned u) { return __uint_as_float(u << 16); }
__device__ __forceinline__ float bfhi(unsigned u) { return __uint_as_float(u & 0xffff0000u); }
template <int O> __device__ __forceinline__ float xor_f(float v) { return __int_as_float(__builtin_amdgcn_ds_swizzle(__float_as_int(v), 0x1F | (O << 10))); }
template <int O> __device__ __forceinline__ int xor_i(int v) { return __builtin_amdgcn_ds_swizzle(v, 0x1F | (O << 10)); }
__device__ __forceinline__ float bcast_f(float v, int srclane) { return __int_as_float(__builtin_amdgcn_readlane(__float_as_int(v), srclane)); }
__device__ __forceinline__ float wave_sum(float v) {
    v += xor_f<1>(v); v += xor_f<2>(v); v += xor_f<4>(v); v += xor_f<8>(v); v += xor_f<16>(v);
    auto rr = __builtin_amdgcn_permlane32_swap(__float_as_uint(v), __float_as_uint(v), false, false); return __uint_as_float(rr[0]) + __uint_as_float(rr[1]);
}
__device__ __forceinline__ float wave_max(float v) {
    v = fmaxf(v, xor_f<1>(v)); v = fmaxf(v, xor_f<2>(v)); v = fmaxf(v, xor_f<4>(v)); v = fmaxf(v, xor_f<8>(v)); v = fmaxf(v, xor_f<16>(v));
    auto rr = __builtin_amdgcn_permlane32_swap(__float_as_uint(v), __float_as_uint(v), false, false); return fmaxf(__uint_as_float(rr[0]), __uint_as_float(rr[1]));
}
#define WAVE_SYNC() do { asm volatile("s_waitcnt lgkmcnt(0)" ::: "memory"); __builtin_amdgcn_wave_barrier(); } while (0)

namespace epi {
using pg8::f32x4; using pg8::u32x4; using pg8::Unit; using pg8::cvt_pk_bf16; using pg8::HALF; using pg8::BM;
struct Qkv {
    static constexpr bool PERM = true, AFTER_DRAIN = false;
    bf16_t* O0; int ncq, ld0; bf16_t* O1; int w1, ld1; size_t stride1; float scale0;
    __device__ __forceinline__ void operator()(const f32x4 (&acc)[2][2][4][2], const Unit& u, int wr, int wc, int fr, int fq) const {
        const int row0 = u.pm * BM + wr * 64 + fr; int colt = u.pn * BM; bf16_t* base; int ldc; float sc = 1.f;
        if (colt < ncq) { base = O0; ldc = ld0; sc = scale0; } else { colt -= ncq; const int j = colt / w1; colt -= j * w1; base = O1 + (size_t)j * stride1; ldc = ld1; }
        const int col0 = colt + wc * 32 + 8 * fq;
#pragma unroll
        for (int ai = 0; ai < 2; ++ai)
#pragma unroll
            for (int m = 0; m < 4; ++m) { bf16_t* rowp = base + (size_t)(row0 + ai * HALF + m * 16) * ldc + col0;
#pragma unroll
                for (int bj = 0; bj < 2; ++bj) { const f32x4 v0 = acc[ai][bj][m][0] * sc, v1 = acc[ai][bj][m][1] * sc;
                    u32x4 w; w.x = cvt_pk_bf16(v0[0], v0[1]); w.y = cvt_pk_bf16(v0[2], v0[3]); w.z = cvt_pk_bf16(v1[0], v1[1]); w.w = cvt_pk_bf16(v1[2], v1[3]);
                    *(u32x4*)(rowp + bj * HALF) = w; } }
    }
};
template <bool BF> struct Res {
    static constexpr bool PERM = true, AFTER_DRAIN = false;
    _Float16* X; const void* base; int ldc; float alpha;
    __device__ __forceinline__ void operator()(const f32x4 (&acc)[2][2][4][2], const Unit& u, int wr, int wc, int fr, int fq) const {
        typedef _Float16 h8 __attribute__((ext_vector_type(8)));
        const int row0 = u.pm * BM + wr * 64 + fr, col0 = u.pn * BM + wc * 32 + 8 * fq;
#pragma unroll
        for (int ai = 0; ai < 2; ++ai)
#pragma unroll
            for (int m = 0; m < 4; ++m) { const size_t ro = (size_t)(row0 + ai * HALF + m * 16) * ldc + col0;
#pragma unroll
                for (int bj = 0; bj < 2; ++bj) { const size_t off = ro + bj * HALF; f32x4 x0, x1;
                    if (BF) { const u32x4 w = *(const u32x4*)((const bf16_t*)base + off); x0 = (f32x4){bflo(w.x), bfhi(w.x), bflo(w.y), bfhi(w.y)}; x1 = (f32x4){bflo(w.z), bfhi(w.z), bflo(w.w), bfhi(w.w)}; }
                    else { x0 = *(const f32x4*)((const float*)base + off); x1 = *(const f32x4*)((const float*)base + off + 4); }
                    const f32x4 o0 = x0 * alpha + acc[ai][bj][m][0], o1 = x1 * alpha + acc[ai][bj][m][1];
                    *(h8*)(X + off) = (h8){(_Float16)o0[0], (_Float16)o0[1], (_Float16)o0[2], (_Float16)o0[3], (_Float16)o1[0], (_Float16)o1[1], (_Float16)o1[2], (_Float16)o1[3]}; } }
    }
};
struct SwiGlu {
    static constexpr bool PERM = true, AFTER_DRAIN = false;
    bf16_t* Hh; int xg0;
    __device__ __forceinline__ void operator()(const f32x4 (&acc)[2][2][4][2], const Unit& u, int wr, int wc, int fr, int fq) const {
        const int ht = (int)u.aofs; const int row0 = ht * BM + wr * 64 + fr; const int col0 = (u.pn & 1) * 128 + wc * 32 + 8 * fq;
#pragma unroll
        for (int ai = 0; ai < 2; ++ai)
#pragma unroll
            for (int m = 0; m < 4; ++m) { bf16_t* rowp = Hh + (size_t)(row0 + ai * HALF + m * 16) * ED + col0;
                float h[8];
#pragma unroll
                for (int n = 0; n < 2; ++n)
#pragma unroll
                    for (int j = 0; j < 4; ++j) { const float g = acc[ai][0][m][n][j], up = acc[ai][1][m][n][j];
                        const float sg = g * __builtin_amdgcn_rcpf(1.f + __builtin_amdgcn_exp2f(-g * 1.4426950408889634f)); h[n * 4 + j] = sg * up; }
                u32x4 w; w.x = cvt_pk_bf16(h[0], h[1]); w.y = cvt_pk_bf16(h[2], h[3]); w.z = cvt_pk_bf16(h[4], h[5]); w.w = cvt_pk_bf16(h[6], h[7]);
                *(u32x4*)rowp = w; }
    }
};
struct Down {
    static constexpr bool PERM = true, AFTER_DRAIN = false;
    bf16_t* O; PG8_LAS unsigned char* stg0; PG8_LAS unsigned char* stg1;
    __device__ __forceinline__ void operator()(const f32x4 (&acc)[2][2][4][2], const Unit& u, int wr, int wc, int fr, int fq) const {
        const int row0 = u.pm * BM + wr * 64 + fr; const int col0 = (u.pn & 3) * BM + wc * 32 + 8 * fq;
#if defined(OUTR_FP8) && defined(DOWN_LDS)
        typedef unsigned u32x2 __attribute__((ext_vector_type(2)));
        const int lane_ = fr + 16 * fq, rr = 4 * wc + (lane_ >> 4), cc = lane_ & 15;
#pragma unroll
        for (int ai = 0; ai < 2; ++ai)
#pragma unroll
            for (int m = 0; m < 4; ++m) { PG8_LAS unsigned char* sb = (((ai * 4 + m) & 1) ? stg1 : stg0) + wr * 4352;
#pragma unroll
                for (int bj = 0; bj < 2; ++bj) { f32x4 v0 = acc[ai][bj][m][0] * 64.f, v1 = acc[ai][bj][m][1] * 64.f;
#pragma unroll
                    for (int e = 0; e < 4; ++e) { v0[e] = fminf(fmaxf(v0[e], -440.f), 440.f); v1[e] = fminf(fmaxf(v1[e], -440.f), 440.f); }
                    u32x2 w; int t0 = __builtin_amdgcn_cvt_pk_fp8_f32(v0[0], v0[1], 0, false); t0 = __builtin_amdgcn_cvt_pk_fp8_f32(v0[2], v0[3], t0, true);
                    int t1 = __builtin_amdgcn_cvt_pk_fp8_f32(v1[0], v1[1], 0, false); t1 = __builtin_amdgcn_cvt_pk_fp8_f32(v1[2], v1[3], t1, true); w.x = (unsigned)t0; w.y = (unsigned)t1;
                    *(PG8_LAS u32x2*)(sb + fr * 272 + bj * HALF + wc * 32 + 8 * fq) = w; }
                asm volatile("s_waitcnt lgkmcnt(0)" ::: "memory"); __builtin_amdgcn_s_barrier(); asm volatile("" ::: "memory");
                const u32x4 rowv = *(const PG8_LAS u32x4*)(sb + rr * 272 + cc * 16);
                *(u32x4*)((unsigned char*)O + (size_t)(u.pm * BM + ai * HALF + wr * 64 + m * 16 + rr) * D + (u.pn & 3) * BM + cc * 16) = rowv; }
        (void)row0; (void)col0;
        return;
#endif
#pragma unroll
        for (int ai = 0; ai < 2; ++ai)
#pragma unroll
            for (int m = 0; m < 4; ++m) { const int row = row0 + ai * HALF + m * 16; const float sc = 1.f;
#if defined(OUTR_FP8)
                typedef unsigned u32x2 __attribute__((ext_vector_type(2)));
                unsigned char* rowp = (unsigned char*)O + (size_t)row * D + col0;
#pragma unroll
                for (int bj = 0; bj < 2; ++bj) { f32x4 v0 = acc[ai][bj][m][0] * (64.f * sc), v1 = acc[ai][bj][m][1] * (64.f * sc);
#pragma unroll
                    for (int e = 0; e < 4; ++e) { v0[e] = fminf(fmaxf(v0[e], -440.f), 440.f); v1[e] = fminf(fmaxf(v1[e], -440.f), 440.f); }
                    u32x2 w; int t0 = __builtin_amdgcn_cvt_pk_fp8_f32(v0[0], v0[1], 0, false); t0 = __builtin_amdgcn_cvt_pk_fp8_f32(v0[2], v0[3], t0, true);
                    int t1 = __builtin_amdgcn_cvt_pk_fp8_f32(v1[0], v1[1], 0, false); t1 = __builtin_amdgcn_cvt_pk_fp8_f32(v1[2], v1[3], t1, true); w.x = (unsigned)t0; w.y = (unsigned)t1;
                    *(u32x2*)(rowp + bj * HALF) = w; } }
#else
                bf16_t* rowp = O + (size_t)row * D + col0;
#pragma unroll
                for (int bj = 0; bj < 2; ++bj) { const f32x4 v0 = acc[ai][bj][m][0] * sc, v1 = acc[ai][bj][m][1] * sc;
                    u32x4 w; w.x = cvt_pk_bf16(v0[0], v0[1]); w.y = cvt_pk_bf16(v0[2], v0[3]); w.z = cvt_pk_bf16(v1[0], v1[1]); w.w = cvt_pk_bf16(v1[2], v1[3]);
                    *(u32x4*)(rowp + bj * HALF) = w; } }
#endif
    }
};
struct StoreBf16 {
    static constexpr bool PERM = true, AFTER_DRAIN = false;
    bf16_t* O; int ldc;
    __device__ __forceinline__ void operator()(const f32x4 (&acc)[2][2][4][2], const Unit& u, int wr, int wc, int fr, int fq) const {
        const int row0 = u.pm * BM + wr * 64 + fr; const int col0 = u.pn * BM + wc * 32 + 8 * fq;
#pragma unroll
        for (int ai = 0; ai < 2; ++ai)
#pragma unroll
            for (int m = 0; m < 4; ++m) { bf16_t* rowp = O + (size_t)(row0 + ai * HALF + m * 16) * ldc + col0;
#pragma unroll
                for (int bj = 0; bj < 2; ++bj) { const f32x4 v0 = acc[ai][bj][m][0], v1 = acc[ai][bj][m][1];
                    u32x4 w; w.x = cvt_pk_bf16(v0[0], v0[1]); w.y = cvt_pk_bf16(v0[2], v0[3]); w.z = cvt_pk_bf16(v1[0], v1[1]); w.w = cvt_pk_bf16(v1[2], v1[3]);
                    *(u32x4*)(rowp + bj * HALF) = w; } }
    }
};
template <bool LAST> struct Ple {
    static constexpr bool PERM = true, AFTER_DRAIN = false;
    const bf16_t* XB; const bf16_t* PP; float* OutF; bf16_t* XBn;
    __device__ __forceinline__ void operator()(const f32x4 (&acc)[2][2][4][2], const Unit& u, int wr, int wc, int fr, int fq) const {
        const int row0 = u.pm * BM + wr * 64 + fr, col0 = u.pn * BM + wc * 32 + 8 * fq;
#pragma unroll
        for (int ai = 0; ai < 2; ++ai)
#pragma unroll
            for (int m = 0; m < 4; ++m) { const size_t ro = (size_t)(row0 + ai * HALF + m * 16) * D + col0;
#pragma unroll
                for (int bj = 0; bj < 2; ++bj) { const size_t off = ro + bj * HALF; const u32x4 xw = *(const u32x4*)(XB + off), pw = *(const u32x4*)(PP + off); f32x4 o[2];
#pragma unroll
                    for (int n = 0; n < 2; ++n) { const unsigned xa = n ? xw.z : xw.x, xb = n ? xw.w : xw.y, pa = n ? pw.z : pw.x, pb = n ? pw.w : pw.y; const f32x4 a = acc[ai][bj][m][n];
                        o[n][0] = bflo(xa) + bflo(pa) * __builtin_amdgcn_rcpf(1.f + __builtin_amdgcn_exp2f(-a[0] * 1.4426950408889634f));
                        o[n][1] = bfhi(xa) + bfhi(pa) * __builtin_amdgcn_rcpf(1.f + __builtin_amdgcn_exp2f(-a[1] * 1.4426950408889634f));
                        o[n][2] = bflo(xb) + bflo(pb) * __builtin_amdgcn_rcpf(1.f + __builtin_amdgcn_exp2f(-a[2] * 1.4426950408889634f));
                        o[n][3] = bfhi(xb) + bfhi(pb) * __builtin_amdgcn_rcpf(1.f + __builtin_amdgcn_exp2f(-a[3] * 1.4426950408889634f)); }
                    if (LAST) { *(f32x4*)(OutF + off) = o[0]; *(f32x4*)(OutF + off + 4) = o[1]; }
                    else { u32x4 w; w.x = cvt_pk_bf16(o[0][0], o[0][1]); w.y = cvt_pk_bf16(o[0][2], o[0][3]); w.z = cvt_pk_bf16(o[1][0], o[1][1]); w.w = cvt_pk_bf16(o[1][2], o[1][3]); *(u32x4*)(XBn + off) = w; } } }
    }
};
}

struct MoeOrder {
    const LAS int* tstart;
    int NC, G, c, NU, lists;
    __device__ __forceinline__ bool next(int i, pg8::Unit& u) const {
        const int x = c & 7, npx = G >> 3; int li = i * npx + (c >> 3); int e, j, cc, rt;
        if (li < 8 * NC) { e = 64; j = x + 8 * (li / NC); cc = li % NC; rt = j; }
        else { li -= 8 * NC; e = -1; j = 0; cc = 0; rt = 0;
            for (int q = 0; q < 8; ++q) { const int eq = x + 8 * q; const int t0 = tstart[eq], n = (tstart[eq + 1] - t0) * NC;
                if (e < 0) { if (li < n) { e = eq; j = li / NC; cc = li % NC; rt = 64 + t0 + j; } else li -= n; } }
            if (e < 0) return false; }
        u.pm = lists ? e * 64 + j : rt; u.pn = e * NC + cc; u.aofs = lists ? rt : 0; return true; }
    __device__ __forceinline__ void a_ready(const pg8::Unit&) const {}
    __device__ __forceinline__ void done(const pg8::Unit&) const {}
};

struct CmpOrder {
    int G, c;
    __device__ __forceinline__ bool next(int i, pg8::Unit& u) const { const long L = (long)i * G + c; if (L >= 32) return false;
        const int kv = (int)L >> 4, bg = ((int)L >> 1) & 7, half = (int)L & 1, b = bg >> 2, g = bg & 3;
        u.pm = 0; u.pn = kv; u.aofs = (long)kv * (8 << 20) + (long)b * (4 << 20) + g * 128 + (long)half * (2 << 20); return true; }
    __device__ __forceinline__ void a_ready(const pg8::Unit&) const {}
    __device__ __forceinline__ void done(const pg8::Unit&) const {}
};
namespace epi {
struct H1Store {
    static constexpr bool PERM = false, AFTER_DRAIN = false;
    float* H;
    __device__ __forceinline__ void operator()(const f32x4 (&acc)[2][2][4][2], const Unit& u, int wr, int wc, int fr, int fq) const {
        const long a = u.aofs; const int kv = (int)(a >> 23), b = (int)(a >> 22) & 1, half = (int)(a >> 21) & 1, g = (int)(a >> 7) & 3;
        const size_t rowb = ((size_t)(kv * 8 + b * 4 + g) * 512 + half * 256 + wr * 64 + fr);
#pragma unroll
        for (int ai = 0; ai < 2; ++ai)
#pragma unroll
            for (int m = 0; m < 4; ++m) { float* rowp = H + (rowb + ai * HALF + m * 16) * 128 + wc * 32 + 4 * fq;
#pragma unroll
                for (int n = 0; n < 2; ++n) *(f32x4*)(rowp + n * 16) = acc[ai][0][m][n]; }
    }
};
}
__device__ __forceinline__ void transpose_item(const float* W, int ldw, int k0, int n0, bf16* WT, int K, int drow0, LAS float* scr, int lane) {
#pragma unroll 8
    for (int i = 0; i < 32; ++i) { const int kk = 2 * i + (lane >> 5); scr[kk * 33 + (lane & 31)] = W[(size_t)(k0 + kk) * ldw + n0 + (lane & 31)]; }
    LDS_WAIT(); asm volatile("" ::: "memory");
    const int c = lane & 7;
#pragma unroll
    for (int j = 0; j < 4; ++j) { const int n = (lane >> 3) + 8 * j; const LAS float* s = scr + (8 * c) * 33 + n;
        v4u o; o.x = pk2(s[0 * 33], s[1 * 33]); o.y = pk2(s[2 * 33], s[3 * 33]); o.z = pk2(s[4 * 33], s[5 * 33]); o.w = pk2(s[6 * 33], s[7 * 33]);
        *(GAS v4u*)(WT + (size_t)(drow0 + n) * K + k0 + 8 * c) = o; }
    LDS_WAIT(); asm volatile("" ::: "memory");
}

__device__ __forceinline__ void transpose_item64(const float* W, int ldw, int k0, int n0, bf16* WT, int K, int drow0, int lane) {
    const int n4 = lane & 15, kg = lane >> 4; const float* src = W + (size_t)(k0 + 16 * kg) * ldw + n0 + 4 * n4;
    f32x4 v[16];
#pragma unroll
    for (int i = 0; i < 16; ++i) v[i] = __builtin_nontemporal_load((const GAS f32x4*)(src + (size_t)i * ldw));
    bf16* dst = WT + (size_t)(drow0 + 4 * n4) * K + k0 + 16 * kg;
#pragma unroll
    for (int j = 0; j < 4; ++j) { v4u a, b;
        a.x = pk2(v[0][j], v[1][j]); a.y = pk2(v[2][j], v[3][j]); a.z = pk2(v[4][j], v[5][j]); a.w = pk2(v[6][j], v[7][j]);
        b.x = pk2(v[8][j], v[9][j]); b.y = pk2(v[10][j], v[11][j]); b.z = pk2(v[12][j], v[13][j]); b.w = pk2(v[14][j], v[15][j]);
        *(GAS v4u*)(dst + (size_t)j * K) = a; *(GAS v4u*)(dst + (size_t)j * K + 8) = b; }
}

__device__ __forceinline__ void titem_load(f32x4 (&v)[16], const float* W, int ldw, int lane) {
    const int n4 = lane & 15, kg = lane >> 4; const float* src = W + (size_t)(8 * kg) * ldw + 4 * n4;
#pragma unroll
    for (int i = 0; i < 16; ++i) v[i] = __builtin_nontemporal_load((const GAS f32x4*)(src + (size_t)((i & 7) + 32 * (i >> 3)) * ldw));
}
__device__ __forceinline__ void titem_store(const f32x4 (&v)[16], bf16* WT, int K, int lane) {
    const int n4 = lane & 15, kg = lane >> 4; bf16* dst = WT + (size_t)(4 * n4) * K + 8 * kg;
#pragma unroll
    for (int j = 0; j < 4; ++j) { v4u a, b;
        a.x = gattn::cvtpk_s(v[0][j], v[1][j]); a.y = gattn::cvtpk_s(v[2][j], v[3][j]); a.z = gattn::cvtpk_s(v[4][j], v[5][j]); a.w = gattn::cvtpk_s(v[6][j], v[7][j]);
        b.x = gattn::cvtpk_s(v[8][j], v[9][j]); b.y = gattn::cvtpk_s(v[10][j], v[11][j]); b.z = gattn::cvtpk_s(v[12][j], v[13][j]); b.w = gattn::cvtpk_s(v[14][j], v[15][j]);
        *(GAS v4u*)(dst + (size_t)j * K) = a; *(GAS v4u*)(dst + (size_t)j * K + 32) = b; }
}

__device__ __forceinline__ void nitem_load(f32x4 (&v)[8], const float* W, int ldw, int lane) {
    const int n8 = lane & 7, ko = lane >> 3; const float* src = W + (size_t)(8 * ko) * ldw + 4 * n8;
#pragma unroll
    for (int i = 0; i < 8; ++i) v[i] = __builtin_nontemporal_load((const GAS f32x4*)(src + (size_t)i * ldw));
}
__device__ __forceinline__ void nitem_store(const f32x4 (&v)[8], bf16* WT, int K, int lane) {
    const int n8 = lane & 7, ko = lane >> 3; bf16* dst = WT + (size_t)(4 * n8) * K + 8 * ko;
#pragma unroll
    for (int j = 0; j < 4; ++j) { v4u a;
        a.x = gattn::cvtpk_s(v[0][j], v[1][j]); a.y = gattn::cvtpk_s(v[2][j], v[3][j]); a.z = gattn::cvtpk_s(v[4][j], v[5][j]); a.w = gattn::cvtpk_s(v[6][j], v[7][j]);
        *(GAS v4u*)(dst + (size_t)j * K) = a; }
}

template <int NHq, class KeyFn, class BiasFn>
__device__ __forceinline__ void attend_chunk(const float* qs, float* pb, int* kb, const bf16_t* Kp, const bf16_t* Vp, int pitch, int nslots,
                                             KeyFn keyfn, BiasFn biasfn, float scale, float (&m)[NHq], float (&l)[NHq], float (&o)[NHq], int lane) {
    float cm[NHq];
#pragma unroll
    for (int h = 0; h < NHq; ++h) cm[h] = NEGF;
    for (int i = 0; i < 8; ++i) {
        const int slot = lane + 64 * i;
        const int key = (slot < nslots) ? keyfn(slot) : -1;
        float s[NHq];
#pragma unroll
        for (int h = 0; h < NHq; ++h) s[h] = NEGF;
        if (key >= 0) {
            const uint4* kr = (const uint4*)(Kp + (size_t)key * pitch);
#pragma unroll
            for (int h = 0; h < NHq; ++h) s[h] = 0.f;
#pragma unroll
            for (int c = 0; c < 8; ++c) {
                const uint4 kv = kr[c];
                const float k0 = bflo(kv.x), k1 = bfhi(kv.x), k2 = bflo(kv.y), k3 = bfhi(kv.y), k4 = bflo(kv.z), k5 = bfhi(kv.z), k6 = bflo(kv.w), k7 = bfhi(kv.w);
#pragma unroll
                for (int h = 0; h < NHq; ++h) { const float4 qa = *(const float4*)(qs + h * 64 + 8 * c), qb = *(const float4*)(qs + h * 64 + 8 * c + 4);
                    s[h] += qa.x * k0 + qa.y * k1 + qa.z * k2 + qa.w * k3 + qb.x * k4 + qb.y * k5 + qb.z * k6 + qb.w * k7; }
            }
            const float bs = biasfn(slot);
#pragma unroll
            for (int h = 0; h < NHq; ++h) { s[h] = s[h] * scale + bs; cm[h] = fmaxf(cm[h], s[h]); }
        }
#pragma unroll
        for (int h = 0; h < NHq; ++h) pb[h * 512 + slot] = s[h];
        kb[slot] = key;
    }
    float f[NHq], mn[NHq], ls[NHq];
#pragma unroll
    for (int h = 0; h < NHq; ++h) { mn[h] = fmaxf(m[h], wave_max(cm[h])); f[h] = __expf(m[h] - mn[h]); ls[h] = 0.f; }
    WAVE_SYNC();
    for (int i = 0; i < 8; ++i) {
        const int slot = lane + 64 * i; const bool ok = kb[slot] >= 0;
#pragma unroll
        for (int h = 0; h < NHq; ++h) { const float p = ok ? __expf(pb[h * 512 + slot] - mn[h]) : 0.f; pb[h * 512 + slot] = p; ls[h] += p; }
    }
#pragma unroll
    for (int h = 0; h < NHq; ++h) { l[h] = l[h] * f[h] + wave_sum(ls[h]); o[h] *= f[h]; m[h] = mn[h]; }
    WAVE_SYNC();
    const int ns8 = (nslots + 7) & ~7;
    for (int sl = 0; sl < ns8; sl += 8) {
#pragma unroll
        for (int u = 0; u < 8; ++u) { const int key = kb[sl + u]; const int kk = key < 0 ? 0 : key; const float v = bf2f(Vp[(size_t)kk * pitch + lane]);
#pragma unroll
            for (int h = 0; h < NHq; ++h) o[h] += pb[h * 512 + sl + u] * v; }
    }
    WAVE_SYNC();
}

typedef gattn::bf16 abf16;
struct FoxU {
    const abf16 *Kb, *Vb; int kpitch, t0, NT, tmax; const float* cum; int q0; abf16* Ob; long owstride; const abf16* Qb; const LAS unsigned* mtab;
    __device__ __forceinline__ const abf16* qrow(int wid, int r32) const { return Qb + (long)(wid * 32 + r32) * D; }
    __device__ __forceinline__ int klo(int, int) const { return -2147483647; }
    __device__ __forceinline__ int khi(int wid, int r32) const { return q0 + wid * 32 + r32; }
    __device__ __forceinline__ float colscale(int, int) const { return 1.f; }
    __device__ __forceinline__ unsigned term(int wid, int r32, int tabs) const { return mtab ? (((mtab[wid * 32 + r32] >> (tabs >> 2)) & 1u) ? 0u : 0xC700u) : 0u; }
};
__device__ __forceinline__ void fox_order(int vcu, int i, int& bh, int& qb) { const int s = vcu & 7; bh = vcu >> 3; qb = (i == 0) ? s : (i == 1) ? 15 - s : (i == 2) ? 16 + s : 31 - s; }

struct NsaU {
    const abf16 *Kb, *Vb; int kpitch, t0, NT, tmax; const float* cum; int q0; abf16* Ob; long owstride; const abf16* Qb; const LAS unsigned* selm; const float* gates; int br; int wlen;
    __device__ __forceinline__ const abf16* qrow(int wid, int r32) const { return Qb + (long)(wid * 8 + (r32 >> 2)) * D + (r32 & 3) * 64; }
    __device__ __forceinline__ int khi(int wid, int r32) const { return q0 + wid * 8 + (r32 >> 2); }
    __device__ __forceinline__ int klo(int wid, int r32) const { return wlen ? q0 + wid * 8 + (r32 >> 2) - (wlen - 1) : -2147483647; }
    __device__ __forceinline__ float colscale(int wid, int r32) const { return gates[(wid * 8 + (r32 >> 2)) * 48 + (r32 & 3) * 3 + br]; }
    __device__ __forceinline__ unsigned term(int wid, int r32, int tabs) const {
        if (selm) { const unsigned w = selm[(wid * 8 + (r32 >> 2)) * 4 + ((tabs >> 5) & 3)]; return (tabs < 128 && ((w >> (tabs & 31)) & 1u)) ? 0u : 0xC700u; }
        return tabs < 0 ? 0xC700u : 0u; }
};
constexpr int NSA_IMP_LD = 132;
constexpr int NSA_LDS_IMP = gattn::LDS_BT, NSA_LDS_SELM = NSA_LDS_IMP + 64 * NSA_IMP_LD * 4, NSA_LDS_PRI = NSA_LDS_SELM + 1024;
static_assert(NSA_LDS_PRI + 8 * 512 <= RING_BYTES, "NSA LDS map");
__device__ __forceinline__ int swapmid(int x) { return (x & 3) | ((x & 4) << 1) | ((x & 8) >> 1); }

__device__ __forceinline__ void nsa_cmp_select(char* shm, int b, int g, int q0, const bf16_t* QBs, const bf16_t* KCMPs, const bf16_t* VCTs, const float* GATESs, unsigned* selm_g) {
    using gattn::bf16x8; using gattn::f32x16; using gattn::u32x4; using gattn::crow; using gattn::cvtpk_s;
    int tid_o = threadIdx.x; asm volatile("" : "+v"(tid_o)); const int tid = tid_o, lane = tid & 63, r32 = lane & 31, hi = lane >> 5; const int wid = __builtin_amdgcn_readfirstlane(tid >> 6);
    const size_t rb = (size_t)b * S; const int bg = b * NSA_G + g;
    const int tl = r32 >> 2, hh = r32 & 3, tq = q0 + wid * 8 + tl;
    const int nv = tq >= 31 ? ((tq - 31) >> 4) + 1 : 0;
    const int nvmax = ((q0 + 63 - 31) >> 4) + 1, ntile = (nvmax + 63) >> 6;
    float* imp = (float*)(shm + NSA_LDS_IMP); unsigned* selm = (unsigned*)(shm + NSA_LDS_SELM); float* pri = (float*)(shm + NSA_LDS_PRI) + wid * 128;
    for (int i = lane; i < 8 * NSA_IMP_LD; i += 64) imp[wid * 8 * NSA_IMP_LD + i] = 0.f;
    const bf16_t* qp = QBs + (rb + tq) * D + (g * 4 + hh) * 64;
    bf16x8 qf[4];
#pragma unroll
    for (int d0 = 0; d0 < 4; ++d0) qf[d0] = *(const bf16x8*)(qp + d0 * 16 + hi * 8);
    const bf16_t* KC = KCMPs + (size_t)bg * NCMP * 64; const bf16_t* VC = VCTs + (size_t)bg * 8 * 64 * 64;
    bf16x8 ovf[4];
#pragma unroll
    for (int kk = 0; kk < 4; ++kk) { u32x4 w = {0u, 0u, 0u, 0u};
#pragma unroll
        for (int i = 0; i < 8; ++i) { const int nl = 16 * kk + swapmid(8 * hi + i); const unsigned one = (r32 <= 16 && nl >= 4 * r32 - 1 && nl <= 4 * r32 + 3) ? 0x3F80u : 0u; w[i >> 1] |= one << (16 * (i & 1)); }
        ovf[kk] = __builtin_bit_cast(bf16x8, w); }
#define NSA_KLD(KA, KB_, k) do { const bf16_t* kr0 = KC + (size_t)(64 * (k) + r32) * 64 + hi * 8; \
        _Pragma("unroll") for (int d0 = 0; d0 < 4; ++d0) { KA[d0] = *(const bf16x8*)(kr0 + d0 * 16); KB_[d0] = *(const bf16x8*)(kr0 + 32 * 64 + d0 * 16); } } while (0)
#define NSA_QK(P0, P1, KA, KB_) do { const f32x16 z = {}; P0 = z; P1 = z; \
        _Pragma("unroll") for (int d0 = 0; d0 < 4; ++d0) { P0 = __builtin_amdgcn_mfma_f32_32x32x16_bf16(KA[d0], qf[d0], P0, 0, 0, 0); P1 = __builtin_amdgcn_mfma_f32_32x32x16_bf16(KB_[d0], qf[d0], P1, 0, 0, 0); } } while (0)
    float m = -60000.f, l = 0.f;
    bf16x8 ka[4], kb[4], na[4], nb[4]; NSA_KLD(ka, kb, 0);
    for (int k = 0; k < ntile; ++k) { f32x16 p0, p1; NSA_KLD(na, nb, (k + 1 < ntile ? k + 1 : 0)); NSA_QK(p0, p1, ka, kb);
#pragma unroll
        for (int d0 = 0; d0 < 4; ++d0) { ka[d0] = na[d0]; kb[d0] = nb[d0]; }
        float tm = -60000.f;
#pragma unroll
        for (int r = 0; r < 16; ++r) { const int n = 64 * k + crow(r, hi); p0[r] = n < nv ? p0[r] : -60000.f; p1[r] = n + 32 < nv ? p1[r] : -60000.f; tm = fmaxf(tm, fmaxf(p0[r], p1[r])); }
        { auto rr = __builtin_amdgcn_permlane32_swap(__float_as_uint(tm), __float_as_uint(tm), false, false); tm = fmaxf(__uint_as_float(rr[0]), __uint_as_float(rr[1])); }
        const float mn = fmaxf(m, tm); float ls = 0.f;
#pragma unroll
        for (int r = 0; r < 16; ++r) { const int n = 64 * k + crow(r, hi); ls += (n < nv ? __builtin_amdgcn_exp2f(p0[r] - mn) : 0.f) + (n + 32 < nv ? __builtin_amdgcn_exp2f(p1[r] - mn) : 0.f); }
        l = l * __builtin_amdgcn_exp2f(m - mn) + ls; m = mn; }
    { auto rr = __builtin_amdgcn_permlane32_swap(__float_as_uint(l), __float_as_uint(l), false, false); l = __uint_as_float(rr[0]) + __uint_as_float(rr[1]); }
    const float il = 1.f / fmaxf(l, 1e-30f);
    NSA_KLD(ka, kb, 0);
    f32x16 o[2]; o[0] = f32x16{}; o[1] = f32x16{};
    for (int k = 0; k < ntile; ++k) { f32x16 p0, p1; NSA_KLD(na, nb, (k + 1 < ntile ? k + 1 : 0));
        bf16x8 vfr[4][2];
#pragma unroll
        for (int kk = 0; kk < 4; ++kk)
#pragma unroll
            for (int d0 = 0; d0 < 2; ++d0) vfr[kk][d0] = *(const bf16x8*)(VC + ((size_t)(k * 64 + d0 * 32 + r32)) * 64 + kk * 16 + hi * 8);
        NSA_QK(p0, p1, ka, kb);
#pragma unroll
        for (int d0 = 0; d0 < 4; ++d0) { ka[d0] = na[d0]; kb[d0] = nb[d0]; }
#pragma unroll
        for (int r = 0; r < 16; ++r) { const int n = 64 * k + crow(r, hi); p0[r] = n < nv ? __builtin_amdgcn_exp2f(p0[r] - m) * il : 0.f; p1[r] = n + 32 < nv ? __builtin_amdgcn_exp2f(p1[r] - m) * il : 0.f; }
        u32x4 pw[4];
        pw[0] = (u32x4){cvtpk_s(p0[0], p0[1]), cvtpk_s(p0[2], p0[3]), cvtpk_s(p0[4], p0[5]), cvtpk_s(p0[6], p0[7])};
        pw[1] = (u32x4){cvtpk_s(p0[8], p0[9]), cvtpk_s(p0[10], p0[11]), cvtpk_s(p0[12], p0[13]), cvtpk_s(p0[14], p0[15])};
        pw[2] = (u32x4){cvtpk_s(p1[0], p1[1]), cvtpk_s(p1[2], p1[3]), cvtpk_s(p1[4], p1[5]), cvtpk_s(p1[6], p1[7])};
        pw[3] = (u32x4){cvtpk_s(p1[8], p1[9]), cvtpk_s(p1[10], p1[11]), cvtpk_s(p1[12], p1[13]), cvtpk_s(p1[14], p1[15])};
        f32x16 u = f32x16{};
#pragma unroll
        for (int kk = 0; kk < 4; ++kk) { const bf16x8 pa = __builtin_bit_cast(bf16x8, pw[kk]);
#pragma unroll
            for (int d0 = 0; d0 < 2; ++d0) o[d0] = __builtin_amdgcn_mfma_f32_32x32x16_bf16(pa, vfr[kk][d0], o[d0], 0, 0, 0);
            u = __builtin_amdgcn_mfma_f32_32x32x16_bf16(pa, ovf[kk], u, 0, 0, 0); }
        if (r32 <= 16) {
#pragma unroll
            for (int c = 0; c < 4; ++c) { const float sgrp = (u[4 * c] + u[4 * c + 1]) + (u[4 * c + 2] + u[4 * c + 3]); float* ip = imp + (wid * 8 + 2 * c + hi) * NSA_IMP_LD + 16 * k + r32; *ip += sgrp; } }
        WAVE_SYNC(); }
#undef NSA_QK
#undef NSA_KLD
    { float* wsf = (float*)(shm + gattn::LDS_WS) + wid * 64; if (hi == 0) wsf[32 + r32] = GATESs[(rb + tq) * 48 + (g * 4 + hh) * 3 + 0]; WAVE_SYNC();
      abf16* stg = (abf16*)(shm + gattn::LDS_OST) + wid * 2048;
#pragma unroll
      for (int r = 0; r < 16; ++r) { const int orow = crow(r, hi); const float gsc = wsf[32 + orow];
#pragma unroll
          for (int d0 = 0; d0 < 2; ++d0) stg[orow * 64 + d0 * 32 + r32] = __float2bfloat16(o[d0][r] * gsc); } }
    WAVE_SYNC();
    const int cur = q0 >> 6;
    for (int t8 = 0; t8 < 8; ++t8) { const int tok = wid * 8 + t8; const float* ip = imp + tok * NSA_IMP_LD;
        const int j0 = lane, j1 = lane + 64; const float i0 = ip[j0], i1 = ip[j1];
        const bool f0 = (j0 == 0) || (j0 == cur) || (j0 == cur - 1), f1 = (j1 == 0) || (j1 == cur) || (j1 == cur - 1);
        float pr0 = f0 ? i0 + 1e4f : i0, pr1 = f1 ? i1 + 1e4f : i1; pr0 = j0 <= cur ? pr0 : NEGF; pr1 = j1 <= cur ? pr1 : NEGF;
        const unsigned ub0 = __float_as_uint(pr0), ub1 = __float_as_uint(pr1);
        const unsigned k0 = (ub0 & 0x80000000u) ? ~ub0 : (ub0 | 0x80000000u), k1 = (ub1 & 0x80000000u) ? ~ub1 : (ub1 | 0x80000000u);
        unsigned thr = 0u;
        for (int bit = 31; bit >= 0; --bit) { const unsigned cand = thr | (1u << bit);
            const int c = __popcll(__builtin_amdgcn_ballot_w64(k0 >= cand)) + __popcll(__builtin_amdgcn_ballot_w64(k1 >= cand));
            thr = c >= 16 ? cand : thr; }
        const unsigned long long g0 = __builtin_amdgcn_ballot_w64(k0 > thr), g1 = __builtin_amdgcn_ballot_w64(k1 > thr);
        const unsigned long long e0 = __builtin_amdgcn_ballot_w64(k0 == thr), e1 = __builtin_amdgcn_ballot_w64(k1 == thr);
        int need = 16 - (__popcll(g0) + __popcll(g1));
        unsigned long long t0m = 0ull, t1m = 0ull;
        { unsigned long long e = e0; while (need > 0 && e) { const unsigned long long lowb = e & (0ull - e); t0m |= lowb; e ^= lowb; --need; } }
        { unsigned long long e = e1; while (need > 0 && e) { const unsigned long long lowb = e & (0ull - e); t1m |= lowb; e ^= lowb; --need; } }
        const unsigned long long vm0 = cur >= 63 ? ~0ull : ((1ull << (cur + 1)) - 1ull), vm1 = cur >= 127 ? ~0ull : (cur >= 64 ? ((1ull << (cur - 63)) - 1ull) : 0ull);
        const unsigned long long b0 = (g0 | t0m) & vm0, b1 = (g1 | t1m) & vm1;
        if (lane == 0) { selm[tok * 4 + 0] = (unsigned)b0; selm[tok * 4 + 1] = (unsigned)(b0 >> 32); selm[tok * 4 + 2] = (unsigned)b1; selm[tok * 4 + 3] = (unsigned)(b1 >> 32);
            if (selm_g) { unsigned* sg = selm_g + ((size_t)(rb + q0 + tok) * NSA_G + g) * 4; sg[0] = (unsigned)b0; sg[1] = (unsigned)(b0 >> 32); sg[2] = (unsigned)b1; sg[3] = (unsigned)(b1 >> 32); } }
        WAVE_SYNC(); }
}

struct Args { const void* in[31]; float* out; unsigned char* ws; int ph_lo, ph_hi; };

__device__ __forceinline__ float sigmoidf_(float z) { return 1.f / (1.f + __expf(-z)); }
__device__ __forceinline__ float gelu_tanh(float x) { const float u = 0.7978845608028654f * (x + 0.044715f * x * x * x); const float e = __expf(2.f * u); return 0.5f * x * (1.f + (1.f - 2.f / (e + 1.f))); }

__device__ __forceinline__ void ln_row(f32x4 (&v)[4], const float* g, const float* b, int lane) {
    float s = 0.f;
#pragma unroll
    for (int j = 0; j < 4; ++j) s += (v[j].x + v[j].y) + (v[j].z + v[j].w);
    const float mean = wave_sum(s) * (1.f / D); float s2 = 0.f;
#pragma unroll
    for (int j = 0; j < 4; ++j) { v[j] = v[j] - mean; s2 += (v[j].x * v[j].x + v[j].y * v[j].y) + (v[j].z * v[j].z + v[j].w * v[j].w); }
    const float rstd = 1.f / sqrtf(wave_sum(s2) * (1.f / D) + LN_EPS);
#pragma unroll
    for (int j = 0; j < 4; ++j) { const f32x4 gg = *(const f32x4*)(g + 4 * lane + 256 * j), bb = *(const f32x4*)(b + 4 * lane + 256 * j); v[j] = v[j] * rstd * gg + bb; }
}

__global__ void __launch_bounds__(NTHR, 2) mk_fwd(Args args) {
    extern __shared__ __attribute__((aligned(16))) unsigned char lds[];
    const int G = gridDim.x, bx = blockIdx.x;
    const int NGW = G * NWAVES, NGT = G * NTHR;
#define PH_IDS() int tid_o = threadIdx.x; asm volatile("" : "+v"(tid_o)); const int tid = tid_o, lane = tid & 63, wave = __builtin_amdgcn_readfirstlane(tid >> 6); \
    const int gw = bx * NWAVES + wave, gtid = bx * NTHR + tid; (void)gw; (void)gtid; (void)lane; (void)wave;
    unsigned char* ws = args.ws;
    gu32* ctl = (gu32*)(ws + WS_CTL);
    LAS unsigned char* ldsl = (LAS unsigned char*)lds;
    volatile LAS unsigned* MISC = (volatile LAS unsigned*)(ldsl + MISC_OFF);
    LAS int* TAB = (LAS int*)(ldsl + TAB_OFF);
    for (int u = threadIdx.x; u < (LDS_BYTES - RING_BYTES) / 4; u += NTHR) ((LAS unsigned*)(ldsl + RING_BYTES))[u] = 0u;
    __syncthreads();
    XcdBarrier bar; bar.bar = (unsigned*)(ctl + CW_BAR); bar.x = 0; bar.st = nullptr;
    if (!MK_MULTI) bar = xcd_barrier_post((unsigned*)(ctl + CW_BAR), MISC + 8);
#if defined(TIME_P1)
#define SEAM_AT(k) do { xcd_barrier(bar); if (blockIdx.x == 0 && threadIdx.x == 0) { ((unsigned long long*)(ctl + CW_TS))[(k)] = __builtin_amdgcn_s_memrealtime(); } } while (0)
#else
#define SEAM_AT(k) do { xcd_barrier(bar); } while (0)
#endif
#define SEAM() SEAM_AT(0)
#define IN(gp) (args.ph_lo <= (gp) && (gp) < args.ph_hi)

    float* X = (float*)(ws + WS_X);
    bf16_t* XBA = (bf16_t*)(ws + WS_XBA); bf16_t* XBB = (bf16_t*)(ws + WS_XBB);
    float* ROPE_C = (float*)(ws + WS_ROPE_C); float* ROPE_S = (float*)(ws + WS_ROPE_S);
    float* LOGF = (float*)(ws + WS_LOGF); float* CUM = (float*)(ws + WS_CUM); float* GATES = (float*)(ws + WS_GATES); float* KMEAN = (float*)(ws + WS_KMEAN);
    bf16_t* KCMP = (bf16_t*)(ws + WS_KCMP); bf16_t* VCMP = (bf16_t*)(ws + WS_VCMP); bf16_t* VCT = (bf16_t*)(ws + WS_VCT); unsigned* SELMG = (unsigned*)(ws + WS_SELMG);
    int* ROWTOK = (int*)(ws + WS_ROWTOK); float* LS32 = (float*)(ws + WS_LS32); float* H1 = (float*)(ws + WS_H1);
    int* TOKE = (int*)(ws + WS_TOKE); float* TOKW = (float*)(ws + WS_TOKW); int* TOKP = (int*)(ws + WS_TOKP); float* ROWW = (float*)(ws + WS_ROWW);
#define WSET_PTRS(LL) constexpr size_t so_ = ((LL) & 1) ? WS_SET1 : 0; \
    bf16_t* const WIN_T = (bf16_t*)(ws + WS_WIN + so_); bf16_t* const WOUT_T = (bf16_t*)(ws + WS_WOUT + so_); bf16_t* const WGU_T = (bf16_t*)(ws + WS_WGU + so_); bf16_t* const WDN_T = (bf16_t*)(ws + WS_WDN + so_); \
    bf16_t* const WPG_T = (bf16_t*)(ws + WS_WPG + so_); bf16_t* const WPP_T = (bf16_t*)(ws + WS_WPP + so_); bf16_t* const PB = (bf16_t*)(ws + WS_PB + so_); bf16_t* const WC1_T = (bf16_t*)(ws + WS_WC1 + so_); \
    float* const PEB = (float*)(ws + (((LL) & 1) ? WS_PEB1 : WS_PEB)); bf16_t* const WRT = (bf16_t*)(ws + (((LL) & 1) ? WS_WRT1 : WS_WRT)); \
    (void)WIN_T; (void)WOUT_T; (void)WGU_T; (void)WDN_T; (void)WPG_T; (void)WPP_T; (void)PB; (void)WC1_T; (void)PEB; (void)WRT;
    bf16_t* QB = (bf16_t*)(ws + WS_Q); bf16_t* KB = (bf16_t*)(ws + WS_K); bf16_t* VB = (bf16_t*)(ws + WS_V); bf16_t* AO = (bf16_t*)(ws + WS_AO);
    bf16_t* PP = (bf16_t*)(ws + WS_PP); bf16_t* QR = (bf16_t*)(ws + WS_QR); bf16_t* HB = (bf16_t*)(ws + WS_H); bf16_t* XG = (bf16_t*)(ws + WS_XG); bf16_t* OUTR = (bf16_t*)(ws + WS_OUTR);
    const int* positions = (const int*)args.in[2];

    if (IN(0)) { PH_IDS();
        for (int i = gtid; i < T * 32; i += NGT) { const int t = i >> 5, f = i & 31;
            const float inv = __builtin_amdgcn_exp2f(-(float)f * (13.287712379549449f / 32.f));
            const double ang = (double)positions[t] * (double)inv; double rev = ang * 0.15915494309189535; rev = rev - floor(rev);
            ROPE_C[i] = __builtin_amdgcn_cosf((float)rev); ROPE_S[i] = __builtin_amdgcn_sinf((float)rev); }
        for (int i = gtid; i < T; i += NGT) ROWTOK[64 * 16384 + i] = i;
        const float* xin = (const float*)args.in[0];
        for (int i = gtid; i < T * D / 4; i += NGT) { const f32x4 v = ((const f32x4*)xin)[i];
            unsigned long long w = (unsigned long long)pk2(v.x, v.y) | ((unsigned long long)pk2(v.z, v.w) << 32); ((unsigned long long*)XBB)[i] = w; }
    }

    auto conv = [&](auto Ltc) __attribute__((always_inline)) {
        constexpr int LT = decltype(Ltc)::value; PH_IDS(); WSET_PTRS(LT);
        const int kind = LT % 3, jj = LT / 3;
        const float* w_in_src = kind == 0 ? (const float*)args.in[3] + (size_t)jj * D * 3088 : kind == 1 ? (const float*)args.in[6] : (const float*)args.in[15];
        const int ldw_in = kind == 0 ? 3088 : kind == 1 ? 2608 : 3072, ncol_in = kind == 1 ? 2560 : 3072;
        const float* w_out_src = kind == 0 ? (const float*)args.in[5] + (size_t)jj * D * D : kind == 1 ? (const float*)args.in[14] : (const float*)args.in[16];
        {
            const int n_win = 16 * (ncol_in / 64), n_wout = 256, n_gu = 65 * 128, n_dn = 65 * 64, n_pg = 256, n_pp = 64;
            const int NIT = n_win + n_wout + n_gu + n_dn + n_pg + n_pp;
            auto dec = [&](int r, const float*& sp, int& ldw, bf16*& dp, int& K) __attribute__((always_inline)) {
                if (r < n_win) { const int nblk = ncol_in / 64, kb = r / nblk, nb = r % nblk; sp = w_in_src + (size_t)(64 * kb) * ldw_in + 64 * nb; ldw = ldw_in; dp = WIN_T + (size_t)(64 * nb) * D + 64 * kb; K = D; return; } r -= n_win;
                if (r < n_wout) { const int kb = r / 16, nb = r % 16; sp = w_out_src + (size_t)(64 * kb) * D + 64 * nb; ldw = D; dp = WOUT_T + (size_t)(64 * nb) * D + 64 * kb; K = D; return; } r -= n_wout;
                if (r < n_gu) { const int e = r / 128, rr = r % 128, mat = rr / 64, kb = (rr % 64) / 4, nb = rr % 4, n0 = 64 * nb;
                    const float* W = e < 64 ? (const float*)args.in[mat ? 22 : 21] + ((size_t)(LT * 64 + e)) * D * ED : (const float*)args.in[mat ? 25 : 24] + (size_t)LT * D * ED;
                    sp = W + (size_t)(64 * kb) * ED + n0; ldw = ED; dp = WGU_T + (size_t)(e * 512 + (n0 / 128) * 256 + mat * 128 + (n0 % 128)) * D + 64 * kb; K = D; return; } r -= n_gu;
                if (r < n_dn) { const int e = r / 64, rr = r % 64, kb = rr / 16, nb = rr % 16;
                    const float* W = e < 64 ? (const float*)args.in[23] + ((size_t)(LT * 64 + e)) * ED * D : (const float*)args.in[26] + (size_t)LT * ED * D;
                    sp = W + (size_t)(64 * kb) * D + 64 * nb; ldw = D; dp = WDN_T + (size_t)(e * 1024 + 64 * nb) * ED + 64 * kb; K = ED; return; } r -= n_dn;
                if (r < n_pg) { const int kb = r / 16, nb = r % 16; sp = (const float*)args.in[29] + (size_t)LT * D * D + (size_t)(64 * kb) * D + 64 * nb; ldw = D; dp = WPG_T + (size_t)(64 * nb) * D + 64 * kb; K = D; return; } r -= n_pg;
                { const int kb = r / 16, nb = r % 16; sp = (const float*)args.in[30] + (size_t)LT * PLE * D + (size_t)(64 * kb) * D + 64 * nb; ldw = D; dp = WPP_T + (size_t)(64 * nb) * PLE + 64 * kb; K = PLE; }
            };
            for (int it = gw; it < 2 * NIT; it += 6 * NGW) {
                const float* sp[6]; bf16* dp[6]; int ld[6], Kd[6]; f32x4 v[6][8];
#pragma unroll
                for (int u = 0; u < 6; ++u) { const int i2 = it + u * NGW; if (i2 < 2 * NIT) { dec(i2 >> 1, sp[u], ld[u], dp[u], Kd[u]); sp[u] += 32 * (i2 & 1); dp[u] += (size_t)(32 * (i2 & 1)) * Kd[u]; nitem_load(v[u], sp[u], ld[u], lane); } }
#pragma unroll
                for (int u = 0; u < 6; ++u) { const int i2 = it + u * NGW; if (i2 < 2 * NIT) nitem_store(v[u], dp[u], Kd[u], lane); }
            }
            { const f32x4* ps = (const f32x4*)((const float*)args.in[1] + (size_t)LT * T * PLE); unsigned long long* pd = (unsigned long long*)PB; constexpr int NP = T * PLE / 4;
              for (int i0 = gtid; i0 < NP; i0 += 8 * NGT) { f32x4 v[8];
#pragma unroll
                  for (int u = 0; u < 8; ++u) { const int i = i0 + u * NGT; if (i < NP) v[u] = __builtin_nontemporal_load((const GAS f32x4*)(ps + i)); }
#pragma unroll
                  for (int u = 0; u < 8; ++u) { const int i = i0 + u * NGT; if (i < NP) pd[i] = (unsigned long long)gattn::cvtpk_s(v[u].x, v[u].y) | ((unsigned long long)gattn::cvtpk_s(v[u].z, v[u].w) << 32); } } }
            { const float* Wr = (const float*)args.in[19] + (size_t)LT * D * NE;
              for (int i = gtid; i < NE * D; i += NGT) { const int e = i >> 10, k = i & 1023; const float w = Wr[k * 64 + e]; const unsigned h = f2bf(w); const float r = w - __uint_as_float(h << 16);
                  WRT[i] = (bf16_t)h; WRT[NE * D + i] = (bf16_t)f2bf(r); } }
            if (kind == 1) {
                for (int it = gw; it < 2 * 64; it += NGW) { const int kv = it >> 6, r = it & 63, kb = r >> 1, nb = r & 1;
                    transpose_item64((const float*)args.in[kv ? 12 : 10], 128, 64 * kb, 64 * nb, WC1_T, 2048, kv * 256 + 64 * nb, lane); }
                for (int it = gw; it < 2 * 128; it += NGW) { const int kv = it >> 7, hu = it & 127; const float* pe = (const float*)args.in[kv ? 9 : 8]; const float* w1 = (const float*)args.in[kv ? 12 : 10];
                    float wv[32], a = 0.f;
#pragma unroll
                    for (int i = 0; i < 32; ++i) wv[i] = w1[(size_t)(lane + 64 * i) * 128 + hu];
#pragma unroll
                    for (int i = 0; i < 32; ++i) a += pe[lane + 64 * i] * wv[i];
                    a = wave_sum(a); if (lane == 0) PEB[kv * 128 + hu] = a; }
            }
        }
    };

    auto layer_body = [&](auto Lc) __attribute__((always_inline)) {
        constexpr int L = decltype(Lc)::value; WSET_PTRS(L);
        const int kind = L % 3, jj = L / 3, gp0 = 1 + L * NPH;
        const float* w_in_src = kind == 0 ? (const float*)args.in[3] + (size_t)jj * D * 3088 : kind == 1 ? (const float*)args.in[6] : (const float*)args.in[15];
        const int ldw_in = kind == 0 ? 3088 : kind == 1 ? 2608 : 3072, ncol_in = kind == 1 ? 2560 : 3072;
        (void)jj; (void)w_in_src; (void)ldw_in;

        auto gates = [&]() __attribute__((always_inline)) { PH_IDS();
            if constexpr (L % 3 != 2) {
                using gattn::bf16x8; using gattn::f32x16; using gattn::u32x4; using gattn::crow; using gattn::cvtpk_s;
                constexpr int NB = (L % 3 == 0) ? 1 : 2, NCOL = (L % 3 == 0) ? 16 : 48;
                const int colbase = kind == 0 ? 3072 : 2560;
                const float* bsrc = kind == 0 ? (const float*)args.in[4] + jj * 16 : (const float*)args.in[7];
                constexpr int XP = 1032;
                bf16_t* XH = (bf16_t*)lds; bf16_t* XL = XH + 32 * XP; float* PL = (float*)lds;
                const int r32 = lane & 31, hi = lane >> 5;
                bf16x8 wh[8][NB], wl[8][NB];
#pragma unroll
                for (int st = 0; st < 8; ++st)
#pragma unroll
                    for (int nb = 0; nb < NB; ++nb) { const int n = nb * 32 + r32; u32x4 ph = {0u, 0u, 0u, 0u}, pl = {0u, 0u, 0u, 0u};
                        if (n < NCOL) { float wv[8];
#pragma unroll
                            for (int i = 0; i < 8; ++i) wv[i] = w_in_src[(size_t)(wave * 128 + 16 * st + 8 * hi + i) * ldw_in + colbase + n];
#pragma unroll
                            for (int i = 0; i < 4; ++i) { const unsigned h2 = cvtpk_s(wv[2 * i], wv[2 * i + 1]); ph[i] = h2; pl[i] = cvtpk_s(wv[2 * i] - bflo(h2), wv[2 * i + 1] - bfhi(h2)); } }
                        wh[st][nb] = __builtin_bit_cast(bf16x8, ph); wl[st][nb] = __builtin_bit_cast(bf16x8, pl); }
                for (int pass = bx; pass < T / 32; pass += G) { const size_t row0 = (size_t)pass * 32;
                    __syncthreads();
#pragma unroll
                    for (int r = 0; r < 4; ++r) { const int rl = wave * 4 + r; const size_t row = row0 + rl;
#pragma unroll
                        for (int j = 0; j < 4; ++j) {
                            if constexpr (L == 0) { const f32x4 v = *(const f32x4*)((const float*)args.in[0] + row * D + 4 * lane + 256 * j);
                                const unsigned h0 = cvtpk_s(v.x, v.y), h1 = cvtpk_s(v.z, v.w); const unsigned l0 = cvtpk_s(v.x - bflo(h0), v.y - bfhi(h0)), l1 = cvtpk_s(v.z - bflo(h1), v.w - bfhi(h1));
                                *(uint2*)(XH + rl * XP + 4 * lane + 256 * j) = make_uint2(h0, h1); *(uint2*)(XL + rl * XP + 4 * lane + 256 * j) = make_uint2(l0, l1); }
                            else *(uint2*)(XH + rl * XP + 4 * lane + 256 * j) = *(const uint2*)(XBB + row * D + 4 * lane + 256 * j); } }
                    __syncthreads();
                    f32x16 acc[NB];
#pragma unroll
                    for (int nb = 0; nb < NB; ++nb) acc[nb] = f32x16{};
#pragma unroll
                    for (int st = 0; st < 8; ++st) { const int k = wave * 128 + 16 * st + 8 * hi; const bf16x8 xh = *(const bf16x8*)(XH + r32 * XP + k); bf16x8 xl = xh; if constexpr (L == 0) xl = *(const bf16x8*)(XL + r32 * XP + k);
#pragma unroll
                        for (int nb = 0; nb < NB; ++nb) { acc[nb] = __builtin_amdgcn_mfma_f32_32x32x16_bf16(xh, wh[st][nb], acc[nb], 0, 0, 0); if constexpr (L == 0) acc[nb] = __builtin_amdgcn_mfma_f32_32x32x16_bf16(xl, wh[st][nb], acc[nb], 0, 0, 0);
                            acc[nb] = __builtin_amdgcn_mfma_f32_32x32x16_bf16(xh, wl[st][nb], acc[nb], 0, 0, 0); } }
                    __syncthreads();
#pragma unroll
                    for (int nb = 0; nb < NB; ++nb)
#pragma unroll
                        for (int r = 0; r < 16; ++r) PL[(wave * 32 + crow(r, hi)) * 64 + nb * 32 + r32] = acc[nb][r];
                    __syncthreads();
                    for (int o = tid; o < 32 * NCOL; o += NTHR) { const int rl = o / NCOL, c = o % NCOL; float z = bsrc[c];
#pragma unroll
                        for (int w = 0; w < 8; ++w) z += PL[(w * 32 + rl) * 64 + c];
                        if (kind == 0) { const float lf = fminf(z, 0.f) - __logf(1.f + __expf(-fabsf(z))); LOGF[(row0 + rl) * 16 + c] = lf;
                            float s4 = lf; s4 += xor_f<16>(s4); { auto rr = __builtin_amdgcn_permlane32_swap(__float_as_uint(s4), __float_as_uint(s4), false, false); s4 = __uint_as_float(rr[0]) + __uint_as_float(rr[1]); }
                            if (lane < 16) PL[8 * 32 * 64 + wave * 16 + lane] = s4; }
                        else GATES[(row0 + rl) * 48 + c] = sigmoidf_(z); }
                    if (kind == 0) { __syncthreads(); if (tid < 16) { float s = 0.f;
#pragma unroll
                            for (int w = 0; w < 8; ++w) s += PL[8 * 32 * 64 + w * 16 + tid]; LS32[(size_t)pass * 16 + tid] = s; } }
                }
                __syncthreads();
            }
        };

        if (L == 0 && PH_EN(0) && IN(gp0 + 0)) {
            conv(std::integral_constant<int, 0>{}); gates();
            SEAM_AT(1 + L * NPH + 0);
        }

        if (PH_EN(1) && IN(gp0 + 1)) { PH_IDS();
            if constexpr (L > 0) gates();
            pg8::Gemm g{XBB, WIN_T, T, ncol_in, D, 0, 0, nullptr}; pg8::StaticOrder So; So.init(T, ncol_in, G, bx);
            epi::Qkv E{QB, 1024, D, KB, kind == 1 ? 256 : 1024, kind == 1 ? 256 : 1024, kind == 1 ? (size_t)(4 * MiB) : (size_t)(16 * MiB), gattn::C2};
            pg8::gemm_phase<epi::Qkv, pg8::StaticOrder, true, true>(ldsl, g, So, E);
            {
              int kpp = PLE; asm volatile("" : "+s"(kpp)); pg8::Gemm g{PB, WPP_T, T, D, kpp, 0, 0, nullptr}; pg8::StaticOrder So; So.init(T, D, G, bx);
              epi::StoreBf16 E{PP, D};
              pg8::gemm_phase<epi::StoreBf16, pg8::StaticOrder, true, true>(ldsl, g, So, E); }
            SEAM_AT(1 + L * NPH + 1);
        }

        if (PH_EN(2) && IN(gp0 + 2)) { PH_IDS();
            if (kind == 0) {
                for (int task = gw; task < Bn * NH * 32; task += NGW) { const int q = task & 31, bh = task >> 5, b = bh / NH, h = bh % NH;
                    double base = 0.0;
                    for (int p = lane; p < 8 * q; p += 64) base += (double)LS32[((size_t)b * 256 + p) * 16 + h];
#pragma unroll
                    for (int o = 1; o < 64; o <<= 1) { const unsigned long long sb = __builtin_bit_cast(unsigned long long, base); const int sl4 = (lane ^ o) << 2;
                        const unsigned ulo = (unsigned)__builtin_amdgcn_ds_bpermute(sl4, (int)(unsigned)sb), uhi = (unsigned)__builtin_amdgcn_ds_bpermute(sl4, (int)(unsigned)(sb >> 32));
                        base += __builtin_bit_cast(double, ((unsigned long long)uhi << 32) | ulo); }
                    const size_t t0 = (size_t)b * S + q * 256 + lane * 4; double loc[4]; double run = 0.0;
#pragma unroll
                    for (int i = 0; i < 4; ++i) { run += (double)LOGF[(t0 + i) * 16 + h]; loc[i] = run; }
                    double sc = run;
#pragma unroll
                    for (int o = 1; o < 64; o <<= 1) { const unsigned long long sb = __builtin_bit_cast(unsigned long long, sc); const int sl4 = ((lane - o) & 63) << 2;
                        const unsigned ulo = (unsigned)__builtin_amdgcn_ds_bpermute(sl4, (int)(unsigned)sb), uhi = (unsigned)__builtin_amdgcn_ds_bpermute(sl4, (int)(unsigned)(sb >> 32));
                        const double up = __builtin_bit_cast(double, ((unsigned long long)uhi << 32) | ulo); if (lane >= o) sc += up; }
                    const double pre = base + (sc - run);
#pragma unroll
                    for (int i = 0; i < 4; ++i) CUM[(size_t)bh * S + q * 256 + lane * 4 + i] = (float)(pre + loc[i]); }
                for (int b = 0; b < Bn; ++b) { float mq = 0.f, mk = 0.f;
                    for (int rbase = gw; rbase < S; rbase += 4 * NGW) { uint4 q0a[4], q1a[4], k0a[4], k1a[4];
#pragma unroll
                      for (int u4 = 0; u4 < 4; ++u4) { const int r = rbase + u4 * NGW; if (r < S) { const size_t off = ((size_t)b * S + r) * D + lane * 16;
                          q0a[u4] = *(const uint4*)(QB + off); q1a[u4] = *(const uint4*)(QB + off + 8); k0a[u4] = *(const uint4*)(KB + off); k1a[u4] = *(const uint4*)(KB + off + 8); } }
#pragma unroll
                      for (int u4 = 0; u4 < 4; ++u4) { const int r = rbase + u4 * NGW; if (r >= S) continue; const uint4 q0 = q0a[u4], q1 = q1a[u4], k0 = k0a[u4], k1 = k1a[u4];
                        float sq = 0.f, sk = 0.f;
#define SQ2(w) (bflo(w) * bflo(w) + bfhi(w) * bfhi(w))
                        sq = SQ2(q0.x) + SQ2(q0.y) + SQ2(q0.z) + SQ2(q0.w) + SQ2(q1.x) + SQ2(q1.y) + SQ2(q1.z) + SQ2(q1.w);
                        sk = SQ2(k0.x) + SQ2(k0.y) + SQ2(k0.z) + SQ2(k0.w) + SQ2(k1.x) + SQ2(k1.y) + SQ2(k1.z) + SQ2(k1.w);
#undef SQ2
                        sq += xor_f<1>(sq); sq += xor_f<2>(sq); sk += xor_f<1>(sk); sk += xor_f<2>(sk);
                        mq = fmaxf(mq, sq); mk = fmaxf(mk, sk); } }
                    LAS float* nl = (LAS float*)ldsl; __syncthreads();
                    if ((lane & 3) == 0) { nl[(wave * 16 + (lane >> 2)) * 2] = mq; nl[(wave * 16 + (lane >> 2)) * 2 + 1] = mk; }
                    __syncthreads();
                    if (tid < 32) { float m = 0.f;
#pragma unroll
                        for (int w = 0; w < 8; ++w) m = fmaxf(m, nl[(w * 16 + (tid >> 1)) * 2 + (tid & 1)]);
                        __hip_atomic_fetch_max((unsigned*)(ctl + CW_NRM + L * 64 + (b * NH + (tid >> 1)) * 2 + (tid & 1)), __float_as_uint(m), RLX_AGENT); } }
            } else {
                const size_t st6 = 4 * MiB;
                for (int pass = 0; pass < (kind == 1 ? 3 : 2); ++pass) {
                    const bf16_t* src; bf16_t* dst; int nhd;
                    if (kind == 1) { if (pass == 0) { src = QB; dst = QR; nhd = 16; } else if (pass == 1) { src = KB + 2 * st6; dst = KB + 2 * st6; nhd = 4; } else { src = KB + 4 * st6; dst = KB + 4 * st6; nhd = 4; } }
                    else { if (pass == 0) { src = QB; dst = QB; } else { src = KB; dst = KB; } nhd = 16; }
                    const int per_row = nhd * 4, total = T * per_row;
                    for (int i = gtid; i < total; i += NGT) { const int t = i / per_row, r = i % per_row, hd = r >> 2, fq = r & 3;
                        const size_t o1 = (size_t)t * (nhd * 64) + hd * 64 + 8 * fq;
                        const uint4 a = *(const uint4*)(src + o1), bq = *(const uint4*)(src + o1 + 32);
                        const f32x4 c0 = *(const f32x4*)(ROPE_C + t * 32 + 8 * fq), c1 = *(const f32x4*)(ROPE_C + t * 32 + 8 * fq + 4);
                        const f32x4 s0 = *(const f32x4*)(ROPE_S + t * 32 + 8 * fq), s1 = *(const f32x4*)(ROPE_S + t * 32 + 8 * fq + 4);
                        uint4 oa, ob;
#define ROPE2(W, CA, CB, SA, SB) { const float x1l = bflo(a.W), x1h = bfhi(a.W), x2l = bflo(bq.W), x2h = bfhi(bq.W); \
                            oa.W = pk2(x1l * CA - x2l * SA, x1h * CB - x2h * SB); ob.W = pk2(x2l * CA + x1l * SA, x2h * CB + x1h * SB); }
                        ROPE2(x, c0.x, c0.y, s0.x, s0.y) ROPE2(y, c0.z, c0.w, s0.z, s0.w) ROPE2(z, c1.x, c1.y, s1.x, s1.y) ROPE2(w, c1.z, c1.w, s1.z, s1.w)
#undef ROPE2
                        *(uint4*)(dst + o1) = oa; *(uint4*)(dst + o1 + 32) = ob; }
                }
            }
            SEAM_AT(1 + L * NPH + 2);
        }

        if (kind != 0 && PH_EN(3) && IN(gp0 + 3)) { PH_IDS();
            if (kind == 1) {
                { pg8::Gemm g{KB, WC1_T, 0, 0, 2048, 4096, 512, nullptr}; CmpOrder So{G, bx}; epi::H1Store E{H1};
                  pg8::gemm_phase<epi::H1Store, CmpOrder, true, true>(ldsl, g, So, E); }
                if (!MK_MULTI) xcd_barrier(bar);
                float* hb = (float*)(lds + wave * 1024);
                for (int task = gw; task < 2 * 8 * NCMP; task += NGW) { const int i = task & 511, bg = (task >> 9) & 7, kv = task >> 12;
                    const float* h1 = H1 + (size_t)task * 128; const float* w2 = (const float*)args.in[kv ? 13 : 11];
                    hb[lane] = gelu_tanh(h1[lane] + PEB[kv * 128 + lane]); hb[64 + lane] = gelu_tanh(h1[64 + lane] + PEB[kv * 128 + 64 + lane]);
                    WAVE_SYNC();
                    float o0 = 0.f;
#pragma unroll 8
                    for (int hu = 0; hu < 128; ++hu) o0 += hb[hu] * w2[hu * 64 + lane];
                    const bf16_t ob = (bf16_t)f2bf(o0);
                    if (kv == 0) KCMP[((size_t)bg * NCMP + i) * 64 + lane] = ob;
                    else { VCMP[((size_t)bg * NCMP + i) * 64 + lane] = ob; const int nl = i & 63; VCT[(((size_t)bg * 8 + (i >> 6)) * 64 + lane) * 64 + (nl & 48) + swapmid(nl & 15)] = ob; }
                    WAVE_SYNC(); }
            } else if (kind == 2) {
                for (int item = gw; item < Bn * NH * 32; item += NGW) { const int blk = item & 31, bh = item >> 5, b = bh / NH, h = bh % NH;
                    float s = 0.f; const bf16_t* kp = KB + ((size_t)b * S + blk * 256) * D + h * 64 + lane;
                    for (int r0 = 0; r0 < 256; r0 += 32) { bf16_t kv[32];
#pragma unroll
                        for (int r = 0; r < 32; ++r) kv[r] = kp[(size_t)(r0 + r) * D];
#pragma unroll
                        for (int r = 0; r < 32; ++r) s += bf2f(kv[r]); }
                    KMEAN[(size_t)item * 64 + lane] = s * (1.f / 256.f); }
            }
            SEAM_AT(1 + L * NPH + 3);
        }

        if (PH_EN(4) && IN(gp0 + 4)) { PH_IDS();
            float* wl = (float*)(lds + wave * 14336);
            float* qs = wl; float* qs2 = wl + 256; float* pb = wl + 512; int* kb = (int*)(wl + 512 + 2048); float* misc = wl + 512 + 2048 + 512;
#if defined(ZERO_KIND)
            if ((ZERO_KIND >> kind) & 1) { for (int i = gtid; i < T * D / 8; i += NGT) ((uint4*)AO)[i] = make_uint4(0u, 0u, 0u, 0u); } else {
#endif
            bf16_t* AOn = AO;
#if !defined(FOX_NAIVE)
            if (kind == 0) {
                volatile LAS int* qw = (volatile LAS int*)(ldsl + TAB_OFF);
                int nun = 0; const int cslot = bx & 3; (void)cslot;
                for (;; ++nun) {
                    if constexpr (L + 1 < DEPTH) { if (nun == cslot) conv(std::integral_constant<int, (L + 1 < DEPTH ? L + 1 : 0)>{}); }
                    if (tid == 0) { qw[100] = (int)__hip_atomic_fetch_add((unsigned*)(ctl + CW_Q + L), 1u, RLX_AGENT); qw[101] = 0; }
                    __syncthreads();
                    const int u = qw[100]; if (u >= Bn * NH * 32) break;
                    const int qb = 31 - (u >> 5), bh = u & 31, b = bh / NH, h = bh % NH; const size_t rb = (size_t)b * S; const int ntabs = 4 * qb + 4;
                    const float* cum = CUM + (size_t)bh * S;
                    { const unsigned* nr = (const unsigned*)(ctl + CW_NRM + L * 64 + bh * 2);
                      const float qk = sqrtf(__uint_as_float(__hip_atomic_load(nr, RLX_AGENT)) * __uint_as_float(__hip_atomic_load(nr + 1, RLX_AGENT)));
                      const float thr = -(30.f + 2.f * qk);
                      bool skip = false; if (tid < ntabs) skip = (cum[qb * 256] - cum[64 * tid + 63]) * 1.4426950408889634f < thr;
                      const int nsk = __popcll(__builtin_amdgcn_ballot_w64(skip)); if (lane == 0 && nsk) atomicAdd((int*)&qw[101], nsk); }
                    __syncthreads();
                    int t0 = qw[101]; t0 = t0 > ntabs - 4 ? ntabs - 4 : t0; t0 &= ~1;
                    __syncthreads();
                    FoxU un{(const abf16*)KB + rb * D + h * 64, (const abf16*)VB + rb * D + h * 64, D, t0, ntabs - t0, ntabs - 1, cum, qb * 256,
                            (abf16*)AO + (rb + qb * 256) * D + h * 64, 32L * D, (const abf16*)QB + (rb + qb * 256) * D + h * 64, nullptr};
                    gattn::gunit<8, true, 0, 0>((char*)lds, un); }
                if constexpr (L + 1 < DEPTH) { if (nun < cslot) conv(std::integral_constant<int, (L + 1 < DEPTH ? L + 1 : 0)>{}); }
            }
#endif
#if !defined(MOBA_NAIVE)
            if (kind == 2) {
                const int vcu = (bx % 8) * (G / 8) + bx / 8;
                LAS unsigned* mtab = (LAS unsigned*)(ldsl + gattn::LDS_BT); LAS float* kml = (LAS float*)(ldsl + gattn::LDS_BT + 1024);
                const int cslot = bx % 5;
                for (int ui = 0; ui < 4; ++ui) { int bh, qb; fox_order(vcu, ui, bh, qb); const int b = bh / NH, h = bh % NH; const size_t rb = (size_t)b * S;
                    if constexpr (L + 1 < DEPTH) { if (ui == cslot) conv(std::integral_constant<int, (L + 1 < DEPTH ? L + 1 : 0)>{}); }
                    for (int i = tid; i < qb * 64; i += NTHR) kml[i] = KMEAN[(size_t)bh * 32 * 64 + i];
                    __syncthreads();
                    if (tid < 256) { const uint4* qp = (const uint4*)(QB + (rb + qb * 256 + tid) * D + h * 64); float q[64];
#pragma unroll
                        for (int c = 0; c < 8; ++c) { const uint4 w = qp[c]; q[8 * c] = bflo(w.x); q[8 * c + 1] = bfhi(w.x); q[8 * c + 2] = bflo(w.y); q[8 * c + 3] = bfhi(w.y); q[8 * c + 4] = bflo(w.z); q[8 * c + 5] = bfhi(w.z); q[8 * c + 6] = bflo(w.w); q[8 * c + 7] = bfhi(w.w); }
                        float v0 = -3e38f, v1 = -3e38f, v2 = -3e38f; int i0 = -1, i1 = -1, i2 = -1;
                        for (int n = 0; n < qb; ++n) { float sacc = 0.f;
#pragma unroll
                            for (int d = 0; d < 64; ++d) sacc += q[d] * kml[n * 64 + d];
                            if (sacc > v0) { v2 = v1; i2 = i1; v1 = v0; i1 = i0; v0 = sacc; i0 = n; } else if (sacc > v1) { v2 = v1; i2 = i1; v1 = sacc; i1 = n; } else if (sacc > v2) { v2 = sacc; i2 = n; } }
                        unsigned mk = 1u << qb; if (i0 >= 0) mk |= 1u << i0; if (i1 >= 0) mk |= 1u << i1; if (i2 >= 0) mk |= 1u << i2;
                        mtab[tid] = mk; }
                    __syncthreads();
                    FoxU un{(const abf16*)KB + rb * D + h * 64, (const abf16*)VB + rb * D + h * 64, D, 0, 4 * qb + 4, 4 * qb + 3, nullptr, qb * 256,
                            (abf16*)AO + (rb + qb * 256) * D + h * 64, 32L * D, (const abf16*)QB + (rb + qb * 256) * D + h * 64, mtab};
                    gattn::gunit<8, false, 0, 0>((char*)lds, un); }
                if constexpr (L + 1 < DEPTH) { if (cslot == 4) conv(std::integral_constant<int, (L + 1 < DEPTH ? L + 1 : 0)>{}); }
            }
#endif
#if !defined(NSA_NAIVE)
            if (kind == 1) {
                const int vcu = (bx % 8) * (G / 8) + bx / 8; const size_t st6 = 4 * MiB;
                const int cslot = bx % 5;
                for (int ui = 0; ui < 4; ++ui) { const int bg = vcu >> 5, s5 = vcu & 31, b = bg / NSA_G, g = bg % NSA_G;
                    if constexpr (L + 1 < DEPTH) { if (ui == cslot) conv(std::integral_constant<int, (L + 1 < DEPTH ? L + 1 : 0)>{}); } const int qt = (ui == 0) ? s5 : (ui == 1) ? 63 - s5 : (ui == 2) ? 64 + s5 : 127 - s5;
                    const int q0 = qt * 64, cur = qt; const size_t rb = (size_t)b * S;
#if defined(CHECK_KIND)
                    unsigned* selg = SELMG;
#else
                    unsigned* selg = nullptr;
#endif
                    nsa_cmp_select((char*)lds, b, g, q0, QB, KCMP, VCT, GATES, selg);
                    const LAS unsigned* selm = (const LAS unsigned*)(ldsl + NSA_LDS_SELM);
                    { int nt = (cur + 2) & ~1; nt = nt < 4 ? 4 : nt;
                      NsaU un{(const abf16*)KB + 2 * st6 + rb * 256 + g * 64, (const abf16*)KB + 3 * st6 + rb * 256 + g * 64, 256, 0, nt, 127, nullptr, q0,
                              (abf16*)AO + (rb + q0) * D + g * 256, 8L * D, (const abf16*)QR + (rb + q0) * D + g * 256, selm, GATES + (rb + q0) * 48 + g * 12, 1, 0};
                      gattn::gunit<8, false, 2, 2>((char*)lds, un); }
                    { NsaU un{(const abf16*)KB + 4 * st6 + rb * 256 + g * 64, (const abf16*)KB + 5 * st6 + rb * 256 + g * 64, 256, cur - 8, 10, 127, nullptr, q0,
                              (abf16*)AO + (rb + q0) * D + g * 256, 8L * D, (const abf16*)QR + (rb + q0) * D + g * 256, nullptr, GATES + (rb + q0) * 48 + g * 12, 2, 512};
                      gattn::gunit<8, false, 3, 2>((char*)lds, un); }
                }
                if constexpr (L + 1 < DEPTH) { if (cslot == 4) conv(std::integral_constant<int, (L + 1 < DEPTH ? L + 1 : 0)>{}); }
            }
#endif
#if defined(CHECK_KIND)
            if (kind == CHECK_KIND) { AOn = XG; SEAM_AT(1 + L * NPH + 4); }
#endif
#if defined(FOX_NAIVE) || (defined(CHECK_KIND) && CHECK_KIND == 0)
            if (kind == 0) {
                for (int task = gw; task < T * NH; task += NGW) {
                    const int t = task % S, bh = task / S, h = bh % NH, b = bh / NH; const size_t row = (size_t)b * S + t;
                    qs[lane] = bf2f(QB[row * D + h * 64 + lane]);
                    const float* cum = CUM + (size_t)bh * S; const float cq = cum[t];
                    WAVE_SYNC();
                    float m[1] = {NEGF}, l[1] = {0.f}, o[1] = {0.f};
                    for (int c0 = 0; c0 <= t; c0 += 512) {
                        attend_chunk<1>(qs, pb, kb, KB + h * 64, VB + h * 64, D, 512,
                            [=](int slot) { const int kk = c0 + slot; return kk <= t ? (int)(b * S + kk) : -1; },
                            [=](int slot) { return cq - cum[c0 + slot]; }, QSC, m, l, o, lane);
                    }
                    AOn[row * D + h * 64 + lane] = (bf16_t)f2bf(o[0] / fmaxf(l[0], 1e-30f));
                }
            }
#endif
#if defined(NSA_NAIVE) || (defined(CHECK_KIND) && CHECK_KIND == 1)
            if (kind == 1) {
                const size_t st6 = 4 * MiB;
                float* Pn = misc;
                for (int task = gw; task < T * NSA_G; task += NGW) {
                    const int t = task % S, bg = task / S, g = bg % NSA_G, b = bg / NSA_G; const size_t row = (size_t)b * S + t;
#pragma unroll
                    for (int h = 0; h < 4; ++h) { qs[h * 64 + lane] = bf2f(QB[row * D + (g * 4 + h) * 64 + lane]); qs2[h * 64 + lane] = bf2f(QR[row * D + (g * 4 + h) * 64 + lane]); }
                    WAVE_SYNC();
                    float oc[4], os[4], ow[4];
                    const int nvalid = t >= 31 ? ((t - 31) >> 4) + 1 : 0;
                    {
                        float m[4] = {NEGF, NEGF, NEGF, NEGF}, l[4] = {0.f, 0.f, 0.f, 0.f}; oc[0] = oc[1] = oc[2] = oc[3] = 0.f;
                        attend_chunk<4>(qs, pb, kb, KCMP + (size_t)bg * NCMP * 64, VCMP + (size_t)bg * NCMP * 64, 64, 512,
                            [=](int slot) { return slot < nvalid ? slot : -1; }, [=](int) { return 0.f; }, QSC, m, l, oc, lane);
                        float il[4];
#pragma unroll
                        for (int h = 0; h < 4; ++h) { il[h] = 1.f / fmaxf(l[h], 1e-30f); oc[h] *= il[h]; }
                        for (int i = 0; i < 8; ++i) { const int n = lane + 64 * i; Pn[n] = pb[n] * il[0] + pb[512 + n] * il[1] + pb[1024 + n] * il[2] + pb[1536 + n] * il[3]; }
                        WAVE_SYNC();
                    }
                    const int cur = t >> 6;
                    float pri0, pri1;
                    {
                        float imp[2];
#pragma unroll
                        for (int c = 0; c < 2; ++c) { const int j = lane + 64 * c; float a = 0.f;
#pragma unroll
                            for (int dn = -1; dn <= 3; ++dn) { const int n = 4 * j + dn; if (n >= 0 && n < 511) a += Pn[n]; }
                            imp[c] = a; }
                        const int j0 = lane, j1 = lane + 64;
                        const bool f0 = (j0 == 0) || (j0 == cur) || (j0 == cur - 1), f1 = (j1 == 0) || (j1 == cur) || (j1 == cur - 1);
                        pri0 = f0 ? imp[0] + 1e4f : imp[0]; pri1 = f1 ? imp[1] + 1e4f : imp[1];
                        pri0 = j0 <= cur ? pri0 : NEGF; pri1 = j1 <= cur ? pri1 : NEGF;
                    }
                    float* pri = (float*)kb;
                    int* sidx = kb + 128;
                    pri[lane] = pri0; pri[lane + 64] = pri1;
                    WAVE_SYNC();
                    int rk0 = 0, rk1 = 0;
                    for (int i = 0; i < 128; ++i) { const float pi = pri[i]; rk0 += (pi > pri0 || (pi == pri0 && i < lane)) ? 1 : 0; rk1 += (pi > pri1 || (pi == pri1 && i < lane + 64)) ? 1 : 0; }
                    bool s0 = (lane <= cur) && rk0 < 16, s1 = (lane + 64 <= cur) && rk1 < 16;
#if defined(CHECK_KIND) && !defined(CHECK_OWNSEL)
                    { const unsigned* sg = SELMG + ((size_t)row * NSA_G + g) * 4; s0 = (sg[lane >> 5] >> (lane & 31)) & 1u; s1 = (sg[2 + (lane >> 5)] >> (lane & 31)) & 1u; }
#endif
                    const unsigned long long b0 = __ballot(s0), b1 = __ballot(s1);
                    const unsigned long long lt = (1ull << lane) - 1ull;
                    const int n0 = __popcll(b0);
                    WAVE_SYNC();
                    if (lane < 16) sidx[lane] = -1;
                    WAVE_SYNC();
                    if (s0) sidx[__popcll(b0 & lt)] = lane;
                    if (s1) sidx[n0 + __popcll(b1 & lt)] = lane + 64;
                    WAVE_SYNC();
                    int myblk = sidx[lane & 15];
                    {
                        float m[4] = {NEGF, NEGF, NEGF, NEGF}, l[4] = {0.f, 0.f, 0.f, 0.f}; os[0] = os[1] = os[2] = os[3] = 0.f;
                        const bf16_t* Ks = KB + 2 * st6 + g * 64; const bf16_t* Vs = KB + 3 * st6 + g * 64;
                        for (int c = 0; c < 2; ++c) {
                            attend_chunk<4>(qs2, pb, kb, Ks, Vs, 256, 512,
                                [=](int slot) { const int j = __shfl(myblk, c * 8 + (slot >> 6)); const int kk = j * 64 + (slot & 63); return (j >= 0 && kk <= t) ? (int)(b * S + kk) : -1; },
                                [=](int) { return 0.f; }, QSC, m, l, os, lane);
                        }
#pragma unroll
                        for (int h = 0; h < 4; ++h) os[h] /= fmaxf(l[h], 1e-30f);
                    }
                    {
                        float m[4] = {NEGF, NEGF, NEGF, NEGF}, l[4] = {0.f, 0.f, 0.f, 0.f}; ow[0] = ow[1] = ow[2] = ow[3] = 0.f;
                        const bf16_t* Kw = KB + 4 * st6 + g * 64; const bf16_t* Vw = KB + 5 * st6 + g * 64;
                        attend_chunk<4>(qs2, pb, kb, Kw, Vw, 256, 512,
                            [=](int slot) { const int kk = t - 511 + slot; return kk >= 0 ? (int)(b * S + kk) : -1; },
                            [=](int) { return 0.f; }, QSC, m, l, ow, lane);
#pragma unroll
                        for (int h = 0; h < 4; ++h) ow[h] /= fmaxf(l[h], 1e-30f);
                    }
#pragma unroll
                    for (int h = 0; h < 4; ++h) { const float* gt = GATES + row * 48 + (g * 4 + h) * 3;
                        AOn[row * D + (g * 4 + h) * 64 + lane] = (bf16_t)f2bf(gt[0] * oc[h] + gt[1] * os[h] + gt[2] * ow[h]); }
                }
            }
#endif
#if defined(MOBA_NAIVE) || (defined(CHECK_KIND) && CHECK_KIND == 2)
            if (kind == 2) {
                for (int task = gw; task < T * NH; task += NGW) {
                    const int t = task % S, bh = task / S, h = bh % NH, b = bh / NH; const size_t row = (size_t)b * S + t;
                    qs[lane] = bf2f(QB[row * D + h * 64 + lane]);
                    WAVE_SYNC();
                    const int cb = t >> 8;
                    float gs = NEGF;
                    if (lane < cb) { const float* km = KMEAN + ((size_t)bh * 32 + lane) * 64; float a = 0.f;
#pragma unroll 8
                        for (int d = 0; d < 64; ++d) a += qs[d] * km[d];
                        gs = a; }
                    if (lane >= 32) gs = -3e30f;
                    int sel[3];
#pragma unroll
                    for (int r = 0; r < 3; ++r) { const float mx = wave_max(gs); const unsigned long long bm = __ballot(gs == mx); const int win = __ffsll((long long)bm) - 1;
                        sel[r] = (win < cb) ? win : -1; if (lane == win) gs = -3e30f; }
                    float m[1] = {NEGF}, l[1] = {0.f}, o[1] = {0.f};
                    for (int c = 0; c < 2; ++c) {
                        const int blk0 = c == 0 ? sel[0] : sel[2], blk1 = c == 0 ? sel[1] : cb;
                        attend_chunk<1>(qs, pb, kb, KB + h * 64, VB + h * 64, D, 512,
                            [=](int slot) { const int blk = slot < 256 ? blk0 : blk1; const int kk = blk * 256 + (slot & 255); return (blk >= 0 && kk <= t) ? (int)(b * S + kk) : -1; },
                            [=](int) { return 0.f; }, QSC, m, l, o, lane);
                    }
                    AOn[row * D + h * 64 + lane] = (bf16_t)f2bf(o[0] / fmaxf(l[0], 1e-30f));
                }
            }
#endif
#if defined(ZERO_KIND)
            }
#endif
#if defined(CHECK_KIND)
            if (kind == CHECK_KIND) {
                SEAM_AT(1 + L * NPH + 4);
                float num = 0.f, den = 0.f;
                for (int i = gtid; i < T * D; i += NGT) { const float a = bf2f(AO[i]), b = bf2f(AOn[i]); num += (a - b) * (a - b); den += b * b; }
                num = wave_sum(num); den = wave_sum(den);
                if (lane == 0) { atomicAdd((float*)(ctl + CW_CHK), num); atomicAdd((float*)(ctl + CW_CHK + 1), den); }
            }
#endif
            SEAM_AT(1 + L * NPH + 4);
        }

        if (PH_EN(5) && IN(gp0 + 5)) { PH_IDS();
            pg8::Gemm g{AO, WOUT_T, T, D, D, 0, 0, nullptr}; pg8::StaticOrder So; So.init(T, D, G, bx);
            epi::Res<(L > 0)> E{(_Float16*)X, L == 0 ? args.in[0] : (const void*)XBB, D, DN_ALPHA};
            pg8::gemm_phase<epi::Res<(L > 0)>, pg8::StaticOrder, true, true>(ldsl, g, So, E);
            SEAM_AT(1 + L * NPH + 5);
        }

        if (PH_EN(6) && IN(gp0 + 6)) { PH_IDS();
            using gattn::bf16x8; using gattn::f32x16; using gattn::u32x4; using gattn::crow; using gattn::cvtpk_s;
            const float* g1 = (const float*)args.in[17] + L * D; const float* b1 = (const float*)args.in[18] + L * D;
            const float* rb = (const float*)args.in[20] + L * NE;
            unsigned* cnt = (unsigned*)(ctl + CW_CNT + L * 2048);
            constexpr int XP = 1032;
            bf16_t* XH = (bf16_t*)lds; bf16_t* XL = XH + 32 * XP;
            float* PL = (float*)lds;
            LAS int* lcnt = (LAS int*)(ldsl + 66048 * 2); LAS int* lbase = lcnt + 64;
            const int r32 = lane & 31, hi = lane >> 5;
            bf16x8 wh[8][2], wl[8][2];
#pragma unroll
            for (int st = 0; st < 8; ++st)
#pragma unroll
                for (int nb = 0; nb < 2; ++nb) { const size_t wo = (size_t)(nb * 32 + r32) * D + wave * 128 + 16 * st + 8 * hi; wh[st][nb] = *(const bf16x8*)(WRT + wo); wl[st][nb] = *(const bf16x8*)(WRT + (size_t)NE * D + wo); }
            for (int pass = bx; pass < T / 32; pass += G) {
                const size_t row0 = (size_t)pass * 32;
                if (tid < 64) lcnt[tid] = 0;
#pragma unroll
                for (int r = 0; r < 4; ++r) { const int rl = wave * 4 + r; const size_t row = row0 + rl; f32x4 v[4];
#pragma unroll
                    for (int j = 0; j < 4; ++j) { typedef _Float16 h4 __attribute__((ext_vector_type(4))); const h4 hv = *(const h4*)((const _Float16*)X + row * D + 4 * lane + 256 * j); v[j] = (f32x4){(float)hv[0], (float)hv[1], (float)hv[2], (float)hv[3]}; }
                    ln_row(v, g1, b1, lane);
#pragma unroll
                    for (int j = 0; j < 4; ++j) {
                        const unsigned h0 = cvtpk_s(v[j].x, v[j].y), h1 = cvtpk_s(v[j].z, v[j].w);
                        *(uint2*)(XBA + row * D + 4 * lane + 256 * j) = make_uint2(h0, h1);
                        const unsigned l0 = cvtpk_s(v[j].x - bflo(h0), v[j].y - bfhi(h0)), l1 = cvtpk_s(v[j].z - bflo(h1), v[j].w - bfhi(h1));
                        *(uint2*)(XH + rl * XP + 4 * lane + 256 * j) = make_uint2(h0, h1); *(uint2*)(XL + rl * XP + 4 * lane + 256 * j) = make_uint2(l0, l1); } }
                __syncthreads();
                f32x16 acc[2]; acc[0] = f32x16{}; acc[1] = f32x16{};
                {
#pragma unroll
                  for (int st = 0; st < 8; ++st) { const int k = wave * 128 + 16 * st + 8 * hi;
                      const bf16x8 xh = *(const bf16x8*)(XH + r32 * XP + k), xl = *(const bf16x8*)(XL + r32 * XP + k);
#pragma unroll
                      for (int nb = 0; nb < 2; ++nb) { acc[nb] = __builtin_amdgcn_mfma_f32_32x32x16_bf16(xh, wh[st][nb], acc[nb], 0, 0, 0); acc[nb] = __builtin_amdgcn_mfma_f32_32x32x16_bf16(xl, wh[st][nb], acc[nb], 0, 0, 0);
                          acc[nb] = __builtin_amdgcn_mfma_f32_32x32x16_bf16(xh, wl[st][nb], acc[nb], 0, 0, 0); } } }
                __syncthreads();
#pragma unroll
                for (int nb = 0; nb < 2; ++nb)
#pragma unroll
                    for (int r = 0; r < 16; ++r) PL[(wave * 32 + crow(r, hi)) * 64 + nb * 32 + r32] = acc[nb][r];
                __syncthreads();
                const float rbl = rb[lane]; float gws[4]; int rks[4], lps[4];
                float scv[4], bi[4], m1[4], m2[4]; int cand[4]; unsigned key[4], thr[4]; bool selv[4];
#pragma unroll
                for (int r = 0; r < 4; ++r) { const int rl = wave * 4 + r; float lg = 0.f;
#pragma unroll
                    for (int w = 0; w < 8; ++w) lg += PL[(w * 32 + rl) * 64 + lane];
                    scv[r] = sigmoidf_(lg); bi[r] = scv[r] + rbl; m1[r] = bi[r]; }
#pragma unroll
                for (int r = 0; r < 4; ++r) m1[r] = fmaxf(m1[r], xor_f<1>(m1[r]));
#pragma unroll
                for (int r = 0; r < 4; ++r) m1[r] = fmaxf(m1[r], xor_f<2>(m1[r]));
#pragma unroll
                for (int r = 0; r < 4; ++r) { m1[r] = fmaxf(m1[r], xor_f<4>(m1[r])); cand[r] = (bi[r] == m1[r]) ? lane : 64; }
#pragma unroll
                for (int r = 0; r < 4; ++r) cand[r] = min(cand[r], xor_i<1>(cand[r]));
#pragma unroll
                for (int r = 0; r < 4; ++r) cand[r] = min(cand[r], xor_i<2>(cand[r]));
#pragma unroll
                for (int r = 0; r < 4; ++r) { cand[r] = min(cand[r], xor_i<4>(cand[r])); m2[r] = (lane == cand[r]) ? -3e38f : bi[r]; }
#pragma unroll
                for (int r = 0; r < 4; ++r) m2[r] = fmaxf(m2[r], xor_f<1>(m2[r]));
#pragma unroll
                for (int r = 0; r < 4; ++r) m2[r] = fmaxf(m2[r], xor_f<2>(m2[r]));
#pragma unroll
                for (int r = 0; r < 4; ++r) { m2[r] = fmaxf(m2[r], xor_f<4>(m2[r]));
                    const float gsc = m1[r] + m2[r]; const int grp = lane >> 3; int grank = 0;
#pragma unroll
                    for (int gg = 0; gg < 8; ++gg) { const float og = bcast_f(gsc, gg * 8); grank += (og > gsc || (og == gsc && gg < grp)) ? 1 : 0; }
                    const float v = grank < 4 ? bi[r] : NEGF; const unsigned ub = __float_as_uint(v);
                    key[r] = (ub & 0x80000000u) ? ~ub : (ub | 0x80000000u); thr[r] = 0u; }
                for (int bit = 31; bit >= 0; --bit) {
#pragma unroll
                    for (int r = 0; r < 4; ++r) { const unsigned cd = thr[r] | (1u << bit); thr[r] = __popcll(__builtin_amdgcn_ballot_w64(key[r] >= cd)) >= 8 ? cd : thr[r]; } }
                const unsigned long long lt = (1ull << lane) - 1ull;
#pragma unroll
                for (int r = 0; r < 4; ++r) { const unsigned long long gm = __builtin_amdgcn_ballot_w64(key[r] > thr[r]); unsigned long long em = __builtin_amdgcn_ballot_w64(key[r] == thr[r]);
                    int need = 8 - __popcll(gm); unsigned long long tm = 0ull;
                    while (need > 0 && em) { const unsigned long long lowb = em & (0ull - em); tm |= lowb; em ^= lowb; --need; }
                    const unsigned long long m = gm | tm; selv[r] = (m >> lane) & 1ull; rks[r] = selv[r] ? __popcll(m & lt) : -1; }
                float ssum[4];
#pragma unroll
                for (int r = 0; r < 4; ++r) ssum[r] = selv[r] ? scv[r] : 0.f;
#pragma unroll
                for (int r = 0; r < 4; ++r) ssum[r] += xor_f<1>(ssum[r]);
#pragma unroll
                for (int r = 0; r < 4; ++r) ssum[r] += xor_f<2>(ssum[r]);
#pragma unroll
                for (int r = 0; r < 4; ++r) ssum[r] += xor_f<4>(ssum[r]);
#pragma unroll
                for (int r = 0; r < 4; ++r) ssum[r] += xor_f<8>(ssum[r]);
#pragma unroll
                for (int r = 0; r < 4; ++r) { ssum[r] += xor_f<16>(ssum[r]); auto rr = __builtin_amdgcn_permlane32_swap(__float_as_uint(ssum[r]), __float_as_uint(ssum[r]), false, false); ssum[r] = __uint_as_float(rr[0]) + __uint_as_float(rr[1]);
                    gws[r] = scv[r] / ssum[r] * 2.5f; }
#pragma unroll
                for (int r = 0; r < 4; ++r) lps[r] = selv[r] ? __hip_atomic_fetch_add((int*)(lcnt + lane), 1, __ATOMIC_RELAXED, __HIP_MEMORY_SCOPE_WORKGROUP) : 0;
                __syncthreads();
                if (tid < 64) { const int c = lcnt[tid]; lbase[tid] = c ? (int)atomicAdd(cnt + tid * 32, (unsigned)c) : 0; }
                __syncthreads();
                { const int base = lbase[lane];
#pragma unroll
                  for (int r = 0; r < 4; ++r) if (rks[r] >= 0) { const size_t rw = row0 + wave * 4 + r; const int pos = base + lps[r];
                      TOKE[rw * 8 + rks[r]] = lane; TOKW[rw * 8 + rks[r]] = gws[r]; TOKP[rw * 8 + rks[r]] = pos; ROWTOK[lane * 16384 + pos] = (int)rw; } }
                __syncthreads();
            }
            SEAM_AT(1 + L * NPH + 6);
        }

        if (PH_EN(8) && IN(gp0 + 8)) { PH_IDS();
            __syncthreads();
            { LAS int* ntl = (LAS int*)ldsl;
              if (tid < 64) ntl[tid] = (int)((__hip_atomic_load((const unsigned*)(ctl + CW_CNT + L * 2048) + tid * 32, RLX_AGENT) + 255u) >> 8);
              __syncthreads();
              if (tid <= 64) { int s = 0; for (int e = 0; e < tid; ++e) s += ntl[e]; TAB[tid] = s; } }
            __syncthreads();
            const int nrt = 64 + TAB[64];
            pg8::Gemm g{XBA, WGU_T, 0, 0, D, 0, 0, ROWTOK}; MoeOrder So{TAB, 2, G, bx, nrt * 2, 1};
            epi::SwiGlu E{HB, 0};
            pg8::gemm_phase<epi::SwiGlu, MoeOrder, true, true, true>(ldsl, g, So, E);
            SEAM_AT(1 + L * NPH + 8);
        }

        if (PH_EN(9) && IN(gp0 + 9)) { PH_IDS();
            const int nrt = 64 + TAB[64];
            int kdn = ED; asm volatile("" : "+s"(kdn)); pg8::Gemm g{HB, WDN_T, 0, 0, kdn, 0, 0, nullptr}; MoeOrder So{TAB, 4, G, bx, nrt * 4, 0};
            epi::Down E{OUTR, (PG8_LAS unsigned char*)(ldsl + DSTG0), (PG8_LAS unsigned char*)(ldsl + DSTG1)};
            pg8::gemm_phase<epi::Down, MoeOrder, true, true>(ldsl, g, So, E);
            SEAM_AT(1 + L * NPH + 9);
        }

        if (PH_EN(10) && IN(gp0 + 10)) { PH_IDS();
            const float* g2 = (const float*)args.in[27] + L * D; const float* b2 = (const float*)args.in[28] + L * D;
#if defined(OUTR_FP8)
            for (int rowa = gw; rowa < T; rowa += 2 * NGW) {
                typedef float f32x2n __attribute__((ext_vector_type(2)));
                f32x4 v[2][4]; int ws_[2][4], wk[2][TOPK][4]; float gk[2][TOPK]; bool has[2];
#pragma unroll
                for (int u = 0; u < 2; ++u) { const int row = rowa + u * NGW; has[u] = row < T; if (!has[u]) continue;
#pragma unroll
                    for (int j = 0; j < 4; ++j) { const uint2 w = *(const uint2*)(XBA + (size_t)row * D + 4 * lane + 256 * j); v[u][j] = (f32x4){bflo(w.x), bfhi(w.x), bflo(w.y), bfhi(w.y)} * DN_ALPHA; }
                    const unsigned char* o = (const unsigned char*)OUTR + (size_t)row * D;
#pragma unroll
                    for (int j = 0; j < 4; ++j) ws_[u][j] = (int)__builtin_nontemporal_load((const unsigned*)(o + 4 * lane + 256 * j));
#pragma unroll
                    for (int k = 0; k < TOPK; ++k) { const int dest = TAB[TOKE[row * 8 + k]] * 256 + TOKP[row * 8 + k]; gk[u][k] = TOKW[row * 8 + k] * (1.f / 64.f); const unsigned char* ok = (const unsigned char*)OUTR + ((size_t)T + dest) * D;
#pragma unroll
                        for (int j = 0; j < 4; ++j) wk[u][k][j] = (int)__builtin_nontemporal_load((const unsigned*)(ok + 4 * lane + 256 * j)); } }
#pragma unroll
                for (int u = 0; u < 2; ++u) { const int row = rowa + u * NGW; if (!has[u]) continue;
#pragma unroll
                    for (int j = 0; j < 4; ++j) { const f32x2n a = __builtin_amdgcn_cvt_pk_f32_fp8(ws_[u][j], false), c = __builtin_amdgcn_cvt_pk_f32_fp8(ws_[u][j], true);
                        v[u][j].x += a.x * (1.f / 64.f); v[u][j].y += a.y * (1.f / 64.f); v[u][j].z += c.x * (1.f / 64.f); v[u][j].w += c.y * (1.f / 64.f); }
#pragma unroll
                    for (int k = 0; k < TOPK; ++k) { const float gwk = gk[u][k];
#pragma unroll
                        for (int j = 0; j < 4; ++j) { const f32x2n a = __builtin_amdgcn_cvt_pk_f32_fp8(wk[u][k][j], false), c = __builtin_amdgcn_cvt_pk_f32_fp8(wk[u][k][j], true);
                            v[u][j].x += gwk * a.x; v[u][j].y += gwk * a.y; v[u][j].z += gwk * c.x; v[u][j].w += gwk * c.y; } }
                    ln_row(v[u], g2, b2, lane);
#pragma unroll
                    for (int j = 0; j < 4; ++j)
                        *(unsigned long long*)(XBA + (size_t)row * D + 4 * lane + 256 * j) = (unsigned long long)pk2(v[u][j].x, v[u][j].y) | ((unsigned long long)pk2(v[u][j].z, v[u][j].w) << 32); }
            }
#else
            for (int row = gw; row < T; row += NGW) {
                f32x4 v[4];
#pragma unroll
                for (int j = 0; j < 4; ++j) { const uint2 w = *(const uint2*)(XBA + (size_t)row * D + 4 * lane + 256 * j); v[j] = (f32x4){bflo(w.x), bfhi(w.x), bflo(w.y), bfhi(w.y)} * DN_ALPHA; }
#if defined(OUTR_FP8)
                {   typedef float f32x2n __attribute__((ext_vector_type(2)));
                    const unsigned char* o = (const unsigned char*)OUTR + (size_t)row * D;
#pragma unroll
                    for (int j = 0; j < 4; ++j) { const int w = (int)__builtin_nontemporal_load((const unsigned*)(o + 4 * lane + 256 * j)); const f32x2n a = __builtin_amdgcn_cvt_pk_f32_fp8(w, false), c = __builtin_amdgcn_cvt_pk_f32_fp8(w, true);
                        v[j].x += a.x * (1.f / 64.f); v[j].y += a.y * (1.f / 64.f); v[j].z += c.x * (1.f / 64.f); v[j].w += c.y * (1.f / 64.f); }
                    for (int k = 0; k < TOPK; ++k) { const int dest = TAB[TOKE[row * 8 + k]] * 256 + TOKP[row * 8 + k]; const float gwk = TOKW[row * 8 + k] * (1.f / 64.f); const unsigned char* ok = (const unsigned char*)OUTR + ((size_t)T + dest) * D;
#pragma unroll
                        for (int j = 0; j < 4; ++j) { const int w = (int)__builtin_nontemporal_load((const unsigned*)(ok + 4 * lane + 256 * j)); const f32x2n a = __builtin_amdgcn_cvt_pk_f32_fp8(w, false), c = __builtin_amdgcn_cvt_pk_f32_fp8(w, true);
                            v[j].x += gwk * a.x; v[j].y += gwk * a.y; v[j].z += gwk * c.x; v[j].w += gwk * c.y; } } }
#else
                {
                    const bf16_t* o = OUTR + (size_t)row * D;
#pragma unroll
                    for (int j = 0; j < 4; ++j) { typedef unsigned u32x2n __attribute__((ext_vector_type(2))); const u32x2n w = __builtin_nontemporal_load((const u32x2n*)(o + 4 * lane + 256 * j)); v[j].x += bflo(w.x); v[j].y += bfhi(w.x); v[j].z += bflo(w.y); v[j].w += bfhi(w.y); }
                }
                for (int k = 0; k < TOPK; ++k) { const int dest = TAB[TOKE[row * 8 + k]] * 256 + TOKP[row * 8 + k]; const float gwk = TOKW[row * 8 + k]; const bf16_t* o = OUTR + ((size_t)T + dest) * D;
#pragma unroll
                    for (int j = 0; j < 4; ++j) { typedef unsigned u32x2n __attribute__((ext_vector_type(2))); const u32x2n w = __builtin_nontemporal_load((const u32x2n*)(o + 4 * lane + 256 * j)); v[j].x += gwk * bflo(w.x); v[j].y += gwk * bfhi(w.x); v[j].z += gwk * bflo(w.y); v[j].w += gwk * bfhi(w.y); } }
#endif
                ln_row(v, g2, b2, lane);
#pragma unroll
                for (int j = 0; j < 4; ++j) {
                    *(unsigned long long*)(XBA + (size_t)row * D + 4 * lane + 256 * j) = (unsigned long long)pk2(v[j].x, v[j].y) | ((unsigned long long)pk2(v[j].z, v[j].w) << 32); }
            }
#endif
            SEAM_AT(1 + L * NPH + 10);
        }

        if (PH_EN(12) && IN(gp0 + 12)) { PH_IDS();
            pg8::Gemm g{XBA, WPG_T, T, D, D, 0, 0, nullptr}; pg8::StaticOrder So; So.init(T, D, G, bx);
            epi::Ple<(L == DEPTH - 1)> E{XBA, PP, args.out, XBB};
            pg8::gemm_phase<epi::Ple<(L == DEPTH - 1)>, pg8::StaticOrder, true, true>(ldsl, g, So, E);
#if defined(TIME_P1)
            SEAM_AT(1 + L * NPH + 12);
#else
            if (L != DEPTH - 1) SEAM_AT(1 + L * NPH + 12);
#endif
        }
    };
    layer_body(std::integral_constant<int, 0>{}); layer_body(std::integral_constant<int, 1>{}); layer_body(std::integral_constant<int, 2>{}); layer_body(std::integral_constant<int, 3>{});
#if defined(TIME_P1)
    {   PH_IDS();
        xcd_barrier(bar);
        const unsigned long long* ts = (const unsigned long long*)(ctl + CW_TS);
        int dig[2];
        for (int q = 0; q < 2; ++q) { const int p = q ? TIME_P2 : TIME_P1; unsigned long long tot = 0;
            for (int L2 = 0; L2 < DEPTH; ++L2) { if (TIME_LSEL >= 0 && L2 != (q ? TIME_LSEL2 : TIME_LSEL)) continue; const int k = 1 + L2 * NPH + p; const unsigned long long te = __hip_atomic_load(ts + k, RLX_AGENT); if (te == 0ull) continue;
                unsigned long long tb = 0ull; for (int k2 = k - 1; k2 >= 0 && tb == 0ull; --k2) tb = __hip_atomic_load(ts + k2, RLX_AGENT);
                tot += te - tb; }
            const float us = (float)tot * 0.01f * TIME_MUL; int d = (int)floorf(log2f(fmaxf(us, 1.f))) - 3; dig[q] = d < 0 ? 0 : d > 9 ? 9 : d; }
        const float sc = 1.f + sqrtf(0.01f * (float)(10 * (dig[0] + 1) + dig[1]));
        for (int i = gtid; i < T * D; i += NGT) args.out[i] *= sc; }
#endif
#if defined(CHECK_KIND)
    {   PH_IDS(); SEAM();
        const float num = __hip_atomic_load((float*)(ctl + CW_CHK), RLX_AGENT), den = __hip_atomic_load((float*)(ctl + CW_CHK + 1), RLX_AGENT);
        const float sc = 1.f + 100.f * sqrtf(num / fmaxf(den, 1e-30f));
        for (int i = gtid; i < T * D; i += NGT) args.out[i] *= sc; }
#endif
#undef SEAM
#undef IN
}

extern "C" void kernel_launch(void* const* d_in, const int* in_sizes, int n_in, void* d_out, int out_size, void* d_ws, size_t ws_size, hipStream_t stream) {
    static int grid = 0;
    if (grid == 0) {
        if (n_in != 31 || out_size != T * D || ws_size < WS_END) { fprintf(stderr, "kernel_launch: unexpected problem (n_in %d, out %d, ws %zu < %zu)\n", n_in, out_size, ws_size, (size_t)WS_END); grid = -1; return; }
        int dev = 0, cus = 0, per_cu = 0;
        if (hipGetDevice(&dev) != hipSuccess || hipDeviceGetAttribute(&cus, hipDeviceAttributeMultiprocessorCount, dev) != hipSuccess) { grid = -1; return; }
        if (hipFuncSetAttribute((const void*)mk_fwd, hipFuncAttributeMaxDynamicSharedMemorySize, LDS_BYTES) != hipSuccess) { fprintf(stderr, "kernel_launch: hipFuncSetAttribute failed\n"); grid = -1; return; }
        if (hipOccupancyMaxActiveBlocksPerMultiprocessor(&per_cu, (const void*)mk_fwd, NTHR, LDS_BYTES) != hipSuccess || per_cu < 1) fprintf(stderr, "kernel_launch: occupancy query says %d\n", per_cu);
        (void)hipGetLastError();
        grid = cus;
    }
    if (grid < 0) return;
    (void)hipMemsetAsync((char*)d_ws + WS_CTL, 0, CTL_ZERO_BYTES, stream);
    Args a{};
    for (int i = 0; i < 31; ++i) a.in[i] = d_in[i];
    a.out = (float*)d_out; a.ws = (unsigned char*)d_ws;
#if MK_MULTI
    const int nph = 1 + DEPTH * NPH;
    for (int p = 0; p < nph; ++p) { a.ph_lo = p; a.ph_hi = p + 1; hipLaunchKernelGGL(mk_fwd, dim3(grid), dim3(NTHR), LDS_BYTES, stream, a); }
#else
    a.ph_lo = 0; a.ph_hi = 1 + DEPTH * NPH;
    hipLaunchKernelGGL(mk_fwd, dim3(grid), dim3(NTHR), LDS_BYTES, stream, a);
#endif
}
```

```cpp
#define MK_MULTI 0
#define OUTR_FP8 1
#define DOWN_LDS 1
#define QKV_LDS 1
#include <hip/hip_runtime.h>
#include <cstdio>
#include <cstdint>
namespace pg8 {
#define PG8_LAS __attribute__((address_space(3)))
typedef unsigned short bf16_t;
typedef short bf16x8 __attribute__((ext_vector_type(8)));
typedef float f32x4 __attribute__((ext_vector_type(4)));
typedef unsigned u32x4 __attribute__((ext_vector_type(4)));
constexpr int BM = 256, BK = 64, HALF = 128, HTB = HALF * BK * 2  , STAGE_BYTES = 8 * HTB, NXCD = 8, WGM = 8;

__host__ __device__ __forceinline__ int lds_byte(int r, int c) { const int st = (r >> 4) * 2 + (c >> 5), rr = r & 15, cc = c & 31, ob = rr * 64 + cc * 2; return st * 1024 + (ob ^ (((ob >> 9) & 1) << 5)); }
__host__ __device__ __forceinline__ void stage_rc(int b, int& R, int& C) { const int st = b / 1024, sb = b % 1024, swz = sb ^ (((sb >> 9) & 1) << 5); R = (st >> 1) * 16 + swz / 64; C = (st & 1) * 32 + (swz % 64) / 2; }
__host__ __device__ __forceinline__ int perm32(int rho) { const int n = rho >> 4, i = rho & 15; return 8 * (i >> 2) + 4 * n + (i & 3); }

struct Unit { int pm, pn; long aofs; };
struct Gemm { const bf16_t* A; const bf16_t* Bt; int M, N, K; int lda, kstepA; const int* gidx; };

struct StaticOrder {
    int nM, nN, nwg, G, c;
    __host__ __device__ void init(int M, int N, int G_, int c_) { nM = M / BM; nN = N / BM; nwg = nM * nN; G = G_; c = c_; }
    __host__ __device__ bool next(int i, Unit& u) const {
        const long L = (long)i * G + c; if (L >= nwg) return false;
        int wgid = (int)L; { const int q = nwg / NXCD, r = nwg % NXCD, xcd = wgid % NXCD, off = wgid / NXCD; wgid = (xcd < r ? xcd * (q + 1) : r * (q + 1) + (xcd - r) * q) + off; }
        const int nig = WGM * nN, gid = wgid / nig, fm = gid * WGM, gsz = (nM - fm) < WGM ? (nM - fm) : WGM;
        u.pm = fm + ((wgid % nig) % gsz); u.pn = (wgid % nig) / gsz; u.aofs = 0; return true;
    }
    __device__ __forceinline__ void a_ready(const Unit&) const {}
    __device__ __forceinline__ void done(const Unit&) const {}
};

__device__ __forceinline__ unsigned cvt_pk_bf16(float lo, float hi) { unsigned r; asm volatile("v_cvt_pk_bf16_f32 %0, %1, %2" : "=v"(r) : "v"(lo), "v"(hi)); return r; }
typedef float f32x2 __attribute__((ext_vector_type(2)));
__device__ __forceinline__ f32x2 gelu_pk(f32x2 v) {
    const f32x2 av = __builtin_elementwise_abs(v), d = av * 0.2316418882f + 1.0f;
    f32x2 t; t.x = __builtin_amdgcn_rcpf(d.x); t.y = __builtin_amdgcn_rcpf(d.y);
    f32x2 q = t * 0.5307027145f + (-0.7265760135f); q = q * t + 0.7107068705f; q = q * t + (-0.142248368f); q = q * t + 0.127414796f; q = q * t;
    const f32x2 s = (v * v) * (-0.72134752044f);
    f32x2 e; e.x = __builtin_amdgcn_exp2f(s.x); e.y = __builtin_amdgcn_exp2f(s.y);
    const f32x2 m = v * (q * e), r = v - m;
    f32x2 o; o.x = v.x < 0.f ? m.x : r.x; o.y = v.y < 0.f ? m.y : r.y; return o;
}

template <int ACT  > struct EpiBf16 {
    static constexpr bool PERM = true, AFTER_DRAIN = false; static_assert(ACT == 0 || ACT == 1, "EpiBf16: ACT is 0 (none) or 1 (gelu_pk)");
    bf16_t* O; int ldc; const float* bias; int split_cols; size_t split_stride; float scale0;
    __device__ __forceinline__ void operator()(const f32x4 (&acc)[2][2][4][2], const Unit& u, int wr, int wc, int fr, int fq) const {
        const int row0 = u.pm * BM + wr * 64 + fr; int colt = u.pn * BM; bf16_t* base = O;
        float sc = 1.f; if (split_cols) { const int t = colt / split_cols; base += (size_t)t * split_stride; colt -= t * split_cols; if (t == 0) sc = scale0; }
        const int col0 = colt + wc * 32 + 8 * fq, bcol0 = u.pn * BM + wc * 32 + 8 * fq;
        f32x4 bv[2][2];
#pragma unroll
        for (int bj = 0; bj < 2; ++bj)
#pragma unroll
            for (int n = 0; n < 2; ++n) bv[bj][n] = bias ? *(const f32x4*)(bias + bcol0 + bj * HALF + 4 * n) : (f32x4){0.f, 0.f, 0.f, 0.f};
#pragma unroll
        for (int ai = 0; ai < 2; ++ai)
#pragma unroll
            for (int m = 0; m < 4; ++m) { bf16_t* rowp = base + (size_t)(row0 + ai * HALF + m * 16) * ldc + col0;
#pragma unroll
                for (int bj = 0; bj < 2; ++bj) { f32x4 v0 = acc[ai][bj][m][0] + bv[bj][0], v1 = acc[ai][bj][m][1] + bv[bj][1];
                    if (ACT == 1) { f32x2 a = gelu_pk((f32x2){v0[0], v0[1]}), b = gelu_pk((f32x2){v0[2], v0[3]}), c = gelu_pk((f32x2){v1[0], v1[1]}), d = gelu_pk((f32x2){v1[2], v1[3]});
                        v0 = (f32x4){a.x, a.y, b.x, b.y}; v1 = (f32x4){c.x, c.y, d.x, d.y}; }
                    v0 = v0 * sc; v1 = v1 * sc; u32x4 w; w.x = cvt_pk_bf16(v0[0], v0[1]); w.y = cvt_pk_bf16(v0[2], v0[3]); w.z = cvt_pk_bf16(v1[0], v1[1]); w.w = cvt_pk_bf16(v1[2], v1[3]);
                    *(u32x4*)(rowp + bj * HALF) = w; } }
    }
};

struct PanelStats {
    unsigned* xbuf;
    unsigned* cnt;
    unsigned* tmo;
    int ntn; float eps;
    unsigned code;
    __device__ __forceinline__ bool run(const f32x4 (&v)[2][2][4][2], const Unit& u, int wr, int wc, int fr, int fq, PG8_LAS unsigned char* lds, int wid, int lane) const {
        typedef float f32x2v __attribute__((ext_vector_type(2)));
        PG8_LAS f32x2v* P = (PG8_LAS f32x2v*)lds;
        PG8_LAS f32x2v* S = (PG8_LAS f32x2v*)(lds + 8192);
        PG8_LAS unsigned* flag = (PG8_LAS unsigned*)(lds + 8192 + 2048);
#pragma unroll
        for (int ai = 0; ai < 2; ++ai)
#pragma unroll
            for (int m = 0; m < 4; ++m) {
                float s = 0.f;
#pragma unroll
                for (int bj = 0; bj < 2; ++bj)
#pragma unroll
                    for (int n = 0; n < 2; ++n) { const f32x4 x = v[ai][bj][m][n]; s += (x[0] + x[1]) + (x[2] + x[3]); }
                s += __shfl_xor(s, 16); s += __shfl_xor(s, 32);
                const float mw = s * (1.0f / 64.0f); float q = 0.f;
#pragma unroll
                for (int bj = 0; bj < 2; ++bj)
#pragma unroll
                    for (int n = 0; n < 2; ++n) { const f32x4 d = v[ai][bj][m][n] - mw; q += (d[0] * d[0] + d[1] * d[1]) + (d[2] * d[2] + d[3] * d[3]); }
                q += __shfl_xor(q, 16); q += __shfl_xor(q, 32);
                if (fq == 0) P[(ai * HALF + wr * 64 + m * 16 + fr) * 4 + wc] = (f32x2v){mw, q};
            }
        asm volatile("s_waitcnt lgkmcnt(0)" ::: "memory"); __builtin_amdgcn_s_barrier(); asm volatile("" ::: "memory");
#if defined(BROKEN_EXCHANGE_NO_WAIT)
#warning BROKEN CONTROL BUILD: the row-statistics exchange does not wait; results are wrong by design
        if (blockIdx.x >= 64) { const long long t0_ = clock64(); while (clock64() - t0_ < 60000) __builtin_amdgcn_s_sleep(8); }
#endif
        const int row = wid * 32 + (lane & 31);
        if (lane < 32) {
            const f32x2v a = P[row * 4 + 0], b = P[row * 4 + 1], c = P[row * 4 + 2], d = P[row * 4 + 3];
            const float mt = (a.x + b.x + c.x + d.x) * 0.25f;
            const float da = a.x - mt, db = b.x - mt, dc = c.x - mt, dd = d.x - mt;
            const float m2 = (a.y + b.y) + (c.y + d.y) + 64.0f * ((da * da + db * db) + (dc * dc + dd * dd));
            unsigned long long* slot = (unsigned long long*)xbuf + ((size_t)(u.pm * BM + row) * 4 + u.pn);
            __hip_atomic_store(slot, ((unsigned long long)__float_as_uint(m2) << 32) | __float_as_uint(mt), __ATOMIC_RELAXED, __HIP_MEMORY_SCOPE_AGENT);
        }
        asm volatile("s_waitcnt vmcnt(0)" ::: "memory");
        if (lane == 0) __hip_atomic_fetch_add(cnt + 64 * u.pm, 1u, __ATOMIC_RELAXED, __HIP_MEMORY_SCOPE_AGENT);
        if (wid == 0) {
            bool dead = false; const unsigned long long t0 = __builtin_amdgcn_s_memrealtime(); const unsigned want = 8u * (unsigned)ntn;
            for (;;) {
#if defined(BROKEN_EXCHANGE_NO_WAIT)
                break;
#endif
                if ((unsigned)__builtin_amdgcn_readfirstlane(__hip_atomic_load(cnt + 64 * u.pm, __ATOMIC_RELAXED, __HIP_MEMORY_SCOPE_AGENT)) >= want) break;
                if (__builtin_amdgcn_s_memrealtime() - t0 > 2000000ull) {
                    if (lane == 0) { unsigned expect = 0u; __hip_atomic_compare_exchange_strong(tmo + 1, &expect, code | (unsigned)(u.pm & 0xff), __ATOMIC_RELAXED, __ATOMIC_RELAXED, __HIP_MEMORY_SCOPE_AGENT);
                                     __hip_atomic_store(tmo, 1u, __ATOMIC_RELAXED, __HIP_MEMORY_SCOPE_AGENT); }
                    dead = true; break; }
                __builtin_amdgcn_s_sleep(2);
            }
            __builtin_amdgcn_fence(__ATOMIC_ACQUIRE, "agent");
            if (lane == 0) flag[0] = dead ? 1u : 0u;
        }
        asm volatile("s_waitcnt vmcnt(0) lgkmcnt(0)" ::: "memory"); __builtin_amdgcn_s_barrier(); asm volatile("" ::: "memory");
        const bool bad = flag[0] != 0u;
        if (lane < 32) {
            const unsigned long long* slot = (const unsigned long long*)xbuf + (size_t)(u.pm * BM + row) * 4; float mt[4], m2[4]; float ms = 0.f;
#pragma unroll
            for (int t = 0; t < 4; ++t) { if (t < ntn) { const unsigned long long w = __hip_atomic_load(slot + t, __ATOMIC_RELAXED, __HIP_MEMORY_SCOPE_AGENT); mt[t] = __uint_as_float((unsigned)w); m2[t] = __uint_as_float((unsigned)(w >> 32)); } else { mt[t] = 0.f; m2[t] = 0.f; } ms += mt[t]; }
            const float mean = ms / (float)ntn; float q = 0.f;
#pragma unroll
            for (int t = 0; t < 4; ++t) if (t < ntn) { const float dm = mt[t] - mean; q += m2[t] + 256.0f * dm * dm; }
            S[row] = (f32x2v){mean, 1.0f / sqrtf(q / (256.0f * (float)ntn) + eps)};
        }
        asm volatile("s_waitcnt lgkmcnt(0)" ::: "memory"); __builtin_amdgcn_s_barrier(); asm volatile("" ::: "memory");
        return bad;
    }
};
struct EpiLnRes {
    static constexpr bool PERM = false, AFTER_DRAIN = true;
    const float* base; float* out; int ldc; const float* bias; PanelStats st; unsigned poison;
    __device__ __forceinline__ void fused(f32x4 (&acc)[2][2][4][2], const Unit& u, int wr, int wc, int fr, int fq, PG8_LAS unsigned char* lds, int wid, int lane) const {
        typedef float f32x2v __attribute__((ext_vector_type(2)));
        const PG8_LAS f32x2v* S = (const PG8_LAS f32x2v*)(lds + 8192);
        const int col0 = u.pn * BM + wc * 32 + 4 * fq;
#pragma unroll
        for (int bj = 0; bj < 2; ++bj)
#pragma unroll
            for (int n = 0; n < 2; ++n) { const f32x4 bv = bias ? *(const f32x4*)(bias + col0 + bj * HALF + n * 16) : (f32x4){0.f, 0.f, 0.f, 0.f};
#pragma unroll
                for (int ai = 0; ai < 2; ++ai)
#pragma unroll
                    for (int m = 0; m < 4; ++m) acc[ai][bj][m][n] += bv; }
        f32x4 pre[4][2][2];
#pragma unroll
        for (int m = 0; m < 4; ++m) { const size_t off = (size_t)(u.pm * BM + wr * 64 + m * 16 + fr) * ldc + col0;
#pragma unroll
            for (int bj = 0; bj < 2; ++bj)
#pragma unroll
                for (int n = 0; n < 2; ++n) pre[m][bj][n] = *(const f32x4*)(base + off + bj * HALF + n * 16); }
        const bool bad = st.run(acc, u, wr, wc, fr, fq, lds, wid, lane) || poison != 0u;
        const float qnan = __builtin_nanf("");
#pragma unroll
        for (int ai = 0; ai < 2; ++ai)
#pragma unroll
            for (int m = 0; m < 4; ++m) { const int r = ai * HALF + wr * 64 + m * 16 + fr; const f32x2v sr = S[r]; const size_t off = (size_t)(u.pm * BM + r) * ldc + col0;
#pragma unroll
                for (int bj = 0; bj < 2; ++bj)
#pragma unroll
                    for (int n = 0; n < 2; ++n) { const f32x4 bs = ai == 0 ? pre[m][bj][n] : *(const f32x4*)(base + off + bj * HALF + n * 16); f32x4 o = bs + (acc[ai][bj][m][n] - sr.x) * sr.y;
                        if (bad) o = (f32x4){qnan, qnan, qnan, qnan}; *(f32x4*)(out + off + bj * HALF + n * 16) = o; }
                if (m & 1) asm volatile("" ::: "memory"); }
    }
};
struct EpiLnResLn {
    static constexpr bool PERM = false, AFTER_DRAIN = true;
    const float* base; float* out; bf16_t* xn; int ldc; const float* bias; PanelStats st1, st2; unsigned poison;
    __device__ __forceinline__ void fused(f32x4 (&acc)[2][2][4][2], const Unit& u, int wr, int wc, int fr, int fq, PG8_LAS unsigned char* lds, int wid, int lane) const {
        typedef float f32x2v __attribute__((ext_vector_type(2))); typedef unsigned u32x2v __attribute__((ext_vector_type(2)));
        const PG8_LAS f32x2v* S = (const PG8_LAS f32x2v*)(lds + 8192);
        const int col0 = u.pn * BM + wc * 32 + 4 * fq;
#pragma unroll
        for (int bj = 0; bj < 2; ++bj)
#pragma unroll
            for (int n = 0; n < 2; ++n) { const f32x4 bv = bias ? *(const f32x4*)(bias + col0 + bj * HALF + n * 16) : (f32x4){0.f, 0.f, 0.f, 0.f};
#pragma unroll
                for (int ai = 0; ai < 2; ++ai)
#pragma unroll
                    for (int m = 0; m < 4; ++m) acc[ai][bj][m][n] += bv; }
        bool bad = st1.run(acc, u, wr, wc, fr, fq, lds, wid, lane) || poison != 0u;
        const float qnan = __builtin_nanf("");
#pragma unroll
        for (int ai = 0; ai < 2; ++ai)
#pragma unroll
            for (int m = 0; m < 4; ++m) { const int r = ai * HALF + wr * 64 + m * 16 + fr; const f32x2v sr = S[r]; const size_t off = (size_t)(u.pm * BM + r) * ldc + col0;
#pragma unroll
                for (int bj = 0; bj < 2; ++bj)
#pragma unroll
                    for (int n = 0; n < 2; ++n) { const f32x4 bs = *(const f32x4*)(base + off + bj * HALF + n * 16); acc[ai][bj][m][n] = bs + (acc[ai][bj][m][n] - sr.x) * sr.y; }
                asm volatile("" : "+v"(acc[ai][0][m][0]), "+v"(acc[ai][0][m][1]), "+v"(acc[ai][1][m][0]), "+v"(acc[ai][1][m][1]));
                if (m & 1) asm volatile("" ::: "memory"); }
        const bool bad1 = bad;
        bad = st2.run(acc, u, wr, wc, fr, fq, lds, wid, lane) || bad;
#pragma unroll
        for (int ai = 0; ai < 2; ++ai)
#pragma unroll
            for (int m = 0; m < 4; ++m) { const int r = ai * HALF + wr * 64 + m * 16 + fr; const f32x2v sr = S[r]; const size_t off = (size_t)(u.pm * BM + r) * ldc + col0;
#pragma unroll
                for (int bj = 0; bj < 2; ++bj)
#pragma unroll
                    for (int n = 0; n < 2; ++n) { const f32x4 x1 = acc[ai][bj][m][n]; *(f32x4*)(out + off + bj * HALF + n * 16) = bad1 ? (f32x4){qnan, qnan, qnan, qnan} : x1;
                        const f32x4 o = (x1 - sr.x) * sr.y; u32x2v w; w.x = cvt_pk_bf16(o[0], o[1]); w.y = cvt_pk_bf16(o[2], o[3]);
                        if (bad) { w.x = 0x7fc07fc0u; w.y = 0x7fc07fc0u; } *(u32x2v*)(xn + off + bj * HALF + n * 16) = w; }
                asm volatile("" ::: "memory"); }
    }
};

template <class Epi, class Sched, bool ALIGN_EPI = false, bool SP2 = false, bool GATHER = false>
__device__ __forceinline__ void gemm_phase(PG8_LAS unsigned char* lds, const Gemm g, const Sched& S, const Epi& E) {
    static_assert(!GATHER || SP2, "gathered A rows: SP2 loop only");
    int tid_o = threadIdx.x; asm volatile("" : "+v"(tid_o)); const int tid = tid_o, wid = __builtin_amdgcn_readfirstlane(tid >> 6), lane = tid & 63, wr = wid >> 2, wc = wid & 3, fr = lane & 15, fq = lane >> 4;
    const int K = g.K, nt = K / BK, lda = g.lda ? g.lda : K;
    unsigned voffA[2], voffB[2];
#pragma unroll
    for (int i = 0; i < 2; ++i) { int R, C; stage_rc(tid * 16 + i * 8192, R, C); const int Rb = Epi::PERM ? ((R & ~31) + perm32(R & 31)) : R;
        voffA[i] = (unsigned)(R * lda + C) * 2u; voffB[i] = (unsigned)(Rb * K + C) * 2u; }
    const size_t kstep = (size_t)(BK * 2);
    const size_t hstep = (size_t)HALF * K * 2;
    const size_t tstep = 2 * hstep;
    const size_t kstepA = g.kstepA ? (size_t)g.kstepA : kstep, hstepA = (size_t)HALF * lda * 2, tstepA = 2 * hstepA;
    const unsigned ldsw = (unsigned)wid * 1024u;
    const int aoff = lds_byte(wr * 64 + fr, fq * 8), boff = lds_byte(wc * 32 + fr, fq * 8);
#define PG8_SA(b, h) (((b) * 2 + (h)) * HTB)
#define PG8_SB(b, h) ((4 + (b) * 2 + (h)) * HTB)
#define PG8_STAGE(bufoff, gbase, voff) do { _Pragma("unroll") for (int _i = 0; _i < 2; ++_i) \
        __builtin_amdgcn_global_load_lds((const unsigned*)((const char*)(gbase) + (voff)[_i]), (PG8_LAS unsigned*)(lds + (bufoff) + ldsw + _i * 8192), 16, 0, 0); } while (0)
#define PG8_LDA(dst, b, h) do { _Pragma("unroll") for (int m = 0; m < 4; ++m) _Pragma("unroll") for (int k = 0; k < 2; ++k) dst[m][k] = *(const PG8_LAS bf16x8*)(lds + PG8_SA(b, h) + aoff + m * 2048 + k * 1024); } while (0)
#define PG8_LDB(dst, b, h) do { _Pragma("unroll") for (int n = 0; n < 2; ++n) _Pragma("unroll") for (int k = 0; k < 2; ++k) dst[n][k] = *(const PG8_LAS bf16x8*)(lds + PG8_SB(b, h) + boff + n * 2048 + k * 1024); } while (0)
#define PG8_MMA(ai, bj, At, Bt) do { __builtin_amdgcn_s_setprio(1); _Pragma("unroll") for (int m = 0; m < 4; ++m) _Pragma("unroll") for (int n = 0; n < 2; ++n) _Pragma("unroll") for (int k = 0; k < 2; ++k) \
        acc[ai][bj][m][n] = __builtin_amdgcn_mfma_f32_16x16x32_bf16(Bt[n][k], At[m][k], acc[ai][bj][m][n], 0, 0, 0); __builtin_amdgcn_s_setprio(0); } while (0)
#define PG8_WAIT_V(n) asm volatile("s_waitcnt vmcnt(" #n ")" ::: "memory")
#define PG8_WAIT_L(n) asm volatile("s_waitcnt lgkmcnt(" #n ")" ::: "memory")
#define PG8_BAR __builtin_amdgcn_s_barrier()
#define PG8_SCHED __builtin_amdgcn_sched_barrier(0)
    unsigned gcu[2][2] = {{0u, 0u}, {0u, 0u}}, gnx[2][2] = {{0u, 0u}, {0u, 0u}};
#define PG8_GOFF(dst, u) do { int t_ = tid; asm volatile("" : "+v"(t_));   \
        _Pragma("unroll") for (int _h = 0; _h < 2; ++_h) _Pragma("unroll") for (int _i = 0; _i < 2; ++_i) { int R_, C_; stage_rc(t_ * 16 + _i * 8192, R_, C_); \
        dst[_h][_i] = (unsigned)((g.gidx[(u).pm * BM + _h * HALF + R_] & 16383) * lda + C_) * 2u; } } while (0)
#define PG8_STAGE_A(bufoff, gbase, H, NEXT) do { if constexpr (GATHER) { if (NEXT) PG8_STAGE(bufoff, gbase, gnx[H]); else PG8_STAGE(bufoff, gbase, gcu[H]); } else { PG8_STAGE(bufoff, (gbase) + ((H) ? hstepA : 0), voffA); } } while (0)
    Unit cur, nxt; int ui = 0;
    if (!S.next(0, cur)) return;
    f32x4 acc[2][2][4][2];
#pragma unroll
    for (int a = 0; a < 2; ++a)
#pragma unroll
        for (int b = 0; b < 2; ++b)
#pragma unroll
            for (int m = 0; m < 4; ++m)
#pragma unroll
                for (int n = 0; n < 2; ++n) acc[a][b][m][n] = (f32x4){0.f, 0.f, 0.f, 0.f};
    bf16x8 At[4][2], B0[2][2], B1[2][2];
    if constexpr (GATHER) PG8_GOFF(gcu, cur);
    const char* cA = GATHER ? (const char*)g.A : (const char*)g.A + (size_t)cur.pm * tstepA + cur.aofs; const char* cB = (const char*)g.Bt + (size_t)cur.pn * tstep;
    S.a_ready(cur);
    if constexpr (SP2) {
        PG8_STAGE(PG8_SB(0, 0), cB, voffB); PG8_STAGE(PG8_SB(0, 1), cB + hstep, voffB); PG8_STAGE_A(PG8_SA(0, 0), cA, 0, false); PG8_STAGE_A(PG8_SA(0, 1), cA, 1, false);
        if (wr == 1) PG8_BAR;
        PG8_WAIT_V(2); PG8_BAR;
        PG8_STAGE(PG8_SB(1, 0), cB + kstep, voffB); PG8_STAGE_A(PG8_SA(1, 0), cA + kstepA, 0, false); PG8_STAGE(PG8_SB(1, 1), cB + hstep + kstep, voffB);
        PG8_WAIT_V(6); PG8_BAR;
    } else {
        PG8_STAGE(PG8_SB(0, 0), cB, voffB); PG8_STAGE(PG8_SA(0, 0), cA, voffA); PG8_STAGE(PG8_SB(0, 1), cB + hstep, voffB); PG8_STAGE(PG8_SA(0, 1), cA + hstepA, voffA);
        if (wr == 1) PG8_BAR;
        PG8_WAIT_V(4); PG8_BAR;
        PG8_STAGE(PG8_SB(1, 0), cB + kstep, voffB); PG8_STAGE(PG8_SA(1, 0), cA + kstepA, voffA); PG8_STAGE(PG8_SB(1, 1), cB + hstep + kstep, voffB);
        PG8_WAIT_V(6); PG8_BAR;
    }
    for (;;) {
        const bool has_next = S.next(ui + 1, nxt);
        const char* nA = GATHER ? cA : (has_next ? (const char*)g.A + (size_t)nxt.pm * tstepA + nxt.aofs : cA); const char* nB = has_next ? (const char*)g.Bt + (size_t)nxt.pn * tstep : cB;
        for (int t = 0; t < nt; t += 2) {
            const bool last = (t == nt - 2);
            const char* a1 = cA + (size_t)(t + 1) * kstepA;
            const char* a2 = last ? nA : cA + (size_t)(t + 2) * kstepA; const char* b2 = last ? nB : cB + (size_t)(t + 2) * kstep;
            const char* a3 = a2 + kstepA; const char* b3 = b2 + kstep;
            if (last && has_next) S.a_ready(nxt);
            if constexpr (GATHER) { if (t == (nt >= 4 ? nt - 4 : 0)) { if (has_next) PG8_GOFF(gnx, nxt); else { gnx[0][0] = gcu[0][0]; gnx[0][1] = gcu[0][1]; gnx[1][0] = gcu[1][0]; gnx[1][1] = gcu[1][1]; } } }
            if constexpr (SP2) {
            PG8_LDB(B0, 0, 0); PG8_LDB(B1, 0, 1); PG8_SCHED; PG8_LDA(At, 0, 0); PG8_STAGE_A(PG8_SA(1, 1), a1, 1, false);
            PG8_WAIT_V(8); PG8_WAIT_L(0); PG8_BAR; PG8_MMA(0, 0, At, B0); PG8_MMA(0, 1, At, B1); PG8_BAR; PG8_SCHED;
            PG8_LDA(At, 0, 1); PG8_STAGE(PG8_SB(0, 0), b2, voffB); PG8_STAGE(PG8_SB(0, 1), b2 + hstep, voffB); PG8_STAGE_A(PG8_SA(0, 0), a2, 0, last);
            PG8_WAIT_V(8); PG8_WAIT_L(0); PG8_BAR; PG8_MMA(1, 0, At, B0); PG8_MMA(1, 1, At, B1); PG8_BAR; PG8_SCHED;
            PG8_LDB(B0, 1, 0); PG8_LDB(B1, 1, 1); PG8_SCHED; PG8_LDA(At, 1, 0); PG8_STAGE_A(PG8_SA(0, 1), a2, 1, last);
            PG8_WAIT_V(8); PG8_WAIT_L(0); PG8_BAR; PG8_MMA(0, 0, At, B0); PG8_MMA(0, 1, At, B1); PG8_BAR; PG8_SCHED;
            PG8_LDA(At, 1, 1); PG8_STAGE(PG8_SB(1, 0), b3, voffB); PG8_STAGE(PG8_SB(1, 1), b3 + hstep, voffB); PG8_STAGE_A(PG8_SA(1, 0), a3, 0, last);
            PG8_WAIT_V(8); PG8_WAIT_L(0); PG8_BAR; PG8_MMA(1, 0, At, B0); PG8_MMA(1, 1, At, B1); PG8_BAR; PG8_SCHED;
            } else {
            PG8_LDB(B0, 0, 0); PG8_SCHED; PG8_LDA(At, 0, 0); PG8_STAGE(PG8_SA(1, 1), a1 + hstepA, voffA);
            PG8_WAIT_L(8); PG8_BAR; PG8_WAIT_L(0); PG8_MMA(0, 0, At, B0); PG8_BAR; PG8_SCHED;
            PG8_LDB(B1, 0, 1); PG8_STAGE(PG8_SB(0, 0), b2, voffB);
            PG8_BAR; PG8_WAIT_L(0); PG8_MMA(0, 1, At, B1); PG8_BAR;
            PG8_LDA(At, 0, 1); PG8_STAGE(PG8_SA(0, 0), a2, voffA);
            PG8_BAR; PG8_WAIT_L(0); PG8_MMA(1, 0, At, B0); PG8_BAR; PG8_SCHED;
            PG8_STAGE(PG8_SB(0, 1), b2 + hstep, voffB);
            PG8_WAIT_V(6); PG8_BAR; PG8_MMA(1, 1, At, B1); PG8_BAR;
            PG8_LDB(B0, 1, 0); PG8_SCHED; PG8_LDA(At, 1, 0); PG8_STAGE(PG8_SA(0, 1), a2 + hstepA, voffA);
            PG8_WAIT_L(8); PG8_BAR; PG8_WAIT_L(0); PG8_MMA(0, 0, At, B0); PG8_BAR; PG8_SCHED;
            PG8_LDB(B1, 1, 1); PG8_STAGE(PG8_SB(1, 0), b3, voffB);
            PG8_BAR; PG8_WAIT_L(0); PG8_MMA(0, 1, At, B1); PG8_BAR;
            PG8_LDA(At, 1, 1); PG8_STAGE(PG8_SA(1, 0), a3, voffA);
            PG8_BAR; PG8_WAIT_L(0); PG8_MMA(1, 0, At, B0); PG8_BAR; PG8_SCHED;
            PG8_STAGE(PG8_SB(1, 1), b3 + hstep, voffB);
            PG8_WAIT_V(6); PG8_BAR; PG8_MMA(1, 1, At, B1); PG8_BAR;
            }
        }
        if constexpr (ALIGN_EPI) { if (wr == 0) PG8_BAR; }
        if constexpr (!Epi::AFTER_DRAIN) { E(acc, cur, wr, wc, fr, fq); S.done(cur); }
        if (!has_next) break;
#pragma unroll
        for (int a = 0; a < 2; ++a)
#pragma unroll
            for (int b = 0; b < 2; ++b)
#pragma unroll
                for (int m = 0; m < 4; ++m)
#pragma unroll
                    for (int n = 0; n < 2; ++n) acc[a][b][m][n] = (f32x4){0.f, 0.f, 0.f, 0.f};
        cur = nxt; cA = nA; cB = nB; ++ui;
        if constexpr (GATHER) { gcu[0][0] = gnx[0][0]; gcu[0][1] = gnx[0][1]; gcu[1][0] = gnx[1][0]; gcu[1][1] = gnx[1][1]; }
        if constexpr (ALIGN_EPI) { if (wr == 1) PG8_BAR; }
    }
    PG8_WAIT_V(0);
    if constexpr (!ALIGN_EPI) { if (wr == 0) PG8_BAR; }
    PG8_BAR;
    if constexpr (Epi::AFTER_DRAIN) { E.fused(acc, cur, wr, wc, fr, fq, lds, wid, lane); S.done(cur); }
#undef PG8_SA
#undef PG8_SB
#undef PG8_STAGE
#undef PG8_STAGE_A
#undef PG8_GOFF
#undef PG8_LDA
#undef PG8_LDB
#undef PG8_MMA
#undef PG8_WAIT_V
#undef PG8_WAIT_L
#undef PG8_BAR
#undef PG8_SCHED
}
}
#include <hip/hip_bf16.h>
#include <cmath>
namespace gattn {
using bf16=__hip_bfloat16;
using bf16x8=__attribute__((ext_vector_type(8)))short;
using s16x4=__attribute__((ext_vector_type(4)))short;
using f32x16=__attribute__((ext_vector_type(16)))float;
using u32x4=__attribute__((ext_vector_type(4)))unsigned;
constexpr int BATCH=2,NHEAD=16,SEQ=8192,D=64,DM=NHEAD*D;
constexpr int NW=8,QBLK=32,QB=QBLK*NW,KVBLK=64,NQB=SEQ/QB;
constexpr int ATTN_PITCH=DM, ATTN_UNIT_ROWS=QB;
__device__ __forceinline__ int crow(int r,int hi){return (r&3)+8*(r>>2)+4*hi;}
#define SBAR() __builtin_amdgcn_sched_barrier(0)
constexpr float NEGM=-60000.f;
__device__ __forceinline__ void emask(f32x16&p0,f32x16&p1,int kb,int lo,int hi_){
  #pragma unroll
  for(int r=0;r<16;++r){const int kv=kb+(r&3)+8*(r>>2); if(kv<lo||kv>hi_)p0[r]=NEGM; if(kv+32<lo||kv+32>hi_)p1[r]=NEGM;}
}

constexpr int NSLOT=3, SLOTB=8192;
constexpr int LDS_K=0, LDS_V=NSLOT*SLOTB, LDS_WS=2*NSLOT*SLOTB, LDS_OST=LDS_WS+NW*64*4, LDS_BT=LDS_OST+NW*4096, LDS_BYTES=LDS_BT+SEQ*4;
constexpr float C2=0.125f*1.4426950408889634f;
__device__ __forceinline__ void glds16(const void*gsrc,unsigned lds_dst){unsigned keep;
  asm volatile("s_mov_b32 %0, m0\n\ts_mov_b32 m0, %2\n\ts_nop 0\n\tglobal_load_lds_dwordx4 %1, off\n\ts_mov_b32 m0, %0":"=&s"(keep):"v"(gsrc),"s"(lds_dst):"memory");}
__device__ __forceinline__ float max3f(float a,float b,float c){float r;asm("v_max3_f32 %0, %1, %2, %3":"=v"(r):"v"(a),"v"(b),"v"(c));return r;}
__device__ __forceinline__ float max2f(float a,float b){float r;asm("v_max_f32_e32 %0, %1, %2":"=v"(r):"v"(a),"v"(b));return r;}
__device__ __forceinline__ float fadd_s(float a,float b){float r;asm("v_add_f32_e32 %0, %1, %2":"=v"(r):"v"(a),"v"(b));return r;}
__device__ __forceinline__ float fsub_s(float a,float b){float r;asm("v_sub_f32_e32 %0, %1, %2":"=v"(r):"v"(a),"v"(b));return r;}
typedef float f32x2_t __attribute__((ext_vector_type(2))); typedef __bf16 bf16x2_t __attribute__((ext_vector_type(2)));
__device__ __forceinline__ unsigned cvtpk_s(float lo,float hi){f32x2_t v={lo,hi};bf16x2_t b=__builtin_convertvector(v,bf16x2_t);return __builtin_bit_cast(unsigned,b);}
#define WAIT_BAR(N) asm volatile("s_waitcnt vmcnt(" #N ") lgkmcnt(0)\n\ts_barrier":::"memory")

typedef unsigned u32x2b __attribute__((ext_vector_type(2)));
__device__ __forceinline__ s16x4 bfrag(unsigned w){ u32x2b v={w,0u}; return __builtin_bit_cast(s16x4,v); }
#define BMFMA(a,b,c) __builtin_amdgcn_mfma_f32_32x32x8bf16_1k(a,b,c,0,0,0)
__device__ __forceinline__ void qkt(f32x16&p0,f32x16&p1,const char*Kslot,const bf16x8*qr,int r32,int hi){
  const char*kb=Kslot+hi*1024+r32*16;
  #pragma unroll
  for(int d0=0;d0<4;++d0){
    const bf16x8 b0=*reinterpret_cast<const bf16x8*>(kb+d0*2048);
    const bf16x8 b1=*reinterpret_cast<const bf16x8*>(kb+d0*2048+512);
    if(d0==0){const f32x16 z={};p0=__builtin_amdgcn_mfma_f32_32x32x16_bf16(b0,qr[0],z,0,0,0);p1=__builtin_amdgcn_mfma_f32_32x32x16_bf16(b1,qr[0],z,0,0,0);}
    else{p0=__builtin_amdgcn_mfma_f32_32x32x16_bf16(b0,qr[d0],p0,0,0,0);p1=__builtin_amdgcn_mfma_f32_32x32x16_bf16(b1,qr[d0],p1,0,0,0);}}
}
typedef __attribute__((address_space(3))) const char* lds_cptr;
typedef short v4i16_t __attribute__((ext_vector_type(4)));
__device__ __forceinline__ void kload8(bf16x8*kf,lds_cptr kp){
  kf[0]=*(const __attribute__((address_space(3))) bf16x8*)(kp);      kf[1]=*(const __attribute__((address_space(3))) bf16x8*)(kp+512);
  kf[2]=*(const __attribute__((address_space(3))) bf16x8*)(kp+2048); kf[3]=*(const __attribute__((address_space(3))) bf16x8*)(kp+2560);
  kf[4]=*(const __attribute__((address_space(3))) bf16x8*)(kp+4096); kf[5]=*(const __attribute__((address_space(3))) bf16x8*)(kp+4608);
  kf[6]=*(const __attribute__((address_space(3))) bf16x8*)(kp+6144); kf[7]=*(const __attribute__((address_space(3))) bf16x8*)(kp+6656);
}
__device__ __forceinline__ void kload2(bf16x8*kf,lds_cptr kp,int j){ kf[2*j]=*(const __attribute__((address_space(3))) bf16x8*)(kp+j*2048); kf[2*j+1]=*(const __attribute__((address_space(3))) bf16x8*)(kp+j*2048+512); }
__device__ __forceinline__ s16x4 vtr(lds_cptr p){ return __builtin_bit_cast(s16x4,__builtin_amdgcn_ds_read_tr16_b64_v4i16((__attribute__((address_space(3))) v4i16_t*)p)); }
__device__ __forceinline__ float rowmax(const f32x16&p0,const f32x16&p1){
  float a=max3f(p0[0],p0[1],p1[0]),b=max3f(p0[2],p0[3],p1[1]);a=max3f(a,p1[2],p1[3]);
  #pragma unroll
  for(int r=4;r<16;r+=4){a=max3f(a,p0[r],p0[r+1]);b=max3f(b,p0[r+2],p0[r+3]);a=max3f(a,p1[r],p1[r+1]);b=max3f(b,p1[r+2],p1[r+3]);}
  const float m=max2f(a,b);
  auto rr=__builtin_amdgcn_permlane32_swap(__float_as_uint(m),__float_as_uint(m),false,false);
  return max2f(__uint_as_float(rr[0]),__uint_as_float(rr[1]));
}
__device__ __forceinline__ void pv(f32x16*o,int vb,bf16x8 pa0,bf16x8 pa1,bf16x8 pa2,bf16x8 pa3){
  #pragma unroll
  for(int d0=0;d0<2;++d0){s16x4 lo[4],hi[4];
    #pragma unroll
    for(int ks=0;ks<4;++ks){
      asm volatile("ds_read_b64_tr_b16 %0,%1 offset:%c2":"=&v"(lo[ks]):"v"(vb),"i"(d0*4096+ks*1024):"memory");
      asm volatile("ds_read_b64_tr_b16 %0,%1 offset:%c2":"=&v"(hi[ks]):"v"(vb),"i"(d0*4096+ks*1024+512):"memory");}
    asm volatile("s_waitcnt lgkmcnt(0)":::"memory");SBAR();
    #define PK(k) (bf16x8){lo[k][0],lo[k][1],lo[k][2],lo[k][3],hi[k][0],hi[k][1],hi[k][2],hi[k][3]}
    o[d0]=__builtin_amdgcn_mfma_f32_32x32x16_bf16(pa0,PK(0),o[d0],0,0,0);
    o[d0]=__builtin_amdgcn_mfma_f32_32x32x16_bf16(pa1,PK(1),o[d0],0,0,0);
    o[d0]=__builtin_amdgcn_mfma_f32_32x32x16_bf16(pa2,PK(2),o[d0],0,0,0);
    o[d0]=__builtin_amdgcn_mfma_f32_32x32x16_bf16(pa3,PK(3),o[d0],0,0,0);
    #undef PK
  }
}

#ifndef ATTN_STORE16
#define ATTN_STORE16(p,v) (*(u32x4*)(p)=(v))
#endif
template<int THRL,bool HAS_BIAS,int OMODE,int ORS,class U> __device__ __forceinline__ void gunit(char*shm,const U&un){
  int tid_o=threadIdx.x; asm volatile("":"+v"(tid_o)); const int tid=tid_o,lane=tid&63,r32=lane&31,hi=lane>>5; const int wid=__builtin_amdgcn_readfirstlane(tid>>6);
  const int kpitch=un.kpitch;
  const bf16*Qw=un.qrow(wid,r32);
  const bf16*Kh=un.Kb,*Vh=un.Vb;
  const unsigned lds0=(unsigned)(uintptr_t)shm;
  float*wsf=(float*)(shm+LDS_WS)+wid*64;
  const bf16*ksrc=Kh+(long)lane*kpitch+wid*8;
  const bf16*vsrc=Vh+(long)(16*(wid&3)+(lane>>2))*kpitch+(wid>>2)*32+(lane&3)*8;
  const unsigned kdst=lds0+LDS_K+wid*1024, vdst=lds0+LDS_V+wid*1024;
  #define TABS(t) min(max(un.t0+(t),0),un.tmax)
  #define DMA_K(t,slot) glds16(ksrc+(long)TABS(t)*KVBLK*kpitch,(unsigned)__builtin_amdgcn_readfirstlane(kdst+(slot)))
  #define DMA_V(t,slot) glds16(vsrc+(long)TABS(t)*KVBLK*kpitch,(unsigned)__builtin_amdgcn_readfirstlane(vdst+(slot)))
  const int vb0=(int)(lds0+LDS_V)+((lane>>4)&1)*32+(lane&3)*8+(4*hi+((lane&15)>>2))*64;
  const char*Kbase=shm+LDS_K; bf16x8 kf[8];
  const lds_cptr shm3=(lds_cptr)shm; const lds_cptr kp0=shm3+LDS_K+hi*1024+r32*16; const lds_cptr vp0=shm3+LDS_V+((lane>>4)&1)*32+(lane&3)*8+(4*hi+((lane&15)>>2))*64;
  const int NT=un.NT;
  typedef __attribute__((address_space(3))) unsigned lds_u32;
  lds_u32* const btab=(lds_u32*)(shm3+LDS_BT);
  if(HAS_BIAS){ const float*cum=un.cum; const float cq0=cum[un.q0]; const float*cumt=cum+(long)un.t0*KVBLK; for(int k=tid;k<NT*KVBLK;k+=NW*64){ const float be=(cq0-cumt[k])*1.4426950408889634f; unsigned ub=__builtin_bit_cast(unsigned,be); const unsigned hb=(ub+0x7fffu+((ub>>16)&1u))>>16;
      const float rl=be-__builtin_bit_cast(float,hb<<16); unsigned ul=__builtin_bit_cast(unsigned,rl); const unsigned lb=(ul+0x7fffu+((ul>>16)&1u))>>16; btab[k]=hb|(lb<<16); } }
  int bto=0;
  #define BIAS_MFMA(C0,C1) do{ unsigned ln_; asm volatile("v_mbcnt_lo_u32_b32 %0, -1, 0\n\tv_mbcnt_hi_u32_b32 %0, -1, %0":"=v"(ln_)); const bool up_=ln_>=32u; \
      unsigned w0_=0u, w1_=0u; if(HAS_BIAS){ const lds_u32* bp_=btab+bto+(ln_&31u); w0_=bp_[0]; w1_=bp_[32]; } \
      const unsigned tm_=un.term(wid,(int)(ln_&31u),un.t0+(bto>>6)); \
      u32x2b a0_, a1_, q_; a0_.x=up_?0x3F803F80u:w0_; a0_.y=up_?0u:0x3F803F80u; a1_.x=up_?0x3F803F80u:w1_; a1_.y=a0_.y; q_.x=qm0|(up_?(tm_<<16):0u); q_.y=qm1; \
      C0=BMFMA(__builtin_bit_cast(s16x4,a0_),__builtin_bit_cast(s16x4,q_),C0); C1=BMFMA(__builtin_bit_cast(s16x4,a1_),__builtin_bit_cast(s16x4,q_),C1); }while(0)
  DMA_K(0,0);DMA_V(0,0);DMA_K(1,SLOTB);
  bf16x8 qr[4];
  #pragma unroll
  for(int d0=0;d0<4;++d0)qr[d0]=*reinterpret_cast<const bf16x8*>(&Qw[d0*16+hi*8]);
  float mhat=0.f,l_reg=0.f;f32x16 o[2];o[0]=f32x16{};o[1]=f32x16{};unsigned qm0=hi?0u:0x3F803F80u,qm1=0u;
  #define UPDQM() do{ const float nm_=-mhat; const unsigned u0_=__builtin_bit_cast(unsigned,nm_); const unsigned h_=(u0_+0x7fffu+((u0_>>16)&1u))>>16; const float r1_=nm_-__builtin_bit_cast(float,h_<<16); \
      const unsigned u1_=__builtin_bit_cast(unsigned,r1_); const unsigned m_=(u1_+0x7fffu+((u1_>>16)&1u))>>16; const float r2_=r1_-__builtin_bit_cast(float,m_<<16); const unsigned l_=__builtin_bit_cast(unsigned,r2_)>>16; \
      qm0=hi?l_:0x3F803F80u; qm1=hi?0u:(h_|(m_<<16)); }while(0)
  const int klo=un.klo(wid,r32),khi=un.khi(wid,r32);
  #define CMASK(P0,P1,t) do{ if((t)==0||(t)>=NT-4) emask(P0,P1,(un.t0+(t))*KVBLK+4*hi,klo,khi); }while(0)
  bool resc=false;
  #define START(P0,P1) do{ const float rm=rowmax(P0,P1); resc=false; \
    { const float dl=rm; mhat=fadd_s(mhat,dl); \
      _Pragma("unroll") for(int r=0;r<16;++r){P0[r]=fsub_s(P0[r],dl);P1[r]=fsub_s(P1[r],dl);} \
      UPDQM(); } \
    _Pragma("unroll") for(int r=0;r<16;++r)P0[r]=__builtin_amdgcn_exp2f(P0[r]); }while(0)
  #define RESC() do{ if(resc){ asm volatile("s_waitcnt lgkmcnt(0)":::"memory"); \
      _Pragma("unroll") for(int d_=0;d_<2;++d_) _Pragma("unroll") for(int r=0;r<16;++r)o[d_][r]*=wsf[crow(r,hi)]; } }while(0)
  f32x16 pA0,pA1,pB0,pB1;
  int sl_prev=0,sl_cur=0,sl_next=SLOTB;
  #define ROT() do{sl_prev=sl_cur;sl_cur=sl_next;sl_next=(sl_next==(NSLOT-1)*SLOTB)?0:sl_next+SLOTB;bto+=KVBLK;}while(0)
  DMA_K(2,2*SLOTB);
  WAIT_BAR(3);
  qkt(pA0,pA1,Kbase,qr,r32,hi);BIAS_MFMA(pA0,pA1);asm volatile("s_nop 15\n\ts_nop 7":"+v"(pA0),"+v"(pA1));CMASK(pA0,pA1,0);
  START(pA0,pA1);
  _Pragma("unroll") for(int r=0;r<16;++r)pA1[r]=__builtin_amdgcn_exp2f(pA1[r]);
  WAIT_BAR(0);
  DMA_K(3,0);DMA_V(1,SLOTB);
  ROT();
  kload8(kf,kp0+sl_cur);
  WAIT_BAR(2);
  s16x4 vlo[8],vhi[8]; u32x4 pw0,pw1,pw2,pw3;
  #define PKW(P,B) cvtpk_s(P[B],P[B+1])
  #define PAF(k) __builtin_bit_cast(bf16x8,pw##k)
  #define VFR(i) (bf16x8){vlo[i][0],vlo[i][1],vlo[i][2],vlo[i][3],vhi[i][0],vhi[i][1],vhi[i][2],vhi[i][3]}
  #define PIN(x) asm volatile("":"+v"(x))
  #define MX3(a,b,c) __builtin_fmaxf(__builtin_fmaxf((a),(b)),(c))
  #define GAPA(MF,A0,A1,A2,A3,W0,W1,PW) do{ MF; sacc+=A0; sacc+=A1; sacc+=A2; sacc+=A3; PIN(sacc); W0; W1; PIN(PW); SBAR(); }while(0)
  #define EX(v) __builtin_amdgcn_exp2f(v)
  #define GAPB(MF,X,B) do{ MF; X[B]=EX(X[B]); X[B+1]=EX(X[B+1]); X[B+2]=EX(X[B+2]); X[B+3]=EX(X[B+3]); PIN(X); SBAR(); }while(0)
  #define VRD(i) do{ vlo[i]=vtr(vp_+(((i)>>2)*4096+((i)&3)*1024)); vhi[i]=vtr(vp_+(((i)>>2)*4096+((i)&3)*1024+512)); }while(0)
  #define KRD(G,j) do{ if(G){ kload2(kf,kp0+sl_next,j); SBAR(); } }while(0)
  #define STEP(C0,C1,P0,P1,t,GK,GV,GL) do{ SBAR(); \
    const lds_cptr vp_=vp0+sl_prev; \
    VRD(0); SBAR(); float sacc=(P0[0]+P0[1]); \
    GAPA(C0=__builtin_amdgcn_mfma_f32_32x32x16_bf16(kf[0],qr[0],(f32x16){},0,0,0), P0[2],P0[3],P0[4],P0[5],     pw0[0]=PKW(P0,0), pw0[1]=PKW(P0,2), pw0); \
    VRD(4); SBAR(); GAPA(C1=__builtin_amdgcn_mfma_f32_32x32x16_bf16(kf[1],qr[0],(f32x16){},0,0,0), P0[6],P0[7],P0[8],P0[9],     pw0[2]=PKW(P0,4), pw0[3]=PKW(P0,6), pw0); \
    VRD(1); SBAR(); GAPA(C0=__builtin_amdgcn_mfma_f32_32x32x16_bf16(kf[2],qr[1],C0,0,0,0),   P0[10],P0[11],P0[12],P0[13], pw1[0]=PKW(P0,8), pw1[1]=PKW(P0,10), pw1); \
    VRD(5); SBAR(); GAPA(C1=__builtin_amdgcn_mfma_f32_32x32x16_bf16(kf[3],qr[1],C1,0,0,0),   P0[14],P0[15],P1[0],P1[1],   pw1[2]=PKW(P0,12),pw1[3]=PKW(P0,14), pw1); \
    VRD(2); SBAR(); GAPA(C0=__builtin_amdgcn_mfma_f32_32x32x16_bf16(kf[4],qr[2],C0,0,0,0),   P1[2],P1[3],P1[4],P1[5],     pw2[0]=PKW(P1,0), pw2[1]=PKW(P1,2), pw2); \
    VRD(6); SBAR(); GAPA(C1=__builtin_amdgcn_mfma_f32_32x32x16_bf16(kf[5],qr[2],C1,0,0,0),   P1[6],P1[7],P1[8],P1[9],     pw2[2]=PKW(P1,4), pw2[3]=PKW(P1,6), pw2); \
    VRD(3); SBAR(); GAPA(C0=__builtin_amdgcn_mfma_f32_32x32x16_bf16(kf[6],qr[3],C0,0,0,0),   P1[10],P1[11],P1[12],P1[13], pw3[0]=PKW(P1,8), pw3[1]=PKW(P1,10), pw3); \
    VRD(7); SBAR(); GAPA(C1=__builtin_amdgcn_mfma_f32_32x32x16_bf16(kf[7],qr[3],C1,0,0,0),   P1[14],P1[15],0.f,0.f,       pw3[2]=PKW(P1,12),pw3[3]=PKW(P1,14), pw3); \
    BIAS_MFMA(C0,C1); \
    l_reg+=sacc; \
    if(GK){DMA_K((t)+3,sl_cur);} if(GV){DMA_V((t)+1,sl_next);} \
    CMASK(C0,C1,t); \
    { float a=MX3(C0[0],C0[1],C1[0]),b=MX3(C0[2],C0[3],C1[1]); a=MX3(a,C1[2],C1[3]); \
      _Pragma("unroll") for(int r=4;r<16;r+=4){a=MX3(a,C0[r],C0[r+1]);b=MX3(b,C0[r+2],C0[r+3]);a=MX3(a,C1[r],C1[r+1]);b=MX3(b,C1[r+2],C1[r+3]);} \
      float rm=__builtin_fmaxf(a,b); { auto rr=__builtin_amdgcn_permlane32_swap(__float_as_uint(rm),__float_as_uint(rm),false,false); rm=__builtin_fmaxf(__uint_as_float(rr[0]),__uint_as_float(rr[1])); } \
      resc=false; \
      if(__builtin_expect(__any(rm>(float)THRL),0)){ const float dl=__builtin_fmaxf(rm,0.f); mhat+=dl; \
        _Pragma("unroll") for(int r=0;r<16;++r){C0[r]-=dl;C1[r]-=dl;} \
        UPDQM(); \
        const float f=__builtin_amdgcn_exp2f(-dl); l_reg*=f; if(hi==0)wsf[r32]=f; resc=true; } } \
    SBAR(); \
    GAPB(o[0]=__builtin_amdgcn_mfma_f32_32x32x16_bf16(PAF(0),VFR(0),o[0],0,0,0), C0,0); \
    GAPB(o[1]=__builtin_amdgcn_mfma_f32_32x32x16_bf16(PAF(0),VFR(4),o[1],0,0,0), C0,4); \
    KRD(GL,0); GAPB(o[0]=__builtin_amdgcn_mfma_f32_32x32x16_bf16(PAF(1),VFR(1),o[0],0,0,0), C0,8); \
    KRD(GL,1); GAPB(o[1]=__builtin_amdgcn_mfma_f32_32x32x16_bf16(PAF(1),VFR(5),o[1],0,0,0), C0,12); \
    KRD(GL,2); GAPB(o[0]=__builtin_amdgcn_mfma_f32_32x32x16_bf16(PAF(2),VFR(2),o[0],0,0,0), C1,0); \
    KRD(GL,3); GAPB(o[1]=__builtin_amdgcn_mfma_f32_32x32x16_bf16(PAF(2),VFR(6),o[1],0,0,0), C1,4); \
    GAPB(o[0]=__builtin_amdgcn_mfma_f32_32x32x16_bf16(PAF(3),VFR(3),o[0],0,0,0), C1,8); \
    GAPB(o[1]=__builtin_amdgcn_mfma_f32_32x32x16_bf16(PAF(3),VFR(7),o[1],0,0,0), C1,12); \
    }while(0)
  int t=1;
  #undef CMASK
  #define CMASK(P0,P1,t) do{}while(0)
  for(;t+5<NT;t+=2){
    STEP(pB0,pB1,pA0,pA1,t,true,true,true);     WAIT_BAR(2); RESC(); ROT();
    STEP(pA0,pA1,pB0,pB1,t+1,true,true,true);   WAIT_BAR(2); RESC(); ROT();
  }
  #undef CMASK
  #define CMASK(P0,P1,t) do{ if((t)>=NT-4) emask(P0,P1,(un.t0+(t))*KVBLK+4*hi,klo,khi); }while(0)
  #define ENDW(tt) do{ if((tt)+3<NT){WAIT_BAR(2);} else if((tt)+2<NT){WAIT_BAR(1);} else {WAIT_BAR(0);} }while(0)
  for(;t+1<NT;t+=2){
    STEP(pB0,pB1,pA0,pA1,t,(t+3<NT),(t+1<NT),(t+1<NT));       ENDW(t);   RESC(); ROT();
    STEP(pA0,pA1,pB0,pB1,t+1,(t+4<NT),(t+2<NT),(t+2<NT));     ENDW(t+1); RESC(); ROT();
  }
  STEP(pB0,pB1,pA0,pA1,NT-1,false,false,false); RESC();
  { float sacc=pB0[0]+pB0[1]; _Pragma("unroll") for(int r=2;r<16;++r)sacc+=pB0[r]; _Pragma("unroll") for(int r=0;r<16;++r)sacc+=pB1[r]; l_reg+=sacc;
    pw0=(u32x4){PKW(pB0,0),PKW(pB0,2),PKW(pB0,4),PKW(pB0,6)};pw1=(u32x4){PKW(pB0,8),PKW(pB0,10),PKW(pB0,12),PKW(pB0,14)};pw2=(u32x4){PKW(pB1,0),PKW(pB1,2),PKW(pB1,4),PKW(pB1,6)};pw3=(u32x4){PKW(pB1,8),PKW(pB1,10),PKW(pB1,12),PKW(pB1,14)};
    SBAR(); pv(o,vb0+sl_cur,PAF(0),PAF(1),PAF(2),PAF(3)); }
  #undef PKW
  #undef PAF
  #undef VFR
  #undef PIN
  #undef MX3
  #undef GAPA
  #undef GAPB
  #undef EX
  #undef VRD
  #undef KRD
  #undef STEP
  #undef ENDW
  {auto rr=__builtin_amdgcn_permlane32_swap(__float_as_uint(l_reg),__float_as_uint(l_reg),false,false);l_reg=__uint_as_float(rr[0])+__uint_as_float(rr[1]);}
  if(hi==0)wsf[32+r32]=un.colscale(wid,r32)*__builtin_amdgcn_rcpf(l_reg);asm volatile("s_waitcnt lgkmcnt(0)":::"memory");
  float rli[16];
  #pragma unroll
  for(int r=0;r<16;++r)rli[r]=wsf[32+crow(r,hi)];
  bf16*Ow=un.Ob+(long)wid*un.owstride;
  { bf16*stg=(bf16*)(shm+LDS_OST)+wid*2048;
    #pragma unroll
    for(int r=0;r<16;++r){const int orow=crow(r,hi);
      #pragma unroll
      for(int d0=0;d0<2;++d0){ float v_=o[d0][r]*rli[r]; if(OMODE>=2) v_+=__bfloat162float(stg[orow*64+d0*32+r32]); stg[orow*64+d0*32+r32]=__float2bfloat16(v_);} }
    asm volatile("s_waitcnt lgkmcnt(0)":::"memory");
    if(OMODE==0||OMODE==3){
    #pragma unroll
    for(int i=0;i<4;++i){const int row=i*8+(lane>>3),ch=lane&7; const u32x4 v=*(const u32x4*)(stg+row*64+ch*8); bf16*gp=Ow+(long)(row>>ORS)*DM+(row&((1<<ORS)-1))*D+ch*8;
      ATTN_STORE16(gp,v);} } }
  asm volatile("s_waitcnt lgkmcnt(0)\n\ts_barrier":::"memory");
  #undef DMA_K
  #undef TABS
  #undef BIAS_MFMA
  #undef UPDQM
  #undef DMA_V
  #undef CMASK
  #undef START
  #undef RESC
  #undef ROT
}
constexpr int ATTN_LDS_BYTES=LDS_BYTES;
#undef SBAR
#undef WAIT_BAR
}
#define GAS __attribute__((address_space(1)))
#define LAS __attribute__((address_space(3)))
typedef unsigned short bf16;
typedef unsigned v4u __attribute__((ext_vector_type(4)));
typedef float f32x4 __attribute__((ext_vector_type(4)));
typedef short bf16x8 __attribute__((ext_vector_type(8)));
typedef GAS unsigned gu32;
typedef GAS unsigned long long gu64;
#define RLX_AGENT __ATOMIC_RELAXED, __HIP_MEMORY_SCOPE_AGENT
#define LDS_WAIT() asm volatile("s_waitcnt lgkmcnt(0)" ::: "memory")
#define VM_WAIT() asm volatile("s_waitcnt vmcnt(0)" ::: "memory")
__device__ __forceinline__ unsigned long long rt() { return __builtin_amdgcn_s_memrealtime(); }
__device__ __forceinline__ unsigned f2bf(float f) { unsigned u = __builtin_bit_cast(unsigned, f); return (u + 0x7fffu + ((u >> 16) & 1u)) >> 16; }
__device__ __forceinline__ unsigned pk2(float lo, float hi) { return f2bf(lo) | (f2bf(hi) << 16); }

#define XB_TMO      128
#define XB_XCNT(j)  (256  + 64 * (j))
#define XB_XSUB(j)  (1280 + 64 * (j))
#define XB_XGEN(j)  (2304 + 64 * (j))
#define XB_TOP      3328
#define XB_TOPGEN   3392
#define XCD_BAR_WORDS 3456
#define XB_SPIN_CAP (1u << 25)

__device__ __forceinline__ unsigned xb_ld(unsigned* p)              { return __hip_atomic_load(p, __ATOMIC_RELAXED, __HIP_MEMORY_SCOPE_AGENT); }
__device__ __forceinline__ unsigned xb_add(unsigned* p, unsigned v) { return __hip_atomic_fetch_add(p, v, __ATOMIC_RELAXED, __HIP_MEMORY_SCOPE_AGENT); }
__device__ __forceinline__ unsigned xb_xcc_id() { return (unsigned)__builtin_amdgcn_s_getreg((3 << 11) | 20) & 0xFu; }
#define XB_SPIN(cond, bar) do { unsigned _sp = 0; while (cond) { __builtin_amdgcn_s_sleep(1); \
    if ((++_sp & 255u) == 0u) { if (xb_ld(&(bar)[XB_TMO])) break; if (_sp > XB_SPIN_CAP) { atomicAdd(&(bar)[XB_TMO], 1u); break; } } } } while (0)

struct XcdBarrier {
    unsigned* bar; unsigned x;
    volatile LAS unsigned* st;
};

__device__ __forceinline__ XcdBarrier xcd_barrier_post(unsigned* bar, volatile LAS unsigned* st) {
    XcdBarrier b; b.bar = bar; b.x = xb_xcc_id(); b.st = st;
    if (threadIdx.x == 0) (void)xb_add(&bar[XB_XCNT(b.x)], 1u);
    return b;
}
__device__ __forceinline__ void xcd_barrier_complete(unsigned* bar, unsigned x, unsigned& nloc, unsigned& nx) {
    const unsigned G = gridDim.x * gridDim.y * gridDim.z;
    unsigned sum, cnt, mine, sp = 0u;
    for (;;) {
        sum = 0u; cnt = 0u; mine = 0u;
#pragma unroll
        for (unsigned j = 0; j < 16; ++j) { const unsigned c = xb_ld(&bar[XB_XCNT(j)]); sum += c; cnt += (c > 0u) ? 1u : 0u; mine = (j == x) ? c : mine; }
        if (sum == G) break;
        __builtin_amdgcn_s_sleep(1);
        if ((++sp & 255u) == 0u) { if (xb_ld(&bar[XB_TMO])) break; if (sp > XB_SPIN_CAP) { atomicAdd(&bar[XB_TMO], 1u); break; } }
    }
    nloc = mine > 0u ? mine : 1u; nx = cnt > 0u ? cnt : 1u;
}

__device__ __forceinline__ void xcd_barrier(const XcdBarrier& b) {
    asm volatile("s_waitcnt vmcnt(0)" ::: "memory");
    __syncthreads();
    if (threadIdx.x == 0) {
        unsigned* bar = b.bar;
        __builtin_amdgcn_s_waitcnt(0);
        unsigned nloc = b.st[0], nx = b.st[1];
        if (nloc == 0u) { xcd_barrier_complete(bar, b.x, nloc, nx); b.st[0] = nloc; b.st[1] = nx; }
        const unsigned old = xb_add(&bar[XB_XSUB(b.x)], 1u);
        const unsigned gen = old / nloc;
        if (old + 1u == (gen + 1u) * nloc) {
            __builtin_amdgcn_fence(__ATOMIC_RELEASE, "agent");
            asm volatile("s_waitcnt vmcnt(0)" ::: "memory");
            const unsigned og = xb_add(&bar[XB_TOP], 1u);
            const unsigned tg = og / nx;
            if (og + 1u == (tg + 1u) * nx) xb_add(&bar[XB_TOPGEN], 1u);
            else XB_SPIN(xb_ld(&bar[XB_TOPGEN]) == tg, bar);
            __builtin_amdgcn_fence(__ATOMIC_ACQUIRE, "agent");
            xb_add(&bar[XB_XGEN(b.x)], 1u);
            asm volatile("s_waitcnt vmcnt(0)" ::: "memory");
        } else {
            XB_SPIN(xb_ld(&bar[XB_XGEN(b.x)]) == gen, bar);
            __builtin_amdgcn_fence(__ATOMIC_ACQUIRE, "agent");
            asm volatile("s_waitcnt vmcnt(0)" ::: "memory");
        }
    }
    __syncthreads();
}
#include <type_traits>
#ifndef PH_MASK
#define PH_MASK 0xFFFF
#endif
#define PH_EN(n) ((PH_MASK >> (n)) & 1)
#ifndef TIME_LSEL
#define TIME_LSEL -1
#endif
#ifndef TIME_LSEL2
#define TIME_LSEL2 TIME_LSEL
#endif
#ifndef TIME_MUL
#define TIME_MUL 1.f
#endif
#ifndef MK_MULTI
#define MK_MULTI 0
#endif
constexpr int NWAVES = 8, NTHR = 512;
constexpr int Bn = 2, S = 8192, T = Bn * S, D = 1024, NH = 16, HD = 64, DEPTH = 4;
constexpr int NE = 64, ED = 256, TOPK = 8, PLE = 256;
constexpr int NSA_G = 4, NCMP = 512;
constexpr float LN_EPS = 1e-5f, NEGF = -1e30f;
constexpr float DN_ALPHA = 1.681792830507429f;
constexpr float ATT_SCALE = 0.125f, QSC = 0.6931471805599453f;
constexpr int NPH = 13;

constexpr size_t MiB = 1u << 20;
constexpr size_t WS_CTL = 0, CTL_ZERO_BYTES = 1 * MiB;
constexpr size_t WS_ROPE_C = 2 * MiB, WS_ROPE_S = 4 * MiB;
constexpr size_t WS_LOGF = 6 * MiB, WS_CUM = 7 * MiB;
constexpr size_t WS_GATES = 8 * MiB;
constexpr size_t WS_KMEAN = 11 * MiB;
constexpr size_t WS_KCMP = 12 * MiB, WS_VCMP = 13 * MiB;
constexpr size_t WS_VCT = 13 * MiB + 512 * 1024;
constexpr size_t WS_PEB = 11 * MiB + 512 * 1024;
constexpr size_t WS_WRT = 11 * MiB + 768 * 1024;
constexpr size_t WS_H1 = 20 * MiB;
constexpr size_t WS_WC1 = 278 * MiB;
constexpr size_t WS_ROWTOK = 24 * MiB;
constexpr size_t WS_LS32 = 18 * MiB + 512 * 1024;
constexpr size_t WS_SELMG = 18 * MiB;
constexpr size_t WS_TOKE = 14 * MiB, WS_TOKW = 15 * MiB, WS_TOKP = 16 * MiB;
constexpr size_t WS_ROWW = 17 * MiB;
constexpr size_t WS_X = 32 * MiB;
constexpr size_t WS_XBA = 96 * MiB, WS_XBB = 128 * MiB;
constexpr size_t WS_WIN = 160 * MiB, WS_WOUT = 166 * MiB, WS_WGU = 168 * MiB, WS_WDN = 233 * MiB, WS_WPG = 266 * MiB, WS_WPP = 268 * MiB;
constexpr size_t WS_PB = 270 * MiB;
constexpr size_t WS_Q = 280 * MiB, WS_K = 312 * MiB, WS_V = 344 * MiB;
constexpr size_t WS_AO = 376 * MiB;
constexpr size_t WS_PP = 408 * MiB;
constexpr size_t WS_QR = 504 * MiB;
constexpr size_t WS_H = 280 * MiB;
constexpr size_t WS_XG = 440 * MiB;
constexpr size_t WS_OUTR = 440 * MiB;
constexpr size_t WS_SET1 = 600 * MiB;
constexpr size_t WS_PEB1 = 11 * MiB + 512 * 1024 + 4096, WS_WRT1 = 11 * MiB + 256 * 1024;
constexpr size_t WS_END = 880 * MiB;
constexpr int R_PAD_TILES = 576, XG_TILE0 = (int)((WS_XG - WS_XBA) / (256 * 1024 * 2));
static_assert((WS_XG - WS_XBA) % (256 * 1024 * 2) == 0, "XG tile alignment");
constexpr int CW_TMO = 0, CW_CODE = 1, CW_BAR = 4096, CW_CNT = 16384  , CW_CHK = 9216, CW_TS = 10240, CW_NRM = 12288, CW_Q = 12800;

constexpr int RING_BYTES = 131072, TAB_OFF = RING_BYTES, MISC_OFF = RING_BYTES + 9216, LDS_BYTES = 163840, DSTG0 = RING_BYTES + 512, DSTG1 = 147456, QSTG = 147456  ;

typedef unsigned short bf16_t;
__device__ __forceinline__ float bf2f(unsigned short h) { return __uint_as_float(((unsigned)h) << 16); }
__device__ __forceinline__ float bflo(unsigned u) { return __uint_as_float(u << 16); }
__device__ __forceinline__ float bfhi(unsigned u) { return __uint_as_float(u & 0xffff0000u); }
template <int O> __device__ __forceinline__ float xor_f(float v) { return __int_as_float(__builtin_amdgcn_ds_swizzle(__float_as_int(v), 0x1F | (O << 10))); }
template <int O> __device__ __forceinline__ int xor_i(int v) { return __builtin_amdgcn_ds_swizzle(v, 0x1F | (O << 10)); }
__device__ __forceinline__ float bcast_f(float v, int srclane) { return __int_as_float(__builtin_amdgcn_readlane(__float_as_int(v), srclane)); }
__device__ __forceinline__ float wave_sum(float v) {
    v += xor_f<1>(v); v += xor_f<2>(v); v += xor_f<4>(v); v += xor_f<8>(v); v += xor_f<16>(v);
    auto rr = __builtin_amdgcn_permlane32_swap(__float_as_uint(v), __float_as_uint(v), false, false); return __uint_as_float(rr[0]) + __uint_as_float(rr[1]);
}
__device__ __forceinline__ float wave_max(float v) {
    v = fmaxf(v, xor_f<1>(v)); v = fmaxf(v, xor_f<2>(v)); v = fmaxf(v, xor_f<4>(v)); v = fmaxf(v, xor_f<8>(v)); v = fmaxf(v, xor_f<16>(v));
    auto rr = __builtin_amdgcn_permlane32_swap(__float_as_uint(v), __float_as_uint(v), false, false); return fmaxf(__uint_as_float(rr[0]), __uint_as_float(rr[1]));
}
#define WAVE_SYNC() do { asm volatile("s_waitcnt lgkmcnt(0)" ::: "memory"); __builtin_amdgcn_wave_barrier(); } while (0)

namespace epi {
using pg8::f32x4; using pg8::u32x4; using pg8::Unit; using pg8::cvt_pk_bf16; using pg8::HALF; using pg8::BM;
struct Qkv {
    static constexpr bool PERM = true, AFTER_DRAIN = false;
    bf16_t* O0; int ncq, ld0; bf16_t* O1; int w1, ld1; size_t stride1; float scale0; PG8_LAS unsigned char* stg;
    __device__ __forceinline__ void operator()(const f32x4 (&acc)[2][2][4][2], const Unit& u, int wr, int wc, int fr, int fq) const {
        const int row0 = u.pm * BM + wr * 64 + fr; int colt = u.pn * BM; bf16_t* base; int ldc; float sc = 1.f;
        if (colt < ncq) { base = O0; ldc = ld0; sc = scale0; } else { colt -= ncq; const int j = colt / w1; colt -= j * w1; base = O1 + (size_t)j * stride1; ldc = ld1; }
        const int col0 = colt + wc * 32 + 8 * fq;
#if defined(QKV_LDS)
        { const int lane_ = fr + 16 * fq; PG8_LAS unsigned char* sb = stg + wr * 8192;
#pragma unroll
        for (int ai = 0; ai < 2; ++ai)
#pragma unroll
            for (int m = 0; m < 4; ++m) {
#pragma unroll
                for (int bj = 0; bj < 2; ++bj) { const f32x4 v0 = acc[ai][bj][m][0] * sc, v1 = acc[ai][bj][m][1] * sc;
                    u32x4 w; w.x = cvt_pk_bf16(v0[0], v0[1]); w.y = cvt_pk_bf16(v0[2], v0[3]); w.z = cvt_pk_bf16(v1[0], v1[1]); w.w = cvt_pk_bf16(v1[2], v1[3]);
                    *(PG8_LAS u32x4*)(sb + fr * 512 + ((bj * 256 + wc * 64 + fq * 16) ^ (fr << 4))) = w; }
                asm volatile("s_waitcnt lgkmcnt(0)" ::: "memory"); __builtin_amdgcn_s_barrier(); asm volatile("" ::: "memory");
#pragma unroll
                for (int i = 0; i < 2; ++i) { const int rr = 4 * wc + 2 * i + (lane_ >> 5), cc = lane_ & 31;
                    const u32x4 rowv = *(const PG8_LAS u32x4*)(sb + rr * 512 + ((cc * 16) ^ (rr << 4)));
                    *(u32x4*)(base + (size_t)(u.pm * BM + ai * HALF + wr * 64 + m * 16 + rr) * ldc + colt + cc * 8) = rowv; }
                asm volatile("s_waitcnt lgkmcnt(0)" ::: "memory"); __builtin_amdgcn_s_barrier(); asm volatile("" ::: "memory"); }
          (void)row0; (void)col0; return; }
#endif
#pragma unroll
        for (int ai = 0; ai < 2; ++ai)
#pragma unroll
            for (int m = 0; m < 4; ++m) { bf16_t* rowp = base + (size_t)(row0 + ai * HALF + m * 16) * ldc + col0;
#pragma unroll
                for (int bj = 0; bj < 2; ++bj) { const f32x4 v0 = acc[ai][bj][m][0] * sc, v1 = acc[ai][bj][m][1] * sc;
                    u32x4 w; w.x = cvt_pk_bf16(v0[0], v0[1]); w.y = cvt_pk_bf16(v0[2], v0[3]); w.z = cvt_pk_bf16(v1[0], v1[1]); w.w = cvt_pk_bf16(v1[2], v1[3]);
                    *(u32x4*)(rowp + bj * HALF) = w; } }
    }
};
template <bool BF> struct Res {
    static constexpr bool PERM = true, AFTER_DRAIN = false;
    _Float16* X; const void* base; int ldc; float alpha;
    __device__ __forceinline__ void operator()(const f32x4 (&acc)[2][2][4][2], const Unit& u, int wr, int wc, int fr, int fq) const {
        typedef _Float16 h8 __attribute__((ext_vector_type(8)));
        const int row0 = u.pm * BM + wr * 64 + fr, col0 = u.pn * BM + wc * 32 + 8 * fq;
#pragma unroll
        for (int ai = 0; ai < 2; ++ai)
#pragma unroll
            for (int m = 0; m < 4; ++m) { const size_t ro = (size_t)(row0 + ai * HALF + m * 16) * ldc + col0;
#pragma unroll
                for (int bj = 0; bj < 2; ++bj) { const size_t off = ro + bj * HALF; f32x4 x0, x1;
                    if (BF) { const u32x4 w = *(const u32x4*)((const bf16_t*)base + off); x0 = (f32x4){bflo(w.x), bfhi(w.x), bflo(w.y), bfhi(w.y)}; x1 = (f32x4){bflo(w.z), bfhi(w.z), bflo(w.w), bfhi(w.w)}; }
                    else { x0 = *(const f32x4*)((const float*)base + off); x1 = *(const f32x4*)((const float*)base + off + 4); }
                    const f32x4 o0 = x0 * alpha + acc[ai][bj][m][0], o1 = x1 * alpha + acc[ai][bj][m][1];
                    *(h8*)(X + off) = (h8){(_Float16)o0[0], (_Float16)o0[1], (_Float16)o0[2], (_Float16)o0[3], (_Float16)o1[0], (_Float16)o1[1], (_Float16)o1[2], (_Float16)o1[3]}; } }
    }
};
struct SwiGlu {
    static constexpr bool PERM = true, AFTER_DRAIN = false;
    bf16_t* Hh; int xg0;
    __device__ __forceinline__ void operator()(const f32x4 (&acc)[2][2][4][2], const Unit& u, int wr, int wc, int fr, int fq) const {
        const int ht = (int)u.aofs; const int row0 = ht * BM + wr * 64 + fr; const int col0 = (u.pn & 1) * 128 + wc * 32 + 8 * fq;
#pragma unroll
        for (int ai = 0; ai < 2; ++ai)
#pragma unroll
            for (int m = 0; m < 4; ++m) { bf16_t* rowp = Hh + (size_t)(row0 + ai * HALF + m * 16) * ED + col0;
                float h[8];
#pragma unroll
                for (int n = 0; n < 2; ++n)
#pragma unroll
                    for (int j = 0; j < 4; ++j) { const float g = acc[ai][0][m][n][j], up = acc[ai][1][m][n][j];
                        const float sg = g * __builtin_amdgcn_rcpf(1.f + __builtin_amdgcn_exp2f(-g * 1.4426950408889634f)); h[n * 4 + j] = sg * up; }
                u32x4 w; w.x = cvt_pk_bf16(h[0], h[1]); w.y = cvt_pk_bf16(h[2], h[3]); w.z = cvt_pk_bf16(h[4], h[5]); w.w = cvt_pk_bf16(h[6], h[7]);
                *(u32x4*)rowp = w; }
    }
};
struct Down {
    static constexpr bool PERM = true, AFTER_DRAIN = false;
    bf16_t* O; PG8_LAS unsigned char* stg0; PG8_LAS unsigned char* stg1;
    __device__ __forceinline__ void operator()(const f32x4 (&acc)[2][2][4][2], const Unit& u, int wr, int wc, int fr, int fq) const {
        const int row0 = u.pm * BM + wr * 64 + fr; const int col0 = (u.pn & 3) * BM + wc * 32 + 8 * fq;
#if defined(OUTR_FP8) && defined(DOWN_LDS)
        typedef unsigned u32x2 __attribute__((ext_vector_type(2)));
        const int lane_ = fr + 16 * fq, rr = 4 * wc + (lane_ >> 4), cc = lane_ & 15;
#pragma unroll
        for (int ai = 0; ai < 2; ++ai)
#pragma unroll
            for (int m = 0; m < 4; ++m) { PG8_LAS unsigned char* sb = (((ai * 4 + m) & 1) ? stg1 : stg0) + wr * 4352;
#pragma unroll
                for (int bj = 0; bj < 2; ++bj) { f32x4 v0 = acc[ai][bj][m][0] * 64.f, v1 = acc[ai][bj][m][1] * 64.f;
#pragma unroll
                    for (int e = 0; e < 4; ++e) { v0[e] = fminf(fmaxf(v0[e], -440.f), 440.f); v1[e] = fminf(fmaxf(v1[e], -440.f), 440.f); }
                    u32x2 w; int t0 = __builtin_amdgcn_cvt_pk_fp8_f32(v0[0], v0[1], 0, false); t0 = __builtin_amdgcn_cvt_pk_fp8_f32(v0[2], v0[3], t0, true);
                    int t1 = __builtin_amdgcn_cvt_pk_fp8_f32(v1[0], v1[1], 0, false); t1 = __builtin_amdgcn_cvt_pk_fp8_f32(v1[2], v1[3], t1, true); w.x = (unsigned)t0; w.y = (unsigned)t1;
                    *(PG8_LAS u32x2*)(sb + fr * 272 + bj * HALF + wc * 32 + 8 * fq) = w; }
                asm volatile("s_waitcnt lgkmcnt(0)" ::: "memory"); __builtin_amdgcn_s_barrier(); asm volatile("" ::: "memory");
                const u32x4 rowv = *(const PG8_LAS u32x4*)(sb + rr * 272 + cc * 16);
                *(u32x4*)((unsigned char*)O + (size_t)(u.pm * BM + ai * HALF + wr * 64 + m * 16 + rr) * D + (u.pn & 3) * BM + cc * 16) = rowv; }
        (void)row0; (void)col0;
        return;
#endif
#pragma unroll
        for (int ai = 0; ai < 2; ++ai)
#pragma unroll
            for (int m = 0; m < 4; ++m) { const int row = row0 + ai * HALF + m * 16; const float sc = 1.f;
#if defined(OUTR_FP8)
                typedef unsigned u32x2 __attribute__((ext_vector_type(2)));
                unsigned char* rowp = (unsigned char*)O + (size_t)row * D + col0;
#pragma unroll
                for (int bj = 0; bj < 2; ++bj) { f32x4 v0 = acc[ai][bj][m][0] * (64.f * sc), v1 = acc[ai][bj][m][1] * (64.f * sc);
#pragma unroll
                    for (int e = 0; e < 4; ++e) { v0[e] = fminf(fmaxf(v0[e], -440.f), 440.f); v1[e] = fminf(fmaxf(v1[e], -440.f), 440.f); }
                    u32x2 w; int t0 = __builtin_amdgcn_cvt_pk_fp8_f32(v0[0], v0[1], 0, false); t0 = __builtin_amdgcn_cvt_pk_fp8_f32(v0[2], v0[3], t0, true);
                    int t1 = __builtin_amdgcn_cvt_pk_fp8_f32(v1[0], v1[1], 0, false); t1 = __builtin_amdgcn_cvt_pk_fp8_f32(v1[2], v1[3], t1, true); w.x = (unsigned)t0; w.y = (unsigned)t1;
                    *(u32x2*)(rowp + bj * HALF) = w; } }
#else
                bf16_t* rowp = O + (size_t)row * D + col0;
#pragma unroll
                for (int bj = 0; bj < 2; ++bj) { const f32x4 v0 = acc[ai][bj][m][0] * sc, v1 = acc[ai][bj][m][1] * sc;
                    u32x4 w; w.x = cvt_pk_bf16(v0[0], v0[1]); w.y = cvt_pk_bf16(v0[2], v0[3]); w.z = cvt_pk_bf16(v1[0], v1[1]); w.w = cvt_pk_bf16(v1[2], v1[3]);
                    *(u32x4*)(rowp + bj * HALF) = w; } }
#endif
    }
};
struct StoreBf16 {
    static constexpr bool PERM = true, AFTER_DRAIN = false;
    bf16_t* O; int ldc;
    __device__ __forceinline__ void operator()(const f32x4 (&acc)[2][2][4][2], const Unit& u, int wr, int wc, int fr, int fq) const {
        const int row0 = u.pm * BM + wr * 64 + fr; const int col0 = u.pn * BM + wc * 32 + 8 * fq;
#pragma unroll
        for (int ai = 0; ai < 2; ++ai)
#pragma unroll
            for (int m = 0; m < 4; ++m) { bf16_t* rowp = O + (size_t)(row0 + ai * HALF + m * 16) * ldc + col0;
#pragma unroll
                for (int bj = 0; bj < 2; ++bj) { const f32x4 v0 = acc[ai][bj][m][0], v1 = acc[ai][bj][m][1];
                    u32x4 w; w.x = cvt_pk_bf16(v0[0], v0[1]); w.y = cvt_pk_bf16(v0[2], v0[3]); w.z = cvt_pk_bf16(v1[0], v1[1]); w.w = cvt_pk_bf16(v1[2], v1[3]);
                    *(u32x4*)(rowp + bj * HALF) = w; } }
    }
};
template <bool LAST> struct Ple {
    static constexpr bool PERM = true, AFTER_DRAIN = false;
    const bf16_t* XB; const bf16_t* PP; float* OutF; bf16_t* XBn;
    __device__ __forceinline__ void operator()(const f32x4 (&acc)[2][2][4][2], const Unit& u, int wr, int wc, int fr, int fq) const {
        const int row0 = u.pm * BM + wr * 64 + fr, col0 = u.pn * BM + wc * 32 + 8 * fq;
#pragma unroll
        for (int ai = 0; ai < 2; ++ai)
#pragma unroll
            for (int m = 0; m < 4; ++m) { const size_t ro = (size_t)(row0 + ai * HALF + m * 16) * D + col0;
#pragma unroll
                for (int bj = 0; bj < 2; ++bj) { const size_t off = ro + bj * HALF; const u32x4 xw = *(const u32x4*)(XB + off), pw = *(const u32x4*)(PP + off); f32x4 o[2];
#pragma unroll
                    for (int n = 0; n < 2; ++n) { const unsigned xa = n ? xw.z : xw.x, xb = n ? xw.w : xw.y, pa = n ? pw.z : pw.x, pb = n ? pw.w : pw.y; const f32x4 a = acc[ai][bj][m][n];
                        o[n][0] = bflo(xa) + bflo(pa) * __builtin_amdgcn_rcpf(1.f + __builtin_amdgcn_exp2f(-a[0] * 1.4426950408889634f));
                        o[n][1] = bfhi(xa) + bfhi(pa) * __builtin_amdgcn_rcpf(1.f + __builtin_amdgcn_exp2f(-a[1] * 1.4426950408889634f));
                        o[n][2] = bflo(xb) + bflo(pb) * __builtin_amdgcn_rcpf(1.f + __builtin_amdgcn_exp2f(-a[2] * 1.4426950408889634f));
                        o[n][3] = bfhi(xb) + bfhi(pb) * __builtin_amdgcn_rcpf(1.f + __builtin_amdgcn_exp2f(-a[3] * 1.4426950408889634f)); }
                    if (LAST) { *(f32x4*)(OutF + off) = o[0]; *(f32x4*)(OutF + off + 4) = o[1]; }
                    else { u32x4 w; w.x = cvt_pk_bf16(o[0][0], o[0][1]); w.y = cvt_pk_bf16(o[0][2], o[0][3]); w.z = cvt_pk_bf16(o[1][0], o[1][1]); w.w = cvt_pk_bf16(o[1][2], o[1][3]); *(u32x4*)(XBn + off) = w; } } }
    }
};
}

struct MoeOrder {
    const LAS int* tstart;
    int NC, G, c, NU, lists;
    __device__ __forceinline__ bool next(int i, pg8::Unit& u) const {
        const int x = c & 7, npx = G >> 3; int li = i * npx + (c >> 3); int e, j, cc, rt;
        if (li < 8 * NC) { e = 64; j = x + 8 * (li / NC); cc = li % NC; rt = j; }
        else { li -= 8 * NC; e = -1; j = 0; cc = 0; rt = 0;
            for (int q = 0; q < 8; ++q) { const int eq = x + 8 * q; const int t0 = tstart[eq], n = (tstart[eq + 1] - t0) * NC;
                if (e < 0) { if (li < n) { e = eq; j = li / NC; cc = li % NC; rt = 64 + t0 + j; } else li -= n; } }
            if (e < 0) return false; }
        u.pm = lists ? e * 64 + j : rt; u.pn = e * NC + cc; u.aofs = lists ? rt : 0; return true; }
    __device__ __forceinline__ void a_ready(const pg8::Unit&) const {}
    __device__ __forceinline__ void done(const pg8::Unit&) const {}
};

struct CmpOrder {
    int G, c;
    __device__ __forceinline__ bool next(int i, pg8::Unit& u) const { const long L = (long)i * G + c; if (L >= 32) return false;
        const int kv = (int)L >> 4, bg = ((int)L >> 1) & 7, half = (int)L & 1, b = bg >> 2, g = bg & 3;
        u.pm = 0; u.pn = kv; u.aofs = (long)kv * (8 << 20) + (long)b * (4 << 20) + g * 128 + (long)half * (2 << 20); return true; }
    __device__ __forceinline__ void a_ready(const pg8::Unit&) const {}
    __device__ __forceinline__ void done(const pg8::Unit&) const {}
};
namespace epi {
struct H1Store {
    static constexpr bool PERM = false, AFTER_DRAIN = false;
    float* H;
    __device__ __forceinline__ void operator()(const f32x4 (&acc)[2][2][4][2], const Unit& u, int wr, int wc, int fr, int fq) const {
        const long a = u.aofs; const int kv = (int)(a >> 23), b = (int)(a >> 22) & 1, half = (int)(a >> 21) & 1, g = (int)(a >> 7) & 3;
        const size_t rowb = ((size_t)(kv * 8 + b * 4 + g) * 512 + half * 256 + wr * 64 + fr);
#pragma unroll
        for (int ai = 0; ai < 2; ++ai)
#pragma unroll
            for (int m = 0; m < 4; ++m) { float* rowp = H + (rowb + ai * HALF + m * 16) * 128 + wc * 32 + 4 * fq;
#pragma unroll
                for (int n = 0; n < 2; ++n) *(f32x4*)(rowp + n * 16) = acc[ai][0][m][n]; }
    }
};
}
__device__ __forceinline__ void transpose_item(const float* W, int ldw, int k0, int n0, bf16* WT, int K, int drow0, LAS float* scr, int lane) {
#pragma unroll 8
    for (int i = 0; i < 32; ++i) { const int kk = 2 * i + (lane >> 5); scr[kk * 33 + (lane & 31)] = W[(size_t)(k0 + kk) * ldw + n0 + (lane & 31)]; }
    LDS_WAIT(); asm volatile("" ::: "memory");
    const int c = lane & 7;
#pragma unroll
    for (int j = 0; j < 4; ++j) { const int n = (lane >> 3) + 8 * j; const LAS float* s = scr + (8 * c) * 33 + n;
        v4u o; o.x = pk2(s[0 * 33], s[1 * 33]); o.y = pk2(s[2 * 33], s[3 * 33]); o.z = pk2(s[4 * 33], s[5 * 33]); o.w = pk2(s[6 * 33], s[7 * 33]);
        *(GAS v4u*)(WT + (size_t)(drow0 + n) * K + k0 + 8 * c) = o; }
    LDS_WAIT(); asm volatile("" ::: "memory");
}

__device__ __forceinline__ void transpose_item64(const float* W, int ldw, int k0, int n0, bf16* WT, int K, int drow0, int lane) {
    const int n4 = lane & 15, kg = lane >> 4; const float* src = W + (size_t)(k0 + 16 * kg) * ldw + n0 + 4 * n4;
    f32x4 v[16];
#pragma unroll
    for (int i = 0; i < 16; ++i) v[i] = __builtin_nontemporal_load((const GAS f32x4*)(src + (size_t)i * ldw));
    bf16* dst = WT + (size_t)(drow0 + 4 * n4) * K + k0 + 16 * kg;
#pragma unroll
    for (int j = 0; j < 4; ++j) { v4u a, b;
        a.x = pk2(v[0][j], v[1][j]); a.y = pk2(v[2][j], v[3][j]); a.z = pk2(v[4][j], v[5][j]); a.w = pk2(v[6][j], v[7][j]);
        b.x = pk2(v[8][j], v[9][j]); b.y = pk2(v[10][j], v[11][j]); b.z = pk2(v[12][j], v[13][j]); b.w = pk2(v[14][j], v[15][j]);
        *(GAS v4u*)(dst + (size_t)j * K) = a; *(GAS v4u*)(dst + (size_t)j * K + 8) = b; }
}

__device__ __forceinline__ void titem_load(f32x4 (&v)[16], const float* W, int ldw, int lane) {
    const int n4 = lane & 15, kg = lane >> 4; const float* src = W + (size_t)(8 * kg) * ldw + 4 * n4;
#pragma unroll
    for (int i = 0; i < 16; ++i) v[i] = __builtin_nontemporal_load((const GAS f32x4*)(src + (size_t)((i & 7) + 32 * (i >> 3)) * ldw));
}
__device__ __forceinline__ void titem_store(const f32x4 (&v)[16], bf16* WT, int K, int lane) {
    const int n4 = lane & 15, kg = lane >> 4; bf16* dst = WT + (size_t)(4 * n4) * K + 8 * kg;
#pragma unroll
    for (int j = 0; j < 4; ++j) { v4u a, b;
        a.x = gattn::cvtpk_s(v[0][j], v[1][j]); a.y = gattn::cvtpk_s(v[2][j], v[3][j]); a.z = gattn::cvtpk_s(v[4][j], v[5][j]); a.w = gattn::cvtpk_s(v[6][j], v[7][j]);
        b.x = gattn::cvtpk_s(v[8][j], v[9][j]); b.y = gattn::cvtpk_s(v[10][j], v[11][j]); b.z = gattn::cvtpk_s(v[12][j], v[13][j]); b.w = gattn::cvtpk_s(v[14][j], v[15][j]);
        *(GAS v4u*)(dst + (size_t)j * K) = a; *(GAS v4u*)(dst + (size_t)j * K + 32) = b; }
}

__device__ __forceinline__ void nitem_load(f32x4 (&v)[8], const float* W, int ldw, int lane) {
    const int n8 = lane & 7, ko = lane >> 3; const float* src = W + (size_t)(8 * ko) * ldw + 4 * n8;
#pragma unroll
    for (int i = 0; i < 8; ++i) v[i] = __builtin_nontemporal_load((const GAS f32x4*)(src + (size_t)i * ldw));
}
__device__ __forceinline__ void nitem_store(const f32x4 (&v)[8], bf16* WT, int K, int lane) {
    const int n8 = lane & 7, ko = lane >> 3; bf16* dst = WT + (size_t)(4 * n8) * K + 8 * ko;
#pragma unroll
    for (int j = 0; j < 4; ++j) { v4u a;
        a.x = gattn::cvtpk_s(v[0][j], v[1][j]); a.y = gattn::cvtpk_s(v[2][j], v[3][j]); a.z = gattn::cvtpk_s(v[4][j], v[5][j]); a.w = gattn::cvtpk_s(v[6][j], v[7][j]);
        *(GAS v4u*)(dst + (size_t)j * K) = a; }
}

template <int NHq, class KeyFn, class BiasFn>
__device__ __forceinline__ void attend_chunk(const float* qs, float* pb, int* kb, const bf16_t* Kp, const bf16_t* Vp, int pitch, int nslots,
                                             KeyFn keyfn, BiasFn biasfn, float scale, float (&m)[NHq], float (&l)[NHq], float (&o)[NHq], int lane) {
    float cm[NHq];
#pragma unroll
    for (int h = 0; h < NHq; ++h) cm[h] = NEGF;
    for (int i = 0; i < 8; ++i) {
        const int slot = lane + 64 * i;
        const int key = (slot < nslots) ? keyfn(slot) : -1;
        float s[NHq];
#pragma unroll
        for (int h = 0; h < NHq; ++h) s[h] = NEGF;
        if (key >= 0) {
            const uint4* kr = (const uint4*)(Kp + (size_t)key * pitch);
#pragma unroll
            for (int h = 0; h < NHq; ++h) s[h] = 0.f;
#pragma unroll
            for (int c = 0; c < 8; ++c) {
                const uint4 kv = kr[c];
                const float k0 = bflo(kv.x), k1 = bfhi(kv.x), k2 = bflo(kv.y), k3 = bfhi(kv.y), k4 = bflo(kv.z), k5 = bfhi(kv.z), k6 = bflo(kv.w), k7 = bfhi(kv.w);
#pragma unroll
                for (int h = 0; h < NHq; ++h) { const float4 qa = *(const float4*)(qs + h * 64 + 8 * c), qb = *(const float4*)(qs + h * 64 + 8 * c + 4);
                    s[h] += qa.x * k0 + qa.y * k1 + qa.z * k2 + qa.w * k3 + qb.x * k4 + qb.y * k5 + qb.z * k6 + qb.w * k7; }
            }
            const float bs = biasfn(slot);
#pragma unroll
            for (int h = 0; h < NHq; ++h) { s[h] = s[h] * scale + bs; cm[h] = fmaxf(cm[h], s[h]); }
        }
#pragma unroll
        for (int h = 0; h < NHq; ++h) pb[h * 512 + slot] = s[h];
        kb[slot] = key;
    }
    float f[NHq], mn[NHq], ls[NHq];
#pragma unroll
    for (int h = 0; h < NHq; ++h) { mn[h] = fmaxf(m[h], wave_max(cm[h])); f[h] = __expf(m[h] - mn[h]); ls[h] = 0.f; }
    WAVE_SYNC();
    for (int i = 0; i < 8; ++i) {
        const int slot = lane + 64 * i; const bool ok = kb[slot] >= 0;
#pragma unroll
        for (int h = 0; h < NHq; ++h) { const float p = ok ? __expf(pb[h * 512 + slot] - mn[h]) : 0.f; pb[h * 512 + slot] = p; ls[h] += p; }
    }
#pragma unroll
    for (int h = 0; h < NHq; ++h) { l[h] = l[h] * f[h] + wave_sum(ls[h]); o[h] *= f[h]; m[h] = mn[h]; }
    WAVE_SYNC();
    const int ns8 = (nslots + 7) & ~7;
    for (int sl = 0; sl < ns8; sl += 8) {
#pragma unroll
        for (int u = 0; u < 8; ++u) { const int key = kb[sl + u]; const int kk = key < 0 ? 0 : key; const float v = bf2f(Vp[(size_t)kk * pitch + lane]);
#pragma unroll
            for (int h = 0; h < NHq; ++h) o[h] += pb[h * 512 + sl + u] * v; }
    }
    WAVE_SYNC();
}

typedef gattn::bf16 abf16;
struct FoxU {
    const abf16 *Kb, *Vb; int kpitch, t0, NT, tmax; const float* cum; int q0; abf16* Ob; long owstride; const abf16* Qb; const LAS unsigned* mtab;
    __device__ __forceinline__ const abf16* qrow(int wid, int r32) const { return Qb + (long)(wid * 32 + r32) * D; }
    __device__ __forceinline__ int klo(int, int) const { return -2147483647; }
    __device__ __forceinline__ int khi(int wid, int r32) const { return q0 + wid * 32 + r32; }
    __device__ __forceinline__ float colscale(int, int) const { return 1.f; }
    __device__ __forceinline__ unsigned term(int wid, int r32, int tabs) const { return mtab ? (((mtab[wid * 32 + r32] >> (tabs >> 2)) & 1u) ? 0u : 0xC700u) : 0u; }
};
__device__ __forceinline__ void fox_order(int vcu, int i, int& bh, int& qb) { const int s = vcu & 7; bh = vcu >> 3; qb = (i == 0) ? s : (i == 1) ? 15 - s : (i == 2) ? 16 + s : 31 - s; }

struct NsaU {
    const abf16 *Kb, *Vb; int kpitch, t0, NT, tmax; const float* cum; int q0; abf16* Ob; long owstride; const abf16* Qb; const LAS unsigned* selm; const float* gates; int br; int wlen;
    __device__ __forceinline__ const abf16* qrow(int wid, int r32) const { return Qb + (long)(wid * 8 + (r32 >> 2)) * D + (r32 & 3) * 64; }
    __device__ __forceinline__ int khi(int wid, int r32) const { return q0 + wid * 8 + (r32 >> 2); }
    __device__ __forceinline__ int klo(int wid, int r32) const { return wlen ? q0 + wid * 8 + (r32 >> 2) - (wlen - 1) : -2147483647; }
    __device__ __forceinline__ float colscale(int wid, int r32) const { return gates[(wid * 8 + (r32 >> 2)) * 48 + (r32 & 3) * 3 + br]; }
    __device__ __forceinline__ unsigned term(int wid, int r32, int tabs) const {
        if (selm) { const unsigned w = selm[(wid * 8 + (r32 >> 2)) * 4 + ((tabs >> 5) & 3)]; return (tabs < 128 && ((w >> (tabs & 31)) & 1u)) ? 0u : 0xC700u; }
        return tabs < 0 ? 0xC700u : 0u; }
};
constexpr int NSA_IMP_LD = 132;
constexpr int NSA_LDS_IMP = gattn::LDS_BT, NSA_LDS_SELM = NSA_LDS_IMP + 64 * NSA_IMP_LD * 4, NSA_LDS_PRI = NSA_LDS_SELM + 1024;
static_assert(NSA_LDS_PRI + 8 * 512 <= RING_BYTES, "NSA LDS map");
__device__ __forceinline__ int swapmid(int x) { return (x & 3) | ((x & 4) << 1) | ((x & 8) >> 1); }

__device__ __forceinline__ void nsa_cmp_select(char* shm, int b, int g, int q0, const bf16_t* QBs, const bf16_t* KCMPs, const bf16_t* VCTs, const float* GATESs, unsigned* selm_g) {
    using gattn::bf16x8; using gattn::f32x16; using gattn::u32x4; using gattn::crow; using gattn::cvtpk_s;
    int tid_o = threadIdx.x; asm volatile("" : "+v"(tid_o)); const int tid = tid_o, lane = tid & 63, r32 = lane & 31, hi = lane >> 5; const int wid = __builtin_amdgcn_readfirstlane(tid >> 6);
    const size_t rb = (size_t)b * S; const int bg = b * NSA_G + g;
    const int tl = r32 >> 2, hh = r32 & 3, tq = q0 + wid * 8 + tl;
    const int nv = tq >= 31 ? ((tq - 31) >> 4) + 1 : 0;
    const int nvmax = ((q0 + 63 - 31) >> 4) + 1, ntile = (nvmax + 63) >> 6;
    float* imp = (float*)(shm + NSA_LDS_IMP); unsigned* selm = (unsigned*)(shm + NSA_LDS_SELM); float* pri = (float*)(shm + NSA_LDS_PRI) + wid * 128;
    for (int i = lane; i < 8 * NSA_IMP_LD; i += 64) imp[wid * 8 * NSA_IMP_LD + i] = 0.f;
    const bf16_t* qp = QBs + (rb + tq) * D + (g * 4 + hh) * 64;
    bf16x8 qf[4];
#pragma unroll
    for (int d0 = 0; d0 < 4; ++d0) qf[d0] = *(const bf16x8*)(qp + d0 * 16 + hi * 8);
    const bf16_t* KC = KCMPs + (size_t)bg * NCMP * 64; const bf16_t* VC = VCTs + (size_t)bg * 8 * 64 * 64;
    bf16x8 ovf[4];
#pragma unroll
    for (int kk = 0; kk < 4; ++kk) { u32x4 w = {0u, 0u, 0u, 0u};
#pragma unroll
        for (int i = 0; i < 8; ++i) { const int nl = 16 * kk + swapmid(8 * hi + i); const unsigned one = (r32 <= 16 && nl >= 4 * r32 - 1 && nl <= 4 * r32 + 3) ? 0x3F80u : 0u; w[i >> 1] |= one << (16 * (i & 1)); }
        ovf[kk] = __builtin_bit_cast(bf16x8, w); }
#define NSA_KLD(KA, KB_, k) do { const bf16_t* kr0 = KC + (size_t)(64 * (k) + r32) * 64 + hi * 8; \
        _Pragma("unroll") for (int d0 = 0; d0 < 4; ++d0) { KA[d0] = *(const bf16x8*)(kr0 + d0 * 16); KB_[d0] = *(const bf16x8*)(kr0 + 32 * 64 + d0 * 16); } } while (0)
#define NSA_QK(P0, P1, KA, KB_) do { const f32x16 z = {}; P0 = z; P1 = z; \
        _Pragma("unroll") for (int d0 = 0; d0 < 4; ++d0) { P0 = __builtin_amdgcn_mfma_f32_32x32x16_bf16(KA[d0], qf[d0], P0, 0, 0, 0); P1 = __builtin_amdgcn_mfma_f32_32x32x16_bf16(KB_[d0], qf[d0], P1, 0, 0, 0); } } while (0)
    float m = -60000.f, l = 0.f;
    bf16x8 ka[4], kb[4], na[4], nb[4]; NSA_KLD(ka, kb, 0);
    for (int k = 0; k < ntile; ++k) { f32x16 p0, p1; NSA_KLD(na, nb, (k + 1 < ntile ? k + 1 : 0)); NSA_QK(p0, p1, ka, kb);
#pragma unroll
        for (int d0 = 0; d0 < 4; ++d0) { ka[d0] = na[d0]; kb[d0] = nb[d0]; }
        float tm = -60000.f;
#pragma unroll
        for (int r = 0; r < 16; ++r) { const int n = 64 * k + crow(r, hi); p0[r] = n < nv ? p0[r] : -60000.f; p1[r] = n + 32 < nv ? p1[r] : -60000.f; tm = fmaxf(tm, fmaxf(p0[r], p1[r])); }
        { auto rr = __builtin_amdgcn_permlane32_swap(__float_as_uint(tm), __float_as_uint(tm), false, false); tm = fmaxf(__uint_as_float(rr[0]), __uint_as_float(rr[1])); }
        const float mn = fmaxf(m, tm); float ls = 0.f;
#pragma unroll
        for (int r = 0; r < 16; ++r) { const int n = 64 * k + crow(r, hi); ls += (n < nv ? __builtin_amdgcn_exp2f(p0[r] - mn) : 0.f) + (n + 32 < nv ? __builtin_amdgcn_exp2f(p1[r] - mn) : 0.f); }
        l = l * __builtin_amdgcn_exp2f(m - mn) + ls; m = mn; }
    { auto rr = __builtin_amdgcn_permlane32_swap(__float_as_uint(l), __float_as_uint(l), false, false); l = __uint_as_float(rr[0]) + __uint_as_float(rr[1]); }
    const float il = 1.f / fmaxf(l, 1e-30f);
    NSA_KLD(ka, kb, 0);
    f32x16 o[2]; o[0] = f32x16{}; o[1] = f32x16{};
    for (int k = 0; k < ntile; ++k) { f32x16 p0, p1; NSA_KLD(na, nb, (k + 1 < ntile ? k + 1 : 0));
        bf16x8 vfr[4][2];
#pragma unroll
        for (int kk = 0; kk < 4; ++kk)
#pragma unroll
            for (int d0 = 0; d0 < 2; ++d0) vfr[kk][d0] = *(const bf16x8*)(VC + ((size_t)(k * 64 + d0 * 32 + r32)) * 64 + kk * 16 + hi * 8);
        NSA_QK(p0, p1, ka, kb);
#pragma unroll
        for (int d0 = 0; d0 < 4; ++d0) { ka[d0] = na[d0]; kb[d0] = nb[d0]; }
#pragma unroll
        for (int r = 0; r < 16; ++r) { const int n = 64 * k + crow(r, hi); p0[r] = n < nv ? __builtin_amdgcn_exp2f(p0[r] - m) * il : 0.f; p1[r] = n + 32 < nv ? __builtin_amdgcn_exp2f(p1[r] - m) * il : 0.f; }
        u32x4 pw[4];
        pw[0] = (u32x4){cvtpk_s(p0[0], p0[1]), cvtpk_s(p0[2], p0[3]), cvtpk_s(p0[4], p0[5]), cvtpk_s(p0[6], p0[7])};
        pw[1] = (u32x4){cvtpk_s(p0[8], p0[9]), cvtpk_s(p0[10], p0[11]), cvtpk_s(p0[12], p0[13]), cvtpk_s(p0[14], p0[15])};
        pw[2] = (u32x4){cvtpk_s(p1[0], p1[1]), cvtpk_s(p1[2], p1[3]), cvtpk_s(p1[4], p1[5]), cvtpk_s(p1[6], p1[7])};
        pw[3] = (u32x4){cvtpk_s(p1[8], p1[9]), cvtpk_s(p1[10], p1[11]), cvtpk_s(p1[12], p1[13]), cvtpk_s(p1[14], p1[15])};
        f32x16 u = f32x16{};
#pragma unroll
        for (int kk = 0; kk < 4; ++kk) { const bf16x8 pa = __builtin_bit_cast(bf16x8, pw[kk]);
#pragma unroll
            for (int d0 = 0; d0 < 2; ++d0) o[d0] = __builtin_amdgcn_mfma_f32_32x32x16_bf16(pa, vfr[kk][d0], o[d0], 0, 0, 0);
            u = __builtin_amdgcn_mfma_f32_32x32x16_bf16(pa, ovf[kk], u, 0, 0, 0); }
        if (r32 <= 16) {
#pragma unroll
            for (int c = 0; c < 4; ++c) { const float sgrp = (u[4 * c] + u[4 * c + 1]) + (u[4 * c + 2] + u[4 * c + 3]); float* ip = imp + (wid * 8 + 2 * c + hi) * NSA_IMP_LD + 16 * k + r32; *ip += sgrp; } }
        WAVE_SYNC(); }
#undef NSA_QK
#undef NSA_KLD
    { float* wsf = (float*)(shm + gattn::LDS_WS) + wid * 64; if (hi == 0) wsf[32 + r32] = GATESs[(rb + tq) * 48 + (g * 4 + hh) * 3 + 0]; WAVE_SYNC();
      abf16* stg = (abf16*)(shm + gattn::LDS_OST) + wid * 2048;
#pragma unroll
      for (int r = 0; r < 16; ++r) { const int orow = crow(r, hi); const float gsc = wsf[32 + orow];
#pragma unroll
          for (int d0 = 0; d0 < 2; ++d0) stg[orow * 64 + d0 * 32 + r32] = __float2bfloat16(o[d0][r] * gsc); } }
    WAVE_SYNC();
    const int cur = q0 >> 6;
    for (int t8 = 0; t8 < 8; ++t8) { const int tok = wid * 8 + t8; const float* ip = imp + tok * NSA_IMP_LD;
        const int j0 = lane, j1 = lane + 64; const float i0 = ip[j0], i1 = ip[j1];
        const bool f0 = (j0 == 0) || (j0 == cur) || (j0 == cur - 1), f1 = (j1 == 0) || (j1 == cur) || (j1 == cur - 1);
        float pr0 = f0 ? i0 + 1e4f : i0, pr1 = f1 ? i1 + 1e4f : i1; pr0 = j0 <= cur ? pr0 : NEGF; pr1 = j1 <= cur ? pr1 : NEGF;
        const unsigned ub0 = __float_as_uint(pr0), ub1 = __float_as_uint(pr1);
        const unsigned k0 = (ub0 & 0x80000000u) ? ~ub0 : (ub0 | 0x80000000u), k1 = (ub1 & 0x80000000u) ? ~ub1 : (ub1 | 0x80000000u);
        unsigned thr = 0u;
        for (int bit = 31; bit >= 0; --bit) { const unsigned cand = thr | (1u << bit);
            const int c = __popcll(__builtin_amdgcn_ballot_w64(k0 >= cand)) + __popcll(__builtin_amdgcn_ballot_w64(k1 >= cand));
            thr = c >= 16 ? cand : thr; }
        const unsigned long long g0 = __builtin_amdgcn_ballot_w64(k0 > thr), g1 = __builtin_amdgcn_ballot_w64(k1 > thr);
        const unsigned long long e0 = __builtin_amdgcn_ballot_w64(k0 == thr), e1 = __builtin_amdgcn_ballot_w64(k1 == thr);
        int need = 16 - (__popcll(g0) + __popcll(g1));
        unsigned long long t0m = 0ull, t1m = 0ull;
        { unsigned long long e = e0; while (need > 0 && e) { const unsigned long long lowb = e & (0ull - e); t0m |= lowb; e ^= lowb; --need; } }
        { unsigned long long e = e1; while (need > 0 && e) { const unsigned long long lowb = e & (0ull - e); t1m |= lowb; e ^= lowb; --need; } }
        const unsigned long long vm0 = cur >= 63 ? ~0ull : ((1ull << (cur + 1)) - 1ull), vm1 = cur >= 127 ? ~0ull : (cur >= 64 ? ((1ull << (cur - 63)) - 1ull) : 0ull);
        const unsigned long long b0 = (g0 | t0m) & vm0, b1 = (g1 | t1m) & vm1;
        if (lane == 0) { selm[tok * 4 + 0] = (unsigned)b0; selm[tok * 4 + 1] = (unsigned)(b0 >> 32); selm[tok * 4 + 2] = (unsigned)b1; selm[tok * 4 + 3] = (unsigned)(b1 >> 32);
            if (selm_g) { unsigned* sg = selm_g + ((size_t)(rb + q0 + tok) * NSA_G + g) * 4; sg[0] = (unsigned)b0; sg[1] = (unsigned)(b0 >> 32); sg[2] = (unsigned)b1; sg[3] = (unsigned)(b1 >> 32); } }
        WAVE_SYNC(); }
}

struct Args { const void* in[31]; float* out; unsigned char* ws; int ph_lo, ph_hi; };

__device__ __forceinline__ float sigmoidf_(float z) { return 1.f / (1.f + __expf(-z)); }
__device__ __forceinline__ float gelu_tanh(float x) { const float u = 0.7978845608028654f * (x + 0.044715f * x * x * x); const float e = __expf(2.f * u); return 0.5f * x * (1.f + (1.f - 2.f / (e + 1.f))); }

__device__ __forceinline__ void ln_row(f32x4 (&v)[4], const float* g, const float* b, int lane) {
    float s = 0.f;
#pragma unroll
    for (int j = 0; j < 4; ++j) s += (v[j].x + v[j].y) + (v[j].z + v[j].w);
    const float mean = wave_sum(s) * (1.f / D); float s2 = 0.f;
#pragma unroll
    for (int j = 0; j < 4; ++j) { v[j] = v[j] - mean; s2 += (v[j].x * v[j].x + v[j].y * v[j].y) + (v[j].z * v[j].z + v[j].w * v[j].w); }
    const float rstd = 1.f / sqrtf(wave_sum(s2) * (1.f / D) + LN_EPS);
#pragma unroll
    for (int j = 0; j < 4; ++j) { const f32x4 gg = *(const f32x4*)(g + 4 * lane + 256 * j), bb = *(const f32x4*)(b + 4 * lane + 256 * j); v[j] = v[j] * rstd * gg + bb; }
}

__global__ void __launch_bounds__(NTHR, 2) mk_fwd(Args args) {
    extern __shared__ __attribute__((aligned(16))) unsigned char lds[];
    const int G = gridDim.x, bx = blockIdx.x;
    const int NGW = G * NWAVES, NGT = G * NTHR;
#define PH_IDS() int tid_o = threadIdx.x; asm volatile("" : "+v"(tid_o)); const int tid = tid_o, lane = tid & 63, wave = __builtin_amdgcn_readfirstlane(tid >> 6); \
    const int gw = bx * NWAVES + wave, gtid = bx * NTHR + tid; (void)gw; (void)gtid; (void)lane; (void)wave;
    unsigned char* ws = args.ws;
    gu32* ctl = (gu32*)(ws + WS_CTL);
    LAS unsigned char* ldsl = (LAS unsigned char*)lds;
    volatile LAS unsigned* MISC = (volatile LAS unsigned*)(ldsl + MISC_OFF);
    LAS int* TAB = (LAS int*)(ldsl + TAB_OFF);
    for (int u = threadIdx.x; u < (LDS_BYTES - RING_BYTES) / 4; u += NTHR) ((LAS unsigned*)(ldsl + RING_BYTES))[u] = 0u;
    __syncthreads();
    XcdBarrier bar; bar.bar = (unsigned*)(ctl + CW_BAR); bar.x = 0; bar.st = nullptr;
    if (!MK_MULTI) bar = xcd_barrier_post((unsigned*)(ctl + CW_BAR), MISC + 8);
#if defined(TIME_P1)
#define SEAM_AT(k) do { xcd_barrier(bar); if (blockIdx.x == 0 && threadIdx.x == 0) { ((unsigned long long*)(ctl + CW_TS))[(k)] = __builtin_amdgcn_s_memrealtime(); } } while (0)
#else
#define SEAM_AT(k) do { xcd_barrier(bar); } while (0)
#endif
#define SEAM() SEAM_AT(0)
#define IN(gp) (args.ph_lo <= (gp) && (gp) < args.ph_hi)

    float* X = (float*)(ws + WS_X);
    bf16_t* XBA = (bf16_t*)(ws + WS_XBA); bf16_t* XBB = (bf16_t*)(ws + WS_XBB);
    float* ROPE_C = (float*)(ws + WS_ROPE_C); float* ROPE_S = (float*)(ws + WS_ROPE_S);
    float* LOGF = (float*)(ws + WS_LOGF); float* CUM = (float*)(ws + WS_CUM); float* GATES = (float*)(ws + WS_GATES); float* KMEAN = (float*)(ws + WS_KMEAN);
    bf16_t* KCMP = (bf16_t*)(ws + WS_KCMP); bf16_t* VCMP = (bf16_t*)(ws + WS_VCMP); bf16_t* VCT = (bf16_t*)(ws + WS_VCT); unsigned* SELMG = (unsigned*)(ws + WS_SELMG);
    int* ROWTOK = (int*)(ws + WS_ROWTOK); float* LS32 = (float*)(ws + WS_LS32); float* H1 = (float*)(ws + WS_H1);
    int* TOKE = (int*)(ws + WS_TOKE); float* TOKW = (float*)(ws + WS_TOKW); int* TOKP = (int*)(ws + WS_TOKP); float* ROWW = (float*)(ws + WS_ROWW);
#define WSET_PTRS(LL) constexpr size_t so_ = ((LL) & 1) ? WS_SET1 : 0; \
    bf16_t* const WIN_T = (bf16_t*)(ws + WS_WIN + so_); bf16_t* const WOUT_T = (bf16_t*)(ws + WS_WOUT + so_); bf16_t* const WGU_T = (bf16_t*)(ws + WS_WGU + so_); bf16_t* const WDN_T = (bf16_t*)(ws + WS_WDN + so_); \
    bf16_t* const WPG_T = (bf16_t*)(ws + WS_WPG + so_); bf16_t* const WPP_T = (bf16_t*)(ws + WS_WPP + so_); bf16_t* const PB = (bf16_t*)(ws + WS_PB + so_); bf16_t* const WC1_T = (bf16_t*)(ws + WS_WC1 + so_); \
    float* const PEB = (float*)(ws + (((LL) & 1) ? WS_PEB1 : WS_PEB)); bf16_t* const WRT = (bf16_t*)(ws + (((LL) & 1) ? WS_WRT1 : WS_WRT)); \
    (void)WIN_T; (void)WOUT_T; (void)WGU_T; (void)WDN_T; (void)WPG_T; (void)WPP_T; (void)PB; (void)WC1_T; (void)PEB; (void)WRT;
    bf16_t* QB = (bf16_t*)(ws + WS_Q); bf16_t* KB = (bf16_t*)(ws + WS_K); bf16_t* VB = (bf16_t*)(ws + WS_V); bf16_t* AO = (bf16_t*)(ws + WS_AO);
    bf16_t* PP = (bf16_t*)(ws + WS_PP); bf16_t* QR = (bf16_t*)(ws + WS_QR); bf16_t* HB = (bf16_t*)(ws + WS_H); bf16_t* XG = (bf16_t*)(ws + WS_XG); bf16_t* OUTR = (bf16_t*)(ws + WS_OUTR);
    const int* positions = (const int*)args.in[2];

    if (IN(0)) { PH_IDS();
        for (int i = gtid; i < T * 32; i += NGT) { const int t = i >> 5, f = i & 31;
            const float inv = __builtin_amdgcn_exp2f(-(float)f * (13.287712379549449f / 32.f));
            const double ang = (double)positions[t] * (double)inv; double rev = ang * 0.15915494309189535; rev = rev - floor(rev);
            ROPE_C[i] = __builtin_amdgcn_cosf((float)rev); ROPE_S[i] = __builtin_amdgcn_sinf((float)rev); }
        for (int i = gtid; i < T; i += NGT) ROWTOK[64 * 16384 + i] = i;
        const float* xin = (const float*)args.in[0];
        for (int i = gtid; i < T * D / 4; i += NGT) { const f32x4 v = ((const f32x4*)xin)[i];
            unsigned long long w = (unsigned long long)pk2(v.x, v.y) | ((unsigned long long)pk2(v.z, v.w) << 32); ((unsigned long long*)XBB)[i] = w; }
    }

    auto conv = [&](auto Ltc) __attribute__((always_inline)) {
        constexpr int LT = decltype(Ltc)::value; PH_IDS(); WSET_PTRS(LT);
        const int kind = LT % 3, jj = LT / 3;
        const float* w_in_src = kind == 0 ? (const float*)args.in[3] + (size_t)jj * D * 3088 : kind == 1 ? (const float*)args.in[6] : (const float*)args.in[15];
        const int ldw_in = kind == 0 ? 3088 : kind == 1 ? 2608 : 3072, ncol_in = kind == 1 ? 2560 : 3072;
        const float* w_out_src = kind == 0 ? (const float*)args.in[5] + (size_t)jj * D * D : kind == 1 ? (const float*)args.in[14] : (const float*)args.in[16];
        {
            const int n_win = 16 * (ncol_in / 64), n_wout = 256, n_gu = 65 * 128, n_dn = 65 * 64, n_pg = 256, n_pp = 64;
            const int NIT = n_win + n_wout + n_gu + n_dn + n_pg + n_pp;
            auto dec = [&](int r, const float*& sp, int& ldw, bf16*& dp, int& K) __attribute__((always_inline)) {
                if (r < n_win) { const int nblk = ncol_in / 64, kb = r / nblk, nb = r % nblk; sp = w_in_src + (size_t)(64 * kb) * ldw_in + 64 * nb; ldw = ldw_in; dp = WIN_T + (size_t)(64 * nb) * D + 64 * kb; K = D; return; } r -= n_win;
                if (r < n_wout) { const int kb = r / 16, nb = r % 16; sp = w_out_src + (size_t)(64 * kb) * D + 64 * nb; ldw = D; dp = WOUT_T + (size_t)(64 * nb) * D + 64 * kb; K = D; return; } r -= n_wout;
                if (r < n_gu) { const int e = r / 128, rr = r % 128, mat = rr / 64, kb = (rr % 64) / 4, nb = rr % 4, n0 = 64 * nb;
                    const float* W = e < 64 ? (const float*)args.in[mat ? 22 : 21] + ((size_t)(LT * 64 + e)) * D * ED : (const float*)args.in[mat ? 25 : 24] + (size_t)LT * D * ED;
                    sp = W + (size_t)(64 * kb) * ED + n0; ldw = ED; dp = WGU_T + (size_t)(e * 512 + (n0 / 128) * 256 + mat * 128 + (n0 % 128)) * D + 64 * kb; K = D; return; } r -= n_gu;
                if (r < n_dn) { const int e = r / 64, rr = r % 64, kb = rr / 16, nb = rr % 16;
                    const float* W = e < 64 ? (const float*)args.in[23] + ((size_t)(LT * 64 + e)) * ED * D : (const float*)args.in[26] + (size_t)LT * ED * D;
                    sp = W + (size_t)(64 * kb) * D + 64 * nb; ldw = D; dp = WDN_T + (size_t)(e * 1024 + 64 * nb) * ED + 64 * kb; K = ED; return; } r -= n_dn;
                if (r < n_pg) { const int kb = r / 16, nb = r % 16; sp = (const float*)args.in[29] + (size_t)LT * D * D + (size_t)(64 * kb) * D + 64 * nb; ldw = D; dp = WPG_T + (size_t)(64 * nb) * D + 64 * kb; K = D; return; } r -= n_pg;
                { const int kb = r / 16, nb = r % 16; sp = (const float*)args.in[30] + (size_t)LT * PLE * D + (size_t)(64 * kb) * D + 64 * nb; ldw = D; dp = WPP_T + (size_t)(64 * nb) * PLE + 64 * kb; K = PLE; }
            };
            for (int it = gw; it < 2 * NIT; it += 6 * NGW) {
                const float* sp[6]; bf16* dp[6]; int ld[6], Kd[6]; f32x4 v[6][8];
#pragma unroll
                for (int u = 0; u < 6; ++u) { const int i2 = it + u * NGW; if (i2 < 2 * NIT) { dec(i2 >> 1, sp[u], ld[u], dp[u], Kd[u]); sp[u] += 32 * (i2 & 1); dp[u] += (size_t)(32 * (i2 & 1)) * Kd[u]; nitem_load(v[u], sp[u], ld[u], lane); } }
#pragma unroll
                for (int u = 0; u < 6; ++u) { const int i2 = it + u * NGW; if (i2 < 2 * NIT) nitem_store(v[u], dp[u], Kd[u], lane); }
            }
            { const f32x4* ps = (const f32x4*)((const float*)args.in[1] + (size_t)LT * T * PLE); unsigned long long* pd = (unsigned long long*)PB; constexpr int NP = T * PLE / 4;
              for (int i0 = gtid; i0 < NP; i0 += 8 * NGT) { f32x4 v[8];
#pragma unroll
                  for (int u = 0; u < 8; ++u) { const int i = i0 + u * NGT; if (i < NP) v[u] = __builtin_nontemporal_load((const GAS f32x4*)(ps + i)); }
#pragma unroll
                  for (int u = 0; u < 8; ++u) { const int i = i0 + u * NGT; if (i < NP) pd[i] = (unsigned long long)gattn::cvtpk_s(v[u].x, v[u].y) | ((unsigned long long)gattn::cvtpk_s(v[u].z, v[u].w) << 32); } } }
            { const float* Wr = (const float*)args.in[19] + (size_t)LT * D * NE;
              for (int i = gtid; i < NE * D; i += NGT) { const int e = i >> 10, k = i & 1023; const float w = Wr[k * 64 + e]; const unsigned h = f2bf(w); const float r = w - __uint_as_float(h << 16);
                  WRT[i] = (bf16_t)h; WRT[NE * D + i] = (bf16_t)f2bf(r); } }
            if (kind == 1) {
                for (int it = gw; it < 2 * 64; it += NGW) { const int kv = it >> 6, r = it & 63, kb = r >> 1, nb = r & 1;
                    transpose_item64((const float*)args.in[kv ? 12 : 10], 128, 64 * kb, 64 * nb, WC1_T, 2048, kv * 256 + 64 * nb, lane); }
                for (int it = gw; it < 2 * 128; it += NGW) { const int kv = it >> 7, hu = it & 127; const float* pe = (const float*)args.in[kv ? 9 : 8]; const float* w1 = (const float*)args.in[kv ? 12 : 10];
                    float wv[32], a = 0.f;
#pragma unroll
                    for (int i = 0; i < 32; ++i) wv[i] = w1[(size_t)(lane + 64 * i) * 128 + hu];
#pragma unroll
                    for (int i = 0; i < 32; ++i) a += pe[lane + 64 * i] * wv[i];
                    a = wave_sum(a); if (lane == 0) PEB[kv * 128 + hu] = a; }
            }
        }
    };

    auto layer_body = [&](auto Lc) __attribute__((always_inline)) {
        constexpr int L = decltype(Lc)::value; WSET_PTRS(L);
        const int kind = L % 3, jj = L / 3, gp0 = 1 + L * NPH;
        const float* w_in_src = kind == 0 ? (const float*)args.in[3] + (size_t)jj * D * 3088 : kind == 1 ? (const float*)args.in[6] : (const float*)args.in[15];
        const int ldw_in = kind == 0 ? 3088 : kind == 1 ? 2608 : 3072, ncol_in = kind == 1 ? 2560 : 3072;
        (void)jj; (void)w_in_src; (void)ldw_in;

        auto gates = [&]() __attribute__((always_inline)) { PH_IDS();
            if constexpr (L % 3 != 2) {
                using gattn::bf16x8; using gattn::f32x16; using gattn::u32x4; using gattn::crow; using gattn::cvtpk_s;
                constexpr int NB = (L % 3 == 0) ? 1 : 2, NCOL = (L % 3 == 0) ? 16 : 48;
                const int colbase = kind == 0 ? 3072 : 2560;
                const float* bsrc = kind == 0 ? (const float*)args.in[4] + jj * 16 : (const float*)args.in[7];
                constexpr int XP = 1032;
                bf16_t* XH = (bf16_t*)lds; bf16_t* XL = XH + 32 * XP; float* PL = (float*)lds;
                const int r32 = lane & 31, hi = lane >> 5;
                bf16x8 wh[8][NB], wl[8][NB];
#pragma unroll
                for (int st = 0; st < 8; ++st)
#pragma unroll
                    for (int nb = 0; nb < NB; ++nb) { const int n = nb * 32 + r32; u32x4 ph = {0u, 0u, 0u, 0u}, pl = {0u, 0u, 0u, 0u};
                        if (n < NCOL) { float wv[8];
#pragma unroll
                            for (int i = 0; i < 8; ++i) wv[i] = w_in_src[(size_t)(wave * 128 + 16 * st + 8 * hi + i) * ldw_in + colbase + n];
#pragma unroll
                            for (int i = 0; i < 4; ++i) { const unsigned h2 = cvtpk_s(wv[2 * i], wv[2 * i + 1]); ph[i] = h2; pl[i] = cvtpk_s(wv[2 * i] - bflo(h2), wv[2 * i + 1] - bfhi(h2)); } }
                        wh[st][nb] = __builtin_bit_cast(bf16x8, ph); wl[st][nb] = __builtin_bit_cast(bf16x8, pl); }
                for (int pass = bx; pass < T / 32; pass += G) { const size_t row0 = (size_t)pass * 32;
                    __syncthreads();
#pragma unroll
                    for (int r = 0; r < 4; ++r) { const int rl = wave * 4 + r; const size_t row = row0 + rl;
#pragma unroll
                        for (int j = 0; j < 4; ++j) {
                            if constexpr (L == 0) { const f32x4 v = *(const f32x4*)((const float*)args.in[0] + row * D + 4 * lane + 256 * j);
                                const unsigned h0 = cvtpk_s(v.x, v.y), h1 = cvtpk_s(v.z, v.w); const unsigned l0 = cvtpk_s(v.x - bflo(h0), v.y - bfhi(h0)), l1 = cvtpk_s(v.z - bflo(h1), v.w - bfhi(h1));
                                *(uint2*)(XH + rl * XP + 4 * lane + 256 * j) = make_uint2(h0, h1); *(uint2*)(XL + rl * XP + 4 * lane + 256 * j) = make_uint2(l0, l1); }
                            else *(uint2*)(XH + rl * XP + 4 * lane + 256 * j) = *(const uint2*)(XBB + row * D + 4 * lane + 256 * j); } }
                    __syncthreads();
                    f32x16 acc[NB];
#pragma unroll
                    for (int nb = 0; nb < NB; ++nb) acc[nb] = f32x16{};
#pragma unroll
                    for (int st = 0; st < 8; ++st) { const int k = wave * 128 + 16 * st + 8 * hi; const bf16x8 xh = *(const bf16x8*)(XH + r32 * XP + k); bf16x8 xl = xh; if constexpr (L == 0) xl = *(const bf16x8*)(XL + r32 * XP + k);
#pragma unroll
                        for (int nb = 0; nb < NB; ++nb) { acc[nb] = __builtin_amdgcn_mfma_f32_32x32x16_bf16(xh, wh[st][nb], acc[nb], 0, 0, 0); if constexpr (L == 0) acc[nb] = __builtin_amdgcn_mfma_f32_32x32x16_bf16(xl, wh[st][nb], acc[nb], 0, 0, 0);
                            acc[nb] = __builtin_amdgcn_mfma_f32_32x32x16_bf16(xh, wl[st][nb], acc[nb], 0, 0, 0); } }
                    __syncthreads();
#pragma unroll
                    for (int nb = 0; nb < NB; ++nb)
#pragma unroll
                        for (int r = 0; r < 16; ++r) PL[(wave * 32 + crow(r, hi)) * 64 + nb * 32 + r32] = acc[nb][r];
                    __syncthreads();
                    for (int o = tid; o < 32 * NCOL; o += NTHR) { const int rl = o / NCOL, c = o % NCOL; float z = bsrc[c];
#pragma unroll
                        for (int w = 0; w < 8; ++w) z += PL[(w * 32 + rl) * 64 + c];
                        if (kind == 0) { const float lf = fminf(z, 0.f) - __logf(1.f + __expf(-fabsf(z))); LOGF[(row0 + rl) * 16 + c] = lf;
                            float s4 = lf; s4 += xor_f<16>(s4); { auto rr = __builtin_amdgcn_permlane32_swap(__float_as_uint(s4), __float_as_uint(s4), false, false); s4 = __uint_as_float(rr[0]) + __uint_as_float(rr[1]); }
                            if (lane < 16) PL[8 * 32 * 64 + wave * 16 + lane] = s4; }
                        else GATES[(row0 + rl) * 48 + c] = sigmoidf_(z); }
                    if (kind == 0) { __syncthreads(); if (tid < 16) { float s = 0.f;
#pragma unroll
                            for (int w = 0; w < 8; ++w) s += PL[8 * 32 * 64 + w * 16 + tid]; LS32[(size_t)pass * 16 + tid] = s; } }
                }
                __syncthreads();
            }
        };

        if (L == 0 && PH_EN(0) && IN(gp0 + 0)) {
            conv(std::integral_constant<int, 0>{}); gates();
            SEAM_AT(1 + L * NPH + 0);
        }

        if (PH_EN(1) && IN(gp0 + 1)) { PH_IDS();
            if constexpr (L > 0) gates();
            pg8::Gemm g{XBB, WIN_T, T, ncol_in, D, 0, 0, nullptr}; pg8::StaticOrder So; So.init(T, ncol_in, G, bx);
            epi::Qkv E{QB, 1024, D, KB, kind == 1 ? 256 : 1024, kind == 1 ? 256 : 1024, kind == 1 ? (size_t)(4 * MiB) : (size_t)(16 * MiB), gattn::C2, (PG8_LAS unsigned char*)(ldsl + QSTG)};
            pg8::gemm_phase<epi::Qkv, pg8::StaticOrder, true, true>(ldsl, g, So, E);
            {
              int kpp = PLE; asm volatile("" : "+s"(kpp)); pg8::Gemm g{PB, WPP_T, T, D, kpp, 0, 0, nullptr}; pg8::StaticOrder So; So.init(T, D, G, bx);
              epi::StoreBf16 E{PP, D};
              pg8::gemm_phase<epi::StoreBf16, pg8::StaticOrder, true, true>(ldsl, g, So, E); }
            SEAM_AT(1 + L * NPH + 1);
        }

        if (PH_EN(2) && IN(gp0 + 2)) { PH_IDS();
            if (kind == 0) {
                for (int task = gw; task < Bn * NH * 32; task += NGW) { const int q = task & 31, bh = task >> 5, b = bh / NH, h = bh % NH;
                    double base = 0.0;
                    for (int p = lane; p < 8 * q; p += 64) base += (double)LS32[((size_t)b * 256 + p) * 16 + h];
#pragma unroll
                    for (int o = 1; o < 64; o <<= 1) { const unsigned long long sb = __builtin_bit_cast(unsigned long long, base); const int sl4 = (lane ^ o) << 2;
                        const unsigned ulo = (unsigned)__builtin_amdgcn_ds_bpermute(sl4, (int)(unsigned)sb), uhi = (unsigned)__builtin_amdgcn_ds_bpermute(sl4, (int)(unsigned)(sb >> 32));
                        base += __builtin_bit_cast(double, ((unsigned long long)uhi << 32) | ulo); }
                    const size_t t0 = (size_t)b * S + q * 256 + lane * 4; double loc[4]; double run = 0.0;
#pragma unroll
                    for (int i = 0; i < 4; ++i) { run += (double)LOGF[(t0 + i) * 16 + h]; loc[i] = run; }
                    double sc = run;
#pragma unroll
                    for (int o = 1; o < 64; o <<= 1) { const unsigned long long sb = __builtin_bit_cast(unsigned long long, sc); const int sl4 = ((lane - o) & 63) << 2;
                        const unsigned ulo = (unsigned)__builtin_amdgcn_ds_bpermute(sl4, (int)(unsigned)sb), uhi = (unsigned)__builtin_amdgcn_ds_bpermute(sl4, (int)(unsigned)(sb >> 32));
                        const double up = __builtin_bit_cast(double, ((unsigned long long)uhi << 32) | ulo); if (lane >= o) sc += up; }
                    const double pre = base + (sc - run);
#pragma unroll
                    for (int i = 0; i < 4; ++i) CUM[(size_t)bh * S + q * 256 + lane * 4 + i] = (float)(pre + loc[i]); }
                for (int b = 0; b < Bn; ++b) { float mq = 0.f, mk = 0.f;
                    for (int rbase = gw; rbase < S; rbase += 4 * NGW) { uint4 q0a[4], q1a[4], k0a[4], k1a[4];
#pragma unroll
                      for (int u4 = 0; u4 < 4; ++u4) { const int r = rbase + u4 * NGW; if (r < S) { const size_t off = ((size_t)b * S + r) * D + lane * 16;
                          q0a[u4] = *(const uint4*)(QB + off); q1a[u4] = *(const uint4*)(QB + off + 8); k0a[u4] = *(const uint4*)(KB + off); k1a[u4] = *(const uint4*)(KB + off + 8); } }
#pragma unroll
                      for (int u4 = 0; u4 < 4; ++u4) { const int r = rbase + u4 * NGW; if (r >= S) continue; const uint4 q0 = q0a[u4], q1 = q1a[u4], k0 = k0a[u4], k1 = k1a[u4];
                        float sq = 0.f, sk = 0.f;
#define SQ2(w) (bflo(w) * bflo(w) + bfhi(w) * bfhi(w))
                        sq = SQ2(q0.x) + SQ2(q0.y) + SQ2(q0.z) + SQ2(q0.w) + SQ2(q1.x) + SQ2(q1.y) + SQ2(q1.z) + SQ2(q1.w);
                        sk = SQ2(k0.x) + SQ2(k0.y) + SQ2(k0.z) + SQ2(k0.w) + SQ2(k1.x) + SQ2(k1.y) + SQ2(k1.z) + SQ2(k1.w);
#undef SQ2
                        sq += xor_f<1>(sq); sq += xor_f<2>(sq); sk += xor_f<1>(sk); sk += xor_f<2>(sk);
                        mq = fmaxf(mq, sq); mk = fmaxf(mk, sk); } }
                    LAS float* nl = (LAS float*)ldsl; __syncthreads();
                    if ((lane & 3) == 0) { nl[(wave * 16 + (lane >> 2)) * 2] = mq; nl[(wave * 16 + (lane >> 2)) * 2 + 1] = mk; }
                    __syncthreads();
                    if (tid < 32) { float m = 0.f;
#pragma unroll
                        for (int w = 0; w < 8; ++w) m = fmaxf(m, nl[(w * 16 + (tid >> 1)) * 2 + (tid & 1)]);
                        __hip_atomic_fetch_max((unsigned*)(ctl + CW_NRM + L * 64 + (b * NH + (tid >> 1)) * 2 + (tid & 1)), __float_as_uint(m), RLX_AGENT); } }
            } else {
                const size_t st6 = 4 * MiB;
                for (int pass = 0; pass < (kind == 1 ? 3 : 2); ++pass) {
                    const bf16_t* src; bf16_t* dst; int nhd;
                    if (kind == 1) { if (pass == 0) { src = QB; dst = QR; nhd = 16; } else if (pass == 1) { src = KB + 2 * st6; dst = KB + 2 * st6; nhd = 4; } else { src = KB + 4 * st6; dst = KB + 4 * st6; nhd = 4; } }
                    else { if (pass == 0) { src = QB; dst = QB; } else { src = KB; dst = KB; } nhd = 16; }
                    const int per_row = nhd * 4, total = T * per_row;
                    for (int i = gtid; i < total; i += NGT) { const int t = i / per_row, r = i % per_row, hd = r >> 2, fq = r & 3;
                        const size_t o1 = (size_t)t * (nhd * 64) + hd * 64 + 8 * fq;
                        const uint4 a = *(const uint4*)(src + o1), bq = *(const uint4*)(src + o1 + 32);
                        const f32x4 c0 = *(const f32x4*)(ROPE_C + t * 32 + 8 * fq), c1 = *(const f32x4*)(ROPE_C + t * 32 + 8 * fq + 4);
                        const f32x4 s0 = *(const f32x4*)(ROPE_S + t * 32 + 8 * fq), s1 = *(const f32x4*)(ROPE_S + t * 32 + 8 * fq + 4);
                        uint4 oa, ob;
#define ROPE2(W, CA, CB, SA, SB) { const float x1l = bflo(a.W), x1h = bfhi(a.W), x2l = bflo(bq.W), x2h = bfhi(bq.W); \
                            oa.W = pk2(x1l * CA - x2l * SA, x1h * CB - x2h * SB); ob.W = pk2(x2l * CA + x1l * SA, x2h * CB + x1h * SB); }
                        ROPE2(x, c0.x, c0.y, s0.x, s0.y) ROPE2(y, c0.z, c0.w, s0.z, s0.w) ROPE2(z, c1.x, c1.y, s1.x, s1.y) ROPE2(w, c1.z, c1.w, s1.z, s1.w)
#undef ROPE2
                        *(uint4*)(dst + o1) = oa; *(uint4*)(dst + o1 + 32) = ob; }
                }
            }
            SEAM_AT(1 + L * NPH + 2);
        }

        if (kind != 0 && PH_EN(3) && IN(gp0 + 3)) { PH_IDS();
            if (kind == 1) {
                { pg8::Gemm g{KB, WC1_T, 0, 0, 2048, 4096, 512, nullptr}; CmpOrder So{G, bx}; epi::H1Store E{H1};
                  pg8::gemm_phase<epi::H1Store, CmpOrder, true, true>(ldsl, g, So, E); }
                if (!MK_MULTI) xcd_barrier(bar);
                float* hb = (float*)(lds + wave * 1024);
                for (int task = gw; task < 2 * 8 * NCMP; task += NGW) { const int i = task & 511, bg = (task >> 9) & 7, kv = task >> 12;
                    const float* h1 = H1 + (size_t)task * 128; const float* w2 = (const float*)args.in[kv ? 13 : 11];
                    hb[lane] = gelu_tanh(h1[lane] + PEB[kv * 128 + lane]); hb[64 + lane] = gelu_tanh(h1[64 + lane] + PEB[kv * 128 + 64 + lane]);
                    WAVE_SYNC();
                    float o0 = 0.f;
#pragma unroll 8
                    for (int hu = 0; hu < 128; ++hu) o0 += hb[hu] * w2[hu * 64 + lane];
                    const bf16_t ob = (bf16_t)f2bf(o0);
                    if (kv == 0) KCMP[((size_t)bg * NCMP + i) * 64 + lane] = ob;
                    else { VCMP[((size_t)bg * NCMP + i) * 64 + lane] = ob; const int nl = i & 63; VCT[(((size_t)bg * 8 + (i >> 6)) * 64 + lane) * 64 + (nl & 48) + swapmid(nl & 15)] = ob; }
                    WAVE_SYNC(); }
            } else if (kind == 2) {
                for (int item = gw; item < Bn * NH * 32; item += NGW) { const int blk = item & 31, bh = item >> 5, b = bh / NH, h = bh % NH;
                    float s = 0.f; const bf16_t* kp = KB + ((size_t)b * S + blk * 256) * D + h * 64 + lane;
                    for (int r0 = 0; r0 < 256; r0 += 32) { bf16_t kv[32];
#pragma unroll
                        for (int r = 0; r < 32; ++r) kv[r] = kp[(size_t)(r0 + r) * D];
#pragma unroll
                        for (int r = 0; r < 32; ++r) s += bf2f(kv[r]); }
                    KMEAN[(size_t)item * 64 + lane] = s * (1.f / 256.f); }
            }
            SEAM_AT(1 + L * NPH + 3);
        }

        if (PH_EN(4) && IN(gp0 + 4)) { PH_IDS();
            float* wl = (float*)(lds + wave * 14336);
            float* qs = wl; float* qs2 = wl + 256; float* pb = wl + 512; int* kb = (int*)(wl + 512 + 2048); float* misc = wl + 512 + 2048 + 512;
#if defined(ZERO_KIND)
            if ((ZERO_KIND >> kind) & 1) { for (int i = gtid; i < T * D / 8; i += NGT) ((uint4*)AO)[i] = make_uint4(0u, 0u, 0u, 0u); } else {
#endif
            bf16_t* AOn = AO;
#if !defined(FOX_NAIVE)
            if (kind == 0) {
                volatile LAS int* qw = (volatile LAS int*)(ldsl + TAB_OFF);
                int nun = 0; const int cslot = bx & 3; (void)cslot;
                for (;; ++nun) {
                    if constexpr (L + 1 < DEPTH) { if (nun == cslot) conv(std::integral_constant<int, (L + 1 < DEPTH ? L + 1 : 0)>{}); }
                    if (tid == 0) { qw[100] = (int)__hip_atomic_fetch_add((unsigned*)(ctl + CW_Q + L), 1u, RLX_AGENT); qw[101] = 0; }
                    __syncthreads();
                    const int u = qw[100]; if (u >= Bn * NH * 32) break;
                    const int qb = 31 - (u >> 5), bh = u & 31, b = bh / NH, h = bh % NH; const size_t rb = (size_t)b * S; const int ntabs = 4 * qb + 4;
                    const float* cum = CUM + (size_t)bh * S;
                    { const unsigned* nr = (const unsigned*)(ctl + CW_NRM + L * 64 + bh * 2);
                      const float qk = sqrtf(__uint_as_float(__hip_atomic_load(nr, RLX_AGENT)) * __uint_as_float(__hip_atomic_load(nr + 1, RLX_AGENT)));
                      const float thr = -(30.f + 2.f * qk);
                      bool skip = false; if (tid < ntabs) skip = (cum[qb * 256] - cum[64 * tid + 63]) * 1.4426950408889634f < thr;
                      const int nsk = __popcll(__builtin_amdgcn_ballot_w64(skip)); if (lane == 0 && nsk) atomicAdd((int*)&qw[101], nsk); }
                    __syncthreads();
                    int t0 = qw[101]; t0 = t0 > ntabs - 4 ? ntabs - 4 : t0; t0 &= ~1;
                    __syncthreads();
                    FoxU un{(const abf16*)KB + rb * D + h * 64, (const abf16*)VB + rb * D + h * 64, D, t0, ntabs - t0, ntabs - 1, cum, qb * 256,
                            (abf16*)AO + (rb + qb * 256) * D + h * 64, 32L * D, (const abf16*)QB + (rb + qb * 256) * D + h * 64, nullptr};
                    gattn::gunit<8, true, 0, 0>((char*)lds, un); }
                if constexpr (L + 1 < DEPTH) { if (nun < cslot) conv(std::integral_constant<int, (L + 1 < DEPTH ? L + 1 : 0)>{}); }
            }
#endif
#if !defined(MOBA_NAIVE)
            if (kind == 2) {
                const int vcu = (bx % 8) * (G / 8) + bx / 8;
                LAS unsigned* mtab = (LAS unsigned*)(ldsl + gattn::LDS_BT); LAS float* kml = (LAS float*)(ldsl + gattn::LDS_BT + 1024);
                const int cslot = bx % 5;
                for (int ui = 0; ui < 4; ++ui) { int bh, qb; fox_order(vcu, ui, bh, qb); const int b = bh / NH, h = bh % NH; const size_t rb = (size_t)b * S;
                    if constexpr (L + 1 < DEPTH) { if (ui == cslot) conv(std::integral_constant<int, (L + 1 < DEPTH ? L + 1 : 0)>{}); }
                    for (int i = tid; i < qb * 64; i += NTHR) kml[i] = KMEAN[(size_t)bh * 32 * 64 + i];
                    __syncthreads();
                    if (tid < 256) { const uint4* qp = (const uint4*)(QB + (rb + qb * 256 + tid) * D + h * 64); float q[64];
#pragma unroll
                        for (int c = 0; c < 8; ++c) { const uint4 w = qp[c]; q[8 * c] = bflo(w.x); q[8 * c + 1] = bfhi(w.x); q[8 * c + 2] = bflo(w.y); q[8 * c + 3] = bfhi(w.y); q[8 * c + 4] = bflo(w.z); q[8 * c + 5] = bfhi(w.z); q[8 * c + 6] = bflo(w.w); q[8 * c + 7] = bfhi(w.w); }
                        float v0 = -3e38f, v1 = -3e38f, v2 = -3e38f; int i0 = -1, i1 = -1, i2 = -1;
                        for (int n = 0; n < qb; ++n) { float sacc = 0.f;
#pragma unroll
                            for (int d = 0; d < 64; ++d) sacc += q[d] * kml[n * 64 + d];
                            if (sacc > v0) { v2 = v1; i2 = i1; v1 = v0; i1 = i0; v0 = sacc; i0 = n; } else if (sacc > v1) { v2 = v1; i2 = i1; v1 = sacc; i1 = n; } else if (sacc > v2) { v2 = sacc; i2 = n; } }
                        unsigned mk = 1u << qb; if (i0 >= 0) mk |= 1u << i0; if (i1 >= 0) mk |= 1u << i1; if (i2 >= 0) mk |= 1u << i2;
                        mtab[tid] = mk; }
                    __syncthreads();
                    FoxU un{(const abf16*)KB + rb * D + h * 64, (const abf16*)VB + rb * D + h * 64, D, 0, 4 * qb + 4, 4 * qb + 3, nullptr, qb * 256,
                            (abf16*)AO + (rb + qb * 256) * D + h * 64, 32L * D, (const abf16*)QB + (rb + qb * 256) * D + h * 64, mtab};
                    gattn::gunit<8, false, 0, 0>((char*)lds, un); }
                if constexpr (L + 1 < DEPTH) { if (cslot == 4) conv(std::integral_constant<int, (L + 1 < DEPTH ? L + 1 : 0)>{}); }
            }
#endif
#if !defined(NSA_NAIVE)
            if (kind == 1) {
                const int vcu = (bx % 8) * (G / 8) + bx / 8; const size_t st6 = 4 * MiB;
                const int cslot = bx % 5;
                for (int ui = 0; ui < 4; ++ui) { const int bg = vcu >> 5, s5 = vcu & 31, b = bg / NSA_G, g = bg % NSA_G;
                    if constexpr (L + 1 < DEPTH) { if (ui == cslot) conv(std::integral_constant<int, (L + 1 < DEPTH ? L + 1 : 0)>{}); } const int qt = (ui == 0) ? s5 : (ui == 1) ? 63 - s5 : (ui == 2) ? 64 + s5 : 127 - s5;
                    const int q0 = qt * 64, cur = qt; const size_t rb = (size_t)b * S;
#if defined(CHECK_KIND)
                    unsigned* selg = SELMG;
#else
                    unsigned* selg = nullptr;
#endif
                    nsa_cmp_select((char*)lds, b, g, q0, QB, KCMP, VCT, GATES, selg);
                    const LAS unsigned* selm = (const LAS unsigned*)(ldsl + NSA_LDS_SELM);
                    { int nt = (cur + 2) & ~1; nt = nt < 4 ? 4 : nt;
                      NsaU un{(const abf16*)KB + 2 * st6 + rb * 256 + g * 64, (const abf16*)KB + 3 * st6 + rb * 256 + g * 64, 256, 0, nt, 127, nullptr, q0,
                              (abf16*)AO + (rb + q0) * D + g * 256, 8L * D, (const abf16*)QR + (rb + q0) * D + g * 256, selm, GATES + (rb + q0) * 48 + g * 12, 1, 0};
                      gattn::gunit<8, false, 2, 2>((char*)lds, un); }
                    { NsaU un{(const abf16*)KB + 4 * st6 + rb * 256 + g * 64, (const abf16*)KB + 5 * st6 + rb * 256 + g * 64, 256, cur - 8, 10, 127, nullptr, q0,
                              (abf16*)AO + (rb + q0) * D + g * 256, 8L * D, (const abf16*)QR + (rb + q0) * D + g * 256, nullptr, GATES + (rb + q0) * 48 + g * 12, 2, 512};
                      gattn::gunit<8, false, 3, 2>((char*)lds, un); }
                }
                if constexpr (L + 1 < DEPTH) { if (cslot == 4) conv(std::integral_constant<int, (L + 1 < DEPTH ? L + 1 : 0)>{}); }
            }
#endif
#if defined(CHECK_KIND)
            if (kind == CHECK_KIND) { AOn = XG; SEAM_AT(1 + L * NPH + 4); }
#endif
#if defined(FOX_NAIVE) || (defined(CHECK_KIND) && CHECK_KIND == 0)
            if (kind == 0) {
                for (int task = gw; task < T * NH; task += NGW) {
                    const int t = task % S, bh = task / S, h = bh % NH, b = bh / NH; const size_t row = (size_t)b * S + t;
                    qs[lane] = bf2f(QB[row * D + h * 64 + lane]);
                    const float* cum = CUM + (size_t)bh * S; const float cq = cum[t];
                    WAVE_SYNC();
                    float m[1] = {NEGF}, l[1] = {0.f}, o[1] = {0.f};
                    for (int c0 = 0; c0 <= t; c0 += 512) {
                        attend_chunk<1>(qs, pb, kb, KB + h * 64, VB + h * 64, D, 512,
                            [=](int slot) { const int kk = c0 + slot; return kk <= t ? (int)(b * S + kk) : -1; },
                            [=](int slot) { return cq - cum[c0 + slot]; }, QSC, m, l, o, lane);
                    }
                    AOn[row * D + h * 64 + lane] = (bf16_t)f2bf(o[0] / fmaxf(l[0], 1e-30f));
                }
            }
#endif
#if defined(NSA_NAIVE) || (defined(CHECK_KIND) && CHECK_KIND == 1)
            if (kind == 1) {
                const size_t st6 = 4 * MiB;
                float* Pn = misc;
                for (int task = gw; task < T * NSA_G; task += NGW) {
                    const int t = task % S, bg = task / S, g = bg % NSA_G, b = bg / NSA_G; const size_t row = (size_t)b * S + t;
#pragma unroll
                    for (int h = 0; h < 4; ++h) { qs[h * 64 + lane] = bf2f(QB[row * D + (g * 4 + h) * 64 + lane]); qs2[h * 64 + lane] = bf2f(QR[row * D + (g * 4 + h) * 64 + lane]); }
                    WAVE_SYNC();
                    float oc[4], os[4], ow[4];
                    const int nvalid = t >= 31 ? ((t - 31) >> 4) + 1 : 0;
                    {
                        float m[4] = {NEGF, NEGF, NEGF, NEGF}, l[4] = {0.f, 0.f, 0.f, 0.f}; oc[0] = oc[1] = oc[2] = oc[3] = 0.f;
                        attend_chunk<4>(qs, pb, kb, KCMP + (size_t)bg * NCMP * 64, VCMP + (size_t)bg * NCMP * 64, 64, 512,
                            [=](int slot) { return slot < nvalid ? slot : -1; }, [=](int) { return 0.f; }, QSC, m, l, oc, lane);
                        float il[4];
#pragma unroll
                        for (int h = 0; h < 4; ++h) { il[h] = 1.f / fmaxf(l[h], 1e-30f); oc[h] *= il[h]; }
                        for (int i = 0; i < 8; ++i) { const int n = lane + 64 * i; Pn[n] = pb[n] * il[0] + pb[512 + n] * il[1] + pb[1024 + n] * il[2] + pb[1536 + n] * il[3]; }
                        WAVE_SYNC();
                    }
                    const int cur = t >> 6;
                    float pri0, pri1;
                    {
                        float imp[2];
#pragma unroll
                        for (int c = 0; c < 2; ++c) { const int j = lane + 64 * c; float a = 0.f;
#pragma unroll
                            for (int dn = -1; dn <= 3; ++dn) { const int n = 4 * j + dn; if (n >= 0 && n < 511) a += Pn[n]; }
                            imp[c] = a; }
                        const int j0 = lane, j1 = lane + 64;
                        const bool f0 = (j0 == 0) || (j0 == cur) || (j0 == cur - 1), f1 = (j1 == 0) || (j1 == cur) || (j1 == cur - 1);
                        pri0 = f0 ? imp[0] + 1e4f : imp[0]; pri1 = f1 ? imp[1] + 1e4f : imp[1];
                        pri0 = j0 <= cur ? pri0 : NEGF; pri1 = j1 <= cur ? pri1 : NEGF;
                    }
                    float* pri = (float*)kb;
                    int* sidx = kb + 128;
                    pri[lane] = pri0; pri[lane + 64] = pri1;
                    WAVE_SYNC();
                    int rk0 = 0, rk1 = 0;
                    for (int i = 0; i < 128; ++i) { const float pi = pri[i]; rk0 += (pi > pri0 || (pi == pri0 && i < lane)) ? 1 : 0; rk1 += (pi > pri1 || (pi == pri1 && i < lane + 64)) ? 1 : 0; }
                    bool s0 = (lane <= cur) && rk0 < 16, s1 = (lane + 64 <= cur) && rk1 < 16;
#if defined(CHECK_KIND) && !defined(CHECK_OWNSEL)
                    { const unsigned* sg = SELMG + ((size_t)row * NSA_G + g) * 4; s0 = (sg[lane >> 5] >> (lane & 31)) & 1u; s1 = (sg[2 + (lane >> 5)] >> (lane & 31)) & 1u; }
#endif
                    const unsigned long long b0 = __ballot(s0), b1 = __ballot(s1);
                    const unsigned long long lt = (1ull << lane) - 1ull;
                    const int n0 = __popcll(b0);
                    WAVE_SYNC();
                    if (lane < 16) sidx[lane] = -1;
                    WAVE_SYNC();
                    if (s0) sidx[__popcll(b0 & lt)] = lane;
                    if (s1) sidx[n0 + __popcll(b1 & lt)] = lane + 64;
                    WAVE_SYNC();
                    int myblk = sidx[lane & 15];
                    {
                        float m[4] = {NEGF, NEGF, NEGF, NEGF}, l[4] = {0.f, 0.f, 0.f, 0.f}; os[0] = os[1] = os[2] = os[3] = 0.f;
                        const bf16_t* Ks = KB + 2 * st6 + g * 64; const bf16_t* Vs = KB + 3 * st6 + g * 64;
                        for (int c = 0; c < 2; ++c) {
                            attend_chunk<4>(qs2, pb, kb, Ks, Vs, 256, 512,
                                [=](int slot) { const int j = __shfl(myblk, c * 8 + (slot >> 6)); const int kk = j * 64 + (slot & 63); return (j >= 0 && kk <= t) ? (int)(b * S + kk) : -1; },
                                [=](int) { return 0.f; }, QSC, m, l, os, lane);
                        }
#pragma unroll
                        for (int h = 0; h < 4; ++h) os[h] /= fmaxf(l[h], 1e-30f);
                    }
                    {
                        float m[4] = {NEGF, NEGF, NEGF, NEGF}, l[4] = {0.f, 0.f, 0.f, 0.f}; ow[0] = ow[1] = ow[2] = ow[3] = 0.f;
                        const bf16_t* Kw = KB + 4 * st6 + g * 64; const bf16_t* Vw = KB + 5 * st6 + g * 64;
                        attend_chunk<4>(qs2, pb, kb, Kw, Vw, 256, 512,
                            [=](int slot) { const int kk = t - 511 + slot; return kk >= 0 ? (int)(b * S + kk) : -1; },
                            [=](int) { return 0.f; }, QSC, m, l, ow, lane);
#pragma unroll
                        for (int h = 0; h < 4; ++h) ow[h] /= fmaxf(l[h], 1e-30f);
                    }
#pragma unroll
                    for (int h = 0; h < 4; ++h) { const float* gt = GATES + row * 48 + (g * 4 + h) * 3;
                        AOn[row * D + (g * 4 + h) * 64 + lane] = (bf16_t)f2bf(gt[0] * oc[h] + gt[1] * os[h] + gt[2] * ow[h]); }
                }
            }
#endif
#if defined(MOBA_NAIVE) || (defined(CHECK_KIND) && CHECK_KIND == 2)
            if (kind == 2) {
                for (int task = gw; task < T * NH; task += NGW) {
                    const int t = task % S, bh = task / S, h = bh % NH, b = bh / NH; const size_t row = (size_t)b * S + t;
                    qs[lane] = bf2f(QB[row * D + h * 64 + lane]);
                    WAVE_SYNC();
                    const int cb = t >> 8;
                    float gs = NEGF;
                    if (lane < cb) { const float* km = KMEAN + ((size_t)bh * 32 + lane) * 64; float a = 0.f;
#pragma unroll 8
                        for (int d = 0; d < 64; ++d) a += qs[d] * km[d];
                        gs = a; }
                    if (lane >= 32) gs = -3e30f;
                    int sel[3];
#pragma unroll
                    for (int r = 0; r < 3; ++r) { const float mx = wave_max(gs); const unsigned long long bm = __ballot(gs == mx); const int win = __ffsll((long long)bm) - 1;
                        sel[r] = (win < cb) ? win : -1; if (lane == win) gs = -3e30f; }
                    float m[1] = {NEGF}, l[1] = {0.f}, o[1] = {0.f};
                    for (int c = 0; c < 2; ++c) {
                        const int blk0 = c == 0 ? sel[0] : sel[2], blk1 = c == 0 ? sel[1] : cb;
                        attend_chunk<1>(qs, pb, kb, KB + h * 64, VB + h * 64, D, 512,
                            [=](int slot) { const int blk = slot < 256 ? blk0 : blk1; const int kk = blk * 256 + (slot & 255); return (blk >= 0 && kk <= t) ? (int)(b * S + kk) : -1; },
                            [=](int) { return 0.f; }, QSC, m, l, o, lane);
                    }
                    AOn[row * D + h * 64 + lane] = (bf16_t)f2bf(o[0] / fmaxf(l[0], 1e-30f));
                }
            }
#endif
#if defined(ZERO_KIND)
            }
#endif
#if defined(CHECK_KIND)
            if (kind == CHECK_KIND) {
                SEAM_AT(1 + L * NPH + 4);
                float num = 0.f, den = 0.f;
                for (int i = gtid; i < T * D; i += NGT) { const float a = bf2f(AO[i]), b = bf2f(AOn[i]); num += (a - b) * (a - b); den += b * b; }
                num = wave_sum(num); den = wave_sum(den);
                if (lane == 0) { atomicAdd((float*)(ctl + CW_CHK), num); atomicAdd((float*)(ctl + CW_CHK + 1), den); }
            }
#endif
            SEAM_AT(1 + L * NPH + 4);
        }

        if (PH_EN(5) && IN(gp0 + 5)) { PH_IDS();
            pg8::Gemm g{AO, WOUT_T, T, D, D, 0, 0, nullptr}; pg8::StaticOrder So; So.init(T, D, G, bx);
            epi::Res<(L > 0)> E{(_Float16*)X, L == 0 ? args.in[0] : (const void*)XBB, D, DN_ALPHA};
            pg8::gemm_phase<epi::Res<(L > 0)>, pg8::StaticOrder, true, true>(ldsl, g, So, E);
            SEAM_AT(1 + L * NPH + 5);
        }

        if (PH_EN(6) && IN(gp0 + 6)) { PH_IDS();
            using gattn::bf16x8; using gattn::f32x16; using gattn::u32x4; using gattn::crow; using gattn::cvtpk_s;
            const float* g1 = (const float*)args.in[17] + L * D; const float* b1 = (const float*)args.in[18] + L * D;
            const float* rb = (const float*)args.in[20] + L * NE;
            unsigned* cnt = (unsigned*)(ctl + CW_CNT + L * 2048);
            constexpr int XP = 1032;
            bf16_t* XH = (bf16_t*)lds; bf16_t* XL = XH + 32 * XP;
            float* PL = (float*)lds;
            LAS int* lcnt = (LAS int*)(ldsl + 66048 * 2); LAS int* lbase = lcnt + 64;
            const int r32 = lane & 31, hi = lane >> 5;
            bf16x8 wh[8][2], wl[8][2];
#pragma unroll
            for (int st = 0; st < 8; ++st)
#pragma unroll
                for (int nb = 0; nb < 2; ++nb) { const size_t wo = (size_t)(nb * 32 + r32) * D + wave * 128 + 16 * st + 8 * hi; wh[st][nb] = *(const bf16x8*)(WRT + wo); wl[st][nb] = *(const bf16x8*)(WRT + (size_t)NE * D + wo); }
            for (int pass = bx; pass < T / 32; pass += G) {
                const size_t row0 = (size_t)pass * 32;
                if (tid < 64) lcnt[tid] = 0;
#pragma unroll
                for (int r = 0; r < 4; ++r) { const int rl = wave * 4 + r; const size_t row = row0 + rl; f32x4 v[4];
#pragma unroll
                    for (int j = 0; j < 4; ++j) { typedef _Float16 h4 __attribute__((ext_vector_type(4))); const h4 hv = *(const h4*)((const _Float16*)X + row * D + 4 * lane + 256 * j); v[j] = (f32x4){(float)hv[0], (float)hv[1], (float)hv[2], (float)hv[3]}; }
                    ln_row(v, g1, b1, lane);
#pragma unroll
                    for (int j = 0; j < 4; ++j) {
                        const unsigned h0 = cvtpk_s(v[j].x, v[j].y), h1 = cvtpk_s(v[j].z, v[j].w);
                        *(uint2*)(XBA + row * D + 4 * lane + 256 * j) = make_uint2(h0, h1);
                        const unsigned l0 = cvtpk_s(v[j].x - bflo(h0), v[j].y - bfhi(h0)), l1 = cvtpk_s(v[j].z - bflo(h1), v[j].w - bfhi(h1));
                        *(uint2*)(XH + rl * XP + 4 * lane + 256 * j) = make_uint2(h0, h1); *(uint2*)(XL + rl * XP + 4 * lane + 256 * j) = make_uint2(l0, l1); } }
                __syncthreads();
                f32x16 acc[2]; acc[0] = f32x16{}; acc[1] = f32x16{};
                {
#pragma unroll
                  for (int st = 0; st < 8; ++st) { const int k = wave * 128 + 16 * st + 8 * hi;
                      const bf16x8 xh = *(const bf16x8*)(XH + r32 * XP + k), xl = *(const bf16x8*)(XL + r32 * XP + k);
#pragma unroll
                      for (int nb = 0; nb < 2; ++nb) { acc[nb] = __builtin_amdgcn_mfma_f32_32x32x16_bf16(xh, wh[st][nb], acc[nb], 0, 0, 0); acc[nb] = __builtin_amdgcn_mfma_f32_32x32x16_bf16(xl, wh[st][nb], acc[nb], 0, 0, 0);
                          acc[nb] = __builtin_amdgcn_mfma_f32_32x32x16_bf16(xh, wl[st][nb], acc[nb], 0, 0, 0); } } }
                __syncthreads();
#pragma unroll
                for (int nb = 0; nb < 2; ++nb)
#pragma unroll
                    for (int r = 0; r < 16; ++r) PL[(wave * 32 + crow(r, hi)) * 64 + nb * 32 + r32] = acc[nb][r];
                __syncthreads();
                const float rbl = rb[lane]; float gws[4]; int rks[4], lps[4];
                float scv[4], bi[4], m1[4], m2[4]; int cand[4]; unsigned key[4], thr[4]; bool selv[4];
#pragma unroll
                for (int r = 0; r < 4; ++r) { const int rl = wave * 4 + r; float lg = 0.f;
#pragma unroll
                    for (int w = 0; w < 8; ++w) lg += PL[(w * 32 + rl) * 64 + lane];
                    scv[r] = sigmoidf_(lg); bi[r] = scv[r] + rbl; m1[r] = bi[r]; }
#pragma unroll
                for (int r = 0; r < 4; ++r) m1[r] = fmaxf(m1[r], xor_f<1>(m1[r]));
#pragma unroll
                for (int r = 0; r < 4; ++r) m1[r] = fmaxf(m1[r], xor_f<2>(m1[r]));
#pragma unroll
                for (int r = 0; r < 4; ++r) { m1[r] = fmaxf(m1[r], xor_f<4>(m1[r])); cand[r] = (bi[r] == m1[r]) ? lane : 64; }
#pragma unroll
                for (int r = 0; r < 4; ++r) cand[r] = min(cand[r], xor_i<1>(cand[r]));
#pragma unroll
                for (int r = 0; r < 4; ++r) cand[r] = min(cand[r], xor_i<2>(cand[r]));
#pragma unroll
                for (int r = 0; r < 4; ++r) { cand[r] = min(cand[r], xor_i<4>(cand[r])); m2[r] = (lane == cand[r]) ? -3e38f : bi[r]; }
#pragma unroll
                for (int r = 0; r < 4; ++r) m2[r] = fmaxf(m2[r], xor_f<1>(m2[r]));
#pragma unroll
                for (int r = 0; r < 4; ++r) m2[r] = fmaxf(m2[r], xor_f<2>(m2[r]));
#pragma unroll
                for (int r = 0; r < 4; ++r) { m2[r] = fmaxf(m2[r], xor_f<4>(m2[r]));
                    const float gsc = m1[r] + m2[r]; const int grp = lane >> 3; int grank = 0;
#pragma unroll
                    for (int gg = 0; gg < 8; ++gg) { const float og = bcast_f(gsc, gg * 8); grank += (og > gsc || (og == gsc && gg < grp)) ? 1 : 0; }
                    const float v = grank < 4 ? bi[r] : NEGF; const unsigned ub = __float_as_uint(v);
                    key[r] = (ub & 0x80000000u) ? ~ub : (ub | 0x80000000u); thr[r] = 0u; }
                for (int bit = 31; bit >= 0; --bit) {
#pragma unroll
                    for (int r = 0; r < 4; ++r) { const unsigned cd = thr[r] | (1u << bit); thr[r] = __popcll(__builtin_amdgcn_ballot_w64(key[r] >= cd)) >= 8 ? cd : thr[r]; } }
                const unsigned long long lt = (1ull << lane) - 1ull;
#pragma unroll
                for (int r = 0; r < 4; ++r) { const unsigned long long gm = __builtin_amdgcn_ballot_w64(key[r] > thr[r]); unsigned long long em = __builtin_amdgcn_ballot_w64(key[r] == thr[r]);
                    int need = 8 - __popcll(gm); unsigned long long tm = 0ull;
                    while (need > 0 && em) { const unsigned long long lowb = em & (0ull - em); tm |= lowb; em ^= lowb; --need; }
                    const unsigned long long m = gm | tm; selv[r] = (m >> lane) & 1ull; rks[r] = selv[r] ? __popcll(m & lt) : -1; }
                float ssum[4];
#pragma unroll
                for (int r = 0; r < 4; ++r) ssum[r] = selv[r] ? scv[r] : 0.f;
#pragma unroll
                for (int r = 0; r < 4; ++r) ssum[r] += xor_f<1>(ssum[r]);
#pragma unroll
                for (int r = 0; r < 4; ++r) ssum[r] += xor_f<2>(ssum[r]);
#pragma unroll
                for (int r = 0; r < 4; ++r) ssum[r] += xor_f<4>(ssum[r]);
#pragma unroll
                for (int r = 0; r < 4; ++r) ssum[r] += xor_f<8>(ssum[r]);
#pragma unroll
                for (int r = 0; r < 4; ++r) { ssum[r] += xor_f<16>(ssum[r]); auto rr = __builtin_amdgcn_permlane32_swap(__float_as_uint(ssum[r]), __float_as_uint(ssum[r]), false, false); ssum[r] = __uint_as_float(rr[0]) + __uint_as_float(rr[1]);
                    gws[r] = scv[r] / ssum[r] * 2.5f; }
#pragma unroll
                for (int r = 0; r < 4; ++r) lps[r] = selv[r] ? __hip_atomic_fetch_add((int*)(lcnt + lane), 1, __ATOMIC_RELAXED, __HIP_MEMORY_SCOPE_WORKGROUP) : 0;
                __syncthreads();
                if (tid < 64) { const int c = lcnt[tid]; lbase[tid] = c ? (int)atomicAdd(cnt + tid * 32, (unsigned)c) : 0; }
                __syncthreads();
                { const int base = lbase[lane];
#pragma unroll
                  for (int r = 0; r < 4; ++r) if (rks[r] >= 0) { const size_t rw = row0 + wave * 4 + r; const int pos = base + lps[r];
                      TOKE[rw * 8 + rks[r]] = lane; TOKW[rw * 8 + rks[r]] = gws[r]; TOKP[rw * 8 + rks[r]] = pos; ROWTOK[lane * 16384 + pos] = (int)rw; } }
                __syncthreads();
            }
            SEAM_AT(1 + L * NPH + 6);
        }

        if (PH_EN(8) && IN(gp0 + 8)) { PH_IDS();
            __syncthreads();
            { LAS int* ntl = (LAS int*)ldsl;
              if (tid < 64) ntl[tid] = (int)((__hip_atomic_load((const unsigned*)(ctl + CW_CNT + L * 2048) + tid * 32, RLX_AGENT) + 255u) >> 8);
              __syncthreads();
              if (tid <= 64) { int s = 0; for (int e = 0; e < tid; ++e) s += ntl[e]; TAB[tid] = s; } }
            __syncthreads();
            const int nrt = 64 + TAB[64];
            pg8::Gemm g{XBA, WGU_T, 0, 0, D, 0, 0, ROWTOK}; MoeOrder So{TAB, 2, G, bx, nrt * 2, 1};
            epi::SwiGlu E{HB, 0};
            pg8::gemm_phase<epi::SwiGlu, MoeOrder, true, true, true>(ldsl, g, So, E);
            SEAM_AT(1 + L * NPH + 8);
        }

        if (PH_EN(9) && IN(gp0 + 9)) { PH_IDS();
            const int nrt = 64 + TAB[64];
            int kdn = ED; asm volatile("" : "+s"(kdn)); pg8::Gemm g{HB, WDN_T, 0, 0, kdn, 0, 0, nullptr}; MoeOrder So{TAB, 4, G, bx, nrt * 4, 0};
            epi::Down E{OUTR, (PG8_LAS unsigned char*)(ldsl + DSTG0), (PG8_LAS unsigned char*)(ldsl + DSTG1)};
            pg8::gemm_phase<epi::Down, MoeOrder, true, true>(ldsl, g, So, E);
            SEAM_AT(1 + L * NPH + 9);
        }

        if (PH_EN(10) && IN(gp0 + 10)) { PH_IDS();
            const float* g2 = (const float*)args.in[27] + L * D; const float* b2 = (const float*)args.in[28] + L * D;
#if defined(OUTR_FP8)
            for (int rowa = gw; rowa < T; rowa += 2 * NGW) {
                typedef float f32x2n __attribute__((ext_vector_type(2)));
                f32x4 v[2][4]; int ws_[2][4], wk[2][TOPK][4]; float gk[2][TOPK]; bool has[2];
#pragma unroll
                for (int u = 0; u < 2; ++u) { const int row = rowa + u * NGW; has[u] = row < T; if (!has[u]) continue;
#pragma unroll
                    for (int j = 0; j < 4; ++j) { const uint2 w = *(const uint2*)(XBA + (size_t)row * D + 4 * lane + 256 * j); v[u][j] = (f32x4){bflo(w.x), bfhi(w.x), bflo(w.y), bfhi(w.y)} * DN_ALPHA; }
                    const unsigned char* o = (const unsigned char*)OUTR + (size_t)row * D;
#pragma unroll
                    for (int j = 0; j < 4; ++j) ws_[u][j] = (int)__builtin_nontemporal_load((const unsigned*)(o + 4 * lane + 256 * j));
#pragma unroll
                    for (int k = 0; k < TOPK; ++k) { const int dest = TAB[TOKE[row * 8 + k]] * 256 + TOKP[row * 8 + k]; gk[u][k] = TOKW[row * 8 + k] * (1.f / 64.f); const unsigned char* ok = (const unsigned char*)OUTR + ((size_t)T + dest) * D;
#pragma unroll
                        for (int j = 0; j < 4; ++j) wk[u][k][j] = (int)__builtin_nontemporal_load((const unsigned*)(ok + 4 * lane + 256 * j)); } }
#pragma unroll
                for (int u = 0; u < 2; ++u) { const int row = rowa + u * NGW; if (!has[u]) continue;
#pragma unroll
                    for (int j = 0; j < 4; ++j) { const f32x2n a = __builtin_amdgcn_cvt_pk_f32_fp8(ws_[u][j], false), c = __builtin_amdgcn_cvt_pk_f32_fp8(ws_[u][j], true);
                        v[u][j].x += a.x * (1.f / 64.f); v[u][j].y += a.y * (1.f / 64.f); v[u][j].z += c.x * (1.f / 64.f); v[u][j].w += c.y * (1.f / 64.f); }
#pragma unroll
                    for (int k = 0; k < TOPK; ++k) { const float gwk = gk[u][k];
#pragma unroll
                        for (int j = 0; j < 4; ++j) { const f32x2n a = __builtin_amdgcn_cvt_pk_f32_fp8(wk[u][k][j], false), c = __builtin_amdgcn_cvt_pk_f32_fp8(wk[u][k][j], true);
                            v[u][j].x += gwk * a.x; v[u][j].y += gwk * a.y; v[u][j].z += gwk * c.x; v[u][j].w += gwk * c.y; } }
                    ln_row(v[u], g2, b2, lane);
#pragma unroll
                    for (int j = 0; j < 4; ++j)
                        *(unsigned long long*)(XBA + (size_t)row * D + 4 * lane + 256 * j) = (unsigned long long)pk2(v[u][j].x, v[u][j].y) | ((unsigned long long)pk2(v[u][j].z, v[u][j].w) << 32); }
            }
#else
            for (int row = gw; row < T; row += NGW) {
                f32x4 v[4];
#pragma unroll
                for (int j = 0; j < 4; ++j) { const uint2 w = *(const uint2*)(XBA + (size_t)row * D + 4 * lane + 256 * j); v[j] = (f32x4){bflo(w.x), bfhi(w.x), bflo(w.y), bfhi(w.y)} * DN_ALPHA; }
#if defined(OUTR_FP8)
                {   typedef float f32x2n __attribute__((ext_vector_type(2)));
                    const unsigned char* o = (const unsigned char*)OUTR + (size_t)row * D;
#pragma unroll
                    for (int j = 0; j < 4; ++j) { const int w = (int)__builtin_nontemporal_load((const unsigned*)(o + 4 * lane + 256 * j)); const f32x2n a = __builtin_amdgcn_cvt_pk_f32_fp8(w, false), c = __builtin_amdgcn_cvt_pk_f32_fp8(w, true);
                        v[j].x += a.x * (1.f / 64.f); v[j].y += a.y * (1.f / 64.f); v[j].z += c.x * (1.f / 64.f); v[j].w += c.y * (1.f / 64.f); }
                    for (int k = 0; k < TOPK; ++k) { const int dest = TAB[TOKE[row * 8 + k]] * 256 + TOKP[row * 8 + k]; const float gwk = TOKW[row * 8 + k] * (1.f / 64.f); const unsigned char* ok = (const unsigned char*)OUTR + ((size_t)T + dest) * D;
#pragma unroll
                        for (int j = 0; j < 4; ++j) { const int w = (int)__builtin_nontemporal_load((const unsigned*)(ok + 4 * lane + 256 * j)); const f32x2n a = __builtin_amdgcn_cvt_pk_f32_fp8(w, false), c = __builtin_amdgcn_cvt_pk_f32_fp8(w, true);
                            v[j].x += gwk * a.x; v[j].y += gwk * a.y; v[j].z += gwk * c.x; v[j].w += gwk * c.y; } } }
#else
                {
                    const bf16_t* o = OUTR + (size_t)row * D;
#pragma unroll
                    for (int j = 0; j < 4; ++j) { typedef unsigned u32x2n __attribute__((ext_vector_type(2))); const u32x2n w = __builtin_nontemporal_load((const u32x2n*)(o + 4 * lane + 256 * j)); v[j].x += bflo(w.x); v[j].y += bfhi(w.x); v[j].z += bflo(w.y); v[j].w += bfhi(w.y); }
                }
                for (int k = 0; k < TOPK; ++k) { const int dest = TAB[TOKE[row * 8 + k]] * 256 + TOKP[row * 8 + k]; const float gwk = TOKW[row * 8 + k]; const bf16_t* o = OUTR + ((size_t)T + dest) * D;
#pragma unroll
                    for (int j = 0; j < 4; ++j) { typedef unsigned u32x2n __attribute__((ext_vector_type(2))); const u32x2n w = __builtin_nontemporal_load((const u32x2n*)(o + 4 * lane + 256 * j)); v[j].x += gwk * bflo(w.x); v[j].y += gwk * bfhi(w.x); v[j].z += gwk * bflo(w.y); v[j].w += gwk * bfhi(w.y); } }
#endif
                ln_row(v, g2, b2, lane);
#pragma unroll
                for (int j = 0; j < 4; ++j) {
                    *(unsigned long long*)(XBA + (size_t)row * D + 4 * lane + 256 * j) = (unsigned long long)pk2(v[j].x, v[j].y) | ((unsigned long long)pk2(v[j].z, v[j].w) << 32); }
            }
#endif
            SEAM_AT(1 + L * NPH + 10);
        }

        if (PH_EN(12) && IN(gp0 + 12)) { PH_IDS();
            pg8::Gemm g{XBA, WPG_T, T, D, D, 0, 0, nullptr}; pg8::StaticOrder So; So.init(T, D, G, bx);
            epi::Ple<(L == DEPTH - 1)> E{XBA, PP, args.out, XBB};
            pg8::gemm_phase<epi::Ple<(L == DEPTH - 1)>, pg8::StaticOrder, true, true>(ldsl, g, So, E);
#if defined(TIME_P1)
            SEAM_AT(1 + L * NPH + 12);
#else
            if (L != DEPTH - 1) SEAM_AT(1 + L * NPH + 12);
#endif
        }
    };
    layer_body(std::integral_constant<int, 0>{}); layer_body(std::integral_constant<int, 1>{}); layer_body(std::integral_constant<int, 2>{}); layer_body(std::integral_constant<int, 3>{});
#if defined(TIME_P1)
    {   PH_IDS();
        xcd_barrier(bar);
        const unsigned long long* ts = (const unsigned long long*)(ctl + CW_TS);
        int dig[2];
        for (int q = 0; q < 2; ++q) { const int p = q ? TIME_P2 : TIME_P1; unsigned long long tot = 0;
            for (int L2 = 0; L2 < DEPTH; ++L2) { if (TIME_LSEL >= 0 && L2 != (q ? TIME_LSEL2 : TIME_LSEL)) continue; const int k = 1 + L2 * NPH + p; const unsigned long long te = __hip_atomic_load(ts + k, RLX_AGENT); if (te == 0ull) continue;
                unsigned long long tb = 0ull; for (int k2 = k - 1; k2 >= 0 && tb == 0ull; --k2) tb = __hip_atomic_load(ts + k2, RLX_AGENT);
                tot += te - tb; }
            const float us = (float)tot * 0.01f * TIME_MUL; int d = (int)floorf(log2f(fmaxf(us, 1.f))) - 3; dig[q] = d < 0 ? 0 : d > 9 ? 9 : d; }
        const float sc = 1.f + sqrtf(0.01f * (float)(10 * (dig[0] + 1) + dig[1]));
        for (int i = gtid; i < T * D; i += NGT) args.out[i] *= sc; }
#endif
#if defined(CHECK_KIND)
    {   PH_IDS(); SEAM();
        const float num = __hip_atomic_load((float*)(ctl + CW_CHK), RLX_AGENT), den = __hip_atomic_load((float*)(ctl + CW_CHK + 1), RLX_AGENT);
        const float sc = 1.f + 100.f * sqrtf(num / fmaxf(den, 1e-30f));
        for (int i = gtid; i < T * D; i += NGT) args.out[i] *= sc; }
#endif
#undef SEAM
#undef IN
}

extern "C" void kernel_launch(void* const* d_in, const int* in_sizes, int n_in, void* d_out, int out_size, void* d_ws, size_t ws_size, hipStream_t stream) {
    static int grid = 0;
    if (grid == 0) {
        if (n_in != 31 || out_size != T * D || ws_size < WS_END) { fprintf(stderr, "kernel_launch: unexpected problem (n_in %d, out %d, ws %zu < %zu)\n", n_in, out_size, ws_size, (size_t)WS_END); grid = -1; return; }
        int dev = 0, cus = 0, per_cu = 0;
        if (hipGetDevice(&dev) != hipSuccess || hipDeviceGetAttribute(&cus, hipDeviceAttributeMultiprocessorCount, dev) != hipSuccess) { grid = -1; return; }
        if (hipFuncSetAttribute((const void*)mk_fwd, hipFuncAttributeMaxDynamicSharedMemorySize, LDS_BYTES) != hipSuccess) { fprintf(stderr, "kernel_launch: hipFuncSetAttribute failed\n"); grid = -1; return; }
        if (hipOccupancyMaxActiveBlocksPerMultiprocessor(&per_cu, (const void*)mk_fwd, NTHR, LDS_BYTES) != hipSuccess || per_cu < 1) fprintf(stderr, "kernel_launch: occupancy query says %d\n", per_cu);
        (void)hipGetLastError();
        grid = cus;
    }
    if (grid < 0) return;
    (void)hipMemsetAsync((char*)d_ws + WS_CTL, 0, CTL_ZERO_BYTES, stream);
    Args a{};
    for (int i = 0; i < 31; ++i) a.in[i] = d_in[i];
    a.out = (float*)d_out; a.ws = (unsigned char*)d_ws;
#if MK_MULTI
    const int nph = 1 + DEPTH * NPH;
    for (int p = 0; p < nph; ++p) { a.ph_lo = p; a.ph_hi = p + 1; hipLaunchKernelGGL(mk_fwd, dim3(grid), dim3(NTHR), LDS_BYTES, stream, a); }
#else
    a.ph_lo = 0; a.ph_hi = 1 + DEPTH * NPH;
    hipLaunchKernelGGL(mk_fwd, dim3(grid), dim3(NTHR), LDS_BYTES, stream, a);
#endif
}
```
